# Optimizing an MI355X kernel written in HIP

```python
import jax, jax.numpy as jnp
from jax import lax
import numpy as np

D_MODEL = 1024
BATCH = 8
SEQ = 2048
DEPTH = 2

N_MIXERS = 2
N_A_LAYERS = (DEPTH + 1) // 2
N_B_LAYERS = DEPTH // 2

ATT_HEADS = 16
ATT_KV_HEADS = 4
HEAD_DIM = D_MODEL // ATT_HEADS
GROUP = ATT_HEADS // ATT_KV_HEADS
IDX_HEADS = 8
IDX_DIM = 64
TOPK_MAX = 256
Q_BLOCK = 128
ROPE_THETA = 10000.0
Q_COLS = ATT_HEADS * HEAD_DIM
KV_COLS = ATT_KV_HEADS * HEAD_DIM
IQ_COLS = IDX_HEADS * IDX_DIM
IK_COLS = IDX_DIM
IW_COLS = IDX_HEADS
IN_COLS = Q_COLS + 2 * KV_COLS + IQ_COLS + IK_COLS + IW_COLS

RWKV_HEAD = 64
RWKV_HEADS = D_MODEL // RWKV_HEAD
DECAY_LORA = 64
ICL_LORA = 64
GATE_LORA = 160
LNX_EPS = 64e-5

D_FF = 4 * D_MODEL
NORM_EPS = 1e-6

kernel_name = "dsa_rwkv7_interleaved_hybrid"


def rms_norm(x, g):
    xf = x.astype(jnp.float32)
    y = xf * lax.rsqrt(jnp.mean(xf * xf, axis=-1, keepdims=True) + NORM_EPS)
    return (y * g.astype(jnp.float32)).astype(x.dtype)


def rope_tables(length, dim):
    inv = 1.0 / (ROPE_THETA ** (jnp.arange(0, dim, 2, dtype=jnp.float32) / dim))
    ang = jnp.arange(length, dtype=jnp.float32)[:, None] * inv[None, :]
    return jnp.cos(ang), jnp.sin(ang)


def apply_rope(x, cos, sin):
    shape = (1, cos.shape[0]) + (1,) * (x.ndim - 3) + (cos.shape[1],)
    c = cos.reshape(shape)
    s = sin.reshape(shape)
    xf = x.astype(jnp.float32)
    x1, x2 = jnp.split(xf, 2, axis=-1)
    return jnp.concatenate([x1 * c - x2 * s, x2 * c + x1 * s], axis=-1).astype(x.dtype)


def dsa_mixer(h, w_in, w_o):
    B, L, _ = h.shape
    top_k = min(TOPK_MAX, L // 4)
    qb_len = min(Q_BLOCK, L)
    n_blk = L // qb_len
    proj = h @ w_in
    o0 = Q_COLS
    o1 = o0 + KV_COLS
    o2 = o1 + KV_COLS
    o3 = o2 + IQ_COLS
    o4 = o3 + IK_COLS
    q = proj[..., :o0].reshape(B, L, ATT_HEADS, HEAD_DIM)
    k = proj[..., o0:o1].reshape(B, L, ATT_KV_HEADS, HEAD_DIM)
    v = proj[..., o1:o2].reshape(B, L, ATT_KV_HEADS, HEAD_DIM)
    qi = proj[..., o2:o3].reshape(B, L, IDX_HEADS, IDX_DIM)
    ki = proj[..., o3:o4]
    wi = proj[..., o4:] * (IDX_HEADS ** -0.5 * IDX_DIM ** -0.5)
    cos, sin = rope_tables(L, HEAD_DIM)
    q = apply_rope(q, cos, sin)
    k = apply_rope(k, cos, sin)
    cos_i, sin_i = rope_tables(L, IDX_DIM)
    qi = apply_rope(qi, cos_i, sin_i)
    ki = apply_rope(ki, cos_i, sin_i)

    def to_blocks(a):
        return jnp.moveaxis(a.reshape((B, n_blk, qb_len) + a.shape[2:]), 1, 0)

    s_pos = jnp.arange(L, dtype=jnp.int32)

    def block_fn(args):
        q_blk, qi_blk, wi_blk, start = args
        t_pos = start + jnp.arange(qb_len, dtype=jnp.int32)
        rel = jax.nn.relu(jnp.einsum('bthd,bsd->bths', qi_blk, ki).astype(jnp.float32))
        score = jnp.einsum('bths,bth->bts', rel, wi_blk.astype(jnp.float32))
        causal = s_pos[None, :] <= t_pos[:, None]
        score = jnp.where(causal[None], score, -jnp.inf)
        _, sel = lax.top_k(score, top_k)
        valid = sel <= t_pos[None, :, None]
        k_sel = jax.vmap(lambda kb, ib: kb[ib])(k, sel)
        v_sel = jax.vmap(lambda vb, ib: vb[ib])(v, sel)
        qg = q_blk.reshape(B, qb_len, ATT_KV_HEADS, GROUP, HEAD_DIM)
        logits = jnp.einsum('btngd,btknd->btngk', qg, k_sel).astype(jnp.float32) * (HEAD_DIM ** -0.5)
        logits = jnp.where(valid[:, :, None, None, :], logits, -jnp.inf)
        p = jax.nn.softmax(logits, axis=-1).astype(v_sel.dtype)
        o = jnp.einsum('btngk,btknd->btngd', p, v_sel)
        return o.reshape(B, qb_len, ATT_HEADS * HEAD_DIM)

    starts = jnp.arange(n_blk, dtype=jnp.int32) * qb_len
    o = lax.map(block_fn, (to_blocks(q), to_blocks(qi), to_blocks(wi), starts))
    o = jnp.moveaxis(o, 0, 1).reshape(B, L, ATT_HEADS * HEAD_DIM)
    return o @ w_o


def token_shift(x):
    return jnp.pad(x, ((0, 0), (1, 0), (0, 0)))[:, :-1]


def rwkv7_mixer(h, mu, w_rkv, w0, w1, w2, a0, a1, a2, g1, g2, k_k, k_a, r_k, lnx_w, lnx_b, w_o):
    B, L, D = h.shape
    H, N = RWKV_HEADS, RWKV_HEAD
    f32 = jnp.float32
    xx = token_shift(h) - h
    xs = h[None] + xx[None] * mu[:, None, None, :]
    r, k, v = jnp.einsum('cbld,cde->cble', xs[:3], w_rkv)
    xw, xa, xg = xs[3], xs[4], xs[5]
    w_log = -jax.nn.softplus(-(w0 + jnp.tanh(xw @ w1) @ w2).astype(f32)) - 0.5
    decay = jnp.exp(-jnp.exp(w_log))
    a = jax.nn.sigmoid((a0 + (xa @ a1) @ a2).astype(f32))
    g = jax.nn.sigmoid(xg @ g1) @ g2
    kf = k.astype(f32)
    kk = (kf * k_k.astype(f32)).reshape(B, L, H, N)
    kk = kk * lax.rsqrt(jnp.maximum(jnp.sum(kk * kk, axis=-1, keepdims=True), 1e-24))
    kf = kf * (1.0 + (a - 1.0) * k_a.astype(f32))

    def heads(z):
        return z.reshape(B, L, H, N)

    rh, wh, kh, vh, ah = heads(r.astype(f32)), heads(decay), heads(kf), heads(v.astype(f32)), heads(a)
    bh = kk * ah

    def step(state, inp):
        r_t, w_t, k_t, v_t, kk_t, b_t = inp
        sa = jnp.einsum('bhvk,bhk->bhv', state, -kk_t)
        state = (state * w_t[:, :, None, :] + sa[..., None] * b_t[:, :, None, :]
                 + v_t[..., None] * k_t[:, :, None, :])
        y = jnp.einsum('bhvk,bhk->bhv', state, r_t)
        return state, y

    def tm(z):
        return jnp.moveaxis(z, 1, 0)

    state0 = jnp.zeros((B, H, N, N), f32)
    _, y = lax.scan(step, state0, (tm(rh), tm(wh), tm(kh), tm(vh), tm(kk), tm(bh)))
    y = jnp.moveaxis(y, 0, 1)
    mean = jnp.mean(y, axis=-1, keepdims=True)
    var = jnp.mean(jnp.square(y - mean), axis=-1, keepdims=True)
    y = ((y - mean) * lax.rsqrt(var + LNX_EPS) * lnx_w.astype(f32).reshape(H, N)
         + lnx_b.astype(f32).reshape(H, N))
    bonus = jnp.sum(rh * kh * r_k.astype(f32), axis=-1, keepdims=True) * vh
    out = (y + bonus).reshape(B, L, D).astype(h.dtype) * g
    return out @ w_o


def sqrelu_mlp(h, w_up, w_down):
    u = jax.nn.relu(h @ w_up)
    return (u * u) @ w_down


def setup_inputs(seed: int = 0) -> dict:
    key = jax.random.key(seed)
    ks = jax.random.split(key, 32)
    D = D_MODEL

    def nrm(k, shape, scale):
        return jax.random.normal(k, shape, jnp.float32) * scale

    nA, nB = N_A_LAYERS, N_B_LAYERS
    return {
        "x": nrm(ks[0], (BATCH, SEQ, D), 1.0),
        "mixer_norm": 1.0 + nrm(ks[1], (DEPTH, D), 0.02),
        "mlp_norm": 1.0 + nrm(ks[2], (DEPTH, D), 0.02),
        "mlp_w_up": nrm(ks[3], (DEPTH, D, D_FF), D ** -0.5),
        "mlp_w_down": nrm(ks[4], (DEPTH, D_FF, D), D_FF ** -0.5),
        "final_norm": 1.0 + nrm(ks[5], (D,), 0.02),
        "dsa_w_in": nrm(ks[6], (nA, D, IN_COLS), D ** -0.5),
        "dsa_w_o": nrm(ks[7], (nA, Q_COLS, D), Q_COLS ** -0.5),
        "rwkv_mu": jax.random.uniform(ks[8], (nB, 6, D), jnp.float32),
        "rwkv_w_rkv": nrm(ks[9], (nB, 3, D, D), D ** -0.5),
        "rwkv_w0": jnp.linspace(-6.0, -1.0, D, dtype=jnp.float32)[None, :] + nrm(ks[10], (nB, D), 0.1),
        "rwkv_w1": nrm(ks[11], (nB, D, DECAY_LORA), D ** -0.5),
        "rwkv_w2": nrm(ks[12], (nB, DECAY_LORA, D), 0.1 * DECAY_LORA ** -0.5),
        "rwkv_a0": nrm(ks[13], (nB, D), 0.1),
        "rwkv_a1": nrm(ks[14], (nB, D, ICL_LORA), D ** -0.5),
        "rwkv_a2": nrm(ks[15], (nB, ICL_LORA, D), 0.1 * ICL_LORA ** -0.5),
        "rwkv_g1": nrm(ks[16], (nB, D, GATE_LORA), D ** -0.5),
        "rwkv_g2": nrm(ks[17], (nB, GATE_LORA, D), GATE_LORA ** -0.5),
        "rwkv_k_k": 0.85 + nrm(ks[18], (nB, D), 0.02),
        "rwkv_k_a": 1.0 + nrm(ks[19], (nB, D), 0.02),
        "rwkv_r_k": -0.04 + nrm(ks[20], (nB, RWKV_HEADS, RWKV_HEAD), 0.02),
        "rwkv_lnx_w": 1.0 + nrm(ks[21], (nB, D), 0.02),
        "rwkv_lnx_b": nrm(ks[22], (nB, D), 0.02),
        "rwkv_w_o": nrm(ks[23], (nB, D, D), D ** -0.5),
    }


def reference(x, mixer_norm, mlp_norm, mlp_w_up, mlp_w_down, final_norm, dsa_w_in, dsa_w_o,
              rwkv_mu, rwkv_w_rkv, rwkv_w0, rwkv_w1, rwkv_w2, rwkv_a0, rwkv_a1, rwkv_a2,
              rwkv_g1, rwkv_g2, rwkv_k_k, rwkv_k_a, rwkv_r_k, rwkv_lnx_w, rwkv_lnx_b, rwkv_w_o):
    for i in range(DEPTH):
        h = rms_norm(x, mixer_norm[i])
        j = i // N_MIXERS
        if i % N_MIXERS == 0:
            x = x + dsa_mixer(h, dsa_w_in[j], dsa_w_o[j])
        else:
            x = x + rwkv7_mixer(h, rwkv_mu[j], rwkv_w_rkv[j], rwkv_w0[j], rwkv_w1[j], rwkv_w2[j],
                                rwkv_a0[j], rwkv_a1[j], rwkv_a2[j], rwkv_g1[j], rwkv_g2[j],
                                rwkv_k_k[j], rwkv_k_a[j], rwkv_r_k[j], rwkv_lnx_w[j],
                                rwkv_lnx_b[j], rwkv_w_o[j])
        x = x + sqrelu_mlp(rms_norm(x, mlp_norm[i]), mlp_w_up[i], mlp_w_down[i])
    return rms_norm(x, final_norm)
```

```cpp
#include <hip/hip_runtime.h>
#include <hip/hip_cooperative_groups.h>
#include <cstdio>
#include <cstdint>
namespace cg = cooperative_groups;

#ifndef FAST_GEMM
#define FAST_GEMM 1
#endif

#define LAS __attribute__((address_space(3)))
#define GAS __attribute__((address_space(1)))
typedef unsigned short bf16_t;
typedef short bf16x8 __attribute__((ext_vector_type(8)));
typedef float f32x4 __attribute__((ext_vector_type(4)));
typedef float f32x2 __attribute__((ext_vector_type(2)));
typedef unsigned u32x4 __attribute__((ext_vector_type(4)));
typedef unsigned u32x2 __attribute__((ext_vector_type(2)));

constexpr int BATCH = 8, SEQ = 2048, DM = 1024, MTOK = BATCH * SEQ, FF = 4096;
constexpr int NWAVES = 8, NTHR = 512;
constexpr int LDS_BYTES = 147456;
constexpr float NORM_EPS = 1e-6f, LNX_EPS = 64e-5f;
constexpr float QSCALE = 0.125f * 1.4426950408889634f;
constexpr float WI_SCALE = 0.044194173824159216f;

enum { IN_X = 0, IN_MIXN, IN_MLPN, IN_WUP, IN_WDN, IN_FINN, IN_WIN, IN_WO, IN_MU, IN_WRKV, IN_W0, IN_W1, IN_W2, IN_A0, IN_A1, IN_A2,
       IN_G1, IN_G2, IN_KK, IN_KA, IN_RK, IN_LNW, IN_LNB, IN_WO1, N_IN };

constexpr size_t MiB = 1u << 20;
constexpr size_t OFF_CTL = 0, CTL_BYTES = 1 * MiB;
constexpr size_t OFF_SSQ0 = 256 * 1024, OFF_SSQ1 = 320 * 1024;
constexpr size_t OFF_ROPE = 1 * MiB;
constexpr size_t OFF_WIN = 2 * MiB, OFF_WO0 = 7 * MiB, OFF_WUP0 = 9 * MiB, OFF_WDN0 = 17 * MiB, OFF_WRK = 25 * MiB, OFF_WVL = 29 * MiB;
constexpr size_t OFF_W2T = 33 * MiB, OFF_A2T = 33 * MiB + 256 * 1024, OFF_G2T = 33 * MiB + 512 * 1024, OFF_WO1 = 34 * MiB, OFF_WUP1 = 36 * MiB, OFF_WDN1 = 44 * MiB;
constexpr size_t OFF_BONUS = 2 * MiB;
constexpr size_t OFF_H0 = 52 * MiB, OFF_QO = 84 * MiB, OFF_K = 116 * MiB, OFF_V = 124 * MiB, OFF_QI = 132 * MiB, OFF_KI = 148 * MiB, OFF_WI = 150 * MiB, OFF_MASK = 152 * MiB;
constexpr size_t OFF_XB = 52 * MiB, OFF_U = 84 * MiB;
constexpr size_t OFF_XSR = 52 * MiB, OFF_XSK = 84 * MiB, OFF_XSV = 116 * MiB, OFF_H1 = 148 * MiB, OFF_R = 180 * MiB, OFF_KR = 212 * MiB;
constexpr size_t OFF_VV = 52 * MiB, OFF_P = 84 * MiB, OFF_AW = 108 * MiB, OFF_AA = 112 * MiB, OFF_AG = 244 * MiB;
constexpr size_t OFF_E = 116 * MiB, OFF_A = 148 * MiB, OFF_Y = 84 * MiB, OFF_STATS = 252 * MiB, OFF_AO = 116 * MiB;
constexpr size_t WS_END = 256 * MiB;

struct Args { const float* in[N_IN]; float* out; unsigned char* ws; int ph_lo, ph_hi; };
#define WSP(T, off) ((T*)(A.ws + (off)))

__device__ __forceinline__ float bf2f(bf16_t u) { return __uint_as_float((unsigned)u << 16); }
__device__ __forceinline__ unsigned f2bf(float f) { unsigned u = __float_as_uint(f); return (u + 0x7fffu + ((u >> 16) & 1u)) >> 16; }
__device__ __forceinline__ unsigned pk2(float lo, float hi) { return f2bf(lo) | (f2bf(hi) << 16); }
__device__ __forceinline__ float wave_sum(float v) {
#pragma unroll
    for (int o = 1; o < 64; o <<= 1) v += __shfl_xor(v, o);
    return v;
}
__device__ __forceinline__ float wave_max(float v) {
#pragma unroll
    for (int o = 1; o < 64; o <<= 1) v = fmaxf(v, __shfl_xor(v, o));
    return v;
}
#define LDS_WAIT() asm volatile("s_waitcnt lgkmcnt(0)" ::: "memory")
__device__ __forceinline__ float sigmoidf_(float z) { return __builtin_amdgcn_rcpf(1.f + __expf(-z)); }

__device__ __forceinline__ float block_sum(float v, float* red, int wave, int lane) {
    v = wave_sum(v); __syncthreads(); if (lane == 0) red[wave] = v; __syncthreads();
    float s = 0.f;
#pragma unroll
    for (int i = 0; i < NWAVES; ++i) s += red[i];
    return s;
}
__device__ __forceinline__ float block_max(float v, float* red, int wave, int lane) {
    v = wave_max(v); __syncthreads(); if (lane == 0) red[wave] = v; __syncthreads();
    float s = red[0];
#pragma unroll
    for (int i = 1; i < NWAVES; ++i) s = fmaxf(s, red[i]);
    return s;
}

template <int ID> __device__ __forceinline__ float wval(const Args& A, int n, int k) {
    if constexpr (ID == 0) {
        int col;
        if (n < 1280 || (n >= 1536 && n < 2112)) { const int hd = n >> 6, j = n & 63; col = (hd << 6) + (j >> 1) + ((j & 1) << 5); }
        else if (n < 2120) col = n; else return 0.f;
        return A.in[IN_WIN][(size_t)k * 2120 + col];
    } else if constexpr (ID == 1) { return A.in[IN_WO][(size_t)k * 1024 + n];
    } else if constexpr (ID == 2) { return A.in[IN_WUP][(size_t)k * 4096 + n] * A.in[IN_MLPN][k];
    } else if constexpr (ID == 3) { return A.in[IN_WDN][(size_t)k * 1024 + n];
    } else if constexpr (ID == 4) { return A.in[IN_WRKV][(size_t)(n >> 10) * 1048576 + (size_t)k * 1024 + (n & 1023)];
    } else if constexpr (ID == 5) {
        if (n < 1024) return A.in[IN_WRKV][(size_t)2 * 1048576 + (size_t)k * 1024 + n];
        const int j = n - 1024; const float* mu = A.in[IN_MU];
        if (j < 128) { const float m = mu[3 * 1024 + k], w = A.in[IN_W1][k * 64 + (j & 63)]; return (j < 64 ? 1.f - m : m) * w; }
        if (j < 256) { const float m = mu[4 * 1024 + k], w = A.in[IN_A1][k * 64 + (j & 63)]; return (j < 192 ? 1.f - m : m) * w; }
        if (j < 576) { const float m = mu[5 * 1024 + k]; const int jj = j - 256, c = jj < 160 ? jj : jj - 160; const float w = A.in[IN_G1][k * 160 + c]; return (jj < 160 ? 1.f - m : m) * w; }
        return 0.f;
    } else if constexpr (ID == 6) { return k < 64 ? A.in[IN_W2][(size_t)k * 1024 + n] : 0.f;
    } else if constexpr (ID == 7) { return k < 64 ? A.in[IN_A2][(size_t)k * 1024 + n] : 0.f;
    } else if constexpr (ID == 8) { return k < 160 ? A.in[IN_G2][(size_t)k * 1024 + n] : 0.f;
    } else if constexpr (ID == 9) { return A.in[IN_WO1][(size_t)k * 1024 + n];
    } else if constexpr (ID == 10) { return A.in[IN_WUP][(size_t)4194304 + (size_t)k * 4096 + n] * A.in[IN_MLPN][1024 + k];
    } else { return A.in[IN_WDN][(size_t)4194304 + (size_t)k * 1024 + n]; }
}
template <int ID> __device__ __forceinline__ void p0_weight(const Args& A, bf16_t* dst, int N, int K, float* scr, int gw, int NGW, int lane) {
    const int nblk = N / 32, nitems = (K / 64) * nblk;
    for (int it = gw; it < nitems; it += NGW) {
        const int kb = it / nblk, nb = it % nblk, k0 = 64 * kb, n0 = 32 * nb;
#pragma unroll 8
        for (int i = 0; i < 32; ++i) { const int kk = 2 * i + (lane >> 5); scr[kk * 33 + (lane & 31)] = wval<ID>(A, n0 + (lane & 31), k0 + kk); }
        LDS_WAIT();
        const int c = lane & 7;
#pragma unroll
        for (int j = 0; j < 4; ++j) { const int n = (lane >> 3) + 8 * j; const float* s = scr + (8 * c) * 33 + n;
            u32x4 o; o.x = pk2(s[0 * 33], s[1 * 33]); o.y = pk2(s[2 * 33], s[3 * 33]); o.z = pk2(s[4 * 33], s[5 * 33]); o.w = pk2(s[6 * 33], s[7 * 33]);
            *(u32x4*)(dst + (size_t)(n0 + n) * K + k0 + 8 * c) = o; }
        LDS_WAIT();
    }
}
__device__ __forceinline__ void rms_row_to_bf16(const float* xrow, const float* g, bf16_t* orow, int lane) {
    const f32x4* xr = (const f32x4*)xrow + lane; const f32x4* gr = (const f32x4*)g + lane;
    f32x4 v[4]; float s = 0.f;
#pragma unroll
    for (int j = 0; j < 4; ++j) { v[j] = xr[64 * j]; s += (v[j].x * v[j].x + v[j].y * v[j].y) + (v[j].z * v[j].z + v[j].w * v[j].w); }
    const float rs = rsqrtf(wave_sum(s) * (1.f / DM) + NORM_EPS);
    u32x2* o8 = (u32x2*)orow + lane;
#pragma unroll
    for (int j = 0; j < 4; ++j) { const f32x4 gg = gr[64 * j]; u32x2 w; w.x = pk2(v[j].x * rs * gg.x, v[j].y * rs * gg.y); w.y = pk2(v[j].z * rs * gg.z, v[j].w * rs * gg.w); o8[64 * j] = w; }
}
__device__ __forceinline__ void p0_prologue(const Args& A, unsigned char* lds) {
    const int tid = threadIdx.x, lane = tid & 63, wave = tid >> 6;
    float* scr = (float*)(lds + wave * 16384);
    const int gw = blockIdx.x * NWAVES + wave, NGW = gridDim.x * NWAVES;
    p0_weight<0>(A, WSP(bf16_t, OFF_WIN), 2304, 1024, scr, gw, NGW, lane);
    p0_weight<1>(A, WSP(bf16_t, OFF_WO0), 1024, 1024, scr, gw, NGW, lane);
    p0_weight<2>(A, WSP(bf16_t, OFF_WUP0), 4096, 1024, scr, gw, NGW, lane);
    p0_weight<3>(A, WSP(bf16_t, OFF_WDN0), 1024, 4096, scr, gw, NGW, lane);
    p0_weight<4>(A, WSP(bf16_t, OFF_WRK), 2048, 1024, scr, gw, NGW, lane);
    p0_weight<5>(A, WSP(bf16_t, OFF_WVL), 1792, 1024, scr, gw, NGW, lane);
    p0_weight<6>(A, WSP(bf16_t, OFF_W2T), 1024, 128, scr, gw, NGW, lane);
    p0_weight<7>(A, WSP(bf16_t, OFF_A2T), 1024, 128, scr, gw, NGW, lane);
    p0_weight<8>(A, WSP(bf16_t, OFF_G2T), 1024, 256, scr, gw, NGW, lane);
    p0_weight<9>(A, WSP(bf16_t, OFF_WO1), 1024, 1024, scr, gw, NGW, lane);
    p0_weight<10>(A, WSP(bf16_t, OFF_WUP1), 4096, 1024, scr, gw, NGW, lane);
    p0_weight<11>(A, WSP(bf16_t, OFF_WDN1), 1024, 4096, scr, gw, NGW, lane);
    float* rc = WSP(float, OFF_ROPE); float* rsn = rc + 2048 * 32;
    for (int idx = blockIdx.x * NTHR + tid; idx < 2048 * 32; idx += gridDim.x * NTHR) {
        const int t = idx >> 5, d = idx & 31;
        double inv = 1.0; for (int i = 0; i < d; ++i) inv *= 0.74989420933245582730;
        const double ang = (double)t * inv;
        const double q = rint(ang * 0.63661977236758134308); const double r = (ang - q * 1.5707963267948966192) - q * 6.123233995736766036e-17;
        const double r2 = r * r;
        double sn = 1.0, cs = 1.0, ts = 1.0, tc = 1.0;
#pragma unroll
        for (int i = 1; i <= 9; ++i) { tc *= -r2 / (double)((2 * i - 1) * (2 * i)); ts *= -r2 / (double)((2 * i) * (2 * i + 1)); cs += tc; sn += ts; }
        sn *= r;
        const int qi = ((int)q) & 3;
        const double c = (qi == 0) ? cs : (qi == 1) ? -sn : (qi == 2) ? -cs : sn;
        const double s = (qi == 0) ? sn : (qi == 1) ? cs : (qi == 2) ? -sn : -cs;
        rc[idx] = (float)c; rsn[idx] = (float)s;
    }
    bf16_t* H0 = WSP(bf16_t, OFF_H0);
    for (int m = gw; m < MTOK; m += NGW) rms_row_to_bf16(A.in[IN_X] + (size_t)m * DM, A.in[IN_MIXN], H0 + (size_t)m * DM, lane);
}

struct Unit { int pm, pn; };
struct Gemm { const bf16_t* A; const bf16_t* A2; int pn2; const bf16_t* Bt; int M, N, K; };
constexpr int NXCD = 8, WGM = 8;
struct StaticOrder {
    int nM, nN, nwg, G, c;
    __device__ void init(int M, int N, int G_, int c_) { nM = M / 256; nN = N / 256; nwg = nM * nN; G = G_; c = c_; }
    __device__ bool next(int i, Unit& u) const {
        const long L = (long)i * G + c; if (L >= nwg) return false;
        int wgid = (int)L; { const int q = nwg / NXCD, r = nwg % NXCD, xcd = wgid % NXCD, off = wgid / NXCD; wgid = (xcd < r ? xcd * (q + 1) : r * (q + 1) + (xcd - r) * q) + off; }
        const int nig = WGM * nN, gid = wgid / nig, fm = gid * WGM, gsz = (nM - fm) < WGM ? (nM - fm) : WGM;
        u.pm = fm + ((wgid % nig) % gsz); u.pn = (wgid % nig) / gsz; return true;
    }
};
typedef f32x4 AccT[2][2][4][2];

template <class Epi> __device__ __forceinline__ void gemm_naive(const Gemm g, const Epi& E) {
    const int tid = threadIdx.x, wave = tid >> 6, lane = tid & 63, wr = wave >> 2, wc = wave & 3, fr = lane & 15, fq = lane >> 4;
    StaticOrder S; S.init(g.M, g.N, gridDim.x, blockIdx.x);
    Unit u;
    for (int i = 0; S.next(i, u); ++i) {
        AccT acc;
#pragma unroll
        for (int a = 0; a < 2; ++a)
#pragma unroll
            for (int b = 0; b < 2; ++b)
#pragma unroll
                for (int m = 0; m < 4; ++m)
#pragma unroll
                    for (int n = 0; n < 2; ++n) acc[a][b][m][n] = (f32x4){0.f, 0.f, 0.f, 0.f};
        const bf16_t* Ab = (u.pn >= g.pn2 ? g.A2 : g.A) + (size_t)(u.pm * 256 + wr * 64 + fr) * g.K;
        const bf16_t* Bb = g.Bt + (size_t)(u.pn * 256 + wc * 32) * g.K;
        for (int k0 = 0; k0 < g.K; k0 += 8) {
            bf16x8 af[2][4];
#pragma unroll
            for (int ai = 0; ai < 2; ++ai)
#pragma unroll
                for (int m = 0; m < 4; ++m) af[ai][m] = *(const bf16x8*)(Ab + (size_t)(ai * 128 + m * 16) * g.K + k0);
#pragma unroll
            for (int bj = 0; bj < 2; ++bj)
#pragma unroll
                for (int n = 0; n < 2; ++n)
#pragma unroll
                    for (int c = 0; c < 4; ++c) {
                        const int col = bj * 128 + (Epi::PERM ? 8 * fq + 4 * n + c : 16 * n + 4 * fq + c);
                        const bf16x8 b = *(const bf16x8*)(Bb + (size_t)col * g.K + k0);
                        float bf[8];
#pragma unroll
                        for (int e = 0; e < 8; ++e) bf[e] = bf2f((bf16_t)b[e]);
#pragma unroll
                        for (int ai = 0; ai < 2; ++ai)
#pragma unroll
                            for (int m = 0; m < 4; ++m) { float s = acc[ai][bj][m][n][c];
#pragma unroll
                                for (int e = 0; e < 8; ++e) s += bf2f((bf16_t)af[ai][m][e]) * bf[e];
                                acc[ai][bj][m][n][c] = s; }
                        asm volatile("" ::: "memory");
                    }
        }
        E(acc, u, wr, wc, fr, fq);
    }
}

struct EpiInProj {
    static constexpr bool PERM = true;
    bf16_t *Q, *K, *V, *QI, *KI; float* WI; const float* rope;
    __device__ __forceinline__ void operator()(const AccT& acc, const Unit& u, int wr, int wc, int fr, int fq) const {
        const int pn = u.pn;
#pragma unroll
        for (int ai = 0; ai < 2; ++ai)
#pragma unroll
            for (int m = 0; m < 4; ++m) {
                const int row = u.pm * 256 + ai * 128 + wr * 64 + m * 16 + fr, t = row & (SEQ - 1);
#pragma unroll
                for (int bj = 0; bj < 2; ++bj) {
                    const int cl = bj * 128 + wc * 32 + fq * 8;
                    f32x4 v0 = acc[ai][bj][m][0], v1 = acc[ai][bj][m][1];
                    const bool rot = (pn <= 4) || pn == 6 || pn == 7 || (pn == 8 && cl < 64);
                    if (rot) {
                        const int d0 = (cl & 63) >> 1;
                        const f32x4 c = *(const f32x4*)(rope + t * 32 + d0), s = *(const f32x4*)(rope + 2048 * 32 + t * 32 + d0);
                        f32x4 a0, a1;
                        a0.x = v0.x * c.x - v0.y * s.x; a0.y = v0.y * c.x + v0.x * s.x;
                        a0.z = v0.z * c.y - v0.w * s.y; a0.w = v0.w * c.y + v0.z * s.y;
                        a1.x = v1.x * c.z - v1.y * s.z; a1.y = v1.y * c.z + v1.x * s.z;
                        a1.z = v1.z * c.w - v1.w * s.w; a1.w = v1.w * c.w + v1.z * s.w;
                        v0 = a0; v1 = a1;
                    }
                    if (pn < 4) { v0 = v0 * QSCALE; v1 = v1 * QSCALE; }
                    u32x4 w; w.x = pk2(v0.x, v0.y); w.y = pk2(v0.z, v0.w); w.z = pk2(v1.x, v1.y); w.w = pk2(v1.z, v1.w);
                    if (pn < 4) *(u32x4*)(Q + (size_t)row * 1024 + pn * 256 + cl) = w;
                    else if (pn == 4) *(u32x4*)(K + (size_t)row * 256 + cl) = w;
                    else if (pn == 5) *(u32x4*)(V + (size_t)row * 256 + cl) = w;
                    else if (pn < 8) *(u32x4*)(QI + (size_t)row * 512 + (pn - 6) * 256 + cl) = w;
                    else { if (cl < 64) *(u32x4*)(KI + (size_t)row * 64 + cl) = w;
                           else if (cl == 64) { *(f32x4*)(WI + (size_t)row * 8) = v0 * WI_SCALE; *(f32x4*)(WI + (size_t)row * 8 + 4) = v1 * WI_SCALE; } }
                }
            }
    }
};
struct EpiResid {
    static constexpr bool PERM = false;
    const float* xin; float* xout; bf16_t* xb; float* ssq;
    __device__ __forceinline__ void operator()(const AccT& acc, const Unit& u, int wr, int wc, int fr, int fq) const {
#pragma unroll
        for (int ai = 0; ai < 2; ++ai)
#pragma unroll
            for (int m = 0; m < 4; ++m) {
                const int row = u.pm * 256 + ai * 128 + wr * 64 + m * 16 + fr; float s = 0.f;
#pragma unroll
                for (int bj = 0; bj < 2; ++bj)
#pragma unroll
                    for (int n = 0; n < 2; ++n) {
                        const size_t off = (size_t)row * DM + u.pn * 256 + bj * 128 + wc * 32 + n * 16 + fq * 4;
                        const f32x4 x = *(const f32x4*)(xin + off) + acc[ai][bj][m][n];
                        *(f32x4*)(xout + off) = x;
                        if (xb) { u32x2 w; w.x = pk2(x.x, x.y); w.y = pk2(x.z, x.w); *(u32x2*)(xb + off) = w; }
                        s += (x.x * x.x + x.y * x.y) + (x.z * x.z + x.w * x.w);
                    }
                if (ssq) { s += __shfl_xor(s, 16); s += __shfl_xor(s, 32); if (fq == 0) atomicAdd(ssq + row, s); }
            }
    }
};
struct EpiUp {
    static constexpr bool PERM = true;
    bf16_t* U; const float* ssq;
    __device__ __forceinline__ void operator()(const AccT& acc, const Unit& u, int wr, int wc, int fr, int fq) const {
#pragma unroll
        for (int ai = 0; ai < 2; ++ai)
#pragma unroll
            for (int m = 0; m < 4; ++m) {
                const int row = u.pm * 256 + ai * 128 + wr * 64 + m * 16 + fr;
                const float rs = rsqrtf(ssq[row] * (1.f / DM) + NORM_EPS);
#pragma unroll
                for (int bj = 0; bj < 2; ++bj) {
                    f32x4 v0 = acc[ai][bj][m][0] * rs, v1 = acc[ai][bj][m][1] * rs;
#pragma unroll
                    for (int c = 0; c < 4; ++c) { const float a = fmaxf(v0[c], 0.f), b = fmaxf(v1[c], 0.f); v0[c] = a * a; v1[c] = b * b; }
                    u32x4 w; w.x = pk2(v0.x, v0.y); w.y = pk2(v0.z, v0.w); w.z = pk2(v1.x, v1.y); w.w = pk2(v1.z, v1.w);
                    *(u32x4*)(U + (size_t)row * FF + u.pn * 256 + bj * 128 + wc * 32 + fq * 8) = w;
                }
            }
    }
};
struct EpiStore {
    static constexpr bool PERM = true;
    bf16_t* b0; int ld0; int split; bf16_t* b1; int ld1;
    __device__ __forceinline__ void operator()(const AccT& acc, const Unit& u, int wr, int wc, int fr, int fq) const {
        bf16_t* base = u.pn < split ? b0 + u.pn * 256 : b1 + (u.pn - split) * 256; const int ld = u.pn < split ? ld0 : ld1;
#pragma unroll
        for (int ai = 0; ai < 2; ++ai)
#pragma unroll
            for (int m = 0; m < 4; ++m) {
                const int row = u.pm * 256 + ai * 128 + wr * 64 + m * 16 + fr;
#pragma unroll
                for (int bj = 0; bj < 2; ++bj) {
                    const f32x4 v0 = acc[ai][bj][m][0], v1 = acc[ai][bj][m][1];
                    u32x4 w; w.x = pk2(v0.x, v0.y); w.y = pk2(v0.z, v0.w); w.z = pk2(v1.x, v1.y); w.w = pk2(v1.z, v1.w);
                    *(u32x4*)(base + (size_t)row * ld + bj * 128 + wc * 32 + fq * 8) = w;
                }
            }
    }
};
struct EpiLoraUp {
    static constexpr bool PERM = true;
    bf16_t* E; bf16_t* AS; const float* w0; const float* a0;
    __device__ __forceinline__ void operator()(const AccT& acc, const Unit& u, int wr, int wc, int fr, int fq) const {
        const bool dec = u.pn < 4; bf16_t* O = dec ? E : AS; const float* bias = dec ? w0 : a0; const float sc = dec ? -0.6065306597126334f : 1.f;
#pragma unroll
        for (int bj = 0; bj < 2; ++bj) {
            const int col = (u.pn & 3) * 256 + bj * 128 + wc * 32 + fq * 8;
            const f32x4 b0 = *(const f32x4*)(bias + col), b1 = *(const f32x4*)(bias + col + 4);
#pragma unroll
            for (int ai = 0; ai < 2; ++ai)
#pragma unroll
                for (int m = 0; m < 4; ++m) {
                    const int row = u.pm * 256 + ai * 128 + wr * 64 + m * 16 + fr;
                    f32x4 v0 = acc[ai][bj][m][0] + b0, v1 = acc[ai][bj][m][1] + b1;
#pragma unroll
                    for (int c = 0; c < 4; ++c) { v0[c] = sc * sigmoidf_(v0[c]); v1[c] = sc * sigmoidf_(v1[c]); }
                    u32x4 w; w.x = pk2(v0.x, v0.y); w.y = pk2(v0.z, v0.w); w.z = pk2(v1.x, v1.y); w.w = pk2(v1.z, v1.w);
                    *(u32x4*)(O + (size_t)row * DM + col) = w;
                    asm volatile("" ::: "memory");
                }
        }
    }
};
struct EpiGatePost {
    static constexpr bool PERM = true;
    bf16_t* AO; const bf16_t* Y; const bf16_t* V; const float* stats; const float* bonus; const float* lnw; const float* lnb;
    __device__ __forceinline__ void operator()(const AccT& acc, const Unit& u, int wr, int wc, int fr, int fq) const {
#pragma unroll
        for (int bj = 0; bj < 2; ++bj) {
            const int col = u.pn * 256 + bj * 128 + wc * 32 + fq * 8, hd = col >> 6;
            const f32x4 w0 = *(const f32x4*)(lnw + col), w1 = *(const f32x4*)(lnw + col + 4), c0 = *(const f32x4*)(lnb + col), c1 = *(const f32x4*)(lnb + col + 4);
#pragma unroll
            for (int ai = 0; ai < 2; ++ai)
#pragma unroll
                for (int m = 0; m < 4; ++m) {
                    const int row = u.pm * 256 + ai * 128 + wr * 64 + m * 16 + fr;
                    const f32x4 st = *(const f32x4*)(stats + ((size_t)row * 16 + hd) * 4);
                    const float mean = (st.x + st.z) * (1.f / 64.f), var = fmaxf((st.y + st.w) * (1.f / 64.f) - mean * mean, 0.f), rstd = rsqrtf(var + LNX_EPS);
                    const float bo = bonus[(size_t)row * 16 + hd];
                    const bf16x8 yv = *(const bf16x8*)(Y + (size_t)row * DM + col), vv = *(const bf16x8*)(V + (size_t)row * DM + col);
                    const f32x4 g0 = acc[ai][bj][m][0], g1 = acc[ai][bj][m][1];
                    float o[8];
#pragma unroll
                    for (int c = 0; c < 4; ++c) {
                        o[c] = ((bf2f((bf16_t)yv[c]) - mean) * rstd * w0[c] + c0[c] + bo * bf2f((bf16_t)vv[c])) * g0[c];
                        o[4 + c] = ((bf2f((bf16_t)yv[4 + c]) - mean) * rstd * w1[c] + c1[c] + bo * bf2f((bf16_t)vv[4 + c])) * g1[c];
                    }
                    u32x4 w; w.x = pk2(o[0], o[1]); w.y = pk2(o[2], o[3]); w.z = pk2(o[4], o[5]); w.w = pk2(o[6], o[7]);
                    *(u32x4*)(AO + (size_t)row * DM + col) = w;
                }
        }
    }
};

#define PG8_LAS __attribute__((address_space(3)))
constexpr int BM = 256, BK = 64, HALF = 128, HTB = HALF * BK * 2  , STAGE_BYTES = 8 * HTB;
__host__ __device__ __forceinline__ int lds_byte(int r, int c) { const int st = (r >> 4) * 2 + (c >> 5), rr = r & 15, cc = c & 31, ob = rr * 64 + cc * 2; return st * 1024 + (ob ^ (((ob >> 9) & 1) << 5)); }
__host__ __device__ __forceinline__ void stage_rc(int b, int& R, int& C) { const int st = b / 1024, sb = b % 1024, swz = sb ^ (((sb >> 9) & 1) << 5); R = (st >> 1) * 16 + swz / 64; C = (st & 1) * 32 + (swz % 64) / 2; }
__host__ __device__ __forceinline__ int perm32(int rho) { const int n = rho >> 4, i = rho & 15; return 8 * (i >> 2) + 4 * n + (i & 3); }
template <class Epi, bool ALIGN_EPI = true, bool SP2 = true>
__device__ __forceinline__ void gemm_fast(PG8_LAS unsigned char* lds, const Gemm g, const Epi& E) {
    StaticOrder S; S.init(g.M, g.N, gridDim.x, blockIdx.x);
    const int tid = threadIdx.x, wid = __builtin_amdgcn_readfirstlane(tid >> 6), lane = tid & 63, wr = wid >> 2, wc = wid & 3, fr = lane & 15, fq = lane >> 4;
    int K_ = g.K; asm volatile("" : "+s"(K_));
    const int K = K_, nt = K / BK;
    unsigned voffA[2], voffB[2];
#pragma unroll
    for (int i = 0; i < 2; ++i) { int R, C; stage_rc(tid * 16 + i * 8192, R, C); const int Rb = Epi::PERM ? ((R & ~31) + perm32(R & 31)) : R;
        voffA[i] = (unsigned)(R * K + C) * 2u; voffB[i] = (unsigned)(Rb * K + C) * 2u; }
    const size_t kstep = (size_t)(BK * 2);
    const size_t hstep = (size_t)HALF * K * 2;
    const size_t tstep = 2 * hstep;
    const unsigned ldsw = (unsigned)wid * 1024u;
    const int aoff = lds_byte(wr * 64 + fr, fq * 8), boff = lds_byte(wc * 32 + fr, fq * 8);
#define PG8_SA(b, h) (((b) * 2 + (h)) * HTB)
#define PG8_SB(b, h) ((4 + (b) * 2 + (h)) * HTB)
#define PG8_STAGE(bufoff, gbase, voff) do { _Pragma("unroll") for (int _i = 0; _i < 2; ++_i) \
        __builtin_amdgcn_global_load_lds((const unsigned*)((const char*)(gbase) + (voff)[_i]), (PG8_LAS unsigned*)(lds + (bufoff) + ldsw + _i * 8192), 16, 0, 0); } while (0)
#define PG8_LDA(dst, b, h) do { _Pragma("unroll") for (int m = 0; m < 4; ++m) _Pragma("unroll") for (int k = 0; k < 2; ++k) dst[m][k] = *(const PG8_LAS bf16x8*)(lds + PG8_SA(b, h) + aoff + m * 2048 + k * 1024); } while (0)
#define PG8_LDB(dst, b, h) do { _Pragma("unroll") for (int n = 0; n < 2; ++n) _Pragma("unroll") for (int k = 0; k < 2; ++k) dst[n][k] = *(const PG8_LAS bf16x8*)(lds + PG8_SB(b, h) + boff + n * 2048 + k * 1024); } while (0)
#define PG8_MMA(ai, bj, At, Bt) do { __builtin_amdgcn_s_setprio(1); _Pragma("unroll") for (int m = 0; m < 4; ++m) _Pragma("unroll") for (int n = 0; n < 2; ++n) _Pragma("unroll") for (int k = 0; k < 2; ++k) \
        acc[ai][bj][m][n] = __builtin_amdgcn_mfma_f32_16x16x32_bf16(Bt[n][k], At[m][k], acc[ai][bj][m][n], 0, 0, 0); __builtin_amdgcn_s_setprio(0); } while (0)
#define PG8_WAIT_V(n) asm volatile("s_waitcnt vmcnt(" #n ")" ::: "memory")
#define PG8_WAIT_L(n) asm volatile("s_waitcnt lgkmcnt(" #n ")" ::: "memory")
#define PG8_BAR __builtin_amdgcn_s_barrier()
#define PG8_SCHED __builtin_amdgcn_sched_barrier(0)
    Unit cur, nxt; int ui = 0;
    if (!S.next(0, cur)) return;
    AccT acc;
#pragma unroll
    for (int a = 0; a < 2; ++a)
#pragma unroll
        for (int b = 0; b < 2; ++b)
#pragma unroll
            for (int m = 0; m < 4; ++m)
#pragma unroll
                for (int n = 0; n < 2; ++n) acc[a][b][m][n] = (f32x4){0.f, 0.f, 0.f, 0.f};
    bf16x8 At[4][2], B0[2][2], B1[2][2];
    const char* cA = (const char*)(cur.pn >= g.pn2 ? g.A2 : g.A) + (size_t)cur.pm * tstep; const char* cB = (const char*)g.Bt + (size_t)cur.pn * tstep;
    if constexpr (SP2) {
        PG8_STAGE(PG8_SB(0, 0), cB, voffB); PG8_STAGE(PG8_SB(0, 1), cB + hstep, voffB); PG8_STAGE(PG8_SA(0, 0), cA, voffA); PG8_STAGE(PG8_SA(0, 1), cA + hstep, voffA);
        if (wr == 1) PG8_BAR;
        PG8_WAIT_V(2); PG8_BAR;
        PG8_STAGE(PG8_SB(1, 0), cB + kstep, voffB); PG8_STAGE(PG8_SA(1, 0), cA + kstep, voffA); PG8_STAGE(PG8_SB(1, 1), cB + hstep + kstep, voffB);
        PG8_WAIT_V(6); PG8_BAR;
    } else {
        PG8_STAGE(PG8_SB(0, 0), cB, voffB); PG8_STAGE(PG8_SA(0, 0), cA, voffA); PG8_STAGE(PG8_SB(0, 1), cB + hstep, voffB); PG8_STAGE(PG8_SA(0, 1), cA + hstep, voffA);
        if (wr == 1) PG8_BAR;
        PG8_WAIT_V(4); PG8_BAR;
        PG8_STAGE(PG8_SB(1, 0), cB + kstep, voffB); PG8_STAGE(PG8_SA(1, 0), cA + kstep, voffA); PG8_STAGE(PG8_SB(1, 1), cB + hstep + kstep, voffB);
        PG8_WAIT_V(6); PG8_BAR;
    }
    for (;;) {
        const bool has_next = S.next(ui + 1, nxt);
        const char* nA = has_next ? (const char*)(nxt.pn >= g.pn2 ? g.A2 : g.A) + (size_t)nxt.pm * tstep : cA; const char* nB = has_next ? (const char*)g.Bt + (size_t)nxt.pn * tstep : cB;
        for (int t = 0; t < nt; t += 2) {
            const bool last = (t == nt - 2);
            const char* a1 = cA + (size_t)(t + 1) * kstep;
            const char* a2 = last ? nA : cA + (size_t)(t + 2) * kstep; const char* b2 = last ? nB : cB + (size_t)(t + 2) * kstep;
            const char* a3 = a2 + kstep; const char* b3 = b2 + kstep;
            if constexpr (SP2) {
            PG8_LDB(B0, 0, 0); PG8_LDB(B1, 0, 1); PG8_SCHED; PG8_LDA(At, 0, 0); PG8_STAGE(PG8_SA(1, 1), a1 + hstep, voffA);
            PG8_WAIT_V(8); PG8_WAIT_L(0); PG8_BAR; PG8_MMA(0, 0, At, B0); PG8_MMA(0, 1, At, B1); PG8_BAR; PG8_SCHED;
            PG8_LDA(At, 0, 1); PG8_STAGE(PG8_SB(0, 0), b2, voffB); PG8_STAGE(PG8_SB(0, 1), b2 + hstep, voffB); PG8_STAGE(PG8_SA(0, 0), a2, voffA);
            PG8_WAIT_V(8); PG8_WAIT_L(0); PG8_BAR; PG8_MMA(1, 0, At, B0); PG8_MMA(1, 1, At, B1); PG8_BAR; PG8_SCHED;
            PG8_LDB(B0, 1, 0); PG8_LDB(B1, 1, 1); PG8_SCHED; PG8_LDA(At, 1, 0); PG8_STAGE(PG8_SA(0, 1), a2 + hstep, voffA);
            PG8_WAIT_V(8); PG8_WAIT_L(0); PG8_BAR; PG8_MMA(0, 0, At, B0); PG8_MMA(0, 1, At, B1); PG8_BAR; PG8_SCHED;
            PG8_LDA(At, 1, 1); PG8_STAGE(PG8_SB(1, 0), b3, voffB); PG8_STAGE(PG8_SB(1, 1), b3 + hstep, voffB); PG8_STAGE(PG8_SA(1, 0), a3, voffA);
            PG8_WAIT_V(8); PG8_WAIT_L(0); PG8_BAR; PG8_MMA(1, 0, At, B0); PG8_MMA(1, 1, At, B1); PG8_BAR; PG8_SCHED;
            } else {
            PG8_LDB(B0, 0, 0); PG8_SCHED; PG8_LDA(At, 0, 0); PG8_STAGE(PG8_SA(1, 1), a1 + hstep, voffA);
            PG8_WAIT_L(8); PG8_BAR; PG8_WAIT_L(0); PG8_MMA(0, 0, At, B0); PG8_BAR; PG8_SCHED;
            PG8_LDB(B1, 0, 1); PG8_STAGE(PG8_SB(0, 0), b2, voffB);
            PG8_BAR; PG8_WAIT_L(0); PG8_MMA(0, 1, At, B1); PG8_BAR;
            PG8_LDA(At, 0, 1); PG8_STAGE(PG8_SA(0, 0), a2, voffA);
            PG8_BAR; PG8_WAIT_L(0); PG8_MMA(1, 0, At, B0); PG8_BAR; PG8_SCHED;
            PG8_STAGE(PG8_SB(0, 1), b2 + hstep, voffB);
            PG8_WAIT_V(6); PG8_BAR; PG8_MMA(1, 1, At, B1); PG8_BAR;
            PG8_LDB(B0, 1, 0); PG8_SCHED; PG8_LDA(At, 1, 0); PG8_STAGE(PG8_SA(0, 1), a2 + hstep, voffA);
            PG8_WAIT_L(8); PG8_BAR; PG8_WAIT_L(0); PG8_MMA(0, 0, At, B0); PG8_BAR; PG8_SCHED;
            PG8_LDB(B1, 1, 1); PG8_STAGE(PG8_SB(1, 0), b3, voffB);
            PG8_BAR; PG8_WAIT_L(0); PG8_MMA(0, 1, At, B1); PG8_BAR;
            PG8_LDA(At, 1, 1); PG8_STAGE(PG8_SA(1, 0), a3, voffA);
            PG8_BAR; PG8_WAIT_L(0); PG8_MMA(1, 0, At, B0); PG8_BAR; PG8_SCHED;
            PG8_STAGE(PG8_SB(1, 1), b3 + hstep, voffB);
            PG8_WAIT_V(6); PG8_BAR; PG8_MMA(1, 1, At, B1); PG8_BAR;
            }
        }
        if constexpr (ALIGN_EPI) { if (wr == 0) PG8_BAR; }
        E(acc, cur, wr, wc, fr, fq);
        if (!has_next) break;
#pragma unroll
        for (int a = 0; a < 2; ++a)
#pragma unroll
            for (int b = 0; b < 2; ++b)
#pragma unroll
                for (int m = 0; m < 4; ++m)
#pragma unroll
                    for (int n = 0; n < 2; ++n) acc[a][b][m][n] = (f32x4){0.f, 0.f, 0.f, 0.f};
        cur = nxt; cA = nA; cB = nB; ++ui;
        if constexpr (ALIGN_EPI) { if (wr == 1) PG8_BAR; }
    }
    PG8_WAIT_V(0);
    if constexpr (!ALIGN_EPI) { if (wr == 0) PG8_BAR; }
    PG8_BAR;
#undef PG8_SA
#undef PG8_SB
#undef PG8_STAGE
#undef PG8_LDA
#undef PG8_LDB
#undef PG8_MMA
#undef PG8_WAIT_V
#undef PG8_WAIT_L
#undef PG8_BAR
#undef PG8_SCHED
}

template <class Epi> __device__ __forceinline__ void gemm_phase(unsigned char* lds, const Gemm g, const Epi& E) {
#if FAST_GEMM
    gemm_fast<Epi>((PG8_LAS unsigned char*)lds, g, E);
#else
    gemm_naive<Epi>(g, E);
#endif
}

__device__ __forceinline__ void p2_naive(const Args& A, unsigned char* lds) {
    const int tid = threadIdx.x, lane = tid & 63, wave = tid >> 6;
    float* sc = (float*)lds; float* qf = sc + 2048; float* wf = qf + 512;
    const bf16_t* QI = WSP(bf16_t, OFF_QI); const bf16_t* KI = WSP(bf16_t, OFF_KI); const float* WI = WSP(float, OFF_WI); unsigned* MASK = WSP(unsigned, OFF_MASK);
    for (int m = blockIdx.x; m < MTOK; m += gridDim.x) {
        const int t = m & (SEQ - 1), b0 = m - t, nk = t + 1;
        unsigned* mrow = MASK + (size_t)m * 64;
        if (t < 256) { if (tid < 64) { const int lo = tid * 32; mrow[tid] = (nk >= lo + 32) ? 0xffffffffu : (nk <= lo ? 0u : ((1u << (nk - lo)) - 1u)); } continue; }
        __syncthreads();
        qf[tid] = bf2f(QI[(size_t)m * 512 + tid]);
        if (tid < 8) wf[tid] = WI[(size_t)m * 8 + tid];
        __syncthreads();
        for (int s = tid; s < nk; s += NTHR) {
            const bf16_t* kr = KI + (size_t)(b0 + s) * 64; float kf[64];
#pragma unroll
            for (int c = 0; c < 8; ++c) { const bf16x8 kv = *(const bf16x8*)(kr + 8 * c);
#pragma unroll
                for (int e = 0; e < 8; ++e) kf[8 * c + e] = bf2f((bf16_t)kv[e]); }
            float score = 0.f;
#pragma unroll
            for (int h = 0; h < 8; ++h) { float d = 0.f;
#pragma unroll
                for (int e = 0; e < 64; ++e) d += qf[h * 64 + e] * kf[e];
                score += wf[h] * fmaxf(d, 0.f); }
            sc[s] = score;
        }
        __syncthreads();
#pragma unroll 1
        for (int j = 0; j < 4; ++j) {
            const int base = 512 * j + 64 * wave;
            if (base >= nk) { if (lane < 2) mrow[(base >> 5) + lane] = 0u; continue; }
            const int s = base + lane; const bool valid = s < nk; const float my = valid ? sc[s] : 0.f; int cnt = 0;
            for (int s2 = 0; s2 < nk; ++s2) { const float o = sc[s2]; cnt += ((o > my) || (o == my && s2 < s)) ? 1 : 0; }
            const unsigned long long bal = __ballot(valid && cnt < 256);
            if (lane == 0) { mrow[base >> 5] = (unsigned)bal; mrow[(base >> 5) + 1] = (unsigned)(bal >> 32); }
        }
    }
}

__device__ __forceinline__ void p3_naive(const Args& A, unsigned char* lds) {
    const int tid = threadIdx.x, lane = tid & 63, wave = tid >> 6;
    float* lg = (float*)lds; float* qf = lg + 2048; float* red = qf + 1024; unsigned* mw = (unsigned*)(red + 1024);
    bf16_t* QO = WSP(bf16_t, OFF_QO); const bf16_t* K = WSP(bf16_t, OFF_K); const bf16_t* V = WSP(bf16_t, OFF_V); const unsigned* MASK = WSP(unsigned, OFF_MASK);
    for (int m = blockIdx.x; m < MTOK; m += gridDim.x) {
        const int t = m & (SEQ - 1), b0 = m - t, nk = t + 1;
        __syncthreads();
        qf[tid] = bf2f(QO[(size_t)m * 1024 + tid]); qf[tid + 512] = bf2f(QO[(size_t)m * 1024 + 512 + tid]);
        if (tid < 64) mw[tid] = MASK[(size_t)m * 64 + tid];
        __syncthreads();
#pragma unroll 1
        for (int hd = 0; hd < 16; ++hd) {
            const int n = hd >> 2; float mx = -INFINITY;
            for (int s = tid; s < nk; s += NTHR) {
                float v = -INFINITY;
                if ((mw[s >> 5] >> (s & 31)) & 1u) {
                    const bf16_t* kr = K + (size_t)(b0 + s) * 256 + n * 64; float d = 0.f;
#pragma unroll
                    for (int c = 0; c < 8; ++c) { const bf16x8 kv = *(const bf16x8*)(kr + 8 * c);
#pragma unroll
                        for (int e = 0; e < 8; ++e) d += qf[hd * 64 + 8 * c + e] * bf2f((bf16_t)kv[e]); }
                    v = d;
                }
                lg[s] = v; mx = fmaxf(mx, v);
            }
            mx = block_max(mx, red, wave, lane);
            float sm = 0.f;
            for (int s = tid; s < nk; s += NTHR) { const float p = exp2f(lg[s] - mx); lg[s] = p; sm += p; }
            sm = block_sum(sm, red, wave, lane);
            float acc = 0.f;
            for (int s = wave; s < nk; s += NWAVES) { const float p = lg[s]; if (p != 0.f) acc += p * bf2f(V[(size_t)(b0 + s) * 256 + n * 64 + lane]); }
            __syncthreads();
            red[16 + wave * 64 + lane] = acc;
            __syncthreads();
            if (tid < 64) { float o = 0.f;
#pragma unroll
                for (int p = 0; p < NWAVES; ++p) o += red[16 + p * 64 + tid];
                QO[(size_t)m * 1024 + hd * 64 + tid] = (bf16_t)f2bf(o / sm); }
            __syncthreads();
        }
    }
}

__device__ __forceinline__ void p7_prep(const Args& A) {
    const int tid = threadIdx.x, lane = tid & 63, wave = tid >> 6;
    const int gw = blockIdx.x * NWAVES + wave, NGW = gridDim.x * NWAVES;
    const float* X = A.out; const float* g = A.in[IN_MIXN] + DM; const float* mu = A.in[IN_MU];
    bf16_t* XSR = WSP(bf16_t, OFF_XSR); bf16_t* XSK = WSP(bf16_t, OFF_XSK); bf16_t* XSV = WSP(bf16_t, OFF_XSV); bf16_t* H1 = WSP(bf16_t, OFF_H1);
    f32x4 gg[4], mr[4], mk[4], mv[4];
#pragma unroll
    for (int j = 0; j < 4; ++j) { gg[j] = ((const f32x4*)g)[lane + 64 * j]; mr[j] = ((const f32x4*)mu)[lane + 64 * j]; mk[j] = ((const f32x4*)(mu + DM))[lane + 64 * j]; mv[j] = ((const f32x4*)(mu + 2 * DM))[lane + 64 * j]; }
    for (int run = gw; run < MTOK / 16; run += NGW) {
        const int r0 = run * 16; f32x4 hp[4];
#pragma unroll 1
        for (int i = -1; i < 16; ++i) {
            const int row = r0 + i; f32x4 h[4];
            if (i < 0 && (r0 & (SEQ - 1)) == 0) {
#pragma unroll
                for (int j = 0; j < 4; ++j) hp[j] = (f32x4){0.f, 0.f, 0.f, 0.f};
                continue;
            }
            const f32x4* xr = (const f32x4*)(X + (size_t)row * DM) + lane; float s = 0.f;
#pragma unroll
            for (int j = 0; j < 4; ++j) { h[j] = xr[64 * j]; s += (h[j].x * h[j].x + h[j].y * h[j].y) + (h[j].z * h[j].z + h[j].w * h[j].w); }
            const float rs = rsqrtf(wave_sum(s) * (1.f / DM) + NORM_EPS);
#pragma unroll
            for (int j = 0; j < 4; ++j) h[j] = h[j] * rs * gg[j];
            if (i >= 0) {
#pragma unroll
                for (int j = 0; j < 4; ++j) {
                    const f32x4 xx = hp[j] - h[j];
                    const f32x4 a = h[j] + xx * mr[j], b = h[j] + xx * mk[j], c = h[j] + xx * mv[j];
                    const size_t off = (size_t)row * DM + 4 * lane + 256 * j;
                    u32x2 w; w.x = pk2(a.x, a.y); w.y = pk2(a.z, a.w); *(u32x2*)(XSR + off) = w;
                    w.x = pk2(b.x, b.y); w.y = pk2(b.z, b.w); *(u32x2*)(XSK + off) = w;
                    w.x = pk2(c.x, c.y); w.y = pk2(c.z, c.w); *(u32x2*)(XSV + off) = w;
                    w.x = pk2(h[j].x, h[j].y); w.y = pk2(h[j].z, h[j].w); *(u32x2*)(H1 + off) = w;
                }
            }
#pragma unroll
            for (int j = 0; j < 4; ++j) hp[j] = h[j];
        }
    }
}
__device__ __forceinline__ void p10_loramid(const Args& A) {
    const bf16_t* P = WSP(bf16_t, OFF_P); bf16_t* AW = WSP(bf16_t, OFF_AW); bf16_t* AA = WSP(bf16_t, OFF_AA); bf16_t* AG = WSP(bf16_t, OFF_AG);
    const size_t total = (size_t)MTOK * 512;
    for (size_t idx = (size_t)blockIdx.x * NTHR + threadIdx.x; idx < total; idx += (size_t)gridDim.x * NTHR) {
        const int m = (int)(idx >> 9), j = (int)(idx & 511); const bool first = (m & (SEQ - 1)) == 0;
        const bf16_t* p0 = P + (size_t)m * 768; const bf16_t* pm = p0 - 768;
        if (j < 128) {
            float v = 0.f; if (j < 64) { const float x = bf2f(p0[j]) + (first ? 0.f : bf2f(pm[64 + j])); const float e = __expf(-2.f * fabsf(x)); const float th = (1.f - e) / (1.f + e); v = x < 0.f ? -th : th; }
            AW[(size_t)m * 128 + j] = (bf16_t)f2bf(v);
        } else if (j < 256) {
            const int jj = j - 128; float v = 0.f; if (jj < 64) v = bf2f(p0[128 + jj]) + (first ? 0.f : bf2f(pm[192 + jj]));
            AA[(size_t)m * 128 + jj] = (bf16_t)f2bf(v);
        } else {
            const int jj = j - 256; float v = 0.f; if (jj < 160) { const float x = bf2f(p0[256 + jj]) + (first ? 0.f : bf2f(pm[416 + jj])); v = sigmoidf_(x); }
            AG[(size_t)m * 256 + jj] = (bf16_t)f2bf(v);
        }
    }
}
__device__ __forceinline__ void p12_naive(const Args& A, unsigned char* lds) {
    const int tid = threadIdx.x, lane = tid & 63, wave = tid >> 6;
    const int gw = blockIdx.x * NWAVES + wave, NGW = gridDim.x * NWAVES;
    float* sh = (float*)lds + wave * 320;
    const bf16_t* R = WSP(bf16_t, OFF_R); const bf16_t* KR = WSP(bf16_t, OFF_KR); const bf16_t* VV = WSP(bf16_t, OFF_VV); const bf16_t* E = WSP(bf16_t, OFF_E); const bf16_t* AS = WSP(bf16_t, OFF_A);
    bf16_t* Y = WSP(bf16_t, OFF_Y);
    for (int it = gw; it < BATCH * 16; it += NGW) {
        const int b = it >> 4, h = it & 15;
        float S[64];
#pragma unroll
        for (int j = 0; j < 64; ++j) S[j] = 0.f;
        const float kkw = A.in[IN_KK][h * 64 + lane], kaw = A.in[IN_KA][h * 64 + lane];
        const size_t base = (size_t)b * SEQ * DM + h * 64 + lane;
        bf16_t rn = R[base], kn = KR[base], vn = VV[base], en = E[base], an = AS[base];
#pragma unroll 1
        for (int t = 0; t < SEQ; ++t) {
            const float r = bf2f(rn), k = bf2f(kn), v = bf2f(vn), e = bf2f(en), a = bf2f(an);
            if (t + 1 < SEQ) { const size_t ix = base + (size_t)(t + 1) * DM; rn = R[ix]; kn = KR[ix]; vn = VV[ix]; en = E[ix]; an = AS[ix]; }
            float kk = k * kkw; const float ss = wave_sum(kk * kk); kk *= rsqrtf(fmaxf(ss, 1e-24f));
            const float kt = k * (1.f + (a - 1.f) * kaw), bb = kk * a, w = __expf(e);
            sh[lane] = -kk; sh[64 + lane] = w; sh[128 + lane] = bb; sh[192 + lane] = kt; sh[256 + lane] = r;
            LDS_WAIT();
            float sa = 0.f;
#pragma unroll
            for (int j = 0; j < 64; ++j) sa += S[j] * sh[j];
            float y = 0.f;
#pragma unroll
            for (int j = 0; j < 64; ++j) { S[j] = S[j] * sh[64 + j] + sa * sh[128 + j] + v * sh[192 + j]; y += S[j] * sh[256 + j]; }
            Y[base + (size_t)t * DM] = (bf16_t)f2bf(y);
            LDS_WAIT();
        }
    }
}
__device__ __forceinline__ void p12b_stats(const Args& A) {
    const int tid = threadIdx.x, lane = tid & 63, wave = tid >> 6;
    const int gw = blockIdx.x * NWAVES + wave, NGW = gridDim.x * NWAVES;
    const bf16_t* R = WSP(bf16_t, OFF_R); const bf16_t* KR = WSP(bf16_t, OFF_KR); const bf16_t* AS = WSP(bf16_t, OFF_A); const bf16_t* Y = WSP(bf16_t, OFF_Y);
    float* ST = WSP(float, OFF_STATS); float* BO = WSP(float, OFF_BONUS);
    for (int it = gw; it < MTOK * 16; it += NGW) {
        const int h = it & 15; const size_t ix = (size_t)(it >> 4) * DM + h * 64 + lane;
        const float y = bf2f(Y[ix]), r = bf2f(R[ix]), k = bf2f(KR[ix]), a = bf2f(AS[ix]);
        const float kt = k * (1.f + (a - 1.f) * A.in[IN_KA][h * 64 + lane]);
        const float s1 = wave_sum(y), s2 = wave_sum(y * y), bo = wave_sum(r * kt * A.in[IN_RK][h * 64 + lane]);
        if (lane == 0) { *(f32x4*)(ST + (size_t)it * 4) = (f32x4){s1, s2, 0.f, 0.f}; BO[it] = bo; }
    }
}
__device__ __forceinline__ void p18_final(const Args& A) {
    const int tid = threadIdx.x, lane = tid & 63, wave = tid >> 6;
    const int gw = blockIdx.x * NWAVES + wave, NGW = gridDim.x * NWAVES;
    const f32x4* gr = (const f32x4*)A.in[IN_FINN] + lane;
    for (int m = gw; m < MTOK; m += NGW) {
        f32x4* xr = (f32x4*)(A.out + (size_t)m * DM) + lane; f32x4 v[4]; float s = 0.f;
#pragma unroll
        for (int j = 0; j < 4; ++j) { v[j] = xr[64 * j]; s += (v[j].x * v[j].x + v[j].y * v[j].y) + (v[j].z * v[j].z + v[j].w * v[j].w); }
        const float rs = rsqrtf(wave_sum(s) * (1.f / DM) + NORM_EPS);
#pragma unroll
        for (int j = 0; j < 4; ++j) xr[64 * j] = v[j] * rs * gr[64 * j];
    }
}

constexpr int N_PHASES = 19;
template <int LO, int HI> __global__ void __launch_bounds__(NTHR, 2) mk_fwd(Args A) {
    extern __shared__ __attribute__((aligned(16))) unsigned char lds[];
#define IN(k) (LO <= (k) && (k) < HI)
    if constexpr (IN(0)) p0_prologue(A, lds);
    if constexpr (IN(1)) {
        Gemm g{WSP(bf16_t, OFF_H0), WSP(bf16_t, OFF_H0), 1 << 30, WSP(bf16_t, OFF_WIN), MTOK, 2304, DM};
        EpiInProj E{WSP(bf16_t, OFF_QO), WSP(bf16_t, OFF_K), WSP(bf16_t, OFF_V), WSP(bf16_t, OFF_QI), WSP(bf16_t, OFF_KI), WSP(float, OFF_WI), WSP(float, OFF_ROPE)};
        gemm_phase(lds, g, E);
    }
    if constexpr (IN(2)) p2_naive(A, lds);
    if constexpr (IN(3)) p3_naive(A, lds);
    if constexpr (IN(4)) {
        Gemm g{WSP(bf16_t, OFF_QO), WSP(bf16_t, OFF_QO), 1 << 30, WSP(bf16_t, OFF_WO0), MTOK, DM, DM};
        EpiResid E{A.in[IN_X], A.out, WSP(bf16_t, OFF_XB), WSP(float, OFF_SSQ0)};
        gemm_phase(lds, g, E);
    }
    if constexpr (IN(5)) {
        Gemm g{WSP(bf16_t, OFF_XB), WSP(bf16_t, OFF_XB), 1 << 30, WSP(bf16_t, OFF_WUP0), MTOK, FF, DM};
        EpiUp E{WSP(bf16_t, OFF_U), WSP(float, OFF_SSQ0)};
        gemm_phase(lds, g, E);
    }
    if constexpr (IN(6)) {
        Gemm g{WSP(bf16_t, OFF_U), WSP(bf16_t, OFF_U), 1 << 30, WSP(bf16_t, OFF_WDN0), MTOK, DM, FF};
        EpiResid E{A.out, A.out, nullptr, nullptr};
        gemm_phase(lds, g, E);
    }
    if constexpr (IN(7)) p7_prep(A);
    if constexpr (IN(8)) {
        Gemm g{WSP(bf16_t, OFF_XSR), WSP(bf16_t, OFF_XSK), 4, WSP(bf16_t, OFF_WRK), MTOK, 2048, DM};
        EpiStore E{WSP(bf16_t, OFF_R), DM, 4, WSP(bf16_t, OFF_KR), DM};
        gemm_phase(lds, g, E);
    }
    if constexpr (IN(9)) {
        Gemm g{WSP(bf16_t, OFF_XSV), WSP(bf16_t, OFF_H1), 4, WSP(bf16_t, OFF_WVL), MTOK, 1792, DM};
        EpiStore E{WSP(bf16_t, OFF_VV), DM, 4, WSP(bf16_t, OFF_P), 768};
        gemm_phase(lds, g, E);
    }
    if constexpr (IN(10)) p10_loramid(A);
    if constexpr (IN(11)) {
        Gemm g{WSP(bf16_t, OFF_AW), WSP(bf16_t, OFF_AA), 4, WSP(bf16_t, OFF_W2T), MTOK, 2048, 128};
        EpiLoraUp E{WSP(bf16_t, OFF_E), WSP(bf16_t, OFF_A), A.in[IN_W0], A.in[IN_A0]};
        gemm_phase(lds, g, E);
    }
    if constexpr (IN(12)) p12_naive(A, lds);
    if constexpr (IN(13)) p12b_stats(A);
    if constexpr (IN(14)) {
        Gemm g{WSP(bf16_t, OFF_AG), WSP(bf16_t, OFF_AG), 1 << 30, WSP(bf16_t, OFF_G2T), MTOK, DM, 256};
        EpiGatePost E{WSP(bf16_t, OFF_AO), WSP(bf16_t, OFF_Y), WSP(bf16_t, OFF_VV), WSP(float, OFF_STATS), WSP(float, OFF_BONUS), A.in[IN_LNW], A.in[IN_LNB]};
        gemm_phase(lds, g, E);
    }
    if constexpr (IN(15)) {
        Gemm g{WSP(bf16_t, OFF_AO), WSP(bf16_t, OFF_AO), 1 << 30, WSP(bf16_t, OFF_WO1), MTOK, DM, DM};
        EpiResid E{A.out, A.out, WSP(bf16_t, OFF_XB), WSP(float, OFF_SSQ1)};
        gemm_phase(lds, g, E);
    }
    if constexpr (IN(16)) {
        Gemm g{WSP(bf16_t, OFF_XB), WSP(bf16_t, OFF_XB), 1 << 30, WSP(bf16_t, OFF_WUP1), MTOK, FF, DM};
        EpiUp E{WSP(bf16_t, OFF_U), WSP(float, OFF_SSQ1)};
        gemm_phase(lds, g, E);
    }
    if constexpr (IN(17)) {
        Gemm g{WSP(bf16_t, OFF_U), WSP(bf16_t, OFF_U), 1 << 30, WSP(bf16_t, OFF_WDN1), MTOK, DM, FF};
        EpiResid E{A.out, A.out, nullptr, nullptr};
        gemm_phase(lds, g, E);
    }
    if constexpr (IN(18)) p18_final(A);
#undef IN
}

template <int P> static void launch_all(int grid, hipStream_t stream, const Args& a) {
    if constexpr (P < N_PHASES) {
        static bool attr_done = false;
        if (!attr_done) { (void)hipFuncSetAttribute((const void*)mk_fwd<P, P + 1>, hipFuncAttributeMaxDynamicSharedMemorySize, LDS_BYTES); attr_done = true; }
        hipLaunchKernelGGL((mk_fwd<P, P + 1>), dim3(grid), dim3(NTHR), LDS_BYTES, stream, a);
        launch_all<P + 1>(grid, stream, a);
    }
}
extern "C" void kernel_launch(void* const* d_in, const int* in_sizes, int n_in, void* d_out, int out_size, void* d_ws, size_t ws_size, hipStream_t stream) {
    static int grid = 0;
    if (grid == 0) {
        if (n_in != N_IN || out_size != MTOK * DM || ws_size < WS_END) { fprintf(stderr, "kernel_launch: unexpected shapes (n_in %d out %d ws %zu)\n", n_in, out_size, ws_size); grid = -1; return; }
        int dev = 0, cus = 0;
        (void)hipGetDevice(&dev); (void)hipDeviceGetAttribute(&cus, hipDeviceAttributeMultiprocessorCount, dev);
        grid = cus > 0 ? cus : 256;
    }
    if (grid < 0) return;
    (void)hipMemsetAsync((char*)d_ws + OFF_CTL, 0, CTL_BYTES, stream);
    Args a{};
    for (int i = 0; i < N_IN; ++i) a.in[i] = (const float*)d_in[i];
    a.out = (float*)d_out; a.ws = (unsigned char*)d_ws;
    launch_all<0>(grid, stream, a);
}
```

```cpp
#include <hip/hip_runtime.h>
#include <hip/hip_cooperative_groups.h>
#include <hip/hip_bf16.h>
#include <cmath>
#include <cstdio>
#include <cstdint>
namespace cg = cooperative_groups;

#ifndef ONE_LAUNCH
#define ONE_LAUNCH 1
#endif
#ifndef DBG_TOPK
#define DBG_TOPK 0
#define DBG_WHICH 2
#define DBG_UNIT 0.001f
#endif
#ifndef REP_MASK
#define REP_MASK 0u
#endif
#ifndef REP_123
#define REP_123 0
#endif
#ifndef FAST_ATTN
#define FAST_ATTN 1
#endif
#ifndef FAST_TOPK
#define FAST_TOPK 1
#endif
#ifndef FAST_SCAN
#define FAST_SCAN 1
#endif
#ifndef FAST_GEMM
#define FAST_GEMM 1
#endif

#define LAS __attribute__((address_space(3)))
#define GAS __attribute__((address_space(1)))
typedef unsigned short bf16_t;
typedef short bf16x8 __attribute__((ext_vector_type(8)));
typedef float f32x4 __attribute__((ext_vector_type(4)));
typedef float f32x2 __attribute__((ext_vector_type(2)));
typedef unsigned u32x4 __attribute__((ext_vector_type(4)));
typedef unsigned u32x2 __attribute__((ext_vector_type(2)));

constexpr int BATCH = 8, SEQ = 2048, DM = 1024, MTOK = BATCH * SEQ, FF = 4096;
constexpr int NWAVES = 8, NTHR = 512;
constexpr int LDS_BYTES = 147456;
constexpr float NORM_EPS = 1e-6f, LNX_EPS = 64e-5f;
constexpr float QSCALE = 0.125f * 1.4426950408889634f;
constexpr float WI_SCALE = 0.044194173824159216f;

enum { IN_X = 0, IN_MIXN, IN_MLPN, IN_WUP, IN_WDN, IN_FINN, IN_WIN, IN_WO, IN_MU, IN_WRKV, IN_W0, IN_W1, IN_W2, IN_A0, IN_A1, IN_A2,
       IN_G1, IN_G2, IN_KK, IN_KA, IN_RK, IN_LNW, IN_LNB, IN_WO1, N_IN };

constexpr size_t MiB = 1u << 20;
constexpr size_t OFF_CTL = 0, CTL_BYTES = 1 * MiB;
constexpr size_t OFF_SSQ0 = 256 * 1024, OFF_SSQ1 = 320 * 1024;
constexpr size_t OFF_ROPE = 1 * MiB;
constexpr size_t OFF_WIN = 2 * MiB, OFF_WO0 = 7 * MiB, OFF_WUP0 = 9 * MiB, OFF_WDN0 = 17 * MiB, OFF_WRK = 25 * MiB, OFF_WVL = 29 * MiB;
constexpr size_t OFF_W2T = 33 * MiB, OFF_A2T = 33 * MiB + 256 * 1024, OFF_G2T = 33 * MiB + 512 * 1024, OFF_WO1 = 34 * MiB, OFF_WUP1 = 36 * MiB, OFF_WDN1 = 44 * MiB;
constexpr size_t OFF_BONUS = 2 * MiB;
constexpr size_t OFF_H0 = 52 * MiB, OFF_QO = 84 * MiB, OFF_K = 116 * MiB, OFF_V = 124 * MiB, OFF_QI = 132 * MiB, OFF_KI = 148 * MiB, OFF_WI = 150 * MiB, OFF_MASK = 152 * MiB;
constexpr size_t OFF_XB = 52 * MiB, OFF_U = 84 * MiB;
constexpr size_t OFF_XSR = 52 * MiB, OFF_XSK = 84 * MiB, OFF_XSV = 116 * MiB, OFF_H1 = 148 * MiB, OFF_R = 180 * MiB, OFF_KR = 212 * MiB;
constexpr size_t OFF_VV = 52 * MiB, OFF_P = 84 * MiB, OFF_AW = 108 * MiB, OFF_AA = 112 * MiB, OFF_AG = 244 * MiB;
constexpr size_t OFF_E = 116 * MiB, OFF_A = 148 * MiB, OFF_Y = 84 * MiB, OFF_STATS = 252 * MiB, OFF_AO = 116 * MiB;
constexpr size_t WS_END = 256 * MiB;

struct Args { const float* in[N_IN]; float* out; unsigned char* ws; int ph_lo, ph_hi; };
#define WSP(T, off) ((T*)(A.ws + (off)))

__device__ __forceinline__ float bf2f(bf16_t u) { return __uint_as_float((unsigned)u << 16); }
__device__ __forceinline__ unsigned f2bf(float f) { unsigned u = __float_as_uint(f); return (u + 0x7fffu + ((u >> 16) & 1u)) >> 16; }
__device__ __forceinline__ unsigned pk2(float lo, float hi) { return f2bf(lo) | (f2bf(hi) << 16); }
__device__ __forceinline__ float wave_sum(float v) {
#pragma unroll
    for (int o = 1; o < 64; o <<= 1) v += __shfl_xor(v, o);
    return v;
}
__device__ __forceinline__ float wave_max(float v) {
#pragma unroll
    for (int o = 1; o < 64; o <<= 1) v = fmaxf(v, __shfl_xor(v, o));
    return v;
}
#define LDS_WAIT() asm volatile("s_waitcnt lgkmcnt(0)" ::: "memory")
__device__ __forceinline__ int opaque_tid() { int t = threadIdx.x; asm volatile("" : "+v"(t)); return t; }
__device__ __forceinline__ float sigmoidf_(float z) { return __builtin_amdgcn_rcpf(1.f + __expf(-z)); }

__device__ __forceinline__ float block_sum(float v, float* red, int wave, int lane) {
    v = wave_sum(v); __syncthreads(); if (lane == 0) red[wave] = v; __syncthreads();
    float s = 0.f;
#pragma unroll
    for (int i = 0; i < NWAVES; ++i) s += red[i];
    return s;
}
__device__ __forceinline__ float block_max(float v, float* red, int wave, int lane) {
    v = wave_max(v); __syncthreads(); if (lane == 0) red[wave] = v; __syncthreads();
    float s = red[0];
#pragma unroll
    for (int i = 1; i < NWAVES; ++i) s = fmaxf(s, red[i]);
    return s;
}

template <int ID> __device__ __forceinline__ float wval(const Args& A, int n, int k) {
    if constexpr (ID == 0) {
        int col;
        if (n < 1280 || (n >= 1536 && n < 2112)) { const int hd = n >> 6, j = n & 63; col = (hd << 6) + (j >> 1) + ((j & 1) << 5); }
        else if (n < 2120) col = n; else return 0.f;
        return A.in[IN_WIN][(size_t)k * 2120 + col];
    } else if constexpr (ID == 1) { return A.in[IN_WO][(size_t)k * 1024 + n];
    } else if constexpr (ID == 2) { return A.in[IN_WUP][(size_t)k * 4096 + n] * A.in[IN_MLPN][k];
    } else if constexpr (ID == 3) { return A.in[IN_WDN][(size_t)k * 1024 + n];
    } else if constexpr (ID == 4) { return A.in[IN_WRKV][(size_t)(n >> 10) * 1048576 + (size_t)k * 1024 + (n & 1023)];
    } else if constexpr (ID == 5) {
        if (n < 1024) return A.in[IN_WRKV][(size_t)2 * 1048576 + (size_t)k * 1024 + n];
        const int j = n - 1024; const float* mu = A.in[IN_MU];
        if (j < 128) { const float m = mu[3 * 1024 + k], w = A.in[IN_W1][k * 64 + (j & 63)]; return (j < 64 ? 1.f - m : m) * w; }
        if (j < 256) { const float m = mu[4 * 1024 + k], w = A.in[IN_A1][k * 64 + (j & 63)]; return (j < 192 ? 1.f - m : m) * w; }
        if (j < 576) { const float m = mu[5 * 1024 + k]; const int jj = j - 256, c = jj < 160 ? jj : jj - 160; const float w = A.in[IN_G1][k * 160 + c]; return (jj < 160 ? 1.f - m : m) * w; }
        return 0.f;
    } else if constexpr (ID == 6) { return k < 64 ? A.in[IN_W2][(size_t)k * 1024 + n] : 0.f;
    } else if constexpr (ID == 7) { return k < 64 ? A.in[IN_A2][(size_t)k * 1024 + n] : 0.f;
    } else if constexpr (ID == 8) { return k < 160 ? A.in[IN_G2][(size_t)k * 1024 + n] : 0.f;
    } else if constexpr (ID == 9) { return A.in[IN_WO1][(size_t)k * 1024 + n];
    } else if constexpr (ID == 10) { return A.in[IN_WUP][(size_t)4194304 + (size_t)k * 4096 + n] * A.in[IN_MLPN][1024 + k];
    } else { return A.in[IN_WDN][(size_t)4194304 + (size_t)k * 1024 + n]; }
}
template <int ID> __device__ __forceinline__ void p0_weight(const Args& A, bf16_t* dst, int N, int K, float* scr, int gw, int NGW, int lane) {
    const int nblk = N / 32, nitems = (K / 64) * nblk;
    for (int it = gw; it < nitems; it += NGW) {
        const int kb = it / nblk, nb = it % nblk, k0 = 64 * kb, n0 = 32 * nb;
#pragma unroll 8
        for (int i = 0; i < 32; ++i) { const int kk = 2 * i + (lane >> 5); scr[kk * 33 + (lane & 31)] = wval<ID>(A, n0 + (lane & 31), k0 + kk); }
        LDS_WAIT();
        const int c = lane & 7;
#pragma unroll
        for (int j = 0; j < 4; ++j) { const int n = (lane >> 3) + 8 * j; const float* s = scr + (8 * c) * 33 + n;
            u32x4 o; o.x = pk2(s[0 * 33], s[1 * 33]); o.y = pk2(s[2 * 33], s[3 * 33]); o.z = pk2(s[4 * 33], s[5 * 33]); o.w = pk2(s[6 * 33], s[7 * 33]);
            *(u32x4*)(dst + (size_t)(n0 + n) * K + k0 + 8 * c) = o; }
        LDS_WAIT();
    }
}
__device__ __forceinline__ void rms_row_to_bf16(const float* xrow, const float* g, bf16_t* orow, int lane) {
    const f32x4* xr = (const f32x4*)xrow + lane; const f32x4* gr = (const f32x4*)g + lane;
    f32x4 v[4]; float s = 0.f;
#pragma unroll
    for (int j = 0; j < 4; ++j) { v[j] = xr[64 * j]; s += (v[j].x * v[j].x + v[j].y * v[j].y) + (v[j].z * v[j].z + v[j].w * v[j].w); }
    const float rs = rsqrtf(wave_sum(s) * (1.f / DM) + NORM_EPS);
    u32x2* o8 = (u32x2*)orow + lane;
#pragma unroll
    for (int j = 0; j < 4; ++j) { const f32x4 gg = gr[64 * j]; u32x2 w; w.x = pk2(v[j].x * rs * gg.x, v[j].y * rs * gg.y); w.y = pk2(v[j].z * rs * gg.z, v[j].w * rs * gg.w); o8[64 * j] = w; }
}
__device__ __forceinline__ void p0_prologue(const Args& A, unsigned char* lds) {
    const int tid = opaque_tid(), lane = tid & 63, wave = tid >> 6;
    float* scr = (float*)(lds + wave * 16384);
    const int gw = blockIdx.x * NWAVES + wave, NGW = gridDim.x * NWAVES;
    p0_weight<0>(A, WSP(bf16_t, OFF_WIN), 2304, 1024, scr, gw, NGW, lane);
    p0_weight<1>(A, WSP(bf16_t, OFF_WO0), 1024, 1024, scr, gw, NGW, lane);
    p0_weight<2>(A, WSP(bf16_t, OFF_WUP0), 4096, 1024, scr, gw, NGW, lane);
    p0_weight<3>(A, WSP(bf16_t, OFF_WDN0), 1024, 4096, scr, gw, NGW, lane);
    p0_weight<4>(A, WSP(bf16_t, OFF_WRK), 2048, 1024, scr, gw, NGW, lane);
    p0_weight<5>(A, WSP(bf16_t, OFF_WVL), 1792, 1024, scr, gw, NGW, lane);
    p0_weight<6>(A, WSP(bf16_t, OFF_W2T), 1024, 128, scr, gw, NGW, lane);
    p0_weight<7>(A, WSP(bf16_t, OFF_A2T), 1024, 128, scr, gw, NGW, lane);
    p0_weight<8>(A, WSP(bf16_t, OFF_G2T), 1024, 256, scr, gw, NGW, lane);
    p0_weight<9>(A, WSP(bf16_t, OFF_WO1), 1024, 1024, scr, gw, NGW, lane);
    p0_weight<10>(A, WSP(bf16_t, OFF_WUP1), 4096, 1024, scr, gw, NGW, lane);
    p0_weight<11>(A, WSP(bf16_t, OFF_WDN1), 1024, 4096, scr, gw, NGW, lane);
    float* rc = WSP(float, OFF_ROPE); float* rsn = rc + 2048 * 32;
    for (int idx = blockIdx.x * NTHR + tid; idx < 2048 * 32; idx += gridDim.x * NTHR) {
        const int t = idx >> 5, d = idx & 31;
        double inv = 1.0; for (int i = 0; i < d; ++i) inv *= 0.74989420933245582730;
        const double ang = (double)t * inv;
        const double q = rint(ang * 0.63661977236758134308); const double r = (ang - q * 1.5707963267948966192) - q * 6.123233995736766036e-17;
        const double r2 = r * r;
        double sn = 1.0, cs = 1.0, ts = 1.0, tc = 1.0;
#pragma unroll
        for (int i = 1; i <= 9; ++i) { tc *= -r2 / (double)((2 * i - 1) * (2 * i)); ts *= -r2 / (double)((2 * i) * (2 * i + 1)); cs += tc; sn += ts; }
        sn *= r;
        const int qi = ((int)q) & 3;
        const double c = (qi == 0) ? cs : (qi == 1) ? -sn : (qi == 2) ? -cs : sn;
        const double s = (qi == 0) ? sn : (qi == 1) ? cs : (qi == 2) ? -sn : -cs;
        rc[idx] = (float)c; rsn[idx] = (float)s;
    }
    bf16_t* H0 = WSP(bf16_t, OFF_H0);
    for (int m = gw; m < MTOK; m += NGW) rms_row_to_bf16(A.in[IN_X] + (size_t)m * DM, A.in[IN_MIXN], H0 + (size_t)m * DM, lane);
}

struct Unit { int pm, pn; };
struct Gemm { const bf16_t* A; const bf16_t* A2; int pn2; const bf16_t* Bt; int M, N, K; };
constexpr int NXCD = 8, WGM = 8;
struct StaticOrder {
    int nM, nN, nwg, G, c;
    __device__ void init(int M, int N, int G_, int c_) { nM = M / 256; nN = N / 256; nwg = nM * nN; G = G_; c = c_; }
    __device__ bool next(int i, Unit& u) const {
        const long L = (long)i * G + c; if (L >= nwg) return false;
        int wgid = (int)L; { const int q = nwg / NXCD, r = nwg % NXCD, xcd = wgid % NXCD, off = wgid / NXCD; wgid = (xcd < r ? xcd * (q + 1) : r * (q + 1) + (xcd - r) * q) + off; }
        const int nig = WGM * nN, gid = wgid / nig, fm = gid * WGM, gsz = (nM - fm) < WGM ? (nM - fm) : WGM;
        u.pm = fm + ((wgid % nig) % gsz); u.pn = (wgid % nig) / gsz; return true;
    }
};
typedef f32x4 AccT[2][2][4][2];

template <class Epi> __device__ __forceinline__ void gemm_naive(const Gemm g, const Epi& E) {
    const int tid = opaque_tid(), wave = tid >> 6, lane = tid & 63, wr = wave >> 2, wc = wave & 3, fr = lane & 15, fq = lane >> 4;
    StaticOrder S; S.init(g.M, g.N, gridDim.x, blockIdx.x);
    Unit u;
    for (int i = 0; S.next(i, u); ++i) {
        AccT acc;
#pragma unroll
        for (int a = 0; a < 2; ++a)
#pragma unroll
            for (int b = 0; b < 2; ++b)
#pragma unroll
                for (int m = 0; m < 4; ++m)
#pragma unroll
                    for (int n = 0; n < 2; ++n) acc[a][b][m][n] = (f32x4){0.f, 0.f, 0.f, 0.f};
        const bf16_t* Ab = (u.pn >= g.pn2 ? g.A2 : g.A) + (size_t)(u.pm * 256 + wr * 64 + fr) * g.K;
        const bf16_t* Bb = g.Bt + (size_t)(u.pn * 256 + wc * 32) * g.K;
        for (int k0 = 0; k0 < g.K; k0 += 8) {
            bf16x8 af[2][4];
#pragma unroll
            for (int ai = 0; ai < 2; ++ai)
#pragma unroll
                for (int m = 0; m < 4; ++m) af[ai][m] = *(const bf16x8*)(Ab + (size_t)(ai * 128 + m * 16) * g.K + k0);
#pragma unroll
            for (int bj = 0; bj < 2; ++bj)
#pragma unroll
                for (int n = 0; n < 2; ++n)
#pragma unroll
                    for (int c = 0; c < 4; ++c) {
                        const int col = bj * 128 + (Epi::PERM ? 8 * fq + 4 * n + c : 16 * n + 4 * fq + c);
                        const bf16x8 b = *(const bf16x8*)(Bb + (size_t)col * g.K + k0);
                        float bf[8];
#pragma unroll
                        for (int e = 0; e < 8; ++e) bf[e] = bf2f((bf16_t)b[e]);
#pragma unroll
                        for (int ai = 0; ai < 2; ++ai)
#pragma unroll
                            for (int m = 0; m < 4; ++m) { float s = acc[ai][bj][m][n][c];
#pragma unroll
                                for (int e = 0; e < 8; ++e) s += bf2f((bf16_t)af[ai][m][e]) * bf[e];
                                acc[ai][bj][m][n][c] = s; }
                        asm volatile("" ::: "memory");
                    }
        }
        E(acc, u, wr, wc, fr, fq);
    }
}

struct EpiInProj {
    static constexpr bool PERM = true;
    bf16_t *Q, *K, *V, *QI, *KI; float* WI; const float* rope;
    __device__ __forceinline__ void operator()(const AccT& acc, const Unit& u, int wr, int wc, int fr, int fq) const {
        const int pn = u.pn;
#pragma unroll
        for (int ai = 0; ai < 2; ++ai)
#pragma unroll
            for (int m = 0; m < 4; ++m) {
                const int row = u.pm * 256 + ai * 128 + wr * 64 + m * 16 + fr, t = row & (SEQ - 1);
#pragma unroll
                for (int bj = 0; bj < 2; ++bj) {
                    const int cl = bj * 128 + wc * 32 + fq * 8;
                    f32x4 v0 = acc[ai][bj][m][0], v1 = acc[ai][bj][m][1];
                    const bool rot = (pn <= 4) || pn == 6 || pn == 7 || (pn == 8 && cl < 64);
                    if (rot) {
                        const int d0 = (cl & 63) >> 1;
                        const f32x4 c = *(const f32x4*)(rope + t * 32 + d0), s = *(const f32x4*)(rope + 2048 * 32 + t * 32 + d0);
                        f32x4 a0, a1;
                        a0.x = v0.x * c.x - v0.y * s.x; a0.y = v0.y * c.x + v0.x * s.x;
                        a0.z = v0.z * c.y - v0.w * s.y; a0.w = v0.w * c.y + v0.z * s.y;
                        a1.x = v1.x * c.z - v1.y * s.z; a1.y = v1.y * c.z + v1.x * s.z;
                        a1.z = v1.z * c.w - v1.w * s.w; a1.w = v1.w * c.w + v1.z * s.w;
                        v0 = a0; v1 = a1;
                    }
                    if (pn < 4) { v0 = v0 * QSCALE; v1 = v1 * QSCALE; }
                    u32x4 w; w.x = pk2(v0.x, v0.y); w.y = pk2(v0.z, v0.w); w.z = pk2(v1.x, v1.y); w.w = pk2(v1.z, v1.w);
                    if (pn < 4) *(u32x4*)(Q + (size_t)row * 1024 + pn * 256 + cl) = w;
                    else if (pn == 4) *(u32x4*)(K + (size_t)row * 256 + cl) = w;
                    else if (pn == 5) *(u32x4*)(V + (size_t)row * 256 + cl) = w;
                    else if (pn < 8) *(u32x4*)(QI + (size_t)row * 512 + (pn - 6) * 256 + cl) = w;
                    else { if (cl < 64) *(u32x4*)(KI + (size_t)row * 64 + cl) = w;
                           else if (cl == 64) { *(f32x4*)(WI + (size_t)row * 8) = v0 * WI_SCALE; *(f32x4*)(WI + (size_t)row * 8 + 4) = v1 * WI_SCALE; } }
                }
            }
    }
};
struct EpiResid {
    static constexpr bool PERM = false;
    const float* xin; float* xout; bf16_t* xb; float* ssq;
    __device__ __forceinline__ void operator()(const AccT& acc, const Unit& u, int wr, int wc, int fr, int fq) const {
#pragma unroll
        for (int ai = 0; ai < 2; ++ai)
#pragma unroll
            for (int m = 0; m < 4; ++m) {
                const int row = u.pm * 256 + ai * 128 + wr * 64 + m * 16 + fr; float s = 0.f;
#pragma unroll
                for (int bj = 0; bj < 2; ++bj)
#pragma unroll
                    for (int n = 0; n < 2; ++n) {
                        const size_t off = (size_t)row * DM + u.pn * 256 + bj * 128 + wc * 32 + n * 16 + fq * 4;
                        const f32x4 x = *(const f32x4*)(xin + off) + acc[ai][bj][m][n];
                        *(f32x4*)(xout + off) = x;
                        if (xb) { u32x2 w; w.x = pk2(x.x, x.y); w.y = pk2(x.z, x.w); *(u32x2*)(xb + off) = w; }
                        s += (x.x * x.x + x.y * x.y) + (x.z * x.z + x.w * x.w);
                    }
                if (ssq) { s += __shfl_xor(s, 16); s += __shfl_xor(s, 32); if (fq == 0) atomicAdd(ssq + row, s); }
            }
    }
};
struct EpiUp {
    static constexpr bool PERM = true;
    bf16_t* U; const float* ssq;
    __device__ __forceinline__ void operator()(const AccT& acc, const Unit& u, int wr, int wc, int fr, int fq) const {
#pragma unroll
        for (int ai = 0; ai < 2; ++ai)
#pragma unroll
            for (int m = 0; m < 4; ++m) {
                const int row = u.pm * 256 + ai * 128 + wr * 64 + m * 16 + fr;
                const float rs = rsqrtf(ssq[row] * (1.f / DM) + NORM_EPS);
#pragma unroll
                for (int bj = 0; bj < 2; ++bj) {
                    f32x4 v0 = acc[ai][bj][m][0] * rs, v1 = acc[ai][bj][m][1] * rs;
#pragma unroll
                    for (int c = 0; c < 4; ++c) { const float a = fmaxf(v0[c], 0.f), b = fmaxf(v1[c], 0.f); v0[c] = a * a; v1[c] = b * b; }
                    u32x4 w; w.x = pk2(v0.x, v0.y); w.y = pk2(v0.z, v0.w); w.z = pk2(v1.x, v1.y); w.w = pk2(v1.z, v1.w);
                    *(u32x4*)(U + (size_t)row * FF + u.pn * 256 + bj * 128 + wc * 32 + fq * 8) = w;
                }
            }
    }
};
struct EpiStore {
    static constexpr bool PERM = true;
    bf16_t* b0; int ld0; int split; bf16_t* b1; int ld1;
    __device__ __forceinline__ void operator()(const AccT& acc, const Unit& u, int wr, int wc, int fr, int fq) const {
        bf16_t* base = u.pn < split ? b0 + u.pn * 256 : b1 + (u.pn - split) * 256; const int ld = u.pn < split ? ld0 : ld1;
#pragma unroll
        for (int ai = 0; ai < 2; ++ai)
#pragma unroll
            for (int m = 0; m < 4; ++m) {
                const int row = u.pm * 256 + ai * 128 + wr * 64 + m * 16 + fr;
#pragma unroll
                for (int bj = 0; bj < 2; ++bj) {
                    const f32x4 v0 = acc[ai][bj][m][0], v1 = acc[ai][bj][m][1];
                    u32x4 w; w.x = pk2(v0.x, v0.y); w.y = pk2(v0.z, v0.w); w.z = pk2(v1.x, v1.y); w.w = pk2(v1.z, v1.w);
                    *(u32x4*)(base + (size_t)row * ld + bj * 128 + wc * 32 + fq * 8) = w;
                }
            }
    }
};
struct EpiLoraUp {
    static constexpr bool PERM = true;
    bf16_t* E; bf16_t* AS; const float* w0; const float* a0;
    __device__ __forceinline__ void operator()(const AccT& acc, const Unit& u, int wr, int wc, int fr, int fq) const {
        const bool dec = u.pn < 4; bf16_t* O = dec ? E : AS; const float* bias = dec ? w0 : a0; const float sc = dec ? -0.6065306597126334f : 1.f;
#pragma unroll
        for (int bj = 0; bj < 2; ++bj) {
            const int col = (u.pn & 3) * 256 + bj * 128 + wc * 32 + fq * 8;
            const f32x4 b0 = *(const f32x4*)(bias + col), b1 = *(const f32x4*)(bias + col + 4);
#pragma unroll
            for (int ai = 0; ai < 2; ++ai)
#pragma unroll
                for (int m = 0; m < 4; ++m) {
                    const int row = u.pm * 256 + ai * 128 + wr * 64 + m * 16 + fr;
                    f32x4 v0 = acc[ai][bj][m][0] + b0, v1 = acc[ai][bj][m][1] + b1;
#pragma unroll
                    for (int c = 0; c < 4; ++c) { v0[c] = sc * sigmoidf_(v0[c]); v1[c] = sc * sigmoidf_(v1[c]); }
                    u32x4 w; w.x = pk2(v0.x, v0.y); w.y = pk2(v0.z, v0.w); w.z = pk2(v1.x, v1.y); w.w = pk2(v1.z, v1.w);
                    *(u32x4*)(O + (size_t)row * DM + col) = w;
                    asm volatile("" ::: "memory");
                }
        }
    }
};
struct EpiGatePost {
    static constexpr bool PERM = true;
    bf16_t* AO; const bf16_t* Y; const bf16_t* V; const float* stats; const float* bonus; const float* lnw; const float* lnb;
    __device__ __forceinline__ void operator()(const AccT& acc, const Unit& u, int wr, int wc, int fr, int fq) const {
#pragma unroll
        for (int bj = 0; bj < 2; ++bj) {
            const int col = u.pn * 256 + bj * 128 + wc * 32 + fq * 8, hd = col >> 6;
            const f32x4 w0 = *(const f32x4*)(lnw + col), w1 = *(const f32x4*)(lnw + col + 4), c0 = *(const f32x4*)(lnb + col), c1 = *(const f32x4*)(lnb + col + 4);
#pragma unroll
            for (int ai = 0; ai < 2; ++ai)
#pragma unroll
                for (int m = 0; m < 4; ++m) {
                    const int row = u.pm * 256 + ai * 128 + wr * 64 + m * 16 + fr;
                    const f32x4 st = *(const f32x4*)(stats + ((size_t)row * 16 + hd) * 4);
                    const float mean = (st.x + st.z) * (1.f / 64.f), var = fmaxf((st.y + st.w) * (1.f / 64.f) - mean * mean, 0.f), rstd = rsqrtf(var + LNX_EPS);
                    const float bo = bonus[(size_t)row * 16 + hd];
                    const bf16x8 yv = *(const bf16x8*)(Y + (size_t)row * DM + col), vv = *(const bf16x8*)(V + (size_t)row * DM + col);
                    const f32x4 g0 = acc[ai][bj][m][0], g1 = acc[ai][bj][m][1];
                    float o[8];
#pragma unroll
                    for (int c = 0; c < 4; ++c) {
                        o[c] = ((bf2f((bf16_t)yv[c]) - mean) * rstd * w0[c] + c0[c] + bo * bf2f((bf16_t)vv[c])) * g0[c];
                        o[4 + c] = ((bf2f((bf16_t)yv[4 + c]) - mean) * rstd * w1[c] + c1[c] + bo * bf2f((bf16_t)vv[4 + c])) * g1[c];
                    }
                    u32x4 w; w.x = pk2(o[0], o[1]); w.y = pk2(o[2], o[3]); w.z = pk2(o[4], o[5]); w.w = pk2(o[6], o[7]);
                    *(u32x4*)(AO + (size_t)row * DM + col) = w;
                }
        }
    }
};

#define PG8_LAS __attribute__((address_space(3)))
constexpr int BM = 256, BK = 64, HALF = 128, HTB = HALF * BK * 2  , STAGE_BYTES = 8 * HTB;
__host__ __device__ __forceinline__ int lds_byte(int r, int c) { const int st = (r >> 4) * 2 + (c >> 5), rr = r & 15, cc = c & 31, ob = rr * 64 + cc * 2; return st * 1024 + (ob ^ (((ob >> 9) & 1) << 5)); }
__host__ __device__ __forceinline__ void stage_rc(int b, int& R, int& C) { const int st = b / 1024, sb = b % 1024, swz = sb ^ (((sb >> 9) & 1) << 5); R = (st >> 1) * 16 + swz / 64; C = (st & 1) * 32 + (swz % 64) / 2; }
__host__ __device__ __forceinline__ int perm32(int rho) { const int n = rho >> 4, i = rho & 15; return 8 * (i >> 2) + 4 * n + (i & 3); }
template <class Epi, bool ALIGN_EPI = true, bool SP2 = true>
__device__ __forceinline__ void gemm_fast(PG8_LAS unsigned char* lds, const Gemm g, const Epi& E) {
    StaticOrder S; S.init(g.M, g.N, gridDim.x, blockIdx.x);
    const int tid = opaque_tid(), wid = __builtin_amdgcn_readfirstlane(tid >> 6), lane = tid & 63, wr = wid >> 2, wc = wid & 3, fr = lane & 15, fq = lane >> 4;
    int K_ = g.K; asm volatile("" : "+s"(K_));
    const int K = K_, nt = K / BK;
    unsigned voffA[2], voffB[2];
#pragma unroll
    for (int i = 0; i < 2; ++i) { int R, C; stage_rc(tid * 16 + i * 8192, R, C); const int Rb = Epi::PERM ? ((R & ~31) + perm32(R & 31)) : R;
        voffA[i] = (unsigned)(R * K + C) * 2u; voffB[i] = (unsigned)(Rb * K + C) * 2u; }
    const size_t kstep = (size_t)(BK * 2);
    const size_t hstep = (size_t)HALF * K * 2;
    const size_t tstep = 2 * hstep;
    const unsigned ldsw = (unsigned)wid * 1024u;
    const int aoff = lds_byte(wr * 64 + fr, fq * 8), boff = lds_byte(wc * 32 + fr, fq * 8);
#define PG8_SA(b, h) (((b) * 2 + (h)) * HTB)
#define PG8_SB(b, h) ((4 + (b) * 2 + (h)) * HTB)
#define PG8_STAGE(bufoff, gbase, voff) do { _Pragma("unroll") for (int _i = 0; _i < 2; ++_i) \
        __builtin_amdgcn_global_load_lds((const unsigned*)((const char*)(gbase) + (voff)[_i]), (PG8_LAS unsigned*)(lds + (bufoff) + ldsw + _i * 8192), 16, 0, 0); } while (0)
#define PG8_LDA(dst, b, h) do { _Pragma("unroll") for (int m = 0; m < 4; ++m) _Pragma("unroll") for (int k = 0; k < 2; ++k) dst[m][k] = *(const PG8_LAS bf16x8*)(lds + PG8_SA(b, h) + aoff + m * 2048 + k * 1024); } while (0)
#define PG8_LDB(dst, b, h) do { _Pragma("unroll") for (int n = 0; n < 2; ++n) _Pragma("unroll") for (int k = 0; k < 2; ++k) dst[n][k] = *(const PG8_LAS bf16x8*)(lds + PG8_SB(b, h) + boff + n * 2048 + k * 1024); } while (0)
#define PG8_MMA(ai, bj, At, Bt) do { __builtin_amdgcn_s_setprio(1); _Pragma("unroll") for (int m = 0; m < 4; ++m) _Pragma("unroll") for (int n = 0; n < 2; ++n) _Pragma("unroll") for (int k = 0; k < 2; ++k) \
        acc[ai][bj][m][n] = __builtin_amdgcn_mfma_f32_16x16x32_bf16(Bt[n][k], At[m][k], acc[ai][bj][m][n], 0, 0, 0); __builtin_amdgcn_s_setprio(0); } while (0)
#define PG8_WAIT_V(n) asm volatile("s_waitcnt vmcnt(" #n ")" ::: "memory")
#define PG8_WAIT_L(n) asm volatile("s_waitcnt lgkmcnt(" #n ")" ::: "memory")
#define PG8_BAR __builtin_amdgcn_s_barrier()
#define PG8_SCHED __builtin_amdgcn_sched_barrier(0)
    Unit cur, nxt; int ui = 0;
    if (!S.next(0, cur)) return;
    AccT acc;
#pragma unroll
    for (int a = 0; a < 2; ++a)
#pragma unroll
        for (int b = 0; b < 2; ++b)
#pragma unroll
            for (int m = 0; m < 4; ++m)
#pragma unroll
                for (int n = 0; n < 2; ++n) acc[a][b][m][n] = (f32x4){0.f, 0.f, 0.f, 0.f};
    bf16x8 At[4][2], B0[2][2], B1[2][2];
    const char* cA = (const char*)(cur.pn >= g.pn2 ? g.A2 : g.A) + (size_t)cur.pm * tstep; const char* cB = (const char*)g.Bt + (size_t)cur.pn * tstep;
    if constexpr (SP2) {
        PG8_STAGE(PG8_SB(0, 0), cB, voffB); PG8_STAGE(PG8_SB(0, 1), cB + hstep, voffB); PG8_STAGE(PG8_SA(0, 0), cA, voffA); PG8_STAGE(PG8_SA(0, 1), cA + hstep, voffA);
        if (wr == 1) PG8_BAR;
        PG8_WAIT_V(2); PG8_BAR;
        PG8_STAGE(PG8_SB(1, 0), cB + kstep, voffB); PG8_STAGE(PG8_SA(1, 0), cA + kstep, voffA); PG8_STAGE(PG8_SB(1, 1), cB + hstep + kstep, voffB);
        PG8_WAIT_V(6); PG8_BAR;
    } else {
        PG8_STAGE(PG8_SB(0, 0), cB, voffB); PG8_STAGE(PG8_SA(0, 0), cA, voffA); PG8_STAGE(PG8_SB(0, 1), cB + hstep, voffB); PG8_STAGE(PG8_SA(0, 1), cA + hstep, voffA);
        if (wr == 1) PG8_BAR;
        PG8_WAIT_V(4); PG8_BAR;
        PG8_STAGE(PG8_SB(1, 0), cB + kstep, voffB); PG8_STAGE(PG8_SA(1, 0), cA + kstep, voffA); PG8_STAGE(PG8_SB(1, 1), cB + hstep + kstep, voffB);
        PG8_WAIT_V(6); PG8_BAR;
    }
    for (;;) {
        const bool has_next = S.next(ui + 1, nxt);
        const char* nA = has_next ? (const char*)(nxt.pn >= g.pn2 ? g.A2 : g.A) + (size_t)nxt.pm * tstep : cA; const char* nB = has_next ? (const char*)g.Bt + (size_t)nxt.pn * tstep : cB;
        for (int t = 0; t < nt; t += 2) {
            const bool last = (t == nt - 2);
            const char* a1 = cA + (size_t)(t + 1) * kstep;
            const char* a2 = last ? nA : cA + (size_t)(t + 2) * kstep; const char* b2 = last ? nB : cB + (size_t)(t + 2) * kstep;
            const char* a3 = a2 + kstep; const char* b3 = b2 + kstep;
            if constexpr (SP2) {
            PG8_LDB(B0, 0, 0); PG8_LDB(B1, 0, 1); PG8_SCHED; PG8_LDA(At, 0, 0); PG8_STAGE(PG8_SA(1, 1), a1 + hstep, voffA);
            PG8_WAIT_V(8); PG8_WAIT_L(0); PG8_BAR; PG8_MMA(0, 0, At, B0); PG8_MMA(0, 1, At, B1); PG8_BAR; PG8_SCHED;
            PG8_LDA(At, 0, 1); PG8_STAGE(PG8_SB(0, 0), b2, voffB); PG8_STAGE(PG8_SB(0, 1), b2 + hstep, voffB); PG8_STAGE(PG8_SA(0, 0), a2, voffA);
            PG8_WAIT_V(8); PG8_WAIT_L(0); PG8_BAR; PG8_MMA(1, 0, At, B0); PG8_MMA(1, 1, At, B1); PG8_BAR; PG8_SCHED;
            PG8_LDB(B0, 1, 0); PG8_LDB(B1, 1, 1); PG8_SCHED; PG8_LDA(At, 1, 0); PG8_STAGE(PG8_SA(0, 1), a2 + hstep, voffA);
            PG8_WAIT_V(8); PG8_WAIT_L(0); PG8_BAR; PG8_MMA(0, 0, At, B0); PG8_MMA(0, 1, At, B1); PG8_BAR; PG8_SCHED;
            PG8_LDA(At, 1, 1); PG8_STAGE(PG8_SB(1, 0), b3, voffB); PG8_STAGE(PG8_SB(1, 1), b3 + hstep, voffB); PG8_STAGE(PG8_SA(1, 0), a3, voffA);
            PG8_WAIT_V(8); PG8_WAIT_L(0); PG8_BAR; PG8_MMA(1, 0, At, B0); PG8_MMA(1, 1, At, B1); PG8_BAR; PG8_SCHED;
            } else {
            PG8_LDB(B0, 0, 0); PG8_SCHED; PG8_LDA(At, 0, 0); PG8_STAGE(PG8_SA(1, 1), a1 + hstep, voffA);
            PG8_WAIT_L(8); PG8_BAR; PG8_WAIT_L(0); PG8_MMA(0, 0, At, B0); PG8_BAR; PG8_SCHED;
            PG8_LDB(B1, 0, 1); PG8_STAGE(PG8_SB(0, 0), b2, voffB);
            PG8_BAR; PG8_WAIT_L(0); PG8_MMA(0, 1, At, B1); PG8_BAR;
            PG8_LDA(At, 0, 1); PG8_STAGE(PG8_SA(0, 0), a2, voffA);
            PG8_BAR; PG8_WAIT_L(0); PG8_MMA(1, 0, At, B0); PG8_BAR; PG8_SCHED;
            PG8_STAGE(PG8_SB(0, 1), b2 + hstep, voffB);
            PG8_WAIT_V(6); PG8_BAR; PG8_MMA(1, 1, At, B1); PG8_BAR;
            PG8_LDB(B0, 1, 0); PG8_SCHED; PG8_LDA(At, 1, 0); PG8_STAGE(PG8_SA(0, 1), a2 + hstep, voffA);
            PG8_WAIT_L(8); PG8_BAR; PG8_WAIT_L(0); PG8_MMA(0, 0, At, B0); PG8_BAR; PG8_SCHED;
            PG8_LDB(B1, 1, 1); PG8_STAGE(PG8_SB(1, 0), b3, voffB);
            PG8_BAR; PG8_WAIT_L(0); PG8_MMA(0, 1, At, B1); PG8_BAR;
            PG8_LDA(At, 1, 1); PG8_STAGE(PG8_SA(1, 0), a3, voffA);
            PG8_BAR; PG8_WAIT_L(0); PG8_MMA(1, 0, At, B0); PG8_BAR; PG8_SCHED;
            PG8_STAGE(PG8_SB(1, 1), b3 + hstep, voffB);
            PG8_WAIT_V(6); PG8_BAR; PG8_MMA(1, 1, At, B1); PG8_BAR;
            }
        }
        if constexpr (ALIGN_EPI) { if (wr == 0) PG8_BAR; }
        E(acc, cur, wr, wc, fr, fq);
        if (!has_next) break;
#pragma unroll
        for (int a = 0; a < 2; ++a)
#pragma unroll
            for (int b = 0; b < 2; ++b)
#pragma unroll
                for (int m = 0; m < 4; ++m)
#pragma unroll
                    for (int n = 0; n < 2; ++n) acc[a][b][m][n] = (f32x4){0.f, 0.f, 0.f, 0.f};
        cur = nxt; cA = nA; cB = nB; ++ui;
        if constexpr (ALIGN_EPI) { if (wr == 1) PG8_BAR; }
    }
    PG8_WAIT_V(0);
    if constexpr (!ALIGN_EPI) { if (wr == 0) PG8_BAR; }
    PG8_BAR;
#undef PG8_SA
#undef PG8_SB
#undef PG8_STAGE
#undef PG8_LDA
#undef PG8_LDB
#undef PG8_MMA
#undef PG8_WAIT_V
#undef PG8_WAIT_L
#undef PG8_BAR
#undef PG8_SCHED
}

template <class Epi> __device__ __forceinline__ void gemm_phase(unsigned char* lds, const Gemm g, const Epi& E) {
#if FAST_GEMM
    gemm_fast<Epi>((PG8_LAS unsigned char*)lds, g, E);
#else
    gemm_naive<Epi>(g, E);
#endif
}

__device__ __forceinline__ void p2_naive(const Args& A, unsigned char* lds, size_t mask_off = OFF_MASK) {
    const int tid = opaque_tid(), lane = tid & 63, wave = tid >> 6;
    float* sc = (float*)lds; float* qf = sc + 2048; float* wf = qf + 512;
    const bf16_t* QI = WSP(bf16_t, OFF_QI); const bf16_t* KI = WSP(bf16_t, OFF_KI); const float* WI = WSP(float, OFF_WI); unsigned* MASK = WSP(unsigned, mask_off);
    for (int m = blockIdx.x; m < MTOK; m += gridDim.x) {
        const int t = m & (SEQ - 1), b0 = m - t, nk = t + 1;
        unsigned* mrow = MASK + (size_t)m * 64;
        if (t < 256) { if (tid < 64) { const int lo = tid * 32; mrow[tid] = (nk >= lo + 32) ? 0xffffffffu : (nk <= lo ? 0u : ((1u << (nk - lo)) - 1u)); } continue; }
        __syncthreads();
        qf[tid] = bf2f(QI[(size_t)m * 512 + tid]);
        if (tid < 8) wf[tid] = WI[(size_t)m * 8 + tid];
        __syncthreads();
        for (int s = tid; s < nk; s += NTHR) {
            const bf16_t* kr = KI + (size_t)(b0 + s) * 64; float kf[64];
#pragma unroll
            for (int c = 0; c < 8; ++c) { const bf16x8 kv = *(const bf16x8*)(kr + 8 * c);
#pragma unroll
                for (int e = 0; e < 8; ++e) kf[8 * c + e] = bf2f((bf16_t)kv[e]); }
            float score = 0.f;
#pragma unroll
            for (int h = 0; h < 8; ++h) { float d = 0.f;
#pragma unroll
                for (int e = 0; e < 64; ++e) d += qf[h * 64 + e] * kf[e];
                score += wf[h] * fmaxf(d, 0.f); }
            sc[s] = score;
        }
        __syncthreads();
#pragma unroll 1
        for (int j = 0; j < 4; ++j) {
            const int base = 512 * j + 64 * wave;
            if (base >= nk) { if (lane < 2) mrow[(base >> 5) + lane] = 0u; continue; }
            const int s = base + lane; const bool valid = s < nk; const float my = valid ? sc[s] : 0.f; int cnt = 0;
            for (int s2 = 0; s2 < nk; ++s2) { const float o = sc[s2]; cnt += ((o > my) || (o == my && s2 < s)) ? 1 : 0; }
            const unsigned long long bal = __ballot(valid && cnt < 256);
            if (lane == 0) { mrow[base >> 5] = (unsigned)bal; mrow[(base >> 5) + 1] = (unsigned)(bal >> 32); }
        }
    }
}

__device__ __forceinline__ void p3_naive(const Args& A, unsigned char* lds) {
    const int tid = opaque_tid(), lane = tid & 63, wave = tid >> 6;
    float* lg = (float*)lds; float* qf = lg + 2048; float* red = qf + 1024; unsigned* mw = (unsigned*)(red + 1024);
    bf16_t* QO = WSP(bf16_t, OFF_QO); const bf16_t* K = WSP(bf16_t, OFF_K); const bf16_t* V = WSP(bf16_t, OFF_V); const unsigned* MASK = WSP(unsigned, OFF_MASK);
    for (int m = blockIdx.x; m < MTOK; m += gridDim.x) {
        const int t = m & (SEQ - 1), b0 = m - t, nk = t + 1;
        __syncthreads();
        qf[tid] = bf2f(QO[(size_t)m * 1024 + tid]); qf[tid + 512] = bf2f(QO[(size_t)m * 1024 + 512 + tid]);
        if (tid < 64) mw[tid] = MASK[(size_t)m * 64 + tid];
        __syncthreads();
#pragma unroll 1
        for (int hd = 0; hd < 16; ++hd) {
            const int n = hd >> 2; float mx = -INFINITY;
            for (int s = tid; s < nk; s += NTHR) {
                float v = -INFINITY;
                if ((mw[s >> 5] >> (s & 31)) & 1u) {
                    const bf16_t* kr = K + (size_t)(b0 + s) * 256 + n * 64; float d = 0.f;
#pragma unroll
                    for (int c = 0; c < 8; ++c) { const bf16x8 kv = *(const bf16x8*)(kr + 8 * c);
#pragma unroll
                        for (int e = 0; e < 8; ++e) d += qf[hd * 64 + 8 * c + e] * bf2f((bf16_t)kv[e]); }
                    v = d;
                }
                lg[s] = v; mx = fmaxf(mx, v);
            }
            mx = block_max(mx, red, wave, lane);
            float sm = 0.f;
            for (int s = tid; s < nk; s += NTHR) { const float p = exp2f(lg[s] - mx); lg[s] = p; sm += p; }
            sm = block_sum(sm, red, wave, lane);
            float acc = 0.f;
            for (int s = wave; s < nk; s += NWAVES) { const float p = lg[s]; if (p != 0.f) acc += p * bf2f(V[(size_t)(b0 + s) * 256 + n * 64 + lane]); }
            __syncthreads();
            red[16 + wave * 64 + lane] = acc;
            __syncthreads();
            if (tid < 64) { float o = 0.f;
#pragma unroll
                for (int p = 0; p < NWAVES; ++p) o += red[16 + p * 64 + tid];
                QO[(size_t)m * 1024 + hd * 64 + tid] = (bf16_t)f2bf(o / sm); }
            __syncthreads();
        }
    }
}

__device__ __forceinline__ void p7_prep(const Args& A) {
    const int tid = opaque_tid(), lane = tid & 63, wave = tid >> 6;
    const int gw = blockIdx.x * NWAVES + wave, NGW = gridDim.x * NWAVES;
    const float* X = A.out; const float* g = A.in[IN_MIXN] + DM; const float* mu = A.in[IN_MU];
    bf16_t* XSR = WSP(bf16_t, OFF_XSR); bf16_t* XSK = WSP(bf16_t, OFF_XSK); bf16_t* XSV = WSP(bf16_t, OFF_XSV); bf16_t* H1 = WSP(bf16_t, OFF_H1);
    f32x4 gg[4], mr[4], mk[4], mv[4];
#pragma unroll
    for (int j = 0; j < 4; ++j) { gg[j] = ((const f32x4*)g)[lane + 64 * j]; mr[j] = ((const f32x4*)mu)[lane + 64 * j]; mk[j] = ((const f32x4*)(mu + DM))[lane + 64 * j]; mv[j] = ((const f32x4*)(mu + 2 * DM))[lane + 64 * j]; }
    for (int run = gw; run < MTOK / 16; run += NGW) {
        const int r0 = run * 16; f32x4 hp[4];
#pragma unroll 1
        for (int i = -1; i < 16; ++i) {
            const int row = r0 + i; f32x4 h[4];
            if (i < 0 && (r0 & (SEQ - 1)) == 0) {
#pragma unroll
                for (int j = 0; j < 4; ++j) hp[j] = (f32x4){0.f, 0.f, 0.f, 0.f};
                continue;
            }
            const f32x4* xr = (const f32x4*)(X + (size_t)row * DM) + lane; float s = 0.f;
#pragma unroll
            for (int j = 0; j < 4; ++j) { h[j] = xr[64 * j]; s += (h[j].x * h[j].x + h[j].y * h[j].y) + (h[j].z * h[j].z + h[j].w * h[j].w); }
            const float rs = rsqrtf(wave_sum(s) * (1.f / DM) + NORM_EPS);
#pragma unroll
            for (int j = 0; j < 4; ++j) h[j] = h[j] * rs * gg[j];
            if (i >= 0) {
#pragma unroll
                for (int j = 0; j < 4; ++j) {
                    const f32x4 xx = hp[j] - h[j];
                    const f32x4 a = h[j] + xx * mr[j], b = h[j] + xx * mk[j], c = h[j] + xx * mv[j];
                    const size_t off = (size_t)row * DM + 4 * lane + 256 * j;
                    u32x2 w; w.x = pk2(a.x, a.y); w.y = pk2(a.z, a.w); *(u32x2*)(XSR + off) = w;
                    w.x = pk2(b.x, b.y); w.y = pk2(b.z, b.w); *(u32x2*)(XSK + off) = w;
                    w.x = pk2(c.x, c.y); w.y = pk2(c.z, c.w); *(u32x2*)(XSV + off) = w;
                    w.x = pk2(h[j].x, h[j].y); w.y = pk2(h[j].z, h[j].w); *(u32x2*)(H1 + off) = w;
                }
            }
#pragma unroll
            for (int j = 0; j < 4; ++j) hp[j] = h[j];
        }
    }
}
__device__ __forceinline__ void p10_loramid(const Args& A) {
    const bf16_t* P = WSP(bf16_t, OFF_P); bf16_t* AW = WSP(bf16_t, OFF_AW); bf16_t* AA = WSP(bf16_t, OFF_AA); bf16_t* AG = WSP(bf16_t, OFF_AG);
    const size_t total = (size_t)MTOK * 512;
    for (size_t idx = (size_t)blockIdx.x * NTHR + threadIdx.x; idx < total; idx += (size_t)gridDim.x * NTHR) {
        const int m = (int)(idx >> 9), j = (int)(idx & 511); const bool first = (m & (SEQ - 1)) == 0;
        const bf16_t* p0 = P + (size_t)m * 768; const bf16_t* pm = p0 - 768;
        if (j < 128) {
            float v = 0.f; if (j < 64) { const float x = bf2f(p0[j]) + (first ? 0.f : bf2f(pm[64 + j])); const float e = __expf(-2.f * fabsf(x)); const float th = (1.f - e) / (1.f + e); v = x < 0.f ? -th : th; }
            AW[(size_t)m * 128 + j] = (bf16_t)f2bf(v);
        } else if (j < 256) {
            const int jj = j - 128; float v = 0.f; if (jj < 64) v = bf2f(p0[128 + jj]) + (first ? 0.f : bf2f(pm[192 + jj]));
            AA[(size_t)m * 128 + jj] = (bf16_t)f2bf(v);
        } else {
            const int jj = j - 256; float v = 0.f; if (jj < 160) { const float x = bf2f(p0[256 + jj]) + (first ? 0.f : bf2f(pm[416 + jj])); v = sigmoidf_(x); }
            AG[(size_t)m * 256 + jj] = (bf16_t)f2bf(v);
        }
    }
}
__device__ __forceinline__ void p12_naive(const Args& A, unsigned char* lds) {
    const int tid = opaque_tid(), lane = tid & 63, wave = tid >> 6;
    const int gw = blockIdx.x * NWAVES + wave, NGW = gridDim.x * NWAVES;
    float* sh = (float*)lds + wave * 320;
    const bf16_t* R = WSP(bf16_t, OFF_R); const bf16_t* KR = WSP(bf16_t, OFF_KR); const bf16_t* VV = WSP(bf16_t, OFF_VV); const bf16_t* E = WSP(bf16_t, OFF_E); const bf16_t* AS = WSP(bf16_t, OFF_A);
    bf16_t* Y = WSP(bf16_t, OFF_Y);
    for (int it = gw; it < BATCH * 16; it += NGW) {
        const int b = it >> 4, h = it & 15;
        float S[64];
#pragma unroll
        for (int j = 0; j < 64; ++j) S[j] = 0.f;
        const float kkw = A.in[IN_KK][h * 64 + lane], kaw = A.in[IN_KA][h * 64 + lane];
        const size_t base = (size_t)b * SEQ * DM + h * 64 + lane;
        bf16_t rn = R[base], kn = KR[base], vn = VV[base], en = E[base], an = AS[base];
#pragma unroll 1
        for (int t = 0; t < SEQ; ++t) {
            const float r = bf2f(rn), k = bf2f(kn), v = bf2f(vn), e = bf2f(en), a = bf2f(an);
            if (t + 1 < SEQ) { const size_t ix = base + (size_t)(t + 1) * DM; rn = R[ix]; kn = KR[ix]; vn = VV[ix]; en = E[ix]; an = AS[ix]; }
            float kk = k * kkw; const float ss = wave_sum(kk * kk); kk *= rsqrtf(fmaxf(ss, 1e-24f));
            const float kt = k * (1.f + (a - 1.f) * kaw), bb = kk * a, w = __expf(e);
            sh[lane] = -kk; sh[64 + lane] = w; sh[128 + lane] = bb; sh[192 + lane] = kt; sh[256 + lane] = r;
            LDS_WAIT();
            float sa = 0.f;
#pragma unroll
            for (int j = 0; j < 64; ++j) sa += S[j] * sh[j];
            float y = 0.f;
#pragma unroll
            for (int j = 0; j < 64; ++j) { S[j] = S[j] * sh[64 + j] + sa * sh[128 + j] + v * sh[192 + j]; y += S[j] * sh[256 + j]; }
            Y[base + (size_t)t * DM] = (bf16_t)f2bf(y);
            LDS_WAIT();
        }
    }
}
__device__ __forceinline__ void p12b_stats(const Args& A) {
    const int tid = opaque_tid(), lane = tid & 63, wave = tid >> 6;
    const int gw = blockIdx.x * NWAVES + wave, NGW = gridDim.x * NWAVES;
    const bf16_t* R = WSP(bf16_t, OFF_R); const bf16_t* KR = WSP(bf16_t, OFF_KR); const bf16_t* AS = WSP(bf16_t, OFF_A); const bf16_t* Y = WSP(bf16_t, OFF_Y);
    float* ST = WSP(float, OFF_STATS); float* BO = WSP(float, OFF_BONUS);
    for (int it = gw; it < MTOK * 16; it += NGW) {
        const int h = it & 15; const size_t ix = (size_t)(it >> 4) * DM + h * 64 + lane;
        const float y = bf2f(Y[ix]), r = bf2f(R[ix]), k = bf2f(KR[ix]), a = bf2f(AS[ix]);
        const float kt = k * (1.f + (a - 1.f) * A.in[IN_KA][h * 64 + lane]);
        const float s1 = wave_sum(y), s2 = wave_sum(y * y), bo = wave_sum(r * kt * A.in[IN_RK][h * 64 + lane]);
        if (lane == 0) { *(f32x4*)(ST + (size_t)it * 4) = (f32x4){s1, s2, 0.f, 0.f}; BO[it] = bo; }
    }
}

template <int CTRL> __device__ __forceinline__ float dppf(float v) { return __int_as_float(__builtin_amdgcn_mov_dpp(__float_as_int(v), CTRL, 0xF, 0xF, false)); }
template <int CTRL> __device__ __forceinline__ int dppi(int v) { return __builtin_amdgcn_mov_dpp(v, CTRL, 0xF, 0xF, false); }
__device__ __forceinline__ float row16_allsum(float v) { v += dppf<0xB1>(v); v += dppf<0x4E>(v); v += dppf<0x124>(v); v += dppf<0x128>(v); return v; }
__device__ __forceinline__ float row16_allsum_fused(float v) {
    float a, b, c, d;
    asm("s_nop 1\n\tv_add_f32_dpp %0, %1, %1 quad_perm:[1,0,3,2] row_mask:0xf bank_mask:0xf" : "=v"(a) : "v"(v));
    asm("s_nop 1\n\tv_add_f32_dpp %0, %1, %1 quad_perm:[2,3,0,1] row_mask:0xf bank_mask:0xf" : "=v"(b) : "v"(a));
    asm("s_nop 1\n\tv_add_f32_dpp %0, %1, %1 row_ror:4 row_mask:0xf bank_mask:0xf" : "=v"(c) : "v"(b));
    asm("s_nop 1\n\tv_add_f32_dpp %0, %1, %1 row_ror:8 row_mask:0xf bank_mask:0xf" : "=v"(d) : "v"(c));
    return d;
}
__device__ __forceinline__ int row16_allsum_i(int v) { v += dppi<0xB1>(v); v += dppi<0x4E>(v); v += dppi<0x124>(v); v += dppi<0x128>(v); return v; }
__device__ __forceinline__ int wave_allsum_i(int v) {
    v = row16_allsum_i(v);
    return __builtin_amdgcn_readlane(v, 0) + __builtin_amdgcn_readlane(v, 16) + __builtin_amdgcn_readlane(v, 32) + __builtin_amdgcn_readlane(v, 48);
}

constexpr int P2_LD = 2052;
__device__ __forceinline__ void p2_fast(const Args& A, unsigned char* lds) {
    const int tid = opaque_tid(), lane = tid & 63, wave = __builtin_amdgcn_readfirstlane(tid >> 6), fr = lane & 15, fq = lane >> 4;
    float* sc = (float*)lds;
    const bf16_t* QI = WSP(bf16_t, OFF_QI); const bf16_t* KI = WSP(bf16_t, OFF_KI); const float* WI = WSP(float, OFF_WI); unsigned* MASK = WSP(unsigned, OFF_MASK);
    for (int it = blockIdx.x; it < 1024; it += gridDim.x) {
        const int q = it >> 8, c = it & 255, b = c & 7, s5 = c >> 3;
        const int tt = (q == 0) ? s5 : (q == 1) ? 63 - s5 : (q == 2) ? 64 + s5 : 127 - s5;
        const int t0 = 16 * tt, m0 = b * SEQ + t0;
        if (t0 >= 256 - 15) {
            bf16x8 qf[8][2]; float wv[8];
#pragma unroll
            for (int h = 0; h < 8; ++h) {
#pragma unroll
                for (int ks = 0; ks < 2; ++ks) qf[h][ks] = *(const bf16x8*)(QI + (size_t)(m0 + fr) * 512 + h * 64 + ks * 32 + fq * 8);
                wv[h] = WI[(size_t)(m0 + fr) * 8 + h];
            }
            const bf16_t* kbase = KI + (size_t)(b * SEQ + fr) * 64 + fq * 8;
            bf16x8 ka0 = *(const bf16x8*)(kbase + (size_t)wave * 16 * 64), ka1 = *(const bf16x8*)(kbase + (size_t)wave * 16 * 64 + 32);
#pragma unroll 1
            for (int kt = wave; kt <= tt; kt += NWAVES) {
                const bf16x8 a0 = ka0, a1 = ka1;
                if (kt + NWAVES <= tt) { ka0 = *(const bf16x8*)(kbase + (size_t)(kt + NWAVES) * 16 * 64); ka1 = *(const bf16x8*)(kbase + (size_t)(kt + NWAVES) * 16 * 64 + 32); }
                f32x4 acc = {0.f, 0.f, 0.f, 0.f};
#pragma unroll
                for (int h = 0; h < 8; ++h) {
                    f32x4 d = __builtin_amdgcn_mfma_f32_16x16x32_bf16(a0, qf[h][0], (f32x4){0.f, 0.f, 0.f, 0.f}, 0, 0, 0);
                    d = __builtin_amdgcn_mfma_f32_16x16x32_bf16(a1, qf[h][1], d, 0, 0, 0);
#pragma unroll
                    for (int e = 0; e < 4; ++e) acc[e] += wv[h] * fmaxf(d[e], 0.f);
                }
                *(f32x4*)(sc + fr * P2_LD + kt * 16 + 4 * fq) = acc;
            }
        }
        __syncthreads();
#pragma unroll 1
        for (int rr = 2 * wave; rr < 2 * wave + 2; ++rr) {
            const int t = t0 + rr, nk = t + 1;
            unsigned long long* mrow = (unsigned long long*)(MASK + (size_t)(m0 + rr) * 64);
            if (t < 256) {
                if (lane < 32) { const int lo = lane * 64; mrow[lane] = (nk >= lo + 64) ? ~0ull : (nk <= lo ? 0ull : ((1ull << (nk - lo)) - 1ull)); }
                continue;
            }
            const int nj = (nk + 63) >> 6;
            float x[32];
            const float* srow = sc + rr * P2_LD + lane;
#pragma unroll
            for (int j = 0; j < 32; ++j) x[j] = (j < nj && lane + 64 * j < nk) ? srow[64 * j] : -INFINITY;
            float mx = x[0], mn = (lane < nk) ? x[0] : INFINITY;
#pragma unroll
            for (int j = 1; j < 32; ++j) { mx = fmaxf(mx, x[j]); mn = fminf(mn, (j < nj && lane + 64 * j < nk) ? x[j] : INFINITY); }
            mx = wave_max(mx); mn = -wave_max(-mn);
            mx = __int_as_float(__builtin_amdgcn_readfirstlane(__float_as_int(mx))); mn = __int_as_float(__builtin_amdgcn_readfirstlane(__float_as_int(mn)));
#define P2_COUNT_GE(thr, out) do { int c_ = 0; \
                _Pragma("unroll") for (int g_ = 0; g_ < 4; ++g_) if (nj > 8 * g_) { _Pragma("unroll") for (int j_ = 0; j_ < 8; ++j_) c_ += (x[8 * g_ + j_] >= (thr)) ? 1 : 0; } \
                (out) = wave_allsum_i(c_); } while (0)
            float lo = mn, hi = mx, thr = 0.f; int c_hi; bool exact = false;
            P2_COUNT_GE(mx, c_hi);
            if (c_hi >= 256) { lo = mx; c_hi = 0; }
            else {
#pragma unroll 1
                for (;;) {
                    const float mid = lo + (hi - lo) * 0.5f;
                    if (!(mid > lo && mid < hi)) break;
                    int cm; P2_COUNT_GE(mid, cm);
                    if (cm == 256) { exact = true; thr = mid; break; }
                    if (cm > 256) lo = mid; else { hi = mid; c_hi = cm; }
                }
            }
            unsigned long long mine = 0ull;
            if (exact) {
#pragma unroll
                for (int j = 0; j < 32; ++j) { const unsigned long long bal = __ballot(x[j] >= thr); if (lane == j) mine = bal; }
            } else {
                int need = 256 - c_hi;
#pragma unroll
                for (int j = 0; j < 32; ++j) {
                    const bool eq = (x[j] == lo); const unsigned long long beq = __ballot(eq);
                    const int pre = __builtin_amdgcn_mbcnt_hi((unsigned)(beq >> 32), __builtin_amdgcn_mbcnt_lo((unsigned)beq, 0));
                    const unsigned long long bal = __ballot((x[j] > lo) || (eq && pre < need));
                    need -= __popcll(beq); need = need < 0 ? 0 : need;
                    if (lane == j) mine = bal;
                }
            }
            if (lane < 32) mrow[lane] = mine;
#undef P2_COUNT_GE
        }
        __syncthreads();
    }
}

constexpr int SC_TC = 32, SC_BUF_F = 5 * SC_TC * 64 + SC_TC * 32;
__device__ __forceinline__ void p12_fast(const Args& A, unsigned char* lds) {
    const int tid = opaque_tid(), lane = tid & 63, wave = __builtin_amdgcn_readfirstlane(tid >> 6);
    const int kq = lane & 15, row = 4 * wave + (lane >> 4), tl = tid >> 4;
    float* fl = (float*)lds; float* ybuf = fl + 2 * SC_BUF_F;
    const bf16_t* R = WSP(bf16_t, OFF_R); const bf16_t* KR = WSP(bf16_t, OFF_KR); const bf16_t* VV = WSP(bf16_t, OFF_VV); const bf16_t* E = WSP(bf16_t, OFF_E); const bf16_t* AS = WSP(bf16_t, OFF_A);
    bf16_t* Y = WSP(bf16_t, OFF_Y); float* ST = WSP(float, OFF_STATS); float* BO = WSP(float, OFF_BONUS);
    for (int it = blockIdx.x; it < BATCH * 16 * 2; it += gridDim.x) {
        const int half = it & 1, h = (it >> 1) & 15, b = it >> 5;
        const f32x4 kkw = *(const f32x4*)(A.in[IN_KK] + h * 64 + 4 * kq), kaw = *(const f32x4*)(A.in[IN_KA] + h * 64 + 4 * kq), rkw = *(const f32x4*)(A.in[IN_RK] + h * 64 + 4 * kq);
        const size_t gbase = ((size_t)b * SEQ + tl) * DM + h * 64 + 4 * kq;
        u32x2 pr, pk, pv, pe, pa;
#define SC_PREFETCH(c) do { const size_t gi_ = gbase + (size_t)(c) * SC_TC * DM; pr = *(const u32x2*)(R + gi_); pk = *(const u32x2*)(KR + gi_); pv = *(const u32x2*)(VV + gi_); pe = *(const u32x2*)(E + gi_); pa = *(const u32x2*)(AS + gi_); } while (0)
#define SC_UNPK(p, o) do { o[0] = __uint_as_float(p.x << 16); o[1] = __uint_as_float(p.x & 0xffff0000u); o[2] = __uint_as_float(p.y << 16); o[3] = __uint_as_float(p.y & 0xffff0000u); } while (0)
#define SC_DERIVE(c) do { float* bf_ = fl + ((c) & 1) * SC_BUF_F; float r_[4], k_[4], v_[4], e_[4], a_[4]; SC_UNPK(pr, r_); SC_UNPK(pk, k_); SC_UNPK(pv, v_); SC_UNPK(pe, e_); SC_UNPK(pa, a_); \
            f32x4 kkv_, w_, n_, b_, kt_, rr_; float ss_ = 0.f, bo_ = 0.f; \
            _Pragma("unroll") for (int i_ = 0; i_ < 4; ++i_) { kkv_[i_] = k_[i_] * kkw[i_]; ss_ += kkv_[i_] * kkv_[i_]; } \
            ss_ = row16_allsum(ss_); const float inv_ = rsqrtf(fmaxf(ss_, 1e-24f)); \
            _Pragma("unroll") for (int i_ = 0; i_ < 4; ++i_) { n_[i_] = -kkv_[i_] * inv_; b_[i_] = -n_[i_] * a_[i_]; kt_[i_] = k_[i_] * (1.f + (a_[i_] - 1.f) * kaw[i_]); w_[i_] = __expf(e_[i_]); rr_[i_] = r_[i_]; bo_ += r_[i_] * kt_[i_] * rkw[i_]; } \
            bo_ = row16_allsum(bo_); \
            if (half == 0 && kq == 0) BO[((size_t)b * SEQ + (c) * SC_TC + tl) * 16 + h] = bo_; \
            float* d_ = bf_ + tl * 64 + 4 * kq; *(f32x4*)(d_) = w_; *(f32x4*)(d_ + 2048) = n_; *(f32x4*)(d_ + 4096) = b_; *(f32x4*)(d_ + 6144) = kt_; *(f32x4*)(d_ + 8192) = rr_; \
            if ((kq >> 3) == half) *(f32x4*)(bf_ + 10240 + tl * 32 + 4 * (kq & 7)) = (f32x4){v_[0], v_[1], v_[2], v_[3]}; } while (0)
        __syncthreads();
        SC_PREFETCH(0); SC_DERIVE(0);
        __syncthreads();
        f32x4 S = {0.f, 0.f, 0.f, 0.f};
#pragma unroll 1
        for (int c = 0; c < SEQ / SC_TC; ++c) {
            if (c + 1 < SEQ / SC_TC) SC_PREFETCH(c + 1);
            const float* bf = fl + (c & 1) * SC_BUF_F + 4 * kq; const float* vb = fl + (c & 1) * SC_BUF_F + 10240 + row; float* yb = ybuf + (c & 1) * 1024 + row;
#define SC_LOAD(P, tt_) do { P##w = *(const f32x4*)(bf + (tt_) * 64); P##n = *(const f32x4*)(bf + (tt_) * 64 + 2048); P##b = *(const f32x4*)(bf + (tt_) * 64 + 4096); P##k = *(const f32x4*)(bf + (tt_) * 64 + 6144); P##r = *(const f32x4*)(bf + (tt_) * 64 + 8192); P##v = vb[(tt_) * 32]; } while (0)
#define SC_STEP(P, tt_) do { \
                const float p_ = (S.x * P##n.x + S.y * P##n.y) + (S.z * P##n.z + S.w * P##n.w); \
                const f32x4 tmp_ = S * P##w + P##v * P##k; \
                const float sa_ = row16_allsum_fused(p_); \
                S = tmp_ + sa_ * P##b; \
                const float qy_ = (S.x * P##r.x + S.y * P##r.y) + (S.z * P##r.z + S.w * P##r.w); \
                const float y_ = row16_allsum_fused(qy_); \
                if (kq == 0) yb[(tt_) * 32] = y_; } while (0)
            f32x4 Aw, An, Ab, Ak, Ar, Bw, Bn, Bb, Bk, Br; float Av, Bv;
            SC_LOAD(A, 0);
#pragma unroll 1
            for (int tt = 0; tt < SC_TC; tt += 2) {
                SC_LOAD(B, tt + 1);
                SC_STEP(A, tt);
                if (tt + 2 < SC_TC) SC_LOAD(A, tt + 2);
                SC_STEP(B, tt + 1);
            }
#undef SC_LOAD
#undef SC_STEP
            if (c + 1 < SEQ / SC_TC) SC_DERIVE(c + 1);
            __syncthreads();
            {
                const int j = tid & 15; const float* ys = ybuf + (c & 1) * 1024 + tl * 32 + 2 * j;
                const float y0 = ys[0], y1 = ys[1];
                const float s1 = row16_allsum(y0 + y1), s2 = row16_allsum(y0 * y0 + y1 * y1);
                const size_t m = (size_t)b * SEQ + c * SC_TC + tl;
                *(unsigned*)(Y + m * DM + h * 64 + 32 * half + 2 * j) = pk2(y0, y1);
                if (j == 0) *(f32x2*)(ST + (m * 16 + h) * 4 + 2 * half) = (f32x2){s1, s2};
            }
        }
#undef SC_PREFETCH
#undef SC_UNPK
#undef SC_DERIVE
    }
}

namespace attn_body {
using bf16=__hip_bfloat16;
using bf16x8=__attribute__((ext_vector_type(8)))short;
using s16x4=__attribute__((ext_vector_type(4)))short;
using f32x16=__attribute__((ext_vector_type(16)))float;
using u32x4=__attribute__((ext_vector_type(4)))unsigned;
constexpr int BATCH=8,NHEAD=16,SEQ=2048,D=64,DM=NHEAD*D,KP=256;
constexpr int NW=8,QBLK=32,QB=QBLK*NW,KVBLK=64,NQB=SEQ/QB;
constexpr int ATTN_PITCH=DM, ATTN_UNIT_ROWS=QB;
__device__ __forceinline__ int crow(int r,int hi){return (r&3)+8*(r>>2)+4*hi;}
#define SBAR() __builtin_amdgcn_sched_barrier(0)
__device__ __forceinline__ void bmask(f32x16&p0,f32x16&p1,unsigned long long mw,int hi){
  const float NEG=-INFINITY; const unsigned lo=(unsigned)mw>>(4*hi), hw=(unsigned)(mw>>32)>>(4*hi);
  #pragma unroll
  for(int r=0;r<16;++r){const int c=(r&3)+8*(r>>2); if(!((lo>>c)&1u))p0[r]=NEG; if(!((hw>>c)&1u))p1[r]=NEG;}
}

constexpr int NSLOT=3, SLOTB=8192;
constexpr int LDS_K=0, LDS_V=NSLOT*SLOTB, LDS_WS=2*NSLOT*SLOTB, LDS_OST=LDS_WS+NW*64*4, LDS_MSK=LDS_OST+NW*4096, LDS_BYTES=LDS_MSK+64*256;
constexpr float C2=0.125f*1.4426950408889634f;
__device__ __forceinline__ void glds16(const void*gsrc,unsigned lds_dst){unsigned keep;
  asm volatile("s_mov_b32 %0, m0\n\ts_mov_b32 m0, %2\n\ts_nop 0\n\tglobal_load_lds_dwordx4 %1, off\n\ts_mov_b32 m0, %0":"=&s"(keep):"v"(gsrc),"s"(lds_dst):"memory");}
__device__ __forceinline__ float max3f(float a,float b,float c){float r;asm("v_max3_f32 %0, %1, %2, %3":"=v"(r):"v"(a),"v"(b),"v"(c));return r;}
__device__ __forceinline__ float max2f(float a,float b){float r;asm("v_max_f32_e32 %0, %1, %2":"=v"(r):"v"(a),"v"(b));return r;}
__device__ __forceinline__ float fadd_s(float a,float b){float r;asm("v_add_f32_e32 %0, %1, %2":"=v"(r):"v"(a),"v"(b));return r;}
__device__ __forceinline__ float fsub_s(float a,float b){float r;asm("v_sub_f32_e32 %0, %1, %2":"=v"(r):"v"(a),"v"(b));return r;}
typedef float f32x2_t __attribute__((ext_vector_type(2))); typedef __bf16 bf16x2_t __attribute__((ext_vector_type(2)));
__device__ __forceinline__ unsigned cvtpk_s(float lo,float hi){f32x2_t v={lo,hi};bf16x2_t b=__builtin_convertvector(v,bf16x2_t);return __builtin_bit_cast(unsigned,b);}
#define WAIT_BAR(N) asm volatile("s_waitcnt vmcnt(" #N ") lgkmcnt(0)\n\ts_barrier":::"memory")

__device__ __forceinline__ void qkt(f32x16&p0,f32x16&p1,const char*Kslot,const bf16x8*qr,const f32x16&negm,int r32,int hi){
  const char*kb=Kslot+hi*1024+r32*16;
  #pragma unroll
  for(int d0=0;d0<4;++d0){
    const bf16x8 b0=*reinterpret_cast<const bf16x8*>(kb+d0*2048);
    const bf16x8 b1=*reinterpret_cast<const bf16x8*>(kb+d0*2048+512);
    if(d0==0){p0=__builtin_amdgcn_mfma_f32_32x32x16_bf16(b0,qr[0],negm,0,0,0);p1=__builtin_amdgcn_mfma_f32_32x32x16_bf16(b1,qr[0],negm,0,0,0);}
    else{p0=__builtin_amdgcn_mfma_f32_32x32x16_bf16(b0,qr[d0],p0,0,0,0);p1=__builtin_amdgcn_mfma_f32_32x32x16_bf16(b1,qr[d0],p1,0,0,0);}}
}
typedef __attribute__((address_space(3))) const char* lds_cptr;
typedef short v4i16_t __attribute__((ext_vector_type(4)));
__device__ __forceinline__ void kload8(bf16x8*kf,lds_cptr kp){
  kf[0]=*(const __attribute__((address_space(3))) bf16x8*)(kp);      kf[1]=*(const __attribute__((address_space(3))) bf16x8*)(kp+512);
  kf[2]=*(const __attribute__((address_space(3))) bf16x8*)(kp+2048); kf[3]=*(const __attribute__((address_space(3))) bf16x8*)(kp+2560);
  kf[4]=*(const __attribute__((address_space(3))) bf16x8*)(kp+4096); kf[5]=*(const __attribute__((address_space(3))) bf16x8*)(kp+4608);
  kf[6]=*(const __attribute__((address_space(3))) bf16x8*)(kp+6144); kf[7]=*(const __attribute__((address_space(3))) bf16x8*)(kp+6656);
}
__device__ __forceinline__ void kload2(bf16x8*kf,lds_cptr kp,int j){ kf[2*j]=*(const __attribute__((address_space(3))) bf16x8*)(kp+j*2048); kf[2*j+1]=*(const __attribute__((address_space(3))) bf16x8*)(kp+j*2048+512); }
__device__ __forceinline__ s16x4 vtr(lds_cptr p){ return __builtin_bit_cast(s16x4,__builtin_amdgcn_ds_read_tr16_b64_v4i16((__attribute__((address_space(3))) v4i16_t*)p)); }
__device__ __forceinline__ float rowmax(const f32x16&p0,const f32x16&p1){
  float a=max3f(p0[0],p0[1],p1[0]),b=max3f(p0[2],p0[3],p1[1]);a=max3f(a,p1[2],p1[3]);
  #pragma unroll
  for(int r=4;r<16;r+=4){a=max3f(a,p0[r],p0[r+1]);b=max3f(b,p0[r+2],p0[r+3]);a=max3f(a,p1[r],p1[r+1]);b=max3f(b,p1[r+2],p1[r+3]);}
  const float m=max2f(a,b);
  auto rr=__builtin_amdgcn_permlane32_swap(__float_as_uint(m),__float_as_uint(m),false,false);
  return max2f(__uint_as_float(rr[0]),__uint_as_float(rr[1]));
}
__device__ __forceinline__ void pv(f32x16*o,int vb,bf16x8 pa0,bf16x8 pa1,bf16x8 pa2,bf16x8 pa3){
  #pragma unroll
  for(int d0=0;d0<2;++d0){s16x4 lo[4],hi[4];
    #pragma unroll
    for(int ks=0;ks<4;++ks){
      asm volatile("ds_read_b64_tr_b16 %0,%1 offset:%c2":"=&v"(lo[ks]):"v"(vb),"i"(d0*4096+ks*1024):"memory");
      asm volatile("ds_read_b64_tr_b16 %0,%1 offset:%c2":"=&v"(hi[ks]):"v"(vb),"i"(d0*4096+ks*1024+512):"memory");}
    asm volatile("s_waitcnt lgkmcnt(0)":::"memory");SBAR();
    #define PK(k) (bf16x8){lo[k][0],lo[k][1],lo[k][2],lo[k][3],hi[k][0],hi[k][1],hi[k][2],hi[k][3]}
    o[d0]=__builtin_amdgcn_mfma_f32_32x32x16_bf16(pa0,PK(0),o[d0],0,0,0);
    o[d0]=__builtin_amdgcn_mfma_f32_32x32x16_bf16(pa1,PK(1),o[d0],0,0,0);
    o[d0]=__builtin_amdgcn_mfma_f32_32x32x16_bf16(pa2,PK(2),o[d0],0,0,0);
    o[d0]=__builtin_amdgcn_mfma_f32_32x32x16_bf16(pa3,PK(3),o[d0],0,0,0);
    #undef PK
  }
}

#ifndef ATTN_STORE16
#define ATTN_STORE16(p,v) (*(u32x4*)(p)=(v))
#endif
template<int THRL> __device__ __forceinline__ void attn_unit(int b,int n,int qt,const bf16*Q,const bf16*__restrict__ K,const bf16*__restrict__ V,bf16*O,const unsigned*__restrict__ MASK,char*shm){
  const int tid=opaque_tid(),lane=tid&63,r32=lane&31,hi=lane>>5; const int wid=__builtin_amdgcn_readfirstlane(tid>>6);
  const long rowbase=(long)b*SEQ; const int q0=qt*64;
  const int hq=4*n+(wid>>1), tok0=q0+32*(wid&1);
  const bf16*Qw=Q+(rowbase+tok0)*DM+hq*D;
  const bf16*Kh=K+rowbase*KP+n*D,*Vh=V+rowbase*KP+n*D;
  const unsigned lds0=(unsigned)(uintptr_t)shm;
  float*wsf=(float*)(shm+LDS_WS)+wid*64;
  const bf16*ksrc=Kh+(long)lane*KP+wid*8;
  const bf16*vsrc=Vh+(long)(16*(wid&3)+(lane>>2))*KP+(wid>>2)*32+(lane&3)*8;
  const unsigned kdst=lds0+LDS_K+wid*1024, vdst=lds0+LDS_V+wid*1024;
  #define DMA_K(t,slot) glds16(ksrc+(long)(t)*KVBLK*KP,(unsigned)__builtin_amdgcn_readfirstlane(kdst+(slot)))
  #define DMA_V(t,slot) glds16(vsrc+(long)(t)*KVBLK*KP,(unsigned)__builtin_amdgcn_readfirstlane(vdst+(slot)))
  const int vb0=(int)(lds0+LDS_V)+((lane>>4)&1)*32+(lane&3)*8+(4*hi+((lane&15)>>2))*64;
  const char*Kbase=shm+LDS_K; bf16x8 kf[8];
  const lds_cptr shm3=(lds_cptr)shm; const lds_cptr kp0=shm3+LDS_K+hi*1024+r32*16; const lds_cptr vp0=shm3+LDS_V+((lane>>4)&1)*32+(lane&3)*8+(4*hi+((lane&15)>>2))*64;
  const int nt0=qt+1; const int NT=nt0<4?4:((nt0+1)&~1);
  DMA_K(0,0);DMA_V(0,0);DMA_K(1,SLOTB);
  bf16x8 qr[4];
  #pragma unroll
  for(int d0=0;d0<4;++d0)qr[d0]=*reinterpret_cast<const bf16x8*>(&Qw[(long)r32*DM+d0*16+hi*8]);
  { const int tk=tid>>3,pc=tid&7; const u32x4*ms=(const u32x4*)(MASK+((size_t)(rowbase+q0+tk))*64+pc*8); const u32x4 m0=ms[0],m1=ms[1];
    __attribute__((address_space(3))) u32x4*md=(__attribute__((address_space(3))) u32x4*)((__attribute__((address_space(3))) char*)shm+LDS_MSK+tk*256+pc*32); md[0]=m0; md[1]=m1; }
  const __attribute__((address_space(3))) unsigned long long*mskrow=(const __attribute__((address_space(3))) unsigned long long*)((__attribute__((address_space(3))) char*)shm+LDS_MSK+(32*(wid&1)+r32)*256);
  float mhat=0.f,l_reg=0.f;f32x16 o[2];o[0]=f32x16{};o[1]=f32x16{};f32x16 negm=f32x16{};asm volatile("":"+v"(negm));
  #define CMASK(P0,P1,t) bmask(P0,P1,mw_,hi)
  bool resc=false;
  #define START(P0,P1) do{ const float rm=max2f(rowmax(P0,P1),-1000.f); resc=false; \
    { const float dl=rm; mhat=fadd_s(mhat,dl); \
      _Pragma("unroll") for(int r=0;r<16;++r){P0[r]=fsub_s(P0[r],dl);P1[r]=fsub_s(P1[r],dl);} \
      _Pragma("unroll") for(int r=0;r<16;++r)negm[r]=-mhat; asm volatile("":"+v"(negm)); } \
    _Pragma("unroll") for(int r=0;r<16;++r)P0[r]=__builtin_amdgcn_exp2f(P0[r]); }while(0)
  #define RESC() do{ if(resc){ asm volatile("s_waitcnt lgkmcnt(0)":::"memory"); \
      _Pragma("unroll") for(int d_=0;d_<2;++d_) _Pragma("unroll") for(int r=0;r<16;++r)o[d_][r]*=wsf[crow(r,hi)]; } }while(0)
  f32x16 pA0,pA1,pB0,pB1;
  int sl_prev=0,sl_cur=0,sl_next=SLOTB;
  #define ROT() do{sl_prev=sl_cur;sl_cur=sl_next;sl_next=(sl_next==(NSLOT-1)*SLOTB)?0:sl_next+SLOTB;}while(0)
  DMA_K(2,2*SLOTB);
  WAIT_BAR(3);
  qkt(pA0,pA1,Kbase,qr,negm,r32,hi);asm volatile("s_nop 15\n\ts_nop 7":"+v"(pA0),"+v"(pA1));{const unsigned long long mw_=mskrow[0];CMASK(pA0,pA1,0);}
  START(pA0,pA1);
  _Pragma("unroll") for(int r=0;r<16;++r)pA1[r]=__builtin_amdgcn_exp2f(pA1[r]);
  WAIT_BAR(0);
  DMA_K(3,0);DMA_V(1,SLOTB);
  ROT();
  kload8(kf,kp0+sl_cur);
  WAIT_BAR(2);
  s16x4 vlo[8],vhi[8]; u32x4 pw0,pw1,pw2,pw3;
  #define PKW(P,B) cvtpk_s(P[B],P[B+1])
  #define PAF(k) __builtin_bit_cast(bf16x8,pw##k)
  #define VFR(i) (bf16x8){vlo[i][0],vlo[i][1],vlo[i][2],vlo[i][3],vhi[i][0],vhi[i][1],vhi[i][2],vhi[i][3]}
  #define PIN(x) asm volatile("":"+v"(x))
  #define MX3(a,b,c) __builtin_fmaxf(__builtin_fmaxf((a),(b)),(c))
  #define GAPA(MF,A0,A1,A2,A3,W0,W1,PW) do{ MF; sacc+=A0; sacc+=A1; sacc+=A2; sacc+=A3; PIN(sacc); W0; W1; PIN(PW); SBAR(); }while(0)
  #define EX(v) __builtin_amdgcn_exp2f(v)
  #define GAPB(MF,X,B) do{ MF; X[B]=EX(X[B]); X[B+1]=EX(X[B+1]); X[B+2]=EX(X[B+2]); X[B+3]=EX(X[B+3]); PIN(X); SBAR(); }while(0)
  #define VRD(i) do{ vlo[i]=vtr(vp_+(((i)>>2)*4096+((i)&3)*1024)); vhi[i]=vtr(vp_+(((i)>>2)*4096+((i)&3)*1024+512)); }while(0)
  #define KRD(G,j) do{ if(G){ kload2(kf,kp0+sl_next,j); SBAR(); } }while(0)
  #define STEP(C0,C1,P0,P1,t,GK,GV,GL) do{ SBAR(); \
    const lds_cptr vp_=vp0+sl_prev; const unsigned long long mw_=mskrow[(t)]; \
    VRD(0); SBAR(); float sacc=(P0[0]+P0[1]); \
    GAPA(C0=__builtin_amdgcn_mfma_f32_32x32x16_bf16(kf[0],qr[0],negm,0,0,0), P0[2],P0[3],P0[4],P0[5],     pw0[0]=PKW(P0,0), pw0[1]=PKW(P0,2), pw0); \
    VRD(4); SBAR(); GAPA(C1=__builtin_amdgcn_mfma_f32_32x32x16_bf16(kf[1],qr[0],negm,0,0,0), P0[6],P0[7],P0[8],P0[9],     pw0[2]=PKW(P0,4), pw0[3]=PKW(P0,6), pw0); \
    VRD(1); SBAR(); GAPA(C0=__builtin_amdgcn_mfma_f32_32x32x16_bf16(kf[2],qr[1],C0,0,0,0),   P0[10],P0[11],P0[12],P0[13], pw1[0]=PKW(P0,8), pw1[1]=PKW(P0,10), pw1); \
    VRD(5); SBAR(); GAPA(C1=__builtin_amdgcn_mfma_f32_32x32x16_bf16(kf[3],qr[1],C1,0,0,0),   P0[14],P0[15],P1[0],P1[1],   pw1[2]=PKW(P0,12),pw1[3]=PKW(P0,14), pw1); \
    VRD(2); SBAR(); GAPA(C0=__builtin_amdgcn_mfma_f32_32x32x16_bf16(kf[4],qr[2],C0,0,0,0),   P1[2],P1[3],P1[4],P1[5],     pw2[0]=PKW(P1,0), pw2[1]=PKW(P1,2), pw2); \
    VRD(6); SBAR(); GAPA(C1=__builtin_amdgcn_mfma_f32_32x32x16_bf16(kf[5],qr[2],C1,0,0,0),   P1[6],P1[7],P1[8],P1[9],     pw2[2]=PKW(P1,4), pw2[3]=PKW(P1,6), pw2); \
    VRD(3); SBAR(); GAPA(C0=__builtin_amdgcn_mfma_f32_32x32x16_bf16(kf[6],qr[3],C0,0,0,0),   P1[10],P1[11],P1[12],P1[13], pw3[0]=PKW(P1,8), pw3[1]=PKW(P1,10), pw3); \
    VRD(7); SBAR(); GAPA(C1=__builtin_amdgcn_mfma_f32_32x32x16_bf16(kf[7],qr[3],C1,0,0,0),   P1[14],P1[15],0.f,0.f,       pw3[2]=PKW(P1,12),pw3[3]=PKW(P1,14), pw3); \
    l_reg+=sacc; \
    if(GK){DMA_K((t)+3,sl_cur);} if(GV){DMA_V((t)+1,sl_next);} \
    CMASK(C0,C1,t); \
    { float a=MX3(C0[0],C0[1],C1[0]),b=MX3(C0[2],C0[3],C1[1]); a=MX3(a,C1[2],C1[3]); \
      _Pragma("unroll") for(int r=4;r<16;r+=4){a=MX3(a,C0[r],C0[r+1]);b=MX3(b,C0[r+2],C0[r+3]);a=MX3(a,C1[r],C1[r+1]);b=MX3(b,C1[r+2],C1[r+3]);} \
      float rm=__builtin_fmaxf(a,b); { auto rr=__builtin_amdgcn_permlane32_swap(__float_as_uint(rm),__float_as_uint(rm),false,false); rm=__builtin_fmaxf(__uint_as_float(rr[0]),__uint_as_float(rr[1])); } \
      resc=false; \
      if(__builtin_expect(__any(rm>(float)THRL),0)){ const float dl=__builtin_fmaxf(rm,0.f); mhat+=dl; \
        _Pragma("unroll") for(int r=0;r<16;++r){C0[r]-=dl;C1[r]-=dl;} \
        _Pragma("unroll") for(int r=0;r<16;++r)negm[r]=-mhat; asm volatile("":"+v"(negm)); \
        const float f=__builtin_amdgcn_exp2f(-dl); l_reg*=f; if(hi==0)wsf[r32]=f; resc=true; } } \
    SBAR(); \
    GAPB(o[0]=__builtin_amdgcn_mfma_f32_32x32x16_bf16(PAF(0),VFR(0),o[0],0,0,0), C0,0); \
    GAPB(o[1]=__builtin_amdgcn_mfma_f32_32x32x16_bf16(PAF(0),VFR(4),o[1],0,0,0), C0,4); \
    KRD(GL,0); GAPB(o[0]=__builtin_amdgcn_mfma_f32_32x32x16_bf16(PAF(1),VFR(1),o[0],0,0,0), C0,8); \
    KRD(GL,1); GAPB(o[1]=__builtin_amdgcn_mfma_f32_32x32x16_bf16(PAF(1),VFR(5),o[1],0,0,0), C0,12); \
    KRD(GL,2); GAPB(o[0]=__builtin_amdgcn_mfma_f32_32x32x16_bf16(PAF(2),VFR(2),o[0],0,0,0), C1,0); \
    KRD(GL,3); GAPB(o[1]=__builtin_amdgcn_mfma_f32_32x32x16_bf16(PAF(2),VFR(6),o[1],0,0,0), C1,4); \
    GAPB(o[0]=__builtin_amdgcn_mfma_f32_32x32x16_bf16(PAF(3),VFR(3),o[0],0,0,0), C1,8); \
    GAPB(o[1]=__builtin_amdgcn_mfma_f32_32x32x16_bf16(PAF(3),VFR(7),o[1],0,0,0), C1,12); \
    }while(0)
  int t=1;
  for(;t+5<NT;t+=2){
    STEP(pB0,pB1,pA0,pA1,t,true,true,true);     WAIT_BAR(2); RESC(); ROT();
    STEP(pA0,pA1,pB0,pB1,t+1,true,true,true);   WAIT_BAR(2); RESC(); ROT();
  }
  #define ENDW(tt) do{ if((tt)+3<NT){WAIT_BAR(2);} else if((tt)+2<NT){WAIT_BAR(1);} else {WAIT_BAR(0);} }while(0)
  for(;t+1<NT;t+=2){
    STEP(pB0,pB1,pA0,pA1,t,(t+3<NT),(t+1<NT),(t+1<NT));       ENDW(t);   RESC(); ROT();
    STEP(pA0,pA1,pB0,pB1,t+1,(t+4<NT),(t+2<NT),(t+2<NT));     ENDW(t+1); RESC(); ROT();
  }
  STEP(pB0,pB1,pA0,pA1,NT-1,false,false,false); RESC();
  { float sacc=pB0[0]+pB0[1]; _Pragma("unroll") for(int r=2;r<16;++r)sacc+=pB0[r]; _Pragma("unroll") for(int r=0;r<16;++r)sacc+=pB1[r]; l_reg+=sacc;
    pw0=(u32x4){PKW(pB0,0),PKW(pB0,2),PKW(pB0,4),PKW(pB0,6)};pw1=(u32x4){PKW(pB0,8),PKW(pB0,10),PKW(pB0,12),PKW(pB0,14)};pw2=(u32x4){PKW(pB1,0),PKW(pB1,2),PKW(pB1,4),PKW(pB1,6)};pw3=(u32x4){PKW(pB1,8),PKW(pB1,10),PKW(pB1,12),PKW(pB1,14)};
    SBAR(); pv(o,vb0+sl_cur,PAF(0),PAF(1),PAF(2),PAF(3)); }
  #undef PKW
  #undef PAF
  #undef VFR
  #undef PIN
  #undef MX3
  #undef GAPA
  #undef GAPB
  #undef EX
  #undef VRD
  #undef KRD
  #undef STEP
  #undef ENDW
  {auto rr=__builtin_amdgcn_permlane32_swap(__float_as_uint(l_reg),__float_as_uint(l_reg),false,false);l_reg=__uint_as_float(rr[0])+__uint_as_float(rr[1]);}
  if(hi==0)wsf[32+r32]=l_reg;asm volatile("s_waitcnt lgkmcnt(0)":::"memory");
  float rli[16];
  #pragma unroll
  for(int r=0;r<16;++r)rli[r]=__builtin_amdgcn_rcpf(wsf[32+crow(r,hi)]);
  bf16*Ow=O+(rowbase+tok0)*DM+hq*D;
  { bf16*stg=(bf16*)(shm+LDS_OST)+wid*2048;
    #pragma unroll
    for(int r=0;r<16;++r){const int orow=crow(r,hi);
      #pragma unroll
      for(int d0=0;d0<2;++d0)stg[orow*64+d0*32+r32]=__float2bfloat16(o[d0][r]*rli[r]);}
    asm volatile("s_waitcnt lgkmcnt(0)":::"memory");
    #pragma unroll
    for(int i=0;i<4;++i){const int row=i*8+(lane>>3),ch=lane&7; const u32x4 v=*(const u32x4*)(stg+row*64+ch*8); ATTN_STORE16(Ow+(long)row*DM+ch*8,v);} }
  asm volatile("s_waitcnt lgkmcnt(0)\n\ts_barrier":::"memory");
  #undef DMA_K
  #undef DMA_V
  #undef CMASK
  #undef START
  #undef RESC
  #undef ROT
}
constexpr int ATTN_LDS_BYTES=LDS_BYTES;
struct AttnTensors { const bf16* Q; const bf16* K; const bf16* V; bf16* O; const unsigned* MASK; };
struct AttnUnit { int bn; int qt; };
struct StaticOrder {
  int vcu, G;
  __device__ __forceinline__ explicit StaticOrder(int grid,int block):vcu((grid%8==0)?(block%8)*(grid/8)+block/8:block),G(grid){}
  __device__ __forceinline__ bool next(int i,AttnUnit&u)const{
    if(G==256){ if(i>=4)return false; const int s=vcu&7; u.bn=vcu>>3; u.qt=(i==0)?31-s:(i==1)?16+s:(i==2)?15-s:s; return true; }
    const int id=vcu+i*G; if(id>=1024)return false; u.bn=id>>5; u.qt=31-(id&31); return true; }
};
template<class Sched,int THRL=8> __device__ __forceinline__ void attn_phase(char*lds,const AttnTensors&T,const Sched&S){
  AttnUnit u;
  for(int i=0;S.next(i,u);++i){ attn_unit<THRL>(u.bn>>2,u.bn&3,u.qt,T.Q,T.K,T.V,T.O,T.MASK,lds); }
}
#undef SBAR
#undef WAIT_BAR
}

__device__ __forceinline__ void p18_final(const Args& A) {
    const int tid = opaque_tid(), lane = tid & 63, wave = tid >> 6;
    const int gw = blockIdx.x * NWAVES + wave, NGW = gridDim.x * NWAVES;
    const f32x4* gr = (const f32x4*)A.in[IN_FINN] + lane;
    for (int m = gw; m < MTOK; m += NGW) {
        f32x4* xr = (f32x4*)(A.out + (size_t)m * DM) + lane; f32x4 v[4]; float s = 0.f;
#pragma unroll
        for (int j = 0; j < 4; ++j) { v[j] = xr[64 * j]; s += (v[j].x * v[j].x + v[j].y * v[j].y) + (v[j].z * v[j].z + v[j].w * v[j].w); }
        const float rs = rsqrtf(wave_sum(s) * (1.f / DM) + NORM_EPS);
#pragma unroll
        for (int j = 0; j < 4; ++j) xr[64 * j] = v[j] * rs * gr[64 * j];
    }
}

typedef GAS unsigned gu32;
#define RLX_AGENT __ATOMIC_RELAXED, __HIP_MEMORY_SCOPE_AGENT
constexpr int CW_BAR = 4096;
constexpr int RING_BYTES = 131072, LDSCTL_OFF = RING_BYTES, MISC_OFF = LDSCTL_OFF + 320;
#define XB_TMO      128
#define XB_XCNT(j)  (256  + 64 * (j))
#define XB_XSUB(j)  (1280 + 64 * (j))
#define XB_XGEN(j)  (2304 + 64 * (j))
#define XB_TOP      3328
#define XB_TOPGEN   3392
#define XCD_BAR_WORDS 3456
#define XB_SPIN_CAP (1u << 18)

__device__ __forceinline__ unsigned xb_ld(unsigned* p)              { return __hip_atomic_load(p, __ATOMIC_RELAXED, __HIP_MEMORY_SCOPE_AGENT); }
__device__ __forceinline__ unsigned xb_add(unsigned* p, unsigned v) { return __hip_atomic_fetch_add(p, v, __ATOMIC_RELAXED, __HIP_MEMORY_SCOPE_AGENT); }
__device__ __forceinline__ unsigned xb_xcc_id() { return (unsigned)__builtin_amdgcn_s_getreg((3 << 11) | 20) & 0xFu; }
#define XB_SPIN(cond, bar) do { unsigned _sp = 0; while (cond) { __builtin_amdgcn_s_sleep(1); \
    if ((++_sp & 255u) == 0u) { if (xb_ld(&(bar)[XB_TMO])) break; if (_sp > XB_SPIN_CAP) { atomicAdd(&(bar)[XB_TMO], 1u); break; } } } } while (0)

struct XcdBarrier {
    unsigned* bar; unsigned x;
    volatile LAS unsigned* st;
};

__device__ __forceinline__ XcdBarrier xcd_barrier_post(unsigned* bar, volatile LAS unsigned* st) {
    XcdBarrier b; b.bar = bar; b.x = xb_xcc_id(); b.st = st;
    if (threadIdx.x == 0) (void)xb_add(&bar[XB_XCNT(b.x)], 1u);
    return b;
}
__device__ __forceinline__ void xcd_barrier_complete(unsigned* bar, unsigned x, unsigned& nloc, unsigned& nx) {
    const unsigned G = gridDim.x * gridDim.y * gridDim.z;
    unsigned sum, cnt, mine, sp = 0u;
    for (;;) {
        sum = 0u; cnt = 0u; mine = 0u;
#pragma unroll
        for (unsigned j = 0; j < 16; ++j) { const unsigned c = xb_ld(&bar[XB_XCNT(j)]); sum += c; cnt += (c > 0u) ? 1u : 0u; mine = (j == x) ? c : mine; }
        if (sum == G) break;
        __builtin_amdgcn_s_sleep(1);
        if ((++sp & 255u) == 0u) { if (xb_ld(&bar[XB_TMO])) break; if (sp > XB_SPIN_CAP) { atomicAdd(&bar[XB_TMO], 1u); break; } }
    }
    nloc = mine > 0u ? mine : 1u; nx = cnt > 0u ? cnt : 1u;
}

__device__ __forceinline__ void xcd_barrier(const XcdBarrier& b) {
    asm volatile("s_waitcnt vmcnt(0)" ::: "memory");
    __syncthreads();
    if (threadIdx.x == 0) {
        unsigned* bar = b.bar;
        __builtin_amdgcn_s_waitcnt(0);
        unsigned nloc = b.st[0], nx = b.st[1];
        if (nloc == 0u) { xcd_barrier_complete(bar, b.x, nloc, nx); b.st[0] = nloc; b.st[1] = nx; }
        const unsigned old = xb_add(&bar[XB_XSUB(b.x)], 1u);
        const unsigned gen = old / nloc;
        if (old + 1u == (gen + 1u) * nloc) {
            __builtin_amdgcn_fence(__ATOMIC_RELEASE, "agent");
            asm volatile("s_waitcnt vmcnt(0)" ::: "memory");
            const unsigned og = xb_add(&bar[XB_TOP], 1u);
            const unsigned tg = og / nx;
            if (og + 1u == (tg + 1u) * nx) xb_add(&bar[XB_TOPGEN], 1u);
            else XB_SPIN(xb_ld(&bar[XB_TOPGEN]) == tg, bar);
            __builtin_amdgcn_fence(__ATOMIC_ACQUIRE, "agent");
            xb_add(&bar[XB_XGEN(b.x)], 1u);
            asm volatile("s_waitcnt vmcnt(0)" ::: "memory");
        } else {
            XB_SPIN(xb_ld(&bar[XB_XGEN(b.x)]) == gen, bar);
            __builtin_amdgcn_fence(__ATOMIC_ACQUIRE, "agent");
            asm volatile("s_waitcnt vmcnt(0)" ::: "memory");
        }
    }
    __syncthreads();
}

constexpr int N_PHASES = 19;
template <int LO, int HI> __global__ void __launch_bounds__(NTHR, 2) mk_fwd(Args A) {
    extern __shared__ __attribute__((aligned(16))) unsigned char lds[];
#define IN(k) (LO <= (k) && (k) < HI)
    constexpr bool FUSED = (HI - LO) > 1;
    XcdBarrier bar; bar.bar = nullptr; bar.x = 0; bar.st = nullptr;
    if constexpr (FUSED) {
        for (int u = threadIdx.x; u < (LDS_BYTES - LDSCTL_OFF) / 4; u += NTHR) ((LAS unsigned*)((LAS unsigned char*)lds + LDSCTL_OFF))[u] = 0u;
        __syncthreads();
        bar = xcd_barrier_post(WSP(unsigned, OFF_CTL) + CW_BAR, (volatile LAS unsigned*)((LAS unsigned char*)lds + MISC_OFF) + 8);
    }
#define SEAM(k) do { if constexpr (FUSED && IN(k) && IN((k) + 1)) { if ((k) == 0) cg::this_grid().sync(); else xcd_barrier(bar); } } while (0)
    if constexpr (IN(0)) p0_prologue(A, lds);
    if constexpr (FUSED && IN(0) && ((REP_MASK >> 0) & 1u)) xcd_barrier(bar);
    if constexpr (FUSED && IN(0) && ((REP_MASK >> 0) & 1u)) p0_prologue(A, lds);
    SEAM(0);
    if constexpr (IN(1)) {
        Gemm g{WSP(bf16_t, OFF_H0), WSP(bf16_t, OFF_H0), 1 << 30, WSP(bf16_t, OFF_WIN), MTOK, 2304, DM};
        EpiInProj E{WSP(bf16_t, OFF_QO), WSP(bf16_t, OFF_K), WSP(bf16_t, OFF_V), WSP(bf16_t, OFF_QI), WSP(bf16_t, OFF_KI), WSP(float, OFF_WI), WSP(float, OFF_ROPE)};
        gemm_phase(lds, g, E);
    }
    SEAM(1);
    if constexpr (IN(2)) { if (FAST_TOPK) p2_fast(A, lds); else p2_naive(A, lds);
#if DBG_TOPK
        __syncthreads(); p2_naive(A, lds, 160 * MiB);
#endif
    }
    if constexpr (FUSED && IN(2) && ((REP_MASK >> 2) & 1u)) xcd_barrier(bar);
    if constexpr (FUSED && IN(2) && ((REP_MASK >> 2) & 1u)) { if (FAST_TOPK) p2_fast(A, lds); else p2_naive(A, lds);
#if DBG_TOPK
        __syncthreads(); p2_naive(A, lds, 160 * MiB);
#endif
    }
    SEAM(2);
    if constexpr (IN(3)) {
#if DBG_TOPK
        {
            const int lane_ = threadIdx.x & 63, gw_ = blockIdx.x * NWAVES + (threadIdx.x >> 6);
            const unsigned* M1 = WSP(unsigned, OFF_MASK); const unsigned* M2 = WSP(unsigned, 160 * MiB); unsigned rows_ = 0, bits_ = 0, bad1_ = 0, bad2_ = 0;
            for (int m = gw_; m < MTOK; m += gridDim.x * NWAVES) { const unsigned d = M1[(size_t)m * 64 + lane_] ^ M2[(size_t)m * 64 + lane_]; const int nb = wave_allsum_i(__popc(d)); if (nb) { rows_ += 1; bits_ += nb; }
                const int t_ = m & (SEQ - 1), ex_ = t_ + 1 < 256 ? t_ + 1 : 256; if (wave_allsum_i(__popc(M1[(size_t)m * 64 + lane_])) != ex_) bad1_ += 1; if (wave_allsum_i(__popc(M2[(size_t)m * 64 + lane_])) != ex_) bad2_ += 1; }
            if (lane_ == 0) { atomicAdd(WSP(unsigned, OFF_CTL) + 1000, rows_); atomicAdd(WSP(unsigned, OFF_CTL) + 1001, bits_); atomicAdd(WSP(unsigned, OFF_CTL) + 1002, bad1_); atomicAdd(WSP(unsigned, OFF_CTL) + 1003, bad2_); }
        }
#endif
        if (FAST_ATTN) {
            static_assert(attn_body::ATTN_LDS_BYTES <= RING_BYTES, "attention LDS");
            const attn_body::AttnTensors AT{(const attn_body::bf16*)WSP(bf16_t, OFF_QO), (const attn_body::bf16*)WSP(bf16_t, OFF_K), (const attn_body::bf16*)WSP(bf16_t, OFF_V), (attn_body::bf16*)WSP(bf16_t, OFF_QO), WSP(unsigned, OFF_MASK)};
            const attn_body::StaticOrder S((int)gridDim.x, (int)blockIdx.x);
            attn_body::attn_phase<attn_body::StaticOrder>((char*)lds, AT, S);
        } else p3_naive(A, lds);
    }
    if constexpr (FUSED && REP_123 && IN(3)) xcd_barrier(bar);
    if constexpr (FUSED && REP_123 && IN(3)) {
        Gemm g{WSP(bf16_t, OFF_H0), WSP(bf16_t, OFF_H0), 1 << 30, WSP(bf16_t, OFF_WIN), MTOK, 2304, DM};
        EpiInProj E{WSP(bf16_t, OFF_QO), WSP(bf16_t, OFF_K), WSP(bf16_t, OFF_V), WSP(bf16_t, OFF_QI), WSP(bf16_t, OFF_KI), WSP(float, OFF_WI), WSP(float, OFF_ROPE)};
        gemm_phase(lds, g, E);
    }
    if constexpr (FUSED && REP_123 && IN(3)) xcd_barrier(bar);
    if constexpr (FUSED && REP_123 && IN(3)) { if (FAST_TOPK) p2_fast(A, lds); else p2_naive(A, lds);
#if DBG_TOPK
        __syncthreads(); p2_naive(A, lds, 160 * MiB);
#endif
    }
    if constexpr (FUSED && REP_123 && IN(3)) xcd_barrier(bar);
    if constexpr (FUSED && REP_123 && IN(3)) {
#if DBG_TOPK
        {
            const int lane_ = threadIdx.x & 63, gw_ = blockIdx.x * NWAVES + (threadIdx.x >> 6);
            const unsigned* M1 = WSP(unsigned, OFF_MASK); const unsigned* M2 = WSP(unsigned, 160 * MiB); unsigned rows_ = 0, bits_ = 0, bad1_ = 0, bad2_ = 0;
            for (int m = gw_; m < MTOK; m += gridDim.x * NWAVES) { const unsigned d = M1[(size_t)m * 64 + lane_] ^ M2[(size_t)m * 64 + lane_]; const int nb = wave_allsum_i(__popc(d)); if (nb) { rows_ += 1; bits_ += nb; }
                const int t_ = m & (SEQ - 1), ex_ = t_ + 1 < 256 ? t_ + 1 : 256; if (wave_allsum_i(__popc(M1[(size_t)m * 64 + lane_])) != ex_) bad1_ += 1; if (wave_allsum_i(__popc(M2[(size_t)m * 64 + lane_])) != ex_) bad2_ += 1; }
            if (lane_ == 0) { atomicAdd(WSP(unsigned, OFF_CTL) + 1000, rows_); atomicAdd(WSP(unsigned, OFF_CTL) + 1001, bits_); atomicAdd(WSP(unsigned, OFF_CTL) + 1002, bad1_); atomicAdd(WSP(unsigned, OFF_CTL) + 1003, bad2_); }
        }
#endif
        if (FAST_ATTN) {
            static_assert(attn_body::ATTN_LDS_BYTES <= RING_BYTES, "attention LDS");
            const attn_body::AttnTensors AT{(const attn_body::bf16*)WSP(bf16_t, OFF_QO), (const attn_body::bf16*)WSP(bf16_t, OFF_K), (const attn_body::bf16*)WSP(bf16_t, OFF_V), (attn_body::bf16*)WSP(bf16_t, OFF_QO), WSP(unsigned, OFF_MASK)};
            const attn_body::StaticOrder S((int)gridDim.x, (int)blockIdx.x);
            attn_body::attn_phase<attn_body::StaticOrder>((char*)lds, AT, S);
        } else p3_naive(A, lds);
    }
    SEAM(3);
    if constexpr (IN(4)) {
        Gemm g{WSP(bf16_t, OFF_QO), WSP(bf16_t, OFF_QO), 1 << 30, WSP(bf16_t, OFF_WO0), MTOK, DM, DM};
        EpiResid E{A.in[IN_X], A.out, WSP(bf16_t, OFF_XB), WSP(float, OFF_SSQ0)};
        gemm_phase(lds, g, E);
    }
    SEAM(4);
    if constexpr (IN(5)) {
        Gemm g{WSP(bf16_t, OFF_XB), WSP(bf16_t, OFF_XB), 1 << 30, WSP(bf16_t, OFF_WUP0), MTOK, FF, DM};
        EpiUp E{WSP(bf16_t, OFF_U), WSP(float, OFF_SSQ0)};
        gemm_phase(lds, g, E);
    }
    if constexpr (FUSED && IN(5) && ((REP_MASK >> 5) & 1u)) xcd_barrier(bar);
    if constexpr (FUSED && IN(5) && ((REP_MASK >> 5) & 1u)) {
        Gemm g{WSP(bf16_t, OFF_XB), WSP(bf16_t, OFF_XB), 1 << 30, WSP(bf16_t, OFF_WUP0), MTOK, FF, DM};
        EpiUp E{WSP(bf16_t, OFF_U), WSP(float, OFF_SSQ0)};
        gemm_phase(lds, g, E);
    }
    SEAM(5);
    if constexpr (IN(6)) {
        Gemm g{WSP(bf16_t, OFF_U), WSP(bf16_t, OFF_U), 1 << 30, WSP(bf16_t, OFF_WDN0), MTOK, DM, FF};
        EpiResid E{A.out, A.out, nullptr, nullptr};
        gemm_phase(lds, g, E);
    }
    SEAM(6);
    if constexpr (IN(7)) p7_prep(A);
    if constexpr (FUSED && IN(7) && ((REP_MASK >> 7) & 1u)) xcd_barrier(bar);
    if constexpr (FUSED && IN(7) && ((REP_MASK >> 7) & 1u)) p7_prep(A);
    SEAM(7);
    if constexpr (IN(8)) {
        Gemm g{WSP(bf16_t, OFF_XSR), WSP(bf16_t, OFF_XSK), 4, WSP(bf16_t, OFF_WRK), MTOK, 2048, DM};
        EpiStore E{WSP(bf16_t, OFF_R), DM, 4, WSP(bf16_t, OFF_KR), DM};
        gemm_phase(lds, g, E);
    }
    if constexpr (FUSED && IN(8) && ((REP_MASK >> 8) & 1u)) xcd_barrier(bar);
    if constexpr (FUSED && IN(8) && ((REP_MASK >> 8) & 1u)) {
        Gemm g{WSP(bf16_t, OFF_XSR), WSP(bf16_t, OFF_XSK), 4, WSP(bf16_t, OFF_WRK), MTOK, 2048, DM};
        EpiStore E{WSP(bf16_t, OFF_R), DM, 4, WSP(bf16_t, OFF_KR), DM};
        gemm_phase(lds, g, E);
    }
    SEAM(8);
    if constexpr (IN(9)) {
        Gemm g{WSP(bf16_t, OFF_XSV), WSP(bf16_t, OFF_H1), 4, WSP(bf16_t, OFF_WVL), MTOK, 1792, DM};
        EpiStore E{WSP(bf16_t, OFF_VV), DM, 4, WSP(bf16_t, OFF_P), 768};
        gemm_phase(lds, g, E);
    }
    if constexpr (FUSED && IN(9) && ((REP_MASK >> 9) & 1u)) xcd_barrier(bar);
    if constexpr (FUSED && IN(9) && ((REP_MASK >> 9) & 1u)) {
        Gemm g{WSP(bf16_t, OFF_XSV), WSP(bf16_t, OFF_H1), 4, WSP(bf16_t, OFF_WVL), MTOK, 1792, DM};
        EpiStore E{WSP(bf16_t, OFF_VV), DM, 4, WSP(bf16_t, OFF_P), 768};
        gemm_phase(lds, g, E);
    }
    SEAM(9);
    if constexpr (IN(10)) p10_loramid(A);
    if constexpr (FUSED && IN(10) && ((REP_MASK >> 10) & 1u)) xcd_barrier(bar);
    if constexpr (FUSED && IN(10) && ((REP_MASK >> 10) & 1u)) p10_loramid(A);
    SEAM(10);
    if constexpr (IN(11)) {
        Gemm g{WSP(bf16_t, OFF_AW), WSP(bf16_t, OFF_AA), 4, WSP(bf16_t, OFF_W2T), MTOK, 2048, 128};
        EpiLoraUp E{WSP(bf16_t, OFF_E), WSP(bf16_t, OFF_A), A.in[IN_W0], A.in[IN_A0]};
        gemm_phase(lds, g, E);
    }
    if constexpr (FUSED && IN(11) && ((REP_MASK >> 11) & 1u)) xcd_barrier(bar);
    if constexpr (FUSED && IN(11) && ((REP_MASK >> 11) & 1u)) {
        Gemm g{WSP(bf16_t, OFF_AW), WSP(bf16_t, OFF_AA), 4, WSP(bf16_t, OFF_W2T), MTOK, 2048, 128};
        EpiLoraUp E{WSP(bf16_t, OFF_E), WSP(bf16_t, OFF_A), A.in[IN_W0], A.in[IN_A0]};
        gemm_phase(lds, g, E);
    }
    SEAM(11);
    if constexpr (IN(12)) { if (FAST_SCAN) p12_fast(A, lds); else p12_naive(A, lds); }
    if constexpr (FUSED && IN(12) && ((REP_MASK >> 12) & 1u)) xcd_barrier(bar);
    if constexpr (FUSED && IN(12) && ((REP_MASK >> 12) & 1u)) { if (FAST_SCAN) p12_fast(A, lds); else p12_naive(A, lds); }
    SEAM(12);
    if constexpr (IN(13)) { if (!FAST_SCAN) p12b_stats(A); }
    SEAM(13);
    if constexpr (IN(14)) {
        Gemm g{WSP(bf16_t, OFF_AG), WSP(bf16_t, OFF_AG), 1 << 30, WSP(bf16_t, OFF_G2T), MTOK, DM, 256};
        EpiGatePost E{WSP(bf16_t, OFF_AO), WSP(bf16_t, OFF_Y), WSP(bf16_t, OFF_VV), WSP(float, OFF_STATS), WSP(float, OFF_BONUS), A.in[IN_LNW], A.in[IN_LNB]};
        gemm_phase(lds, g, E);
    }
    if constexpr (FUSED && IN(14) && ((REP_MASK >> 14) & 1u)) xcd_barrier(bar);
    if constexpr (FUSED && IN(14) && ((REP_MASK >> 14) & 1u)) {
        Gemm g{WSP(bf16_t, OFF_AG), WSP(bf16_t, OFF_AG), 1 << 30, WSP(bf16_t, OFF_G2T), MTOK, DM, 256};
        EpiGatePost E{WSP(bf16_t, OFF_AO), WSP(bf16_t, OFF_Y), WSP(bf16_t, OFF_VV), WSP(float, OFF_STATS), WSP(float, OFF_BONUS), A.in[IN_LNW], A.in[IN_LNB]};
        gemm_phase(lds, g, E);
    }
    SEAM(14);
    if constexpr (IN(15)) {
        Gemm g{WSP(bf16_t, OFF_AO), WSP(bf16_t, OFF_AO), 1 << 30, WSP(bf16_t, OFF_WO1), MTOK, DM, DM};
        EpiResid E{A.out, A.out, WSP(bf16_t, OFF_XB), WSP(float, OFF_SSQ1)};
        gemm_phase(lds, g, E);
    }
    SEAM(15);
    if constexpr (IN(16)) {
        Gemm g{WSP(bf16_t, OFF_XB), WSP(bf16_t, OFF_XB), 1 << 30, WSP(bf16_t, OFF_WUP1), MTOK, FF, DM};
        EpiUp E{WSP(bf16_t, OFF_U), WSP(float, OFF_SSQ1)};
        gemm_phase(lds, g, E);
    }
    if constexpr (FUSED && IN(16) && ((REP_MASK >> 16) & 1u)) xcd_barrier(bar);
    if constexpr (FUSED && IN(16) && ((REP_MASK >> 16) & 1u)) {
        Gemm g{WSP(bf16_t, OFF_XB), WSP(bf16_t, OFF_XB), 1 << 30, WSP(bf16_t, OFF_WUP1), MTOK, FF, DM};
        EpiUp E{WSP(bf16_t, OFF_U), WSP(float, OFF_SSQ1)};
        gemm_phase(lds, g, E);
    }
    SEAM(16);
    if constexpr (IN(17)) {
        Gemm g{WSP(bf16_t, OFF_U), WSP(bf16_t, OFF_U), 1 << 30, WSP(bf16_t, OFF_WDN1), MTOK, DM, FF};
        EpiResid E{A.out, A.out, nullptr, nullptr};
        gemm_phase(lds, g, E);
    }
    SEAM(17);
    if constexpr (IN(18)) {
        p18_final(A);
#if DBG_TOPK
        {   __syncthreads(); const float sc_ = 1.f + (float)WSP(unsigned, OFF_CTL)[1000 + DBG_WHICH] * DBG_UNIT;
            const int gw_ = blockIdx.x * NWAVES + (threadIdx.x >> 6), lane_ = threadIdx.x & 63;
            for (int m = gw_; m < MTOK; m += gridDim.x * NWAVES) for (int j = 0; j < 16; ++j) A.out[(size_t)m * DM + lane_ + 64 * j] *= sc_; }
#endif
    }
#undef IN
#undef SEAM
}

template <int P> static void launch_all(int grid, hipStream_t stream, const Args& a) {
    if constexpr (P < N_PHASES) {
        static bool attr_done = false;
        if (!attr_done) { (void)hipFuncSetAttribute((const void*)mk_fwd<P, P + 1>, hipFuncAttributeMaxDynamicSharedMemorySize, LDS_BYTES); attr_done = true; }
        hipLaunchKernelGGL((mk_fwd<P, P + 1>), dim3(grid), dim3(NTHR), LDS_BYTES, stream, a);
        launch_all<P + 1>(grid, stream, a);
    }
}
extern "C" void kernel_launch(void* const* d_in, const int* in_sizes, int n_in, void* d_out, int out_size, void* d_ws, size_t ws_size, hipStream_t stream) {
    static int grid = 0;
    if (grid == 0) {
        if (n_in != N_IN || out_size != MTOK * DM || ws_size < WS_END) { fprintf(stderr, "kernel_launch: unexpected shapes (n_in %d out %d ws %zu)\n", n_in, out_size, ws_size); grid = -1; return; }
        int dev = 0, cus = 0;
        (void)hipGetDevice(&dev); (void)hipDeviceGetAttribute(&cus, hipDeviceAttributeMultiprocessorCount, dev);
        grid = cus > 0 ? cus : 256;
    }
    if (grid < 0) return;
    (void)hipMemsetAsync((char*)d_ws + OFF_CTL, 0, CTL_BYTES, stream);
    Args a{};
    for (int i = 0; i < N_IN; ++i) a.in[i] = (const float*)d_in[i];
    a.out = (float*)d_out; a.ws = (unsigned char*)d_ws;
#if ONE_LAUNCH
    static bool attr_done = false;
    if (!attr_done) {
        (void)hipFuncSetAttribute((const void*)mk_fwd<0, N_PHASES>, hipFuncAttributeMaxDynamicSharedMemorySize, LDS_BYTES);
        int per_cu = 0;
        if (hipOccupancyMaxActiveBlocksPerMultiprocessor(&per_cu, (const void*)mk_fwd<0, N_PHASES>, NTHR, LDS_BYTES) != hipSuccess || per_cu < 1)
            fprintf(stderr, "kernel_launch: occupancy query reports %d blocks per CU\n", per_cu);
        (void)hipGetLastError();
        attr_done = true;
    }
    void* kargs[] = {(void*)&a};
    hipError_t e = hipLaunchCooperativeKernel((const void*)mk_fwd<0, N_PHASES>, dim3(grid), dim3(NTHR), kargs, LDS_BYTES, stream);
    if (e != hipSuccess) fprintf(stderr, "kernel_launch: cooperative launch failed: %s (grid %d)\n", hipGetErrorString(e), grid);
#else
    launch_all<0>(grid, stream, a);
#endif
}
```

```cpp
#include <hip/hip_runtime.h>
#include <hip/hip_cooperative_groups.h>
#include <hip/hip_bf16.h>
#include <cmath>
#include <cstdio>
#include <cstdint>
namespace cg = cooperative_groups;

#ifndef ONE_LAUNCH
#define ONE_LAUNCH 1
#endif
#ifndef DBG_TOPK
#define DBG_TOPK 0
#define DBG_WHICH 2
#define DBG_UNIT 0.001f
#endif
#ifndef REP_MASK
#define REP_MASK 0u
#endif
#ifndef REP_123
#define REP_123 0
#endif
#ifndef FAST_ATTN
#define FAST_ATTN 1
#endif
#ifndef FAST_TOPK
#define FAST_TOPK 1
#endif
#ifndef FAST_SCAN
#define FAST_SCAN 1
#endif
#ifndef FAST_GEMM
#define FAST_GEMM 1
#endif

#define LAS __attribute__((address_space(3)))
#define GAS __attribute__((address_space(1)))
typedef unsigned short bf16_t;
typedef short bf16x8 __attribute__((ext_vector_type(8)));
typedef float f32x4 __attribute__((ext_vector_type(4)));
typedef float f32x2 __attribute__((ext_vector_type(2)));
typedef unsigned u32x4 __attribute__((ext_vector_type(4)));
typedef unsigned u32x2 __attribute__((ext_vector_type(2)));

constexpr int BATCH = 8, SEQ = 2048, DM = 1024, MTOK = BATCH * SEQ, FF = 4096;
constexpr int NWAVES = 8, NTHR = 512;
constexpr int LDS_BYTES = 147456;
constexpr float NORM_EPS = 1e-6f, LNX_EPS = 64e-5f;
constexpr float QSCALE = 0.125f * 1.4426950408889634f;
constexpr float WI_SCALE = 0.044194173824159216f;

enum { IN_X = 0, IN_MIXN, IN_MLPN, IN_WUP, IN_WDN, IN_FINN, IN_WIN, IN_WO, IN_MU, IN_WRKV, IN_W0, IN_W1, IN_W2, IN_A0, IN_A1, IN_A2,
       IN_G1, IN_G2, IN_KK, IN_KA, IN_RK, IN_LNW, IN_LNB, IN_WO1, N_IN };

constexpr size_t MiB = 1u << 20;
constexpr size_t OFF_CTL = 0, CTL_BYTES = 1 * MiB;
constexpr size_t OFF_SSQ0 = 256 * 1024, OFF_SSQ1 = 320 * 1024;
constexpr size_t OFF_ROPE = 1 * MiB;
constexpr size_t OFF_WIN = 2 * MiB, OFF_WO0 = 7 * MiB, OFF_WUP0 = 9 * MiB, OFF_WDN0 = 17 * MiB, OFF_WRK = 25 * MiB, OFF_WVL = 29 * MiB;
constexpr size_t OFF_W2T = 33 * MiB, OFF_A2T = 33 * MiB + 256 * 1024, OFF_G2T = 33 * MiB + 512 * 1024, OFF_WO1 = 34 * MiB, OFF_WUP1 = 36 * MiB, OFF_WDN1 = 44 * MiB;
constexpr size_t OFF_BONUS = 2 * MiB;
constexpr size_t OFF_H0 = 52 * MiB, OFF_QO = 84 * MiB, OFF_K = 116 * MiB, OFF_V = 124 * MiB, OFF_QI = 132 * MiB, OFF_KI = 148 * MiB, OFF_WI = 150 * MiB, OFF_MASK = 152 * MiB;
constexpr size_t OFF_XB = 52 * MiB, OFF_U = 84 * MiB;
constexpr size_t OFF_XSR = 52 * MiB, OFF_XSK = 84 * MiB, OFF_XSV = 116 * MiB, OFF_H1 = 148 * MiB, OFF_R = 180 * MiB, OFF_KR = 212 * MiB;
constexpr size_t OFF_VV = 52 * MiB, OFF_P = 84 * MiB, OFF_AW = 108 * MiB, OFF_AA = 112 * MiB, OFF_AG = 244 * MiB;
constexpr size_t OFF_E = 116 * MiB, OFF_A = 148 * MiB, OFF_Y = 84 * MiB, OFF_STATS = 252 * MiB, OFF_AO = 116 * MiB;
constexpr size_t WS_END = 256 * MiB;

struct Args { const float* in[N_IN]; float* out; unsigned char* ws; int ph_lo, ph_hi; };
#define WSP(T, off) ((T*)(A.ws + (off)))

__device__ __forceinline__ float bf2f(bf16_t u) { return __uint_as_float((unsigned)u << 16); }
__device__ __forceinline__ unsigned f2bf(float f) { unsigned u = __float_as_uint(f); return (u + 0x7fffu + ((u >> 16) & 1u)) >> 16; }
__device__ __forceinline__ unsigned pk2(float lo, float hi) { return f2bf(lo) | (f2bf(hi) << 16); }
__device__ __forceinline__ float wave_sum(float v) {
#pragma unroll
    for (int o = 1; o < 64; o <<= 1) v += __shfl_xor(v, o);
    return v;
}
__device__ __forceinline__ float wave_max(float v) {
#pragma unroll
    for (int o = 1; o < 64; o <<= 1) v = fmaxf(v, __shfl_xor(v, o));
    return v;
}
#define LDS_WAIT() asm volatile("s_waitcnt lgkmcnt(0)" ::: "memory")
__device__ __forceinline__ int opaque_tid() { int t = threadIdx.x; asm volatile("" : "+v"(t)); return t; }
__device__ __forceinline__ float sigmoidf_(float z) { return __builtin_amdgcn_rcpf(1.f + __expf(-z)); }

__device__ __forceinline__ float block_sum(float v, float* red, int wave, int lane) {
    v = wave_sum(v); __syncthreads(); if (lane == 0) red[wave] = v; __syncthreads();
    float s = 0.f;
#pragma unroll
    for (int i = 0; i < NWAVES; ++i) s += red[i];
    return s;
}
__device__ __forceinline__ float block_max(float v, float* red, int wave, int lane) {
    v = wave_max(v); __syncthreads(); if (lane == 0) red[wave] = v; __syncthreads();
    float s = red[0];
#pragma unroll
    for (int i = 1; i < NWAVES; ++i) s = fmaxf(s, red[i]);
    return s;
}

template <int ID> __device__ __forceinline__ float wval(const Args& A, int n, int k) {
    if constexpr (ID == 0) {
        int col;
        if (n < 1280 || (n >= 1536 && n < 2112)) { const int hd = n >> 6, j = n & 63; col = (hd << 6) + (j >> 1) + ((j & 1) << 5); }
        else if (n < 2120) col = n; else return 0.f;
        return A.in[IN_WIN][(size_t)k * 2120 + col];
    } else if constexpr (ID == 1) { return A.in[IN_WO][(size_t)k * 1024 + n];
    } else if constexpr (ID == 2) { return A.in[IN_WUP][(size_t)k * 4096 + n] * A.in[IN_MLPN][k];
    } else if constexpr (ID == 3) { return A.in[IN_WDN][(size_t)k * 1024 + n];
    } else if constexpr (ID == 4) { return A.in[IN_WRKV][(size_t)(n >> 10) * 1048576 + (size_t)k * 1024 + (n & 1023)];
    } else if constexpr (ID == 5) {
        if (n < 1024) return A.in[IN_WRKV][(size_t)2 * 1048576 + (size_t)k * 1024 + n];
        const int j = n - 1024; const float* mu = A.in[IN_MU];
        if (j < 128) { const float m = mu[3 * 1024 + k], w = A.in[IN_W1][k * 64 + (j & 63)]; return (j < 64 ? 1.f - m : m) * w; }
        if (j < 256) { const float m = mu[4 * 1024 + k], w = A.in[IN_A1][k * 64 + (j & 63)]; return (j < 192 ? 1.f - m : m) * w; }
        if (j < 576) { const float m = mu[5 * 1024 + k]; const int jj = j - 256, c = jj < 160 ? jj : jj - 160; const float w = A.in[IN_G1][k * 160 + c]; return (jj < 160 ? 1.f - m : m) * w; }
        return 0.f;
    } else if constexpr (ID == 6) { return k < 64 ? A.in[IN_W2][(size_t)k * 1024 + n] : 0.f;
    } else if constexpr (ID == 7) { return k < 64 ? A.in[IN_A2][(size_t)k * 1024 + n] : 0.f;
    } else if constexpr (ID == 8) { return k < 160 ? A.in[IN_G2][(size_t)k * 1024 + n] : 0.f;
    } else if constexpr (ID == 9) { return A.in[IN_WO1][(size_t)k * 1024 + n];
    } else if constexpr (ID == 10) { return A.in[IN_WUP][(size_t)4194304 + (size_t)k * 4096 + n] * A.in[IN_MLPN][1024 + k];
    } else { return A.in[IN_WDN][(size_t)4194304 + (size_t)k * 1024 + n]; }
}
template <int ID> __device__ __forceinline__ void p0_weight(const Args& A, bf16_t* dst, int N, int K, float* scr, int gw, int NGW, int lane) {
    const int nblk = N / 32, nitems = (K / 64) * nblk;
    for (int it = gw; it < nitems; it += NGW) {
        const int kb = it / nblk, nb = it % nblk, k0 = 64 * kb, n0 = 32 * nb;
#pragma unroll 8
        for (int i = 0; i < 32; ++i) { const int kk = 2 * i + (lane >> 5); scr[kk * 33 + (lane & 31)] = wval<ID>(A, n0 + (lane & 31), k0 + kk); }
        LDS_WAIT();
        const int c = lane & 7;
#pragma unroll
        for (int j = 0; j < 4; ++j) { const int n = (lane >> 3) + 8 * j; const float* s = scr + (8 * c) * 33 + n;
            u32x4 o; o.x = pk2(s[0 * 33], s[1 * 33]); o.y = pk2(s[2 * 33], s[3 * 33]); o.z = pk2(s[4 * 33], s[5 * 33]); o.w = pk2(s[6 * 33], s[7 * 33]);
            *(u32x4*)(dst + (size_t)(n0 + n) * K + k0 + 8 * c) = o; }
        LDS_WAIT();
    }
}
__device__ __forceinline__ void rms_row_to_bf16(const float* xrow, const float* g, bf16_t* orow, int lane) {
    const f32x4* xr = (const f32x4*)xrow + lane; const f32x4* gr = (const f32x4*)g + lane;
    f32x4 v[4]; float s = 0.f;
#pragma unroll
    for (int j = 0; j < 4; ++j) { v[j] = xr[64 * j]; s += (v[j].x * v[j].x + v[j].y * v[j].y) + (v[j].z * v[j].z + v[j].w * v[j].w); }
    const float rs = rsqrtf(wave_sum(s) * (1.f / DM) + NORM_EPS);
    u32x2* o8 = (u32x2*)orow + lane;
#pragma unroll
    for (int j = 0; j < 4; ++j) { const f32x4 gg = gr[64 * j]; u32x2 w; w.x = pk2(v[j].x * rs * gg.x, v[j].y * rs * gg.y); w.y = pk2(v[j].z * rs * gg.z, v[j].w * rs * gg.w); o8[64 * j] = w; }
}
__device__ __forceinline__ void p0_prologue(const Args& A, unsigned char* lds) {
    const int tid = opaque_tid(), lane = tid & 63, wave = tid >> 6;
    float* scr = (float*)(lds + wave * 16384);
    const int gw = blockIdx.x * NWAVES + wave, NGW = gridDim.x * NWAVES;
    p0_weight<0>(A, WSP(bf16_t, OFF_WIN), 2304, 1024, scr, gw, NGW, lane);
    p0_weight<1>(A, WSP(bf16_t, OFF_WO0), 1024, 1024, scr, gw, NGW, lane);
    p0_weight<2>(A, WSP(bf16_t, OFF_WUP0), 4096, 1024, scr, gw, NGW, lane);
    p0_weight<3>(A, WSP(bf16_t, OFF_WDN0), 1024, 4096, scr, gw, NGW, lane);
    p0_weight<4>(A, WSP(bf16_t, OFF_WRK), 2048, 1024, scr, gw, NGW, lane);
    p0_weight<5>(A, WSP(bf16_t, OFF_WVL), 1792, 1024, scr, gw, NGW, lane);
    p0_weight<6>(A, WSP(bf16_t, OFF_W2T), 1024, 128, scr, gw, NGW, lane);
    p0_weight<7>(A, WSP(bf16_t, OFF_A2T), 1024, 128, scr, gw, NGW, lane);
    p0_weight<8>(A, WSP(bf16_t, OFF_G2T), 1024, 256, scr, gw, NGW, lane);
    p0_weight<9>(A, WSP(bf16_t, OFF_WO1), 1024, 1024, scr, gw, NGW, lane);
    p0_weight<10>(A, WSP(bf16_t, OFF_WUP1), 4096, 1024, scr, gw, NGW, lane);
    p0_weight<11>(A, WSP(bf16_t, OFF_WDN1), 1024, 4096, scr, gw, NGW, lane);
    float* rc = WSP(float, OFF_ROPE); float* rsn = rc + 2048 * 32;
    for (int idx = blockIdx.x * NTHR + tid; idx < 2048 * 32; idx += gridDim.x * NTHR) {
        const int t = idx >> 5, d = idx & 31;
        double inv = 1.0; for (int i = 0; i < d; ++i) inv *= 0.74989420933245582730;
        const double ang = (double)t * inv;
        const double q = rint(ang * 0.63661977236758134308); const double r = (ang - q * 1.5707963267948966192) - q * 6.123233995736766036e-17;
        const double r2 = r * r;
        double sn = 1.0, cs = 1.0, ts = 1.0, tc = 1.0;
#pragma unroll
        for (int i = 1; i <= 9; ++i) { tc *= -r2 / (double)((2 * i - 1) * (2 * i)); ts *= -r2 / (double)((2 * i) * (2 * i + 1)); cs += tc; sn += ts; }
        sn *= r;
        const int qi = ((int)q) & 3;
        const double c = (qi == 0) ? cs : (qi == 1) ? -sn : (qi == 2) ? -cs : sn;
        const double s = (qi == 0) ? sn : (qi == 1) ? cs : (qi == 2) ? -sn : -cs;
        rc[idx] = (float)c; rsn[idx] = (float)s;
    }
    bf16_t* H0 = WSP(bf16_t, OFF_H0);
    for (int m = gw; m < MTOK; m += NGW) rms_row_to_bf16(A.in[IN_X] + (size_t)m * DM, A.in[IN_MIXN], H0 + (size_t)m * DM, lane);
}

struct Unit { int pm, pn; };
struct Gemm { const bf16_t* A; const bf16_t* A2; int pn2; const bf16_t* Bt; int M, N, K; };
constexpr int NXCD = 8, WGM = 8;
struct StaticOrder {
    int nM, nN, nwg, G, c;
    __device__ void init(int M, int N, int G_, int c_) { nM = M / 256; nN = N / 256; nwg = nM * nN; G = G_; c = c_; }
    __device__ bool next(int i, Unit& u) const {
        const long L = (long)i * G + c; if (L >= nwg) return false;
        int wgid = (int)L; { const int q = nwg / NXCD, r = nwg % NXCD, xcd = wgid % NXCD, off = wgid / NXCD; wgid = (xcd < r ? xcd * (q + 1) : r * (q + 1) + (xcd - r) * q) + off; }
        const int nig = WGM * nN, gid = wgid / nig, fm = gid * WGM, gsz = (nM - fm) < WGM ? (nM - fm) : WGM;
        u.pm = fm + ((wgid % nig) % gsz); u.pn = (wgid % nig) / gsz; return true;
    }
};
typedef f32x4 AccT[2][2][4][2];

template <class Epi> __device__ __forceinline__ void gemm_naive(const Gemm g, const Epi& E) {
    const int tid = opaque_tid(), wave = tid >> 6, lane = tid & 63, wr = wave >> 2, wc = wave & 3, fr = lane & 15, fq = lane >> 4;
    StaticOrder S; S.init(g.M, g.N, gridDim.x, blockIdx.x);
    Unit u;
    for (int i = 0; S.next(i, u); ++i) {
        AccT acc;
#pragma unroll
        for (int a = 0; a < 2; ++a)
#pragma unroll
            for (int b = 0; b < 2; ++b)
#pragma unroll
                for (int m = 0; m < 4; ++m)
#pragma unroll
                    for (int n = 0; n < 2; ++n) acc[a][b][m][n] = (f32x4){0.f, 0.f, 0.f, 0.f};
        const bf16_t* Ab = (u.pn >= g.pn2 ? g.A2 : g.A) + (size_t)(u.pm * 256 + wr * 64 + fr) * g.K;
        const bf16_t* Bb = g.Bt + (size_t)(u.pn * 256 + wc * 32) * g.K;
        for (int k0 = 0; k0 < g.K; k0 += 8) {
            bf16x8 af[2][4];
#pragma unroll
            for (int ai = 0; ai < 2; ++ai)
#pragma unroll
                for (int m = 0; m < 4; ++m) af[ai][m] = *(const bf16x8*)(Ab + (size_t)(ai * 128 + m * 16) * g.K + k0);
#pragma unroll
            for (int bj = 0; bj < 2; ++bj)
#pragma unroll
                for (int n = 0; n < 2; ++n)
#pragma unroll
                    for (int c = 0; c < 4; ++c) {
                        const int col = bj * 128 + (Epi::PERM ? 8 * fq + 4 * n + c : 16 * n + 4 * fq + c);
                        const bf16x8 b = *(const bf16x8*)(Bb + (size_t)col * g.K + k0);
                        float bf[8];
#pragma unroll
                        for (int e = 0; e < 8; ++e) bf[e] = bf2f((bf16_t)b[e]);
#pragma unroll
                        for (int ai = 0; ai < 2; ++ai)
#pragma unroll
                            for (int m = 0; m < 4; ++m) { float s = acc[ai][bj][m][n][c];
#pragma unroll
                                for (int e = 0; e < 8; ++e) s += bf2f((bf16_t)af[ai][m][e]) * bf[e];
                                acc[ai][bj][m][n][c] = s; }
                        asm volatile("" ::: "memory");
                    }
        }
        E(acc, u, wr, wc, fr, fq);
    }
}

struct EpiInProj {
    static constexpr bool PERM = true;
    bf16_t *Q, *K, *V, *QI, *KI; float* WI; const float* rope;
    __device__ __forceinline__ void operator()(const AccT& acc, const Unit& u, int wr, int wc, int fr, int fq) const {
        const int pn = u.pn;
#pragma unroll
        for (int ai = 0; ai < 2; ++ai)
#pragma unroll
            for (int m = 0; m < 4; ++m) {
                const int row = u.pm * 256 + ai * 128 + wr * 64 + m * 16 + fr, t = row & (SEQ - 1);
#pragma unroll
                for (int bj = 0; bj < 2; ++bj) {
                    const int cl = bj * 128 + wc * 32 + fq * 8;
                    f32x4 v0 = acc[ai][bj][m][0], v1 = acc[ai][bj][m][1];
                    const bool rot = (pn <= 4) || pn == 6 || pn == 7 || (pn == 8 && cl < 64);
                    if (rot) {
                        const int d0 = (cl & 63) >> 1;
                        const f32x4 c = *(const f32x4*)(rope + t * 32 + d0), s = *(const f32x4*)(rope + 2048 * 32 + t * 32 + d0);
                        f32x4 a0, a1;
                        a0.x = v0.x * c.x - v0.y * s.x; a0.y = v0.y * c.x + v0.x * s.x;
                        a0.z = v0.z * c.y - v0.w * s.y; a0.w = v0.w * c.y + v0.z * s.y;
                        a1.x = v1.x * c.z - v1.y * s.z; a1.y = v1.y * c.z + v1.x * s.z;
                        a1.z = v1.z * c.w - v1.w * s.w; a1.w = v1.w * c.w + v1.z * s.w;
                        v0 = a0; v1 = a1;
                    }
                    if (pn < 4) { v0 = v0 * QSCALE; v1 = v1 * QSCALE; }
                    u32x4 w; w.x = pk2(v0.x, v0.y); w.y = pk2(v0.z, v0.w); w.z = pk2(v1.x, v1.y); w.w = pk2(v1.z, v1.w);
                    if (pn < 4) *(u32x4*)(Q + (size_t)row * 1024 + pn * 256 + cl) = w;
                    else if (pn == 4) *(u32x4*)(K + (size_t)row * 256 + cl) = w;
                    else if (pn == 5) *(u32x4*)(V + (size_t)row * 256 + cl) = w;
                    else if (pn < 8) *(u32x4*)(QI + (size_t)row * 512 + (pn - 6) * 256 + cl) = w;
                    else { if (cl < 64) *(u32x4*)(KI + (size_t)row * 64 + cl) = w;
                           else if (cl == 64) { *(f32x4*)(WI + (size_t)row * 8) = v0 * WI_SCALE; *(f32x4*)(WI + (size_t)row * 8 + 4) = v1 * WI_SCALE; } }
                }
            }
    }
};
struct EpiResid {
    static constexpr bool PERM = false;
    const float* xin; float* xout; bf16_t* xb; float* ssq;
    __device__ __forceinline__ void operator()(const AccT& acc, const Unit& u, int wr, int wc, int fr, int fq) const {
#pragma unroll
        for (int ai = 0; ai < 2; ++ai)
#pragma unroll
            for (int m = 0; m < 4; ++m) {
                const int row = u.pm * 256 + ai * 128 + wr * 64 + m * 16 + fr; float s = 0.f;
#pragma unroll
                for (int bj = 0; bj < 2; ++bj)
#pragma unroll
                    for (int n = 0; n < 2; ++n) {
                        const size_t off = (size_t)row * DM + u.pn * 256 + bj * 128 + wc * 32 + n * 16 + fq * 4;
                        const f32x4 x = *(const f32x4*)(xin + off) + acc[ai][bj][m][n];
                        *(f32x4*)(xout + off) = x;
                        if (xb) { u32x2 w; w.x = pk2(x.x, x.y); w.y = pk2(x.z, x.w); *(u32x2*)(xb + off) = w; }
                        s += (x.x * x.x + x.y * x.y) + (x.z * x.z + x.w * x.w);
                    }
                if (ssq) { s += __shfl_xor(s, 16); s += __shfl_xor(s, 32); if (fq == 0) atomicAdd(ssq + row, s); }
            }
    }
};
struct EpiUp {
    static constexpr bool PERM = true;
    bf16_t* U; const float* ssq;
    __device__ __forceinline__ void operator()(const AccT& acc, const Unit& u, int wr, int wc, int fr, int fq) const {
#pragma unroll
        for (int ai = 0; ai < 2; ++ai)
#pragma unroll
            for (int m = 0; m < 4; ++m) {
                const int row = u.pm * 256 + ai * 128 + wr * 64 + m * 16 + fr;
                const float rs = rsqrtf(ssq[row] * (1.f / DM) + NORM_EPS);
#pragma unroll
                for (int bj = 0; bj < 2; ++bj) {
                    f32x4 v0 = acc[ai][bj][m][0] * rs, v1 = acc[ai][bj][m][1] * rs;
#pragma unroll
                    for (int c = 0; c < 4; ++c) { const float a = fmaxf(v0[c], 0.f), b = fmaxf(v1[c], 0.f); v0[c] = a * a; v1[c] = b * b; }
                    u32x4 w; w.x = pk2(v0.x, v0.y); w.y = pk2(v0.z, v0.w); w.z = pk2(v1.x, v1.y); w.w = pk2(v1.z, v1.w);
                    *(u32x4*)(U + (size_t)row * FF + u.pn * 256 + bj * 128 + wc * 32 + fq * 8) = w;
                }
            }
    }
};
struct EpiStore {
    static constexpr bool PERM = true;
    bf16_t* b0; int ld0; int split; bf16_t* b1; int ld1;
    __device__ __forceinline__ void operator()(const AccT& acc, const Unit& u, int wr, int wc, int fr, int fq) const {
        bf16_t* base = u.pn < split ? b0 + u.pn * 256 : b1 + (u.pn - split) * 256; const int ld = u.pn < split ? ld0 : ld1;
#pragma unroll
        for (int ai = 0; ai < 2; ++ai)
#pragma unroll
            for (int m = 0; m < 4; ++m) {
                const int row = u.pm * 256 + ai * 128 + wr * 64 + m * 16 + fr;
#pragma unroll
                for (int bj = 0; bj < 2; ++bj) {
                    const f32x4 v0 = acc[ai][bj][m][0], v1 = acc[ai][bj][m][1];
                    u32x4 w; w.x = pk2(v0.x, v0.y); w.y = pk2(v0.z, v0.w); w.z = pk2(v1.x, v1.y); w.w = pk2(v1.z, v1.w);
                    *(u32x4*)(base + (size_t)row * ld + bj * 128 + wc * 32 + fq * 8) = w;
                }
            }
    }
};
struct EpiLoraUp {
    static constexpr bool PERM = true;
    bf16_t* E; bf16_t* AS; const float* w0; const float* a0;
    __device__ __forceinline__ void operator()(const AccT& acc, const Unit& u, int wr, int wc, int fr, int fq) const {
        const bool dec = u.pn < 4; bf16_t* O = dec ? E : AS; const float* bias = dec ? w0 : a0; const float sc = dec ? -0.6065306597126334f : 1.f;
#pragma unroll
        for (int bj = 0; bj < 2; ++bj) {
            const int col = (u.pn & 3) * 256 + bj * 128 + wc * 32 + fq * 8;
            const f32x4 b0 = *(const f32x4*)(bias + col), b1 = *(const f32x4*)(bias + col + 4);
#pragma unroll
            for (int ai = 0; ai < 2; ++ai)
#pragma unroll
                for (int m = 0; m < 4; ++m) {
                    const int row = u.pm * 256 + ai * 128 + wr * 64 + m * 16 + fr;
                    f32x4 v0 = acc[ai][bj][m][0] + b0, v1 = acc[ai][bj][m][1] + b1;
#pragma unroll
                    for (int c = 0; c < 4; ++c) { v0[c] = sc * sigmoidf_(v0[c]); v1[c] = sc * sigmoidf_(v1[c]); }
                    u32x4 w; w.x = pk2(v0.x, v0.y); w.y = pk2(v0.z, v0.w); w.z = pk2(v1.x, v1.y); w.w = pk2(v1.z, v1.w);
                    *(u32x4*)(O + (size_t)row * DM + col) = w;
                    asm volatile("" ::: "memory");
                }
        }
    }
};
struct EpiGatePost {
    static constexpr bool PERM = true;
    bf16_t* AO; const bf16_t* Y; const bf16_t* V; const float* stats; const float* bonus; const float* lnw; const float* lnb;
    __device__ __forceinline__ void operator()(const AccT& acc, const Unit& u, int wr, int wc, int fr, int fq) const {
#pragma unroll
        for (int bj = 0; bj < 2; ++bj) {
            const int col = u.pn * 256 + bj * 128 + wc * 32 + fq * 8, hd = col >> 6;
            const f32x4 w0 = *(const f32x4*)(lnw + col), w1 = *(const f32x4*)(lnw + col + 4), c0 = *(const f32x4*)(lnb + col), c1 = *(const f32x4*)(lnb + col + 4);
#pragma unroll
            for (int ai = 0; ai < 2; ++ai)
#pragma unroll
                for (int m = 0; m < 4; ++m) {
                    const int row = u.pm * 256 + ai * 128 + wr * 64 + m * 16 + fr;
                    const f32x4 st = *(const f32x4*)(stats + ((size_t)row * 16 + hd) * 4);
                    const float mean = (st.x + st.z) * (1.f / 64.f), var = fmaxf((st.y + st.w) * (1.f / 64.f) - mean * mean, 0.f), rstd = rsqrtf(var + LNX_EPS);
                    const float bo = bonus[(size_t)row * 16 + hd];
                    const bf16x8 yv = *(const bf16x8*)(Y + (size_t)row * DM + col), vv = *(const bf16x8*)(V + (size_t)row * DM + col);
                    const f32x4 g0 = acc[ai][bj][m][0], g1 = acc[ai][bj][m][1];
                    float o[8];
#pragma unroll
                    for (int c = 0; c < 4; ++c) {
                        o[c] = ((bf2f((bf16_t)yv[c]) - mean) * rstd * w0[c] + c0[c] + bo * bf2f((bf16_t)vv[c])) * g0[c];
                        o[4 + c] = ((bf2f((bf16_t)yv[4 + c]) - mean) * rstd * w1[c] + c1[c] + bo * bf2f((bf16_t)vv[4 + c])) * g1[c];
                    }
                    u32x4 w; w.x = pk2(o[0], o[1]); w.y = pk2(o[2], o[3]); w.z = pk2(o[4], o[5]); w.w = pk2(o[6], o[7]);
                    *(u32x4*)(AO + (size_t)row * DM + col) = w;
                }
        }
    }
};

#define PG8_LAS __attribute__((address_space(3)))
constexpr int BM = 256, BK = 64, HALF = 128, HTB = HALF * BK * 2  , STAGE_BYTES = 8 * HTB;
__host__ __device__ __forceinline__ int lds_byte(int r, int c) { const int st = (r >> 4) * 2 + (c >> 5), rr = r & 15, cc = c & 31, ob = rr * 64 + cc * 2; return st * 1024 + (ob ^ (((ob >> 9) & 1) << 5)); }
__host__ __device__ __forceinline__ void stage_rc(int b, int& R, int& C) { const int st = b / 1024, sb = b % 1024, swz = sb ^ (((sb >> 9) & 1) << 5); R = (st >> 1) * 16 + swz / 64; C = (st & 1) * 32 + (swz % 64) / 2; }
__host__ __device__ __forceinline__ int perm32(int rho) { const int n = rho >> 4, i = rho & 15; return 8 * (i >> 2) + 4 * n + (i & 3); }
template <class Epi, bool ALIGN_EPI = true, bool SP2 = true>
__device__ __forceinline__ void gemm_fast(PG8_LAS unsigned char* lds, const Gemm g, const Epi& E) {
    StaticOrder S; S.init(g.M, g.N, gridDim.x, blockIdx.x);
    const int tid = opaque_tid(), wid = __builtin_amdgcn_readfirstlane(tid >> 6), lane = tid & 63, wr = wid >> 2, wc = wid & 3, fr = lane & 15, fq = lane >> 4;
    int K_ = g.K; asm volatile("" : "+s"(K_));
    const int K = K_, nt = K / BK;
    unsigned voffA[2], voffB[2];
#pragma unroll
    for (int i = 0; i < 2; ++i) { int R, C; stage_rc(tid * 16 + i * 8192, R, C); const int Rb = Epi::PERM ? ((R & ~31) + perm32(R & 31)) : R;
        voffA[i] = (unsigned)(R * K + C) * 2u; voffB[i] = (unsigned)(Rb * K + C) * 2u; }
    const size_t kstep = (size_t)(BK * 2);
    const size_t hstep = (size_t)HALF * K * 2;
    const size_t tstep = 2 * hstep;
    const unsigned ldsw = (unsigned)wid * 1024u;
    const int aoff = lds_byte(wr * 64 + fr, fq * 8), boff = lds_byte(wc * 32 + fr, fq * 8);
#define PG8_SA(b, h) (((b) * 2 + (h)) * HTB)
#define PG8_SB(b, h) ((4 + (b) * 2 + (h)) * HTB)
#define PG8_STAGE(bufoff, gbase, voff) do { _Pragma("unroll") for (int _i = 0; _i < 2; ++_i) \
        __builtin_amdgcn_global_load_lds((const unsigned*)((const char*)(gbase) + (voff)[_i]), (PG8_LAS unsigned*)(lds + (bufoff) + ldsw + _i * 8192), 16, 0, 0); } while (0)
#define PG8_LDA(dst, b, h) do { _Pragma("unroll") for (int m = 0; m < 4; ++m) _Pragma("unroll") for (int k = 0; k < 2; ++k) dst[m][k] = *(const PG8_LAS bf16x8*)(lds + PG8_SA(b, h) + aoff + m * 2048 + k * 1024); } while (0)
#define PG8_LDB(dst, b, h) do { _Pragma("unroll") for (int n = 0; n < 2; ++n) _Pragma("unroll") for (int k = 0; k < 2; ++k) dst[n][k] = *(const PG8_LAS bf16x8*)(lds + PG8_SB(b, h) + boff + n * 2048 + k * 1024); } while (0)
#define PG8_MMA(ai, bj, At, Bt) do { __builtin_amdgcn_s_setprio(1); _Pragma("unroll") for (int m = 0; m < 4; ++m) _Pragma("unroll") for (int n = 0; n < 2; ++n) _Pragma("unroll") for (int k = 0; k < 2; ++k) \
        acc[ai][bj][m][n] = __builtin_amdgcn_mfma_f32_16x16x32_bf16(Bt[n][k], At[m][k], acc[ai][bj][m][n], 0, 0, 0); __builtin_amdgcn_s_setprio(0); } while (0)
#define PG8_WAIT_V(n) asm volatile("s_waitcnt vmcnt(" #n ")" ::: "memory")
#define PG8_WAIT_L(n) asm volatile("s_waitcnt lgkmcnt(" #n ")" ::: "memory")
#define PG8_BAR __builtin_amdgcn_s_barrier()
#define PG8_SCHED __builtin_amdgcn_sched_barrier(0)
    Unit cur, nxt; int ui = 0;
    if (!S.next(0, cur)) return;
    AccT acc;
#pragma unroll
    for (int a = 0; a < 2; ++a)
#pragma unroll
        for (int b = 0; b < 2; ++b)
#pragma unroll
            for (int m = 0; m < 4; ++m)
#pragma unroll
                for (int n = 0; n < 2; ++n) acc[a][b][m][n] = (f32x4){0.f, 0.f, 0.f, 0.f};
    bf16x8 At[4][2], B0[2][2], B1[2][2];
    const char* cA = (const char*)(cur.pn >= g.pn2 ? g.A2 : g.A) + (size_t)cur.pm * tstep; const char* cB = (const char*)g.Bt + (size_t)cur.pn * tstep;
    if constexpr (SP2) {
        PG8_STAGE(PG8_SB(0, 0), cB, voffB); PG8_STAGE(PG8_SB(0, 1), cB + hstep, voffB); PG8_STAGE(PG8_SA(0, 0), cA, voffA); PG8_STAGE(PG8_SA(0, 1), cA + hstep, voffA);
        if (wr == 1) PG8_BAR;
        PG8_WAIT_V(2); PG8_BAR;
        PG8_STAGE(PG8_SB(1, 0), cB + kstep, voffB); PG8_STAGE(PG8_SA(1, 0), cA + kstep, voffA); PG8_STAGE(PG8_SB(1, 1), cB + hstep + kstep, voffB);
        PG8_WAIT_V(6); PG8_BAR;
    } else {
        PG8_STAGE(PG8_SB(0, 0), cB, voffB); PG8_STAGE(PG8_SA(0, 0), cA, voffA); PG8_STAGE(PG8_SB(0, 1), cB + hstep, voffB); PG8_STAGE(PG8_SA(0, 1), cA + hstep, voffA);
        if (wr == 1) PG8_BAR;
        PG8_WAIT_V(4); PG8_BAR;
        PG8_STAGE(PG8_SB(1, 0), cB + kstep, voffB); PG8_STAGE(PG8_SA(1, 0), cA + kstep, voffA); PG8_STAGE(PG8_SB(1, 1), cB + hstep + kstep, voffB);
        PG8_WAIT_V(6); PG8_BAR;
    }
    for (;;) {
        const bool has_next = S.next(ui + 1, nxt);
        const char* nA = has_next ? (const char*)(nxt.pn >= g.pn2 ? g.A2 : g.A) + (size_t)nxt.pm * tstep : cA; const char* nB = has_next ? (const char*)g.Bt + (size_t)nxt.pn * tstep : cB;
        for (int t = 0; t < nt; t += 2) {
            const bool last = (t == nt - 2);
            const char* a1 = cA + (size_t)(t + 1) * kstep;
            const char* a2 = last ? nA : cA + (size_t)(t + 2) * kstep; const char* b2 = last ? nB : cB + (size_t)(t + 2) * kstep;
            const char* a3 = a2 + kstep; const char* b3 = b2 + kstep;
            if constexpr (SP2) {
            PG8_LDB(B0, 0, 0); PG8_LDB(B1, 0, 1); PG8_SCHED; PG8_LDA(At, 0, 0); PG8_STAGE(PG8_SA(1, 1), a1 + hstep, voffA);
            PG8_WAIT_V(8); PG8_WAIT_L(0); PG8_BAR; PG8_MMA(0, 0, At, B0); PG8_MMA(0, 1, At, B1); PG8_BAR; PG8_SCHED;
            PG8_LDA(At, 0, 1); PG8_STAGE(PG8_SB(0, 0), b2, voffB); PG8_STAGE(PG8_SB(0, 1), b2 + hstep, voffB); PG8_STAGE(PG8_SA(0, 0), a2, voffA);
            PG8_WAIT_V(8); PG8_WAIT_L(0); PG8_BAR; PG8_MMA(1, 0, At, B0); PG8_MMA(1, 1, At, B1); PG8_BAR; PG8_SCHED;
            PG8_LDB(B0, 1, 0); PG8_LDB(B1, 1, 1); PG8_SCHED; PG8_LDA(At, 1, 0); PG8_STAGE(PG8_SA(0, 1), a2 + hstep, voffA);
            PG8_WAIT_V(8); PG8_WAIT_L(0); PG8_BAR; PG8_MMA(0, 0, At, B0); PG8_MMA(0, 1, At, B1); PG8_BAR; PG8_SCHED;
            PG8_LDA(At, 1, 1); PG8_STAGE(PG8_SB(1, 0), b3, voffB); PG8_STAGE(PG8_SB(1, 1), b3 + hstep, voffB); PG8_STAGE(PG8_SA(1, 0), a3, voffA);
            PG8_WAIT_V(8); PG8_WAIT_L(0); PG8_BAR; PG8_MMA(1, 0, At, B0); PG8_MMA(1, 1, At, B1); PG8_BAR; PG8_SCHED;
            } else {
            PG8_LDB(B0, 0, 0); PG8_SCHED; PG8_LDA(At, 0, 0); PG8_STAGE(PG8_SA(1, 1), a1 + hstep, voffA);
            PG8_WAIT_L(8); PG8_BAR; PG8_WAIT_L(0); PG8_MMA(0, 0, At, B0); PG8_BAR; PG8_SCHED;
            PG8_LDB(B1, 0, 1); PG8_STAGE(PG8_SB(0, 0), b2, voffB);
            PG8_BAR; PG8_WAIT_L(0); PG8_MMA(0, 1, At, B1); PG8_BAR;
            PG8_LDA(At, 0, 1); PG8_STAGE(PG8_SA(0, 0), a2, voffA);
            PG8_BAR; PG8_WAIT_L(0); PG8_MMA(1, 0, At, B0); PG8_BAR; PG8_SCHED;
            PG8_STAGE(PG8_SB(0, 1), b2 + hstep, voffB);
            PG8_WAIT_V(6); PG8_BAR; PG8_MMA(1, 1, At, B1); PG8_BAR;
            PG8_LDB(B0, 1, 0); PG8_SCHED; PG8_LDA(At, 1, 0); PG8_STAGE(PG8_SA(0, 1), a2 + hstep, voffA);
            PG8_WAIT_L(8); PG8_BAR; PG8_WAIT_L(0); PG8_MMA(0, 0, At, B0); PG8_BAR; PG8_SCHED;
            PG8_LDB(B1, 1, 1); PG8_STAGE(PG8_SB(1, 0), b3, voffB);
            PG8_BAR; PG8_WAIT_L(0); PG8_MMA(0, 1, At, B1); PG8_BAR;
            PG8_LDA(At, 1, 1); PG8_STAGE(PG8_SA(1, 0), a3, voffA);
            PG8_BAR; PG8_WAIT_L(0); PG8_MMA(1, 0, At, B0); PG8_BAR; PG8_SCHED;
            PG8_STAGE(PG8_SB(1, 1), b3 + hstep, voffB);
            PG8_WAIT_V(6); PG8_BAR; PG8_MMA(1, 1, At, B1); PG8_BAR;
            }
        }
        if constexpr (ALIGN_EPI) { if (wr == 0) PG8_BAR; }
        E(acc, cur, wr, wc, fr, fq);
        if (!has_next) break;
#pragma unroll
        for (int a = 0; a < 2; ++a)
#pragma unroll
            for (int b = 0; b < 2; ++b)
#pragma unroll
                for (int m = 0; m < 4; ++m)
#pragma unroll
                    for (int n = 0; n < 2; ++n) acc[a][b][m][n] = (f32x4){0.f, 0.f, 0.f, 0.f};
        cur = nxt; cA = nA; cB = nB; ++ui;
        if constexpr (ALIGN_EPI) { if (wr == 1) PG8_BAR; }
    }
    PG8_WAIT_V(0);
    if constexpr (!ALIGN_EPI) { if (wr == 0) PG8_BAR; }
    PG8_BAR;
#undef PG8_SA
#undef PG8_SB
#undef PG8_STAGE
#undef PG8_LDA
#undef PG8_LDB
#undef PG8_MMA
#undef PG8_WAIT_V
#undef PG8_WAIT_L
#undef PG8_BAR
#undef PG8_SCHED
}

template <class Epi> __device__ __forceinline__ void gemm_phase(unsigned char* lds, const Gemm g, const Epi& E) {
#if FAST_GEMM
    gemm_fast<Epi>((PG8_LAS unsigned char*)lds, g, E);
#else
    gemm_naive<Epi>(g, E);
#endif
}

__device__ __forceinline__ void p2_naive(const Args& A, unsigned char* lds, size_t mask_off = OFF_MASK) {
    const int tid = opaque_tid(), lane = tid & 63, wave = tid >> 6;
    float* sc = (float*)lds; float* qf = sc + 2048; float* wf = qf + 512;
    const bf16_t* QI = WSP(bf16_t, OFF_QI); const bf16_t* KI = WSP(bf16_t, OFF_KI); const float* WI = WSP(float, OFF_WI); unsigned* MASK = WSP(unsigned, mask_off);
    for (int m = blockIdx.x; m < MTOK; m += gridDim.x) {
        const int t = m & (SEQ - 1), b0 = m - t, nk = t + 1;
        unsigned* mrow = MASK + (size_t)m * 64;
        if (t < 256) { if (tid < 64) { const int lo = tid * 32; mrow[tid] = (nk >= lo + 32) ? 0xffffffffu : (nk <= lo ? 0u : ((1u << (nk - lo)) - 1u)); } continue; }
        __syncthreads();
        qf[tid] = bf2f(QI[(size_t)m * 512 + tid]);
        if (tid < 8) wf[tid] = WI[(size_t)m * 8 + tid];
        __syncthreads();
        for (int s = tid; s < nk; s += NTHR) {
            const bf16_t* kr = KI + (size_t)(b0 + s) * 64; float kf[64];
#pragma unroll
            for (int c = 0; c < 8; ++c) { const bf16x8 kv = *(const bf16x8*)(kr + 8 * c);
#pragma unroll
                for (int e = 0; e < 8; ++e) kf[8 * c + e] = bf2f((bf16_t)kv[e]); }
            float score = 0.f;
#pragma unroll
            for (int h = 0; h < 8; ++h) { float d = 0.f;
#pragma unroll
                for (int e = 0; e < 64; ++e) d += qf[h * 64 + e] * kf[e];
                score += wf[h] * fmaxf(d, 0.f); }
            sc[s] = score;
        }
        __syncthreads();
#pragma unroll 1
        for (int j = 0; j < 4; ++j) {
            const int base = 512 * j + 64 * wave;
            if (base >= nk) { if (lane < 2) mrow[(base >> 5) + lane] = 0u; continue; }
            const int s = base + lane; const bool valid = s < nk; const float my = valid ? sc[s] : 0.f; int cnt = 0;
            for (int s2 = 0; s2 < nk; ++s2) { const float o = sc[s2]; cnt += ((o > my) || (o == my && s2 < s)) ? 1 : 0; }
            const unsigned long long bal = __ballot(valid && cnt < 256);
            if (lane == 0) { mrow[base >> 5] = (unsigned)bal; mrow[(base >> 5) + 1] = (unsigned)(bal >> 32); }
        }
    }
}

__device__ __forceinline__ void p3_naive(const Args& A, unsigned char* lds) {
    const int tid = opaque_tid(), lane = tid & 63, wave = tid >> 6;
    float* lg = (float*)lds; float* qf = lg + 2048; float* red = qf + 1024; unsigned* mw = (unsigned*)(red + 1024);
    bf16_t* QO = WSP(bf16_t, OFF_QO); const bf16_t* K = WSP(bf16_t, OFF_K); const bf16_t* V = WSP(bf16_t, OFF_V); const unsigned* MASK = WSP(unsigned, OFF_MASK);
    for (int m = blockIdx.x; m < MTOK; m += gridDim.x) {
        const int t = m & (SEQ - 1), b0 = m - t, nk = t + 1;
        __syncthreads();
        qf[tid] = bf2f(QO[(size_t)m * 1024 + tid]); qf[tid + 512] = bf2f(QO[(size_t)m * 1024 + 512 + tid]);
        if (tid < 64) mw[tid] = MASK[(size_t)m * 64 + tid];
        __syncthreads();
#pragma unroll 1
        for (int hd = 0; hd < 16; ++hd) {
            const int n = hd >> 2; float mx = -INFINITY;
            for (int s = tid; s < nk; s += NTHR) {
                float v = -INFINITY;
                if ((mw[s >> 5] >> (s & 31)) & 1u) {
                    const bf16_t* kr = K + (size_t)(b0 + s) * 256 + n * 64; float d = 0.f;
#pragma unroll
                    for (int c = 0; c < 8; ++c) { const bf16x8 kv = *(const bf16x8*)(kr + 8 * c);
#pragma unroll
                        for (int e = 0; e < 8; ++e) d += qf[hd * 64 + 8 * c + e] * bf2f((bf16_t)kv[e]); }
                    v = d;
                }
                lg[s] = v; mx = fmaxf(mx, v);
            }
            mx = block_max(mx, red, wave, lane);
            float sm = 0.f;
            for (int s = tid; s < nk; s += NTHR) { const float p = exp2f(lg[s] - mx); lg[s] = p; sm += p; }
            sm = block_sum(sm, red, wave, lane);
            float acc = 0.f;
            for (int s = wave; s < nk; s += NWAVES) { const float p = lg[s]; if (p != 0.f) acc += p * bf2f(V[(size_t)(b0 + s) * 256 + n * 64 + lane]); }
            __syncthreads();
            red[16 + wave * 64 + lane] = acc;
            __syncthreads();
            if (tid < 64) { float o = 0.f;
#pragma unroll
                for (int p = 0; p < NWAVES; ++p) o += red[16 + p * 64 + tid];
                QO[(size_t)m * 1024 + hd * 64 + tid] = (bf16_t)f2bf(o / sm); }
            __syncthreads();
        }
    }
}

__device__ __forceinline__ void p7_prep(const Args& A) {
    const int tid = opaque_tid(), lane = tid & 63, wave = tid >> 6;
    const int gw = blockIdx.x * NWAVES + wave, NGW = gridDim.x * NWAVES;
    const float* X = A.out; const float* g = A.in[IN_MIXN] + DM; const float* mu = A.in[IN_MU];
    bf16_t* XSR = WSP(bf16_t, OFF_XSR); bf16_t* XSK = WSP(bf16_t, OFF_XSK); bf16_t* XSV = WSP(bf16_t, OFF_XSV); bf16_t* H1 = WSP(bf16_t, OFF_H1);
    f32x4 gg[4], mr[4], mk[4], mv[4];
#pragma unroll
    for (int j = 0; j < 4; ++j) { gg[j] = ((const f32x4*)g)[lane + 64 * j]; mr[j] = ((const f32x4*)mu)[lane + 64 * j]; mk[j] = ((const f32x4*)(mu + DM))[lane + 64 * j]; mv[j] = ((const f32x4*)(mu + 2 * DM))[lane + 64 * j]; }
    for (int run = gw; run < MTOK / 16; run += NGW) {
        const int r0 = run * 16; f32x4 hp[4];
#pragma unroll 1
        for (int i = -1; i < 16; ++i) {
            const int row = r0 + i; f32x4 h[4];
            if (i < 0 && (r0 & (SEQ - 1)) == 0) {
#pragma unroll
                for (int j = 0; j < 4; ++j) hp[j] = (f32x4){0.f, 0.f, 0.f, 0.f};
                continue;
            }
            const f32x4* xr = (const f32x4*)(X + (size_t)row * DM) + lane; float s = 0.f;
#pragma unroll
            for (int j = 0; j < 4; ++j) { h[j] = xr[64 * j]; s += (h[j].x * h[j].x + h[j].y * h[j].y) + (h[j].z * h[j].z + h[j].w * h[j].w); }
            const float rs = rsqrtf(wave_sum(s) * (1.f / DM) + NORM_EPS);
#pragma unroll
            for (int j = 0; j < 4; ++j) h[j] = h[j] * rs * gg[j];
            if (i >= 0) {
#pragma unroll
                for (int j = 0; j < 4; ++j) {
                    const f32x4 xx = hp[j] - h[j];
                    const f32x4 a = h[j] + xx * mr[j], b = h[j] + xx * mk[j], c = h[j] + xx * mv[j];
                    const size_t off = (size_t)row * DM + 4 * lane + 256 * j;
                    u32x2 w; w.x = pk2(a.x, a.y); w.y = pk2(a.z, a.w); *(u32x2*)(XSR + off) = w;
                    w.x = pk2(b.x, b.y); w.y = pk2(b.z, b.w); *(u32x2*)(XSK + off) = w;
                    w.x = pk2(c.x, c.y); w.y = pk2(c.z, c.w); *(u32x2*)(XSV + off) = w;
                    w.x = pk2(h[j].x, h[j].y); w.y = pk2(h[j].z, h[j].w); *(u32x2*)(H1 + off) = w;
                }
            }
#pragma unroll
            for (int j = 0; j < 4; ++j) hp[j] = h[j];
        }
    }
}
__device__ __forceinline__ void p10_loramid(const Args& A) {
    const bf16_t* P = WSP(bf16_t, OFF_P); bf16_t* AW = WSP(bf16_t, OFF_AW); bf16_t* AA = WSP(bf16_t, OFF_AA); bf16_t* AG = WSP(bf16_t, OFF_AG);
    const size_t total = (size_t)MTOK * 512;
    for (size_t idx = (size_t)blockIdx.x * NTHR + threadIdx.x; idx < total; idx += (size_t)gridDim.x * NTHR) {
        const int m = (int)(idx >> 9), j = (int)(idx & 511); const bool first = (m & (SEQ - 1)) == 0;
        const bf16_t* p0 = P + (size_t)m * 768; const bf16_t* pm = p0 - 768;
        if (j < 128) {
            float v = 0.f; if (j < 64) { const float x = bf2f(p0[j]) + (first ? 0.f : bf2f(pm[64 + j])); const float e = __expf(-2.f * fabsf(x)); const float th = (1.f - e) / (1.f + e); v = x < 0.f ? -th : th; }
            AW[(size_t)m * 128 + j] = (bf16_t)f2bf(v);
        } else if (j < 256) {
            const int jj = j - 128; float v = 0.f; if (jj < 64) v = bf2f(p0[128 + jj]) + (first ? 0.f : bf2f(pm[192 + jj]));
            AA[(size_t)m * 128 + jj] = (bf16_t)f2bf(v);
        } else {
            const int jj = j - 256; float v = 0.f; if (jj < 160) { const float x = bf2f(p0[256 + jj]) + (first ? 0.f : bf2f(pm[416 + jj])); v = sigmoidf_(x); }
            AG[(size_t)m * 256 + jj] = (bf16_t)f2bf(v);
        }
    }
}
__device__ __forceinline__ void p12_naive(const Args& A, unsigned char* lds) {
    const int tid = opaque_tid(), lane = tid & 63, wave = tid >> 6;
    const int gw = blockIdx.x * NWAVES + wave, NGW = gridDim.x * NWAVES;
    float* sh = (float*)lds + wave * 320;
    const bf16_t* R = WSP(bf16_t, OFF_R); const bf16_t* KR = WSP(bf16_t, OFF_KR); const bf16_t* VV = WSP(bf16_t, OFF_VV); const bf16_t* E = WSP(bf16_t, OFF_E); const bf16_t* AS = WSP(bf16_t, OFF_A);
    bf16_t* Y = WSP(bf16_t, OFF_Y);
    for (int it = gw; it < BATCH * 16; it += NGW) {
        const int b = it >> 4, h = it & 15;
        float S[64];
#pragma unroll
        for (int j = 0; j < 64; ++j) S[j] = 0.f;
        const float kkw = A.in[IN_KK][h * 64 + lane], kaw = A.in[IN_KA][h * 64 + lane];
        const size_t base = (size_t)b * SEQ * DM + h * 64 + lane;
        bf16_t rn = R[base], kn = KR[base], vn = VV[base], en = E[base], an = AS[base];
#pragma unroll 1
        for (int t = 0; t < SEQ; ++t) {
            const float r = bf2f(rn), k = bf2f(kn), v = bf2f(vn), e = bf2f(en), a = bf2f(an);
            if (t + 1 < SEQ) { const size_t ix = base + (size_t)(t + 1) * DM; rn = R[ix]; kn = KR[ix]; vn = VV[ix]; en = E[ix]; an = AS[ix]; }
            float kk = k * kkw; const float ss = wave_sum(kk * kk); kk *= rsqrtf(fmaxf(ss, 1e-24f));
            const float kt = k * (1.f + (a - 1.f) * kaw), bb = kk * a, w = __expf(e);
            sh[lane] = -kk; sh[64 + lane] = w; sh[128 + lane] = bb; sh[192 + lane] = kt; sh[256 + lane] = r;
            LDS_WAIT();
            float sa = 0.f;
#pragma unroll
            for (int j = 0; j < 64; ++j) sa += S[j] * sh[j];
            float y = 0.f;
#pragma unroll
            for (int j = 0; j < 64; ++j) { S[j] = S[j] * sh[64 + j] + sa * sh[128 + j] + v * sh[192 + j]; y += S[j] * sh[256 + j]; }
            Y[base + (size_t)t * DM] = (bf16_t)f2bf(y);
            LDS_WAIT();
        }
    }
}
__device__ __forceinline__ void p12b_stats(const Args& A) {
    const int tid = opaque_tid(), lane = tid & 63, wave = tid >> 6;
    const int gw = blockIdx.x * NWAVES + wave, NGW = gridDim.x * NWAVES;
    const bf16_t* R = WSP(bf16_t, OFF_R); const bf16_t* KR = WSP(bf16_t, OFF_KR); const bf16_t* AS = WSP(bf16_t, OFF_A); const bf16_t* Y = WSP(bf16_t, OFF_Y);
    float* ST = WSP(float, OFF_STATS); float* BO = WSP(float, OFF_BONUS);
    for (int it = gw; it < MTOK * 16; it += NGW) {
        const int h = it & 15; const size_t ix = (size_t)(it >> 4) * DM + h * 64 + lane;
        const float y = bf2f(Y[ix]), r = bf2f(R[ix]), k = bf2f(KR[ix]), a = bf2f(AS[ix]);
        const float kt = k * (1.f + (a - 1.f) * A.in[IN_KA][h * 64 + lane]);
        const float s1 = wave_sum(y), s2 = wave_sum(y * y), bo = wave_sum(r * kt * A.in[IN_RK][h * 64 + lane]);
        if (lane == 0) { *(f32x4*)(ST + (size_t)it * 4) = (f32x4){s1, s2, 0.f, 0.f}; BO[it] = bo; }
    }
}

template <int CTRL> __device__ __forceinline__ float dppf(float v) { return __int_as_float(__builtin_amdgcn_mov_dpp(__float_as_int(v), CTRL, 0xF, 0xF, false)); }
template <int CTRL> __device__ __forceinline__ int dppi(int v) { return __builtin_amdgcn_mov_dpp(v, CTRL, 0xF, 0xF, false); }
__device__ __forceinline__ float row16_allsum(float v) { v += dppf<0xB1>(v); v += dppf<0x4E>(v); v += dppf<0x124>(v); v += dppf<0x128>(v); return v; }
__device__ __forceinline__ float ffma_s(float a, float b, float c) { float r; asm("v_fma_f32 %0, %1, %2, %3" : "=v"(r) : "v"(a), "v"(b), "v"(c)); return r; }
__device__ __forceinline__ float fmul_s(float a, float b) { float r; asm("v_mul_f32_e32 %0, %1, %2" : "=v"(r) : "v"(a), "v"(b)); return r; }
__device__ __forceinline__ float row16_allsum_fused(float v) {
    float a, b, c, d;
    asm("s_nop 1\n\tv_add_f32_dpp %0, %1, %1 quad_perm:[1,0,3,2] row_mask:0xf bank_mask:0xf" : "=v"(a) : "v"(v));
    asm("s_nop 1\n\tv_add_f32_dpp %0, %1, %1 quad_perm:[2,3,0,1] row_mask:0xf bank_mask:0xf" : "=v"(b) : "v"(a));
    asm("s_nop 1\n\tv_add_f32_dpp %0, %1, %1 row_ror:4 row_mask:0xf bank_mask:0xf" : "=v"(c) : "v"(b));
    asm("s_nop 1\n\tv_add_f32_dpp %0, %1, %1 row_ror:8 row_mask:0xf bank_mask:0xf" : "=v"(d) : "v"(c));
    return d;
}
__device__ __forceinline__ int row16_allsum_i(int v) { v += dppi<0xB1>(v); v += dppi<0x4E>(v); v += dppi<0x124>(v); v += dppi<0x128>(v); return v; }
__device__ __forceinline__ int wave_allsum_i(int v) {
    v = row16_allsum_i(v);
    return __builtin_amdgcn_readlane(v, 0) + __builtin_amdgcn_readlane(v, 16) + __builtin_amdgcn_readlane(v, 32) + __builtin_amdgcn_readlane(v, 48);
}

constexpr int P2_LD = 2052;
__device__ __forceinline__ void p2_fast(const Args& A, unsigned char* lds) {
    const int tid = opaque_tid(), lane = tid & 63, wave = __builtin_amdgcn_readfirstlane(tid >> 6), fr = lane & 15, fq = lane >> 4;
    float* sc = (float*)lds;
    const bf16_t* QI = WSP(bf16_t, OFF_QI); const bf16_t* KI = WSP(bf16_t, OFF_KI); const float* WI = WSP(float, OFF_WI); unsigned* MASK = WSP(unsigned, OFF_MASK);
    for (int it = blockIdx.x; it < 1024; it += gridDim.x) {
        const int q = it >> 8, c = it & 255, b = c & 7, s5 = c >> 3;
        const int tt = (q == 0) ? s5 : (q == 1) ? 63 - s5 : (q == 2) ? 64 + s5 : 127 - s5;
        const int t0 = 16 * tt, m0 = b * SEQ + t0;
        if (t0 >= 256 - 15) {
            bf16x8 qf[8][2]; float wv[8];
#pragma unroll
            for (int h = 0; h < 8; ++h) {
#pragma unroll
                for (int ks = 0; ks < 2; ++ks) qf[h][ks] = *(const bf16x8*)(QI + (size_t)(m0 + fr) * 512 + h * 64 + ks * 32 + fq * 8);
                wv[h] = WI[(size_t)(m0 + fr) * 8 + h];
            }
            const bf16_t* kbase = KI + (size_t)(b * SEQ + fr) * 64 + fq * 8;
            bf16x8 ka0 = *(const bf16x8*)(kbase + (size_t)wave * 16 * 64), ka1 = *(const bf16x8*)(kbase + (size_t)wave * 16 * 64 + 32);
#pragma unroll 1
            for (int kt = wave; kt <= tt; kt += NWAVES) {
                const bf16x8 a0 = ka0, a1 = ka1;
                if (kt + NWAVES <= tt) { ka0 = *(const bf16x8*)(kbase + (size_t)(kt + NWAVES) * 16 * 64); ka1 = *(const bf16x8*)(kbase + (size_t)(kt + NWAVES) * 16 * 64 + 32); }
                f32x4 acc = {0.f, 0.f, 0.f, 0.f};
#pragma unroll
                for (int h = 0; h < 8; ++h) {
                    f32x4 d = __builtin_amdgcn_mfma_f32_16x16x32_bf16(a0, qf[h][0], (f32x4){0.f, 0.f, 0.f, 0.f}, 0, 0, 0);
                    d = __builtin_amdgcn_mfma_f32_16x16x32_bf16(a1, qf[h][1], d, 0, 0, 0);
#pragma unroll
                    for (int e = 0; e < 4; ++e) acc[e] += wv[h] * fmaxf(d[e], 0.f);
                }
                *(f32x4*)(sc + fr * P2_LD + kt * 16 + 4 * fq) = acc;
            }
        }
        __syncthreads();
#pragma unroll 1
        for (int rr = 2 * wave; rr < 2 * wave + 2; ++rr) {
            const int t = t0 + rr, nk = t + 1;
            unsigned long long* mrow = (unsigned long long*)(MASK + (size_t)(m0 + rr) * 64);
            if (t < 256) {
                if (lane < 32) { const int lo = lane * 64; mrow[lane] = (nk >= lo + 64) ? ~0ull : (nk <= lo ? 0ull : ((1ull << (nk - lo)) - 1ull)); }
                continue;
            }
            const int nj = (nk + 63) >> 6;
            float x[32];
            const float* srow = sc + rr * P2_LD + lane;
#pragma unroll
            for (int j = 0; j < 32; ++j) x[j] = (j < nj && lane + 64 * j < nk) ? srow[64 * j] : -INFINITY;
            float mx = x[0], mn = (lane < nk) ? x[0] : INFINITY;
#pragma unroll
            for (int j = 1; j < 32; ++j) { mx = fmaxf(mx, x[j]); mn = fminf(mn, (j < nj && lane + 64 * j < nk) ? x[j] : INFINITY); }
            mx = wave_max(mx); mn = -wave_max(-mn);
            mx = __int_as_float(__builtin_amdgcn_readfirstlane(__float_as_int(mx))); mn = __int_as_float(__builtin_amdgcn_readfirstlane(__float_as_int(mn)));
#define P2_COUNT_GE(thr, out) do { int c_ = 0; \
                _Pragma("unroll") for (int g_ = 0; g_ < 4; ++g_) if (nj > 8 * g_) { _Pragma("unroll") for (int j_ = 0; j_ < 8; ++j_) c_ += (x[8 * g_ + j_] >= (thr)) ? 1 : 0; } \
                (out) = wave_allsum_i(c_); } while (0)
            float lo = mn, hi = mx, thr = 0.f; int c_hi; bool exact = false;
            P2_COUNT_GE(mx, c_hi);
            if (c_hi >= 256) { lo = mx; c_hi = 0; }
            else {
#pragma unroll 1
                for (;;) {
                    const float mid = lo + (hi - lo) * 0.5f;
                    if (!(mid > lo && mid < hi)) break;
                    int cm; P2_COUNT_GE(mid, cm);
                    if (cm == 256) { exact = true; thr = mid; break; }
                    if (cm > 256) lo = mid; else { hi = mid; c_hi = cm; }
                }
            }
            unsigned long long mine = 0ull;
            if (exact) {
#pragma unroll
                for (int j = 0; j < 32; ++j) { const unsigned long long bal = __ballot(x[j] >= thr); if (lane == j) mine = bal; }
            } else {
                int need = 256 - c_hi;
#pragma unroll
                for (int j = 0; j < 32; ++j) {
                    const bool eq = (x[j] == lo); const unsigned long long beq = __ballot(eq);
                    const int pre = __builtin_amdgcn_mbcnt_hi((unsigned)(beq >> 32), __builtin_amdgcn_mbcnt_lo((unsigned)beq, 0));
                    const unsigned long long bal = __ballot((x[j] > lo) || (eq && pre < need));
                    need -= __popcll(beq); need = need < 0 ? 0 : need;
                    if (lane == j) mine = bal;
                }
            }
            if (lane < 32) mrow[lane] = mine;
#undef P2_COUNT_GE
        }
        __syncthreads();
    }
}

constexpr int SC_TC = 32, SC_BUF_F = 5 * SC_TC * 64 + SC_TC * 32;
__device__ __forceinline__ void p12_fast(const Args& A, unsigned char* lds) {
    const int tid = opaque_tid(), lane = tid & 63, wave = __builtin_amdgcn_readfirstlane(tid >> 6);
    const int kq = lane & 15, row = 4 * wave + (lane >> 4), tl = tid >> 4;
    float* fl = (float*)lds; float* ybuf = fl + 2 * SC_BUF_F;
    const bf16_t* R = WSP(bf16_t, OFF_R); const bf16_t* KR = WSP(bf16_t, OFF_KR); const bf16_t* VV = WSP(bf16_t, OFF_VV); const bf16_t* E = WSP(bf16_t, OFF_E); const bf16_t* AS = WSP(bf16_t, OFF_A);
    bf16_t* Y = WSP(bf16_t, OFF_Y); float* ST = WSP(float, OFF_STATS); float* BO = WSP(float, OFF_BONUS);
    for (int it = blockIdx.x; it < BATCH * 16 * 2; it += gridDim.x) {
        const int half = it & 1, h = (it >> 1) & 15, b = it >> 5;
        const f32x4 kkw = *(const f32x4*)(A.in[IN_KK] + h * 64 + 4 * kq), kaw = *(const f32x4*)(A.in[IN_KA] + h * 64 + 4 * kq), rkw = *(const f32x4*)(A.in[IN_RK] + h * 64 + 4 * kq);
        const size_t gbase = ((size_t)b * SEQ + tl) * DM + h * 64 + 4 * kq;
        u32x2 pr, pk, pv, pe, pa;
#define SC_PREFETCH(c) do { const size_t gi_ = gbase + (size_t)(c) * SC_TC * DM; pr = *(const u32x2*)(R + gi_); pk = *(const u32x2*)(KR + gi_); pv = *(const u32x2*)(VV + gi_); pe = *(const u32x2*)(E + gi_); pa = *(const u32x2*)(AS + gi_); } while (0)
#define SC_UNPK(p, o) do { o[0] = __uint_as_float(p.x << 16); o[1] = __uint_as_float(p.x & 0xffff0000u); o[2] = __uint_as_float(p.y << 16); o[3] = __uint_as_float(p.y & 0xffff0000u); } while (0)
#define SC_DERIVE(c) do { float* bf_ = fl + ((c) & 1) * SC_BUF_F; float r_[4], k_[4], v_[4], e_[4], a_[4]; SC_UNPK(pr, r_); SC_UNPK(pk, k_); SC_UNPK(pv, v_); SC_UNPK(pe, e_); SC_UNPK(pa, a_); \
            f32x4 kkv_, w_, n_, b_, kt_, rr_; float ss_ = 0.f, bo_ = 0.f; \
            _Pragma("unroll") for (int i_ = 0; i_ < 4; ++i_) { kkv_[i_] = k_[i_] * kkw[i_]; ss_ += kkv_[i_] * kkv_[i_]; } \
            ss_ = row16_allsum(ss_); const float inv_ = rsqrtf(fmaxf(ss_, 1e-24f)); \
            _Pragma("unroll") for (int i_ = 0; i_ < 4; ++i_) { n_[i_] = -kkv_[i_] * inv_; b_[i_] = -n_[i_] * a_[i_]; kt_[i_] = k_[i_] * (1.f + (a_[i_] - 1.f) * kaw[i_]); w_[i_] = __expf(e_[i_]); rr_[i_] = r_[i_]; bo_ += r_[i_] * kt_[i_] * rkw[i_]; } \
            bo_ = row16_allsum(bo_); \
            if (half == 0 && kq == 0) BO[((size_t)b * SEQ + (c) * SC_TC + tl) * 16 + h] = bo_; \
            float* d_ = bf_ + tl * 64 + 4 * kq; *(f32x4*)(d_) = w_; *(f32x4*)(d_ + 2048) = n_; *(f32x4*)(d_ + 4096) = b_; *(f32x4*)(d_ + 6144) = kt_; *(f32x4*)(d_ + 8192) = rr_; \
            if ((kq >> 3) == half) *(f32x4*)(bf_ + 10240 + tl * 32 + 4 * (kq & 7)) = (f32x4){v_[0], v_[1], v_[2], v_[3]}; } while (0)
        __syncthreads();
        SC_PREFETCH(0); SC_DERIVE(0);
        __syncthreads();
        float S0 = 0.f, S1 = 0.f, S2 = 0.f, S3 = 0.f;
#pragma unroll 1
        for (int c = 0; c < SEQ / SC_TC; ++c) {
            if (c + 1 < SEQ / SC_TC) SC_PREFETCH(c + 1);
            const float* bf = fl + (c & 1) * SC_BUF_F + 4 * kq; const float* vb = fl + (c & 1) * SC_BUF_F + 10240 + row; float* yb = ybuf + (c & 1) * 1024 + row;
#define SC_LOAD(P, tt_) do { P##w = *(const f32x4*)(bf + (tt_) * 64); P##n = *(const f32x4*)(bf + (tt_) * 64 + 2048); P##b = *(const f32x4*)(bf + (tt_) * 64 + 4096); P##k = *(const f32x4*)(bf + (tt_) * 64 + 6144); P##r = *(const f32x4*)(bf + (tt_) * 64 + 8192); P##v = vb[(tt_) * 32]; } while (0)
#define SC_STEP(P, tt_) do { \
                float p_ = fmul_s(S0, P##n.x); p_ = ffma_s(S1, P##n.y, p_); p_ = ffma_s(S2, P##n.z, p_); p_ = ffma_s(S3, P##n.w, p_); \
                float t0_ = fmul_s(S0, P##w.x), t1_ = fmul_s(S1, P##w.y), t2_ = fmul_s(S2, P##w.z), t3_ = fmul_s(S3, P##w.w); \
                t0_ = ffma_s(P##v, P##k.x, t0_); t1_ = ffma_s(P##v, P##k.y, t1_); t2_ = ffma_s(P##v, P##k.z, t2_); t3_ = ffma_s(P##v, P##k.w, t3_); \
                const float sa_ = row16_allsum_fused(p_); \
                S0 = ffma_s(sa_, P##b.x, t0_); S1 = ffma_s(sa_, P##b.y, t1_); S2 = ffma_s(sa_, P##b.z, t2_); S3 = ffma_s(sa_, P##b.w, t3_); \
                float qy_ = fmul_s(S0, P##r.x); qy_ = ffma_s(S1, P##r.y, qy_); qy_ = ffma_s(S2, P##r.z, qy_); qy_ = ffma_s(S3, P##r.w, qy_); \
                const float y_ = row16_allsum_fused(qy_); \
                if (kq == 0) yb[(tt_) * 32] = y_; } while (0)
            f32x4 Aw, An, Ab, Ak, Ar, Bw, Bn, Bb, Bk, Br; float Av, Bv;
            SC_LOAD(A, 0);
#pragma unroll 1
            for (int tt = 0; tt < SC_TC; tt += 2) {
                SC_LOAD(B, tt + 1);
                SC_STEP(A, tt);
                if (tt + 2 < SC_TC) SC_LOAD(A, tt + 2);
                SC_STEP(B, tt + 1);
            }
#undef SC_LOAD
#undef SC_STEP
            if (c + 1 < SEQ / SC_TC) SC_DERIVE(c + 1);
            __syncthreads();
            {
                const int j = tid & 15; const float* ys = ybuf + (c & 1) * 1024 + tl * 32 + 2 * j;
                const float y0 = ys[0], y1 = ys[1];
                const float s1 = row16_allsum(y0 + y1), s2 = row16_allsum(y0 * y0 + y1 * y1);
                const size_t m = (size_t)b * SEQ + c * SC_TC + tl;
                *(unsigned*)(Y + m * DM + h * 64 + 32 * half + 2 * j) = pk2(y0, y1);
                if (j == 0) *(f32x2*)(ST + (m * 16 + h) * 4 + 2 * half) = (f32x2){s1, s2};
            }
        }
#undef SC_PREFETCH
#undef SC_UNPK
#undef SC_DERIVE
    }
}

namespace attn_body {
using bf16=__hip_bfloat16;
using bf16x8=__attribute__((ext_vector_type(8)))short;
using s16x4=__attribute__((ext_vector_type(4)))short;
using f32x16=__attribute__((ext_vector_type(16)))float;
using u32x4=__attribute__((ext_vector_type(4)))unsigned;
constexpr int BATCH=8,NHEAD=16,SEQ=2048,D=64,DM=NHEAD*D,KP=256;
constexpr int NW=8,QBLK=32,QB=QBLK*NW,KVBLK=64,NQB=SEQ/QB;
constexpr int ATTN_PITCH=DM, ATTN_UNIT_ROWS=QB;
__device__ __forceinline__ int crow(int r,int hi){return (r&3)+8*(r>>2)+4*hi;}
#define SBAR() __builtin_amdgcn_sched_barrier(0)
__device__ __forceinline__ void bmask(f32x16&p0,f32x16&p1,unsigned long long mw,int hi){
  const float NEG=-INFINITY; const unsigned lo=(unsigned)mw>>(4*hi), hw=(unsigned)(mw>>32)>>(4*hi);
  #pragma unroll
  for(int r=0;r<16;++r){const int c=(r&3)+8*(r>>2); if(!((lo>>c)&1u))p0[r]=NEG; if(!((hw>>c)&1u))p1[r]=NEG;}
}

constexpr int NSLOT=3, SLOTB=8192;
constexpr int LDS_K=0, LDS_V=NSLOT*SLOTB, LDS_WS=2*NSLOT*SLOTB, LDS_OST=LDS_WS+NW*64*4, LDS_MSK=LDS_OST+NW*4096, LDS_BYTES=LDS_MSK+64*256;
constexpr float C2=0.125f*1.4426950408889634f;
__device__ __forceinline__ void glds16(const void*gsrc,unsigned lds_dst){unsigned keep;
  asm volatile("s_mov_b32 %0, m0\n\ts_mov_b32 m0, %2\n\ts_nop 0\n\tglobal_load_lds_dwordx4 %1, off\n\ts_mov_b32 m0, %0":"=&s"(keep):"v"(gsrc),"s"(lds_dst):"memory");}
__device__ __forceinline__ float max3f(float a,float b,float c){float r;asm("v_max3_f32 %0, %1, %2, %3":"=v"(r):"v"(a),"v"(b),"v"(c));return r;}
__device__ __forceinline__ float max2f(float a,float b){float r;asm("v_max_f32_e32 %0, %1, %2":"=v"(r):"v"(a),"v"(b));return r;}
__device__ __forceinline__ float fadd_s(float a,float b){float r;asm("v_add_f32_e32 %0, %1, %2":"=v"(r):"v"(a),"v"(b));return r;}
__device__ __forceinline__ float fsub_s(float a,float b){float r;asm("v_sub_f32_e32 %0, %1, %2":"=v"(r):"v"(a),"v"(b));return r;}
typedef float f32x2_t __attribute__((ext_vector_type(2))); typedef __bf16 bf16x2_t __attribute__((ext_vector_type(2)));
__device__ __forceinline__ unsigned cvtpk_s(float lo,float hi){f32x2_t v={lo,hi};bf16x2_t b=__builtin_convertvector(v,bf16x2_t);return __builtin_bit_cast(unsigned,b);}
#define WAIT_BAR(N) asm volatile("s_waitcnt vmcnt(" #N ") lgkmcnt(0)\n\ts_barrier":::"memory")

__device__ __forceinline__ void qkt(f32x16&p0,f32x16&p1,const char*Kslot,const bf16x8*qr,const f32x16&negm,int r32,int hi){
  const char*kb=Kslot+hi*1024+r32*16;
  #pragma unroll
  for(int d0=0;d0<4;++d0){
    const bf16x8 b0=*reinterpret_cast<const bf16x8*>(kb+d0*2048);
    const bf16x8 b1=*reinterpret_cast<const bf16x8*>(kb+d0*2048+512);
    if(d0==0){p0=__builtin_amdgcn_mfma_f32_32x32x16_bf16(b0,qr[0],negm,0,0,0);p1=__builtin_amdgcn_mfma_f32_32x32x16_bf16(b1,qr[0],negm,0,0,0);}
    else{p0=__builtin_amdgcn_mfma_f32_32x32x16_bf16(b0,qr[d0],p0,0,0,0);p1=__builtin_amdgcn_mfma_f32_32x32x16_bf16(b1,qr[d0],p1,0,0,0);}}
}
typedef __attribute__((address_space(3))) const char* lds_cptr;
typedef short v4i16_t __attribute__((ext_vector_type(4)));
__device__ __forceinline__ void kload8(bf16x8*kf,lds_cptr kp){
  kf[0]=*(const __attribute__((address_space(3))) bf16x8*)(kp);      kf[1]=*(const __attribute__((address_space(3))) bf16x8*)(kp+512);
  kf[2]=*(const __attribute__((address_space(3))) bf16x8*)(kp+2048); kf[3]=*(const __attribute__((address_space(3))) bf16x8*)(kp+2560);
  kf[4]=*(const __attribute__((address_space(3))) bf16x8*)(kp+4096); kf[5]=*(const __attribute__((address_space(3))) bf16x8*)(kp+4608);
  kf[6]=*(const __attribute__((address_space(3))) bf16x8*)(kp+6144); kf[7]=*(const __attribute__((address_space(3))) bf16x8*)(kp+6656);
}
__device__ __forceinline__ void kload2(bf16x8*kf,lds_cptr kp,int j){ kf[2*j]=*(const __attribute__((address_space(3))) bf16x8*)(kp+j*2048); kf[2*j+1]=*(const __attribute__((address_space(3))) bf16x8*)(kp+j*2048+512); }
__device__ __forceinline__ s16x4 vtr(lds_cptr p){ return __builtin_bit_cast(s16x4,__builtin_amdgcn_ds_read_tr16_b64_v4i16((__attribute__((address_space(3))) v4i16_t*)p)); }
__device__ __forceinline__ float rowmax(const f32x16&p0,const f32x16&p1){
  float a=max3f(p0[0],p0[1],p1[0]),b=max3f(p0[2],p0[3],p1[1]);a=max3f(a,p1[2],p1[3]);
  #pragma unroll
  for(int r=4;r<16;r+=4){a=max3f(a,p0[r],p0[r+1]);b=max3f(b,p0[r+2],p0[r+3]);a=max3f(a,p1[r],p1[r+1]);b=max3f(b,p1[r+2],p1[r+3]);}
  const float m=max2f(a,b);
  auto rr=__builtin_amdgcn_permlane32_swap(__float_as_uint(m),__float_as_uint(m),false,false);
  return max2f(__uint_as_float(rr[0]),__uint_as_float(rr[1]));
}
__device__ __forceinline__ void pv(f32x16*o,int vb,bf16x8 pa0,bf16x8 pa1,bf16x8 pa2,bf16x8 pa3){
  #pragma unroll
  for(int d0=0;d0<2;++d0){s16x4 lo[4],hi[4];
    #pragma unroll
    for(int ks=0;ks<4;++ks){
      asm volatile("ds_read_b64_tr_b16 %0,%1 offset:%c2":"=&v"(lo[ks]):"v"(vb),"i"(d0*4096+ks*1024):"memory");
      asm volatile("ds_read_b64_tr_b16 %0,%1 offset:%c2":"=&v"(hi[ks]):"v"(vb),"i"(d0*4096+ks*1024+512):"memory");}
    asm volatile("s_waitcnt lgkmcnt(0)":::"memory");SBAR();
    #define PK(k) (bf16x8){lo[k][0],lo[k][1],lo[k][2],lo[k][3],hi[k][0],hi[k][1],hi[k][2],hi[k][3]}
    o[d0]=__builtin_amdgcn_mfma_f32_32x32x16_bf16(pa0,PK(0),o[d0],0,0,0);
    o[d0]=__builtin_amdgcn_mfma_f32_32x32x16_bf16(pa1,PK(1),o[d0],0,0,0);
    o[d0]=__builtin_amdgcn_mfma_f32_32x32x16_bf16(pa2,PK(2),o[d0],0,0,0);
    o[d0]=__builtin_amdgcn_mfma_f32_32x32x16_bf16(pa3,PK(3),o[d0],0,0,0);
    #undef PK
  }
}

#ifndef ATTN_STORE16
#define ATTN_STORE16(p,v) (*(u32x4*)(p)=(v))
#endif
template<int THRL> __device__ __forceinline__ void attn_unit(int b,int n,int qt,const bf16*Q,const bf16*__restrict__ K,const bf16*__restrict__ V,bf16*O,const unsigned*__restrict__ MASK,char*shm){
  const int tid=opaque_tid(),lane=tid&63,r32=lane&31,hi=lane>>5; const int wid=__builtin_amdgcn_readfirstlane(tid>>6);
  const long rowbase=(long)b*SEQ; const int q0=qt*64;
  const int hq=4*n+(wid>>1), tok0=q0+32*(wid&1);
  const bf16*Qw=Q+(rowbase+tok0)*DM+hq*D;
  const bf16*Kh=K+rowbase*KP+n*D,*Vh=V+rowbase*KP+n*D;
  const unsigned lds0=(unsigned)(uintptr_t)shm;
  float*wsf=(float*)(shm+LDS_WS)+wid*64;
  const bf16*ksrc=Kh+(long)lane*KP+wid*8;
  const bf16*vsrc=Vh+(long)(16*(wid&3)+(lane>>2))*KP+(wid>>2)*32+(lane&3)*8;
  const unsigned kdst=lds0+LDS_K+wid*1024, vdst=lds0+LDS_V+wid*1024;
  #define DMA_K(t,slot) glds16(ksrc+(long)(t)*KVBLK*KP,(unsigned)__builtin_amdgcn_readfirstlane(kdst+(slot)))
  #define DMA_V(t,slot) glds16(vsrc+(long)(t)*KVBLK*KP,(unsigned)__builtin_amdgcn_readfirstlane(vdst+(slot)))
  const int vb0=(int)(lds0+LDS_V)+((lane>>4)&1)*32+(lane&3)*8+(4*hi+((lane&15)>>2))*64;
  const char*Kbase=shm+LDS_K; bf16x8 kf[8];
  const lds_cptr shm3=(lds_cptr)shm; const lds_cptr kp0=shm3+LDS_K+hi*1024+r32*16; const lds_cptr vp0=shm3+LDS_V+((lane>>4)&1)*32+(lane&3)*8+(4*hi+((lane&15)>>2))*64;
  const int nt0=qt+1; const int NT=nt0<4?4:((nt0+1)&~1);
  DMA_K(0,0);DMA_V(0,0);DMA_K(1,SLOTB);
  bf16x8 qr[4];
  #pragma unroll
  for(int d0=0;d0<4;++d0)qr[d0]=*reinterpret_cast<const bf16x8*>(&Qw[(long)r32*DM+d0*16+hi*8]);
  { const int tk=tid>>3,pc=tid&7; const u32x4*ms=(const u32x4*)(MASK+((size_t)(rowbase+q0+tk))*64+pc*8); const u32x4 m0=ms[0],m1=ms[1];
    __attribute__((address_space(3))) u32x4*md=(__attribute__((address_space(3))) u32x4*)((__attribute__((address_space(3))) char*)shm+LDS_MSK+tk*256+pc*32); md[0]=m0; md[1]=m1; }
  const __attribute__((address_space(3))) unsigned long long*mskrow=(const __attribute__((address_space(3))) unsigned long long*)((__attribute__((address_space(3))) char*)shm+LDS_MSK+(32*(wid&1)+r32)*256);
  float mhat=0.f,l_reg=0.f;f32x16 o[2];o[0]=f32x16{};o[1]=f32x16{};f32x16 negm=f32x16{};asm volatile("":"+v"(negm));
  #define CMASK(P0,P1,t) bmask(P0,P1,mw_,hi)
  bool resc=false;
  #define START(P0,P1) do{ const float rm=max2f(rowmax(P0,P1),-1000.f); resc=false; \
    { const float dl=rm; mhat=fadd_s(mhat,dl); \
      _Pragma("unroll") for(int r=0;r<16;++r){P0[r]=fsub_s(P0[r],dl);P1[r]=fsub_s(P1[r],dl);} \
      _Pragma("unroll") for(int r=0;r<16;++r)negm[r]=-mhat; asm volatile("":"+v"(negm)); } \
    _Pragma("unroll") for(int r=0;r<16;++r)P0[r]=__builtin_amdgcn_exp2f(P0[r]); }while(0)
  #define RESC() do{ if(resc){ asm volatile("s_waitcnt lgkmcnt(0)":::"memory"); \
      _Pragma("unroll") for(int d_=0;d_<2;++d_) _Pragma("unroll") for(int r=0;r<16;++r)o[d_][r]*=wsf[crow(r,hi)]; } }while(0)
  f32x16 pA0,pA1,pB0,pB1;
  int sl_prev=0,sl_cur=0,sl_next=SLOTB;
  #define ROT() do{sl_prev=sl_cur;sl_cur=sl_next;sl_next=(sl_next==(NSLOT-1)*SLOTB)?0:sl_next+SLOTB;}while(0)
  DMA_K(2,2*SLOTB);
  WAIT_BAR(3);
  qkt(pA0,pA1,Kbase,qr,negm,r32,hi);asm volatile("s_nop 15\n\ts_nop 7":"+v"(pA0),"+v"(pA1));{const unsigned long long mw_=mskrow[0];CMASK(pA0,pA1,0);}
  START(pA0,pA1);
  _Pragma("unroll") for(int r=0;r<16;++r)pA1[r]=__builtin_amdgcn_exp2f(pA1[r]);
  WAIT_BAR(0);
  DMA_K(3,0);DMA_V(1,SLOTB);
  ROT();
  kload8(kf,kp0+sl_cur);
  WAIT_BAR(2);
  s16x4 vlo[8],vhi[8]; u32x4 pw0,pw1,pw2,pw3;
  #define PKW(P,B) cvtpk_s(P[B],P[B+1])
  #define PAF(k) __builtin_bit_cast(bf16x8,pw##k)
  #define VFR(i) (bf16x8){vlo[i][0],vlo[i][1],vlo[i][2],vlo[i][3],vhi[i][0],vhi[i][1],vhi[i][2],vhi[i][3]}
  #define PIN(x) asm volatile("":"+v"(x))
  #define MX3(a,b,c) __builtin_fmaxf(__builtin_fmaxf((a),(b)),(c))
  #define GAPA(MF,A0,A1,A2,A3,W0,W1,PW) do{ MF; sacc+=A0; sacc+=A1; sacc+=A2; sacc+=A3; PIN(sacc); W0; W1; PIN(PW); SBAR(); }while(0)
  #define EX(v) __builtin_amdgcn_exp2f(v)
  #define GAPB(MF,X,B) do{ MF; X[B]=EX(X[B]); X[B+1]=EX(X[B+1]); X[B+2]=EX(X[B+2]); X[B+3]=EX(X[B+3]); PIN(X); SBAR(); }while(0)
  #define VRD(i) do{ vlo[i]=vtr(vp_+(((i)>>2)*4096+((i)&3)*1024)); vhi[i]=vtr(vp_+(((i)>>2)*4096+((i)&3)*1024+512)); }while(0)
  #define KRD(G,j) do{ if(G){ kload2(kf,kp0+sl_next,j); SBAR(); } }while(0)
  #define STEP(C0,C1,P0,P1,t,GK,GV,GL) do{ SBAR(); \
    const lds_cptr vp_=vp0+sl_prev; const unsigned long long mw_=mskrow[(t)]; \
    VRD(0); SBAR(); float sacc=(P0[0]+P0[1]); \
    GAPA(C0=__builtin_amdgcn_mfma_f32_32x32x16_bf16(kf[0],qr[0],negm,0,0,0), P0[2],P0[3],P0[4],P0[5],     pw0[0]=PKW(P0,0), pw0[1]=PKW(P0,2), pw0); \
    VRD(4); SBAR(); GAPA(C1=__builtin_amdgcn_mfma_f32_32x32x16_bf16(kf[1],qr[0],negm,0,0,0), P0[6],P0[7],P0[8],P0[9],     pw0[2]=PKW(P0,4), pw0[3]=PKW(P0,6), pw0); \
    VRD(1); SBAR(); GAPA(C0=__builtin_amdgcn_mfma_f32_32x32x16_bf16(kf[2],qr[1],C0,0,0,0),   P0[10],P0[11],P0[12],P0[13], pw1[0]=PKW(P0,8), pw1[1]=PKW(P0,10), pw1); \
    VRD(5); SBAR(); GAPA(C1=__builtin_amdgcn_mfma_f32_32x32x16_bf16(kf[3],qr[1],C1,0,0,0),   P0[14],P0[15],P1[0],P1[1],   pw1[2]=PKW(P0,12),pw1[3]=PKW(P0,14), pw1); \
    VRD(2); SBAR(); GAPA(C0=__builtin_amdgcn_mfma_f32_32x32x16_bf16(kf[4],qr[2],C0,0,0,0),   P1[2],P1[3],P1[4],P1[5],     pw2[0]=PKW(P1,0), pw2[1]=PKW(P1,2), pw2); \
    VRD(6); SBAR(); GAPA(C1=__builtin_amdgcn_mfma_f32_32x32x16_bf16(kf[5],qr[2],C1,0,0,0),   P1[6],P1[7],P1[8],P1[9],     pw2[2]=PKW(P1,4), pw2[3]=PKW(P1,6), pw2); \
    VRD(3); SBAR(); GAPA(C0=__builtin_amdgcn_mfma_f32_32x32x16_bf16(kf[6],qr[3],C0,0,0,0),   P1[10],P1[11],P1[12],P1[13], pw3[0]=PKW(P1,8), pw3[1]=PKW(P1,10), pw3); \
    VRD(7); SBAR(); GAPA(C1=__builtin_amdgcn_mfma_f32_32x32x16_bf16(kf[7],qr[3],C1,0,0,0),   P1[14],P1[15],0.f,0.f,       pw3[2]=PKW(P1,12),pw3[3]=PKW(P1,14), pw3); \
    l_reg+=sacc; \
    if(GK){DMA_K((t)+3,sl_cur);} if(GV){DMA_V((t)+1,sl_next);} \
    CMASK(C0,C1,t); \
    { float a=MX3(C0[0],C0[1],C1[0]),b=MX3(C0[2],C0[3],C1[1]); a=MX3(a,C1[2],C1[3]); \
      _Pragma("unroll") for(int r=4;r<16;r+=4){a=MX3(a,C0[r],C0[r+1]);b=MX3(b,C0[r+2],C0[r+3]);a=MX3(a,C1[r],C1[r+1]);b=MX3(b,C1[r+2],C1[r+3]);} \
      float rm=__builtin_fmaxf(a,b); { auto rr=__builtin_amdgcn_permlane32_swap(__float_as_uint(rm),__float_as_uint(rm),false,false); rm=__builtin_fmaxf(__uint_as_float(rr[0]),__uint_as_float(rr[1])); } \
      resc=false; \
      if(__builtin_expect(__any(rm>(float)THRL),0)){ const float dl=__builtin_fmaxf(rm,0.f); mhat+=dl; \
        _Pragma("unroll") for(int r=0;r<16;++r){C0[r]-=dl;C1[r]-=dl;} \
        _Pragma("unroll") for(int r=0;r<16;++r)negm[r]=-mhat; asm volatile("":"+v"(negm)); \
        const float f=__builtin_amdgcn_exp2f(-dl); l_reg*=f; if(hi==0)wsf[r32]=f; resc=true; } } \
    SBAR(); \
    GAPB(o[0]=__builtin_amdgcn_mfma_f32_32x32x16_bf16(PAF(0),VFR(0),o[0],0,0,0), C0,0); \
    GAPB(o[1]=__builtin_amdgcn_mfma_f32_32x32x16_bf16(PAF(0),VFR(4),o[1],0,0,0), C0,4); \
    KRD(GL,0); GAPB(o[0]=__builtin_amdgcn_mfma_f32_32x32x16_bf16(PAF(1),VFR(1),o[0],0,0,0), C0,8); \
    KRD(GL,1); GAPB(o[1]=__builtin_amdgcn_mfma_f32_32x32x16_bf16(PAF(1),VFR(5),o[1],0,0,0), C0,12); \
    KRD(GL,2); GAPB(o[0]=__builtin_amdgcn_mfma_f32_32x32x16_bf16(PAF(2),VFR(2),o[0],0,0,0), C1,0); \
    KRD(GL,3); GAPB(o[1]=__builtin_amdgcn_mfma_f32_32x32x16_bf16(PAF(2),VFR(6),o[1],0,0,0), C1,4); \
    GAPB(o[0]=__builtin_amdgcn_mfma_f32_32x32x16_bf16(PAF(3),VFR(3),o[0],0,0,0), C1,8); \
    GAPB(o[1]=__builtin_amdgcn_mfma_f32_32x32x16_bf16(PAF(3),VFR(7),o[1],0,0,0), C1,12); \
    }while(0)
  int t=1;
  for(;t+5<NT;t+=2){
    STEP(pB0,pB1,pA0,pA1,t,true,true,true);     WAIT_BAR(2); RESC(); ROT();
    STEP(pA0,pA1,pB0,pB1,t+1,true,true,true);   WAIT_BAR(2); RESC(); ROT();
  }
  #define ENDW(tt) do{ if((tt)+3<NT){WAIT_BAR(2);} else if((tt)+2<NT){WAIT_BAR(1);} else {WAIT_BAR(0);} }while(0)
  for(;t+1<NT;t+=2){
    STEP(pB0,pB1,pA0,pA1,t,(t+3<NT),(t+1<NT),(t+1<NT));       ENDW(t);   RESC(); ROT();
    STEP(pA0,pA1,pB0,pB1,t+1,(t+4<NT),(t+2<NT),(t+2<NT));     ENDW(t+1); RESC(); ROT();
  }
  STEP(pB0,pB1,pA0,pA1,NT-1,false,false,false); RESC();
  { float sacc=pB0[0]+pB0[1]; _Pragma("unroll") for(int r=2;r<16;++r)sacc+=pB0[r]; _Pragma("unroll") for(int r=0;r<16;++r)sacc+=pB1[r]; l_reg+=sacc;
    pw0=(u32x4){PKW(pB0,0),PKW(pB0,2),PKW(pB0,4),PKW(pB0,6)};pw1=(u32x4){PKW(pB0,8),PKW(pB0,10),PKW(pB0,12),PKW(pB0,14)};pw2=(u32x4){PKW(pB1,0),PKW(pB1,2),PKW(pB1,4),PKW(pB1,6)};pw3=(u32x4){PKW(pB1,8),PKW(pB1,10),PKW(pB1,12),PKW(pB1,14)};
    SBAR(); pv(o,vb0+sl_cur,PAF(0),PAF(1),PAF(2),PAF(3)); }
  #undef PKW
  #undef PAF
  #undef VFR
  #undef PIN
  #undef MX3
  #undef GAPA
  #undef GAPB
  #undef EX
  #undef VRD
  #undef KRD
  #undef STEP
  #undef ENDW
  {auto rr=__builtin_amdgcn_permlane32_swap(__float_as_uint(l_reg),__float_as_uint(l_reg),false,false);l_reg=__uint_as_float(rr[0])+__uint_as_float(rr[1]);}
  if(hi==0)wsf[32+r32]=l_reg;asm volatile("s_waitcnt lgkmcnt(0)":::"memory");
  float rli[16];
  #pragma unroll
  for(int r=0;r<16;++r)rli[r]=__builtin_amdgcn_rcpf(wsf[32+crow(r,hi)]);
  bf16*Ow=O+(rowbase+tok0)*DM+hq*D;
  { bf16*stg=(bf16*)(shm+LDS_OST)+wid*2048;
    #pragma unroll
    for(int r=0;r<16;++r){const int orow=crow(r,hi);
      #pragma unroll
      for(int d0=0;d0<2;++d0)stg[orow*64+d0*32+r32]=__float2bfloat16(o[d0][r]*rli[r]);}
    asm volatile("s_waitcnt lgkmcnt(0)":::"memory");
    #pragma unroll
    for(int i=0;i<4;++i){const int row=i*8+(lane>>3),ch=lane&7; const u32x4 v=*(const u32x4*)(stg+row*64+ch*8); ATTN_STORE16(Ow+(long)row*DM+ch*8,v);} }
  asm volatile("s_waitcnt lgkmcnt(0)\n\ts_barrier":::"memory");
  #undef DMA_K
  #undef DMA_V
  #undef CMASK
  #undef START
  #undef RESC
  #undef ROT
}
constexpr int ATTN_LDS_BYTES=LDS_BYTES;
struct AttnTensors { const bf16* Q; const bf16* K; const bf16* V; bf16* O; const unsigned* MASK; };
struct AttnUnit { int bn; int qt; };
struct StaticOrder {
  int vcu, G;
  __device__ __forceinline__ explicit StaticOrder(int grid,int block):vcu((grid%8==0)?(block%8)*(grid/8)+block/8:block),G(grid){}
  __device__ __forceinline__ bool next(int i,AttnUnit&u)const{
    if(G==256){ if(i>=4)return false; const int s=vcu&7; u.bn=vcu>>3; u.qt=(i==0)?31-s:(i==1)?16+s:(i==2)?15-s:s; return true; }
    const int id=vcu+i*G; if(id>=1024)return false; u.bn=id>>5; u.qt=31-(id&31); return true; }
};
template<class Sched,int THRL=8> __device__ __forceinline__ void attn_phase(char*lds,const AttnTensors&T,const Sched&S){
  AttnUnit u;
  for(int i=0;S.next(i,u);++i){ attn_unit<THRL>(u.bn>>2,u.bn&3,u.qt,T.Q,T.K,T.V,T.O,T.MASK,lds); }
}
#undef SBAR
#undef WAIT_BAR
}

__device__ __forceinline__ void p18_final(const Args& A) {
    const int tid = opaque_tid(), lane = tid & 63, wave = tid >> 6;
    const int gw = blockIdx.x * NWAVES + wave, NGW = gridDim.x * NWAVES;
    const f32x4* gr = (const f32x4*)A.in[IN_FINN] + lane;
    for (int m = gw; m < MTOK; m += NGW) {
        f32x4* xr = (f32x4*)(A.out + (size_t)m * DM) + lane; f32x4 v[4]; float s = 0.f;
#pragma unroll
        for (int j = 0; j < 4; ++j) { v[j] = xr[64 * j]; s += (v[j].x * v[j].x + v[j].y * v[j].y) + (v[j].z * v[j].z + v[j].w * v[j].w); }
        const float rs = rsqrtf(wave_sum(s) * (1.f / DM) + NORM_EPS);
#pragma unroll
        for (int j = 0; j < 4; ++j) xr[64 * j] = v[j] * rs * gr[64 * j];
    }
}

typedef GAS unsigned gu32;
#define RLX_AGENT __ATOMIC_RELAXED, __HIP_MEMORY_SCOPE_AGENT
constexpr int CW_BAR = 4096;
constexpr int RING_BYTES = 131072, LDSCTL_OFF = RING_BYTES, MISC_OFF = LDSCTL_OFF + 320;
#define XB_TMO      128
#define XB_XCNT(j)  (256  + 64 * (j))
#define XB_XSUB(j)  (1280 + 64 * (j))
#define XB_XGEN(j)  (2304 + 64 * (j))
#define XB_TOP      3328
#define XB_TOPGEN   3392
#define XCD_BAR_WORDS 3456
#define XB_SPIN_CAP (1u << 18)

__device__ __forceinline__ unsigned xb_ld(unsigned* p)              { return __hip_atomic_load(p, __ATOMIC_RELAXED, __HIP_MEMORY_SCOPE_AGENT); }
__device__ __forceinline__ unsigned xb_add(unsigned* p, unsigned v) { return __hip_atomic_fetch_add(p, v, __ATOMIC_RELAXED, __HIP_MEMORY_SCOPE_AGENT); }
__device__ __forceinline__ unsigned xb_xcc_id() { return (unsigned)__builtin_amdgcn_s_getreg((3 << 11) | 20) & 0xFu; }
#define XB_SPIN(cond, bar) do { unsigned _sp = 0; while (cond) { __builtin_amdgcn_s_sleep(1); \
    if ((++_sp & 255u) == 0u) { if (xb_ld(&(bar)[XB_TMO])) break; if (_sp > XB_SPIN_CAP) { atomicAdd(&(bar)[XB_TMO], 1u); break; } } } } while (0)

struct XcdBarrier {
    unsigned* bar; unsigned x;
    volatile LAS unsigned* st;
};

__device__ __forceinline__ XcdBarrier xcd_barrier_post(unsigned* bar, volatile LAS unsigned* st) {
    XcdBarrier b; b.bar = bar; b.x = xb_xcc_id(); b.st = st;
    if (threadIdx.x == 0) (void)xb_add(&bar[XB_XCNT(b.x)], 1u);
    return b;
}
__device__ __forceinline__ void xcd_barrier_complete(unsigned* bar, unsigned x, unsigned& nloc, unsigned& nx) {
    const unsigned G = gridDim.x * gridDim.y * gridDim.z;
    unsigned sum, cnt, mine, sp = 0u;
    for (;;) {
        sum = 0u; cnt = 0u; mine = 0u;
#pragma unroll
        for (unsigned j = 0; j < 16; ++j) { const unsigned c = xb_ld(&bar[XB_XCNT(j)]); sum += c; cnt += (c > 0u) ? 1u : 0u; mine = (j == x) ? c : mine; }
        if (sum == G) break;
        __builtin_amdgcn_s_sleep(1);
        if ((++sp & 255u) == 0u) { if (xb_ld(&bar[XB_TMO])) break; if (sp > XB_SPIN_CAP) { atomicAdd(&bar[XB_TMO], 1u); break; } }
    }
    nloc = mine > 0u ? mine : 1u; nx = cnt > 0u ? cnt : 1u;
}

__device__ __forceinline__ void xcd_barrier(const XcdBarrier& b) {
    asm volatile("s_waitcnt vmcnt(0)" ::: "memory");
    __syncthreads();
    if (threadIdx.x == 0) {
        unsigned* bar = b.bar;
        __builtin_amdgcn_s_waitcnt(0);
        unsigned nloc = b.st[0], nx = b.st[1];
        if (nloc == 0u) { xcd_barrier_complete(bar, b.x, nloc, nx); b.st[0] = nloc; b.st[1] = nx; }
        const unsigned old = xb_add(&bar[XB_XSUB(b.x)], 1u);
        const unsigned gen = old / nloc;
        if (old + 1u == (gen + 1u) * nloc) {
            __builtin_amdgcn_fence(__ATOMIC_RELEASE, "agent");
            asm volatile("s_waitcnt vmcnt(0)" ::: "memory");
            const unsigned og = xb_add(&bar[XB_TOP], 1u);
            const unsigned tg = og / nx;
            if (og + 1u == (tg + 1u) * nx) xb_add(&bar[XB_TOPGEN], 1u);
            else XB_SPIN(xb_ld(&bar[XB_TOPGEN]) == tg, bar);
            __builtin_amdgcn_fence(__ATOMIC_ACQUIRE, "agent");
            xb_add(&bar[XB_XGEN(b.x)], 1u);
            asm volatile("s_waitcnt vmcnt(0)" ::: "memory");
        } else {
            XB_SPIN(xb_ld(&bar[XB_XGEN(b.x)]) == gen, bar);
            __builtin_amdgcn_fence(__ATOMIC_ACQUIRE, "agent");
            asm volatile("s_waitcnt vmcnt(0)" ::: "memory");
        }
    }
    __syncthreads();
}

constexpr int N_PHASES = 19;
template <int LO, int HI> __global__ void __launch_bounds__(NTHR, 2) mk_fwd(Args A) {
    extern __shared__ __attribute__((aligned(16))) unsigned char lds[];
#define IN(k) (LO <= (k) && (k) < HI)
    constexpr bool FUSED = (HI - LO) > 1;
    XcdBarrier bar; bar.bar = nullptr; bar.x = 0; bar.st = nullptr;
    if constexpr (FUSED) {
        for (int u = threadIdx.x; u < (LDS_BYTES - LDSCTL_OFF) / 4; u += NTHR) ((LAS unsigned*)((LAS unsigned char*)lds + LDSCTL_OFF))[u] = 0u;
        __syncthreads();
        bar = xcd_barrier_post(WSP(unsigned, OFF_CTL) + CW_BAR, (volatile LAS unsigned*)((LAS unsigned char*)lds + MISC_OFF) + 8);
    }
#define SEAM(k) do { if constexpr (FUSED && IN(k) && IN((k) + 1)) { if ((k) == 0) cg::this_grid().sync(); else xcd_barrier(bar); } } while (0)
    if constexpr (IN(0)) p0_prologue(A, lds);
    if constexpr (FUSED && IN(0) && ((REP_MASK >> 0) & 1u)) xcd_barrier(bar);
    if constexpr (FUSED && IN(0) && ((REP_MASK >> 0) & 1u)) p0_prologue(A, lds);
    SEAM(0);
    if constexpr (IN(1)) {
        Gemm g{WSP(bf16_t, OFF_H0), WSP(bf16_t, OFF_H0), 1 << 30, WSP(bf16_t, OFF_WIN), MTOK, 2304, DM};
        EpiInProj E{WSP(bf16_t, OFF_QO), WSP(bf16_t, OFF_K), WSP(bf16_t, OFF_V), WSP(bf16_t, OFF_QI), WSP(bf16_t, OFF_KI), WSP(float, OFF_WI), WSP(float, OFF_ROPE)};
        gemm_phase(lds, g, E);
    }
    SEAM(1);
    if constexpr (IN(2)) { if (FAST_TOPK) p2_fast(A, lds); else p2_naive(A, lds);
#if DBG_TOPK
        __syncthreads(); p2_naive(A, lds, 160 * MiB);
#endif
    }
    if constexpr (FUSED && IN(2) && ((REP_MASK >> 2) & 1u)) xcd_barrier(bar);
    if constexpr (FUSED && IN(2) && ((REP_MASK >> 2) & 1u)) { if (FAST_TOPK) p2_fast(A, lds); else p2_naive(A, lds);
#if DBG_TOPK
        __syncthreads(); p2_naive(A, lds, 160 * MiB);
#endif
    }
    SEAM(2);
    if constexpr (IN(3)) {
#if DBG_TOPK
        {
            const int lane_ = threadIdx.x & 63, gw_ = blockIdx.x * NWAVES + (threadIdx.x >> 6);
            const unsigned* M1 = WSP(unsigned, OFF_MASK); const unsigned* M2 = WSP(unsigned, 160 * MiB); unsigned rows_ = 0, bits_ = 0, bad1_ = 0, bad2_ = 0;
            for (int m = gw_; m < MTOK; m += gridDim.x * NWAVES) { const unsigned d = M1[(size_t)m * 64 + lane_] ^ M2[(size_t)m * 64 + lane_]; const int nb = wave_allsum_i(__popc(d)); if (nb) { rows_ += 1; bits_ += nb; }
                const int t_ = m & (SEQ - 1), ex_ = t_ + 1 < 256 ? t_ + 1 : 256; if (wave_allsum_i(__popc(M1[(size_t)m * 64 + lane_])) != ex_) bad1_ += 1; if (wave_allsum_i(__popc(M2[(size_t)m * 64 + lane_])) != ex_) bad2_ += 1; }
            if (lane_ == 0) { atomicAdd(WSP(unsigned, OFF_CTL) + 1000, rows_); atomicAdd(WSP(unsigned, OFF_CTL) + 1001, bits_); atomicAdd(WSP(unsigned, OFF_CTL) + 1002, bad1_); atomicAdd(WSP(unsigned, OFF_CTL) + 1003, bad2_); }
        }
#endif
        if (FAST_ATTN) {
            static_assert(attn_body::ATTN_LDS_BYTES <= RING_BYTES, "attention LDS");
            const attn_body::AttnTensors AT{(const attn_body::bf16*)WSP(bf16_t, OFF_QO), (const attn_body::bf16*)WSP(bf16_t, OFF_K), (const attn_body::bf16*)WSP(bf16_t, OFF_V), (attn_body::bf16*)WSP(bf16_t, OFF_QO), WSP(unsigned, OFF_MASK)};
            const attn_body::StaticOrder S((int)gridDim.x, (int)blockIdx.x);
            attn_body::attn_phase<attn_body::StaticOrder>((char*)lds, AT, S);
        } else p3_naive(A, lds);
    }
    if constexpr (FUSED && REP_123 && IN(3)) xcd_barrier(bar);
    if constexpr (FUSED && REP_123 && IN(3)) {
        Gemm g{WSP(bf16_t, OFF_H0), WSP(bf16_t, OFF_H0), 1 << 30, WSP(bf16_t, OFF_WIN), MTOK, 2304, DM};
        EpiInProj E{WSP(bf16_t, OFF_QO), WSP(bf16_t, OFF_K), WSP(bf16_t, OFF_V), WSP(bf16_t, OFF_QI), WSP(bf16_t, OFF_KI), WSP(float, OFF_WI), WSP(float, OFF_ROPE)};
        gemm_phase(lds, g, E);
    }
    if constexpr (FUSED && REP_123 && IN(3)) xcd_barrier(bar);
    if constexpr (FUSED && REP_123 && IN(3)) { if (FAST_TOPK) p2_fast(A, lds); else p2_naive(A, lds);
#if DBG_TOPK
        __syncthreads(); p2_naive(A, lds, 160 * MiB);
#endif
    }
    if constexpr (FUSED && REP_123 && IN(3)) xcd_barrier(bar);
    if constexpr (FUSED && REP_123 && IN(3)) {
#if DBG_TOPK
        {
            const int lane_ = threadIdx.x & 63, gw_ = blockIdx.x * NWAVES + (threadIdx.x >> 6);
            const unsigned* M1 = WSP(unsigned, OFF_MASK); const unsigned* M2 = WSP(unsigned, 160 * MiB); unsigned rows_ = 0, bits_ = 0, bad1_ = 0, bad2_ = 0;
            for (int m = gw_; m < MTOK; m += gridDim.x * NWAVES) { const unsigned d = M1[(size_t)m * 64 + lane_] ^ M2[(size_t)m * 64 + lane_]; const int nb = wave_allsum_i(__popc(d)); if (nb) { rows_ += 1; bits_ += nb; }
                const int t_ = m & (SEQ - 1), ex_ = t_ + 1 < 256 ? t_ + 1 : 256; if (wave_allsum_i(__popc(M1[(size_t)m * 64 + lane_])) != ex_) bad1_ += 1; if (wave_allsum_i(__popc(M2[(size_t)m * 64 + lane_])) != ex_) bad2_ += 1; }
            if (lane_ == 0) { atomicAdd(WSP(unsigned, OFF_CTL) + 1000, rows_); atomicAdd(WSP(unsigned, OFF_CTL) + 1001, bits_); atomicAdd(WSP(unsigned, OFF_CTL) + 1002, bad1_); atomicAdd(WSP(unsigned, OFF_CTL) + 1003, bad2_); }
        }
#endif
        if (FAST_ATTN) {
            static_assert(attn_body::ATTN_LDS_BYTES <= RING_BYTES, "attention LDS");
            const attn_body::AttnTensors AT{(const attn_body::bf16*)WSP(bf16_t, OFF_QO), (const attn_body::bf16*)WSP(bf16_t, OFF_K), (const attn_body::bf16*)WSP(bf16_t, OFF_V), (attn_body::bf16*)WSP(bf16_t, OFF_QO), WSP(unsigned, OFF_MASK)};
            const attn_body::StaticOrder S((int)gridDim.x, (int)blockIdx.x);
            attn_body::attn_phase<attn_body::StaticOrder>((char*)lds, AT, S);
        } else p3_naive(A, lds);
    }
    SEAM(3);
    if constexpr (IN(4)) {
        Gemm g{WSP(bf16_t, OFF_QO), WSP(bf16_t, OFF_QO), 1 << 30, WSP(bf16_t, OFF_WO0), MTOK, DM, DM};
        EpiResid E{A.in[IN_X], A.out, WSP(bf16_t, OFF_XB), WSP(float, OFF_SSQ0)};
        gemm_phase(lds, g, E);
    }
    SEAM(4);
    if constexpr (IN(5)) {
        Gemm g{WSP(bf16_t, OFF_XB), WSP(bf16_t, OFF_XB), 1 << 30, WSP(bf16_t, OFF_WUP0), MTOK, FF, DM};
        EpiUp E{WSP(bf16_t, OFF_U), WSP(float, OFF_SSQ0)};
        gemm_phase(lds, g, E);
    }
    if constexpr (FUSED && IN(5) && ((REP_MASK >> 5) & 1u)) xcd_barrier(bar);
    if constexpr (FUSED && IN(5) && ((REP_MASK >> 5) & 1u)) {
        Gemm g{WSP(bf16_t, OFF_XB), WSP(bf16_t, OFF_XB), 1 << 30, WSP(bf16_t, OFF_WUP0), MTOK, FF, DM};
        EpiUp E{WSP(bf16_t, OFF_U), WSP(float, OFF_SSQ0)};
        gemm_phase(lds, g, E);
    }
    SEAM(5);
    if constexpr (IN(6)) {
        Gemm g{WSP(bf16_t, OFF_U), WSP(bf16_t, OFF_U), 1 << 30, WSP(bf16_t, OFF_WDN0), MTOK, DM, FF};
        EpiResid E{A.out, A.out, nullptr, nullptr};
        gemm_phase(lds, g, E);
    }
    SEAM(6);
    if constexpr (IN(7)) p7_prep(A);
    if constexpr (FUSED && IN(7) && ((REP_MASK >> 7) & 1u)) xcd_barrier(bar);
    if constexpr (FUSED && IN(7) && ((REP_MASK >> 7) & 1u)) p7_prep(A);
    SEAM(7);
    if constexpr (IN(8)) {
        Gemm g{WSP(bf16_t, OFF_XSR), WSP(bf16_t, OFF_XSK), 4, WSP(bf16_t, OFF_WRK), MTOK, 2048, DM};
        EpiStore E{WSP(bf16_t, OFF_R), DM, 4, WSP(bf16_t, OFF_KR), DM};
        gemm_phase(lds, g, E);
    }
    if constexpr (FUSED && IN(8) && ((REP_MASK >> 8) & 1u)) xcd_barrier(bar);
    if constexpr (FUSED && IN(8) && ((REP_MASK >> 8) & 1u)) {
        Gemm g{WSP(bf16_t, OFF_XSR), WSP(bf16_t, OFF_XSK), 4, WSP(bf16_t, OFF_WRK), MTOK, 2048, DM};
        EpiStore E{WSP(bf16_t, OFF_R), DM, 4, WSP(bf16_t, OFF_KR), DM};
        gemm_phase(lds, g, E);
    }
    SEAM(8);
    if constexpr (IN(9)) {
        Gemm g{WSP(bf16_t, OFF_XSV), WSP(bf16_t, OFF_H1), 4, WSP(bf16_t, OFF_WVL), MTOK, 1792, DM};
        EpiStore E{WSP(bf16_t, OFF_VV), DM, 4, WSP(bf16_t, OFF_P), 768};
        gemm_phase(lds, g, E);
    }
    if constexpr (FUSED && IN(9) && ((REP_MASK >> 9) & 1u)) xcd_barrier(bar);
    if constexpr (FUSED && IN(9) && ((REP_MASK >> 9) & 1u)) {
        Gemm g{WSP(bf16_t, OFF_XSV), WSP(bf16_t, OFF_H1), 4, WSP(bf16_t, OFF_WVL), MTOK, 1792, DM};
        EpiStore E{WSP(bf16_t, OFF_VV), DM, 4, WSP(bf16_t, OFF_P), 768};
        gemm_phase(lds, g, E);
    }
    SEAM(9);
    if constexpr (IN(10)) p10_loramid(A);
    if constexpr (FUSED && IN(10) && ((REP_MASK >> 10) & 1u)) xcd_barrier(bar);
    if constexpr (FUSED && IN(10) && ((REP_MASK >> 10) & 1u)) p10_loramid(A);
    SEAM(10);
    if constexpr (IN(11)) {
        Gemm g{WSP(bf16_t, OFF_AW), WSP(bf16_t, OFF_AA), 4, WSP(bf16_t, OFF_W2T), MTOK, 2048, 128};
        EpiLoraUp E{WSP(bf16_t, OFF_E), WSP(bf16_t, OFF_A), A.in[IN_W0], A.in[IN_A0]};
        gemm_phase(lds, g, E);
    }
    if constexpr (FUSED && IN(11) && ((REP_MASK >> 11) & 1u)) xcd_barrier(bar);
    if constexpr (FUSED && IN(11) && ((REP_MASK >> 11) & 1u)) {
        Gemm g{WSP(bf16_t, OFF_AW), WSP(bf16_t, OFF_AA), 4, WSP(bf16_t, OFF_W2T), MTOK, 2048, 128};
        EpiLoraUp E{WSP(bf16_t, OFF_E), WSP(bf16_t, OFF_A), A.in[IN_W0], A.in[IN_A0]};
        gemm_phase(lds, g, E);
    }
    SEAM(11);
    if constexpr (IN(12)) { if (FAST_SCAN) p12_fast(A, lds); else p12_naive(A, lds); }
    if constexpr (FUSED && IN(12) && ((REP_MASK >> 12) & 1u)) xcd_barrier(bar);
    if constexpr (FUSED && IN(12) && ((REP_MASK >> 12) & 1u)) { if (FAST_SCAN) p12_fast(A, lds); else p12_naive(A, lds); }
    SEAM(12);
    if constexpr (IN(13)) { if (!FAST_SCAN) p12b_stats(A); }
    SEAM(13);
    if constexpr (IN(14)) {
        Gemm g{WSP(bf16_t, OFF_AG), WSP(bf16_t, OFF_AG), 1 << 30, WSP(bf16_t, OFF_G2T), MTOK, DM, 256};
        EpiGatePost E{WSP(bf16_t, OFF_AO), WSP(bf16_t, OFF_Y), WSP(bf16_t, OFF_VV), WSP(float, OFF_STATS), WSP(float, OFF_BONUS), A.in[IN_LNW], A.in[IN_LNB]};
        gemm_phase(lds, g, E);
    }
    if constexpr (FUSED && IN(14) && ((REP_MASK >> 14) & 1u)) xcd_barrier(bar);
    if constexpr (FUSED && IN(14) && ((REP_MASK >> 14) & 1u)) {
        Gemm g{WSP(bf16_t, OFF_AG), WSP(bf16_t, OFF_AG), 1 << 30, WSP(bf16_t, OFF_G2T), MTOK, DM, 256};
        EpiGatePost E{WSP(bf16_t, OFF_AO), WSP(bf16_t, OFF_Y), WSP(bf16_t, OFF_VV), WSP(float, OFF_STATS), WSP(float, OFF_BONUS), A.in[IN_LNW], A.in[IN_LNB]};
        gemm_phase(lds, g, E);
    }
    SEAM(14);
    if constexpr (IN(15)) {
        Gemm g{WSP(bf16_t, OFF_AO), WSP(bf16_t, OFF_AO), 1 << 30, WSP(bf16_t, OFF_WO1), MTOK, DM, DM};
        EpiResid E{A.out, A.out, WSP(bf16_t, OFF_XB), WSP(float, OFF_SSQ1)};
        gemm_phase(lds, g, E);
    }
    SEAM(15);
    if constexpr (IN(16)) {
        Gemm g{WSP(bf16_t, OFF_XB), WSP(bf16_t, OFF_XB), 1 << 30, WSP(bf16_t, OFF_WUP1), MTOK, FF, DM};
        EpiUp E{WSP(bf16_t, OFF_U), WSP(float, OFF_SSQ1)};
        gemm_phase(lds, g, E);
    }
    if constexpr (FUSED && IN(16) && ((REP_MASK >> 16) & 1u)) xcd_barrier(bar);
    if constexpr (FUSED && IN(16) && ((REP_MASK >> 16) & 1u)) {
        Gemm g{WSP(bf16_t, OFF_XB), WSP(bf16_t, OFF_XB), 1 << 30, WSP(bf16_t, OFF_WUP1), MTOK, FF, DM};
        EpiUp E{WSP(bf16_t, OFF_U), WSP(float, OFF_SSQ1)};
        gemm_phase(lds, g, E);
    }
    SEAM(16);
    if constexpr (IN(17)) {
        Gemm g{WSP(bf16_t, OFF_U), WSP(bf16_t, OFF_U), 1 << 30, WSP(bf16_t, OFF_WDN1), MTOK, DM, FF};
        EpiResid E{A.out, A.out, nullptr, nullptr};
        gemm_phase(lds, g, E);
    }
    SEAM(17);
    if constexpr (IN(18)) {
        p18_final(A);
#if DBG_TOPK
        {   __syncthreads(); const float sc_ = 1.f + (float)WSP(unsigned, OFF_CTL)[1000 + DBG_WHICH] * DBG_UNIT;
            const int gw_ = blockIdx.x * NWAVES + (threadIdx.x >> 6), lane_ = threadIdx.x & 63;
            for (int m = gw_; m < MTOK; m += gridDim.x * NWAVES) for (int j = 0; j < 16; ++j) A.out[(size_t)m * DM + lane_ + 64 * j] *= sc_; }
#endif
    }
#undef IN
#undef SEAM
}

template <int P> static void launch_all(int grid, hipStream_t stream, const Args& a) {
    if constexpr (P < N_PHASES) {
        static bool attr_done = false;
        if (!attr_done) { (void)hipFuncSetAttribute((const void*)mk_fwd<P, P + 1>, hipFuncAttributeMaxDynamicSharedMemorySize, LDS_BYTES); attr_done = true; }
        hipLaunchKernelGGL((mk_fwd<P, P + 1>), dim3(grid), dim3(NTHR), LDS_BYTES, stream, a);
        launch_all<P + 1>(grid, stream, a);
    }
}
extern "C" void kernel_launch(void* const* d_in, const int* in_sizes, int n_in, void* d_out, int out_size, void* d_ws, size_t ws_size, hipStream_t stream) {
    static int grid = 0;
    if (grid == 0) {
        if (n_in != N_IN || out_size != MTOK * DM || ws_size < WS_END) { fprintf(stderr, "kernel_launch: unexpected shapes (n_in %d out %d ws %zu)\n", n_in, out_size, ws_size); grid = -1; return; }
        int dev = 0, cus = 0;
        (void)hipGetDevice(&dev); (void)hipDeviceGetAttribute(&cus, hipDeviceAttributeMultiprocessorCount, dev);
        grid = cus > 0 ? cus : 256;
    }
    if (grid < 0) return;
    (void)hipMemsetAsync((char*)d_ws + OFF_CTL, 0, CTL_BYTES, stream);
    Args a{};
    for (int i = 0; i < N_IN; ++i) a.in[i] = (const float*)d_in[i];
    a.out = (float*)d_out; a.ws = (unsigned char*)d_ws;
#if ONE_LAUNCH
    static bool attr_done = false;
    if (!attr_done) {
        (void)hipFuncSetAttribute((const void*)mk_fwd<0, N_PHASES>, hipFuncAttributeMaxDynamicSharedMemorySize, LDS_BYTES);
        int per_cu = 0;
        if (hipOccupancyMaxActiveBlocksPerMultiprocessor(&per_cu, (const void*)mk_fwd<0, N_PHASES>, NTHR, LDS_BYTES) != hipSuccess || per_cu < 1)
            fprintf(stderr, "kernel_launch: occupancy query reports %d blocks per CU\n", per_cu);
        (void)hipGetLastError();
        attr_done = true;
    }
    void* kargs[] = {(void*)&a};
    hipError_t e = hipLaunchCooperativeKernel((const void*)mk_fwd<0, N_PHASES>, dim3(grid), dim3(NTHR), kargs, LDS_BYTES, stream);
    if (e != hipSuccess) fprintf(stderr, "kernel_launch: cooperative launch failed: %s (grid %d)\n", hipGetErrorString(e), grid);
#else
    launch_all<0>(grid, stream, a);
#endif
}
```

```cpp
#include <hip/hip_runtime.h>
#include <hip/hip_cooperative_groups.h>
#include <hip/hip_bf16.h>
#include <cmath>
#include <cstdio>
#include <cstdint>
namespace cg = cooperative_groups;

#ifndef ONE_LAUNCH
#define ONE_LAUNCH 1
#endif
#ifndef DBG_TOPK
#define DBG_TOPK 0
#define DBG_WHICH 2
#define DBG_UNIT 0.001f
#endif
#ifndef REP_MASK
#define REP_MASK 0u
#endif
#ifndef REP_123
#define REP_123 0
#endif
#ifndef CHUNK_SCAN
#define CHUNK_SCAN 1
#endif
#ifndef FAST_ATTN
#define FAST_ATTN 1
#endif
#ifndef FAST_TOPK
#define FAST_TOPK 1
#endif
#ifndef FAST_SCAN
#define FAST_SCAN 1
#endif
#ifndef FAST_GEMM
#define FAST_GEMM 1
#endif

#define LAS __attribute__((address_space(3)))
#define GAS __attribute__((address_space(1)))
typedef unsigned short bf16_t;
typedef short bf16x8 __attribute__((ext_vector_type(8)));
typedef float f32x4 __attribute__((ext_vector_type(4)));
typedef float f32x2 __attribute__((ext_vector_type(2)));
typedef unsigned u32x4 __attribute__((ext_vector_type(4)));
typedef unsigned u32x2 __attribute__((ext_vector_type(2)));

constexpr int BATCH = 8, SEQ = 2048, DM = 1024, MTOK = BATCH * SEQ, FF = 4096;
constexpr int NWAVES = 8, NTHR = 512;
constexpr int LDS_BYTES = 147456;
constexpr float NORM_EPS = 1e-6f, LNX_EPS = 64e-5f;
constexpr float QSCALE = 0.125f * 1.4426950408889634f;
constexpr float WI_SCALE = 0.044194173824159216f;

enum { IN_X = 0, IN_MIXN, IN_MLPN, IN_WUP, IN_WDN, IN_FINN, IN_WIN, IN_WO, IN_MU, IN_WRKV, IN_W0, IN_W1, IN_W2, IN_A0, IN_A1, IN_A2,
       IN_G1, IN_G2, IN_KK, IN_KA, IN_RK, IN_LNW, IN_LNB, IN_WO1, N_IN };

constexpr size_t MiB = 1u << 20;
constexpr size_t OFF_CTL = 0, CTL_BYTES = 1 * MiB;
constexpr size_t OFF_SSQ0 = 256 * 1024, OFF_SSQ1 = 320 * 1024;
constexpr size_t OFF_ROPE = 1 * MiB;
constexpr size_t OFF_WIN = 2 * MiB, OFF_WO0 = 7 * MiB, OFF_WUP0 = 9 * MiB, OFF_WDN0 = 17 * MiB, OFF_WRK = 25 * MiB, OFF_WVL = 29 * MiB;
constexpr size_t OFF_W2T = 33 * MiB, OFF_A2T = 33 * MiB + 256 * 1024, OFF_G2T = 33 * MiB + 512 * 1024, OFF_WO1 = 34 * MiB, OFF_WUP1 = 36 * MiB, OFF_WDN1 = 44 * MiB;
constexpr size_t OFF_BONUS = 2 * MiB;
constexpr size_t OFF_H0 = 52 * MiB, OFF_QO = 84 * MiB, OFF_K = 116 * MiB, OFF_V = 124 * MiB, OFF_QI = 132 * MiB, OFF_KI = 148 * MiB, OFF_WI = 150 * MiB, OFF_MASK = 152 * MiB;
constexpr size_t OFF_XB = 52 * MiB, OFF_U = 84 * MiB;
constexpr size_t OFF_XSR = 52 * MiB, OFF_XSK = 84 * MiB, OFF_XSV = 116 * MiB, OFF_H1 = 148 * MiB, OFF_R = 180 * MiB, OFF_KR = 212 * MiB;
constexpr size_t OFF_VV = 52 * MiB, OFF_P = 84 * MiB, OFF_AW = 108 * MiB, OFF_AA = 112 * MiB, OFF_AG = 244 * MiB;
constexpr size_t OFF_E = 116 * MiB, OFF_A = 148 * MiB, OFF_Y = 84 * MiB, OFF_STATS = 252 * MiB, OFF_AO = 116 * MiB;
constexpr size_t WS_END = 256 * MiB;

struct Args { const float* in[N_IN]; float* out; unsigned char* ws; int ph_lo, ph_hi; };
#define WSP(T, off) ((T*)(A.ws + (off)))

__device__ __forceinline__ float bf2f(bf16_t u) { return __uint_as_float((unsigned)u << 16); }
__device__ __forceinline__ unsigned f2bf(float f) { unsigned u = __float_as_uint(f); return (u + 0x7fffu + ((u >> 16) & 1u)) >> 16; }
__device__ __forceinline__ unsigned pk2(float lo, float hi) { return f2bf(lo) | (f2bf(hi) << 16); }
__device__ __forceinline__ float wave_sum(float v) {
#pragma unroll
    for (int o = 1; o < 64; o <<= 1) v += __shfl_xor(v, o);
    return v;
}
__device__ __forceinline__ float wave_max(float v) {
#pragma unroll
    for (int o = 1; o < 64; o <<= 1) v = fmaxf(v, __shfl_xor(v, o));
    return v;
}
#define LDS_WAIT() asm volatile("s_waitcnt lgkmcnt(0)" ::: "memory")
__device__ __forceinline__ int opaque_tid() { int t = threadIdx.x; asm volatile("" : "+v"(t)); return t; }
__device__ __forceinline__ float sigmoidf_(float z) { return __builtin_amdgcn_rcpf(1.f + __expf(-z)); }

__device__ __forceinline__ float block_sum(float v, float* red, int wave, int lane) {
    v = wave_sum(v); __syncthreads(); if (lane == 0) red[wave] = v; __syncthreads();
    float s = 0.f;
#pragma unroll
    for (int i = 0; i < NWAVES; ++i) s += red[i];
    return s;
}
__device__ __forceinline__ float block_max(float v, float* red, int wave, int lane) {
    v = wave_max(v); __syncthreads(); if (lane == 0) red[wave] = v; __syncthreads();
    float s = red[0];
#pragma unroll
    for (int i = 1; i < NWAVES; ++i) s = fmaxf(s, red[i]);
    return s;
}

template <int ID> __device__ __forceinline__ float wval(const Args& A, int n, int k) {
    if constexpr (ID == 0) {
        int col;
        if (n < 1280 || (n >= 1536 && n < 2112)) { const int hd = n >> 6, j = n & 63; col = (hd << 6) + (j >> 1) + ((j & 1) << 5); }
        else if (n < 2120) col = n; else return 0.f;
        return A.in[IN_WIN][(size_t)k * 2120 + col];
    } else if constexpr (ID == 1) { return A.in[IN_WO][(size_t)k * 1024 + n];
    } else if constexpr (ID == 2) { return A.in[IN_WUP][(size_t)k * 4096 + n] * A.in[IN_MLPN][k];
    } else if constexpr (ID == 3) { return A.in[IN_WDN][(size_t)k * 1024 + n];
    } else if constexpr (ID == 4) { return A.in[IN_WRKV][(size_t)(n >> 10) * 1048576 + (size_t)k * 1024 + (n & 1023)];
    } else if constexpr (ID == 5) {
        if (n < 1024) return A.in[IN_WRKV][(size_t)2 * 1048576 + (size_t)k * 1024 + n];
        const int j = n - 1024; const float* mu = A.in[IN_MU];
        if (j < 128) { const float m = mu[3 * 1024 + k], w = A.in[IN_W1][k * 64 + (j & 63)]; return (j < 64 ? 1.f - m : m) * w; }
        if (j < 256) { const float m = mu[4 * 1024 + k], w = A.in[IN_A1][k * 64 + (j & 63)]; return (j < 192 ? 1.f - m : m) * w; }
        if (j < 576) { const float m = mu[5 * 1024 + k]; const int jj = j - 256, c = jj < 160 ? jj : jj - 160; const float w = A.in[IN_G1][k * 160 + c]; return (jj < 160 ? 1.f - m : m) * w; }
        return 0.f;
    } else if constexpr (ID == 6) { return k < 64 ? A.in[IN_W2][(size_t)k * 1024 + n] : 0.f;
    } else if constexpr (ID == 7) { return k < 64 ? A.in[IN_A2][(size_t)k * 1024 + n] : 0.f;
    } else if constexpr (ID == 8) { return k < 160 ? A.in[IN_G2][(size_t)k * 1024 + n] : 0.f;
    } else if constexpr (ID == 9) { return A.in[IN_WO1][(size_t)k * 1024 + n];
    } else if constexpr (ID == 10) { return A.in[IN_WUP][(size_t)4194304 + (size_t)k * 4096 + n] * A.in[IN_MLPN][1024 + k];
    } else { return A.in[IN_WDN][(size_t)4194304 + (size_t)k * 1024 + n]; }
}
template <int ID> __device__ __forceinline__ void p0_weight(const Args& A, bf16_t* dst, int N, int K, float* scr, int gw, int NGW, int lane) {
    const int nblk = N / 32, nitems = (K / 64) * nblk;
    for (int it = gw; it < nitems; it += NGW) {
        const int kb = it / nblk, nb = it % nblk, k0 = 64 * kb, n0 = 32 * nb;
#pragma unroll 8
        for (int i = 0; i < 32; ++i) { const int kk = 2 * i + (lane >> 5); scr[kk * 33 + (lane & 31)] = wval<ID>(A, n0 + (lane & 31), k0 + kk); }
        LDS_WAIT();
        const int c = lane & 7;
#pragma unroll
        for (int j = 0; j < 4; ++j) { const int n = (lane >> 3) + 8 * j; const float* s = scr + (8 * c) * 33 + n;
            u32x4 o; o.x = pk2(s[0 * 33], s[1 * 33]); o.y = pk2(s[2 * 33], s[3 * 33]); o.z = pk2(s[4 * 33], s[5 * 33]); o.w = pk2(s[6 * 33], s[7 * 33]);
            *(u32x4*)(dst + (size_t)(n0 + n) * K + k0 + 8 * c) = o; }
        LDS_WAIT();
    }
}
__device__ __forceinline__ void rms_row_to_bf16(const float* xrow, const float* g, bf16_t* orow, int lane) {
    const f32x4* xr = (const f32x4*)xrow + lane; const f32x4* gr = (const f32x4*)g + lane;
    f32x4 v[4]; float s = 0.f;
#pragma unroll
    for (int j = 0; j < 4; ++j) { v[j] = xr[64 * j]; s += (v[j].x * v[j].x + v[j].y * v[j].y) + (v[j].z * v[j].z + v[j].w * v[j].w); }
    const float rs = rsqrtf(wave_sum(s) * (1.f / DM) + NORM_EPS);
    u32x2* o8 = (u32x2*)orow + lane;
#pragma unroll
    for (int j = 0; j < 4; ++j) { const f32x4 gg = gr[64 * j]; u32x2 w; w.x = pk2(v[j].x * rs * gg.x, v[j].y * rs * gg.y); w.y = pk2(v[j].z * rs * gg.z, v[j].w * rs * gg.w); o8[64 * j] = w; }
}
__device__ __forceinline__ void p0_prologue(const Args& A, unsigned char* lds) {
    const int tid = opaque_tid(), lane = tid & 63, wave = tid >> 6;
    float* scr = (float*)(lds + wave * 16384);
    const int gw = blockIdx.x * NWAVES + wave, NGW = gridDim.x * NWAVES;
    p0_weight<0>(A, WSP(bf16_t, OFF_WIN), 2304, 1024, scr, gw, NGW, lane);
    p0_weight<1>(A, WSP(bf16_t, OFF_WO0), 1024, 1024, scr, gw, NGW, lane);
    p0_weight<2>(A, WSP(bf16_t, OFF_WUP0), 4096, 1024, scr, gw, NGW, lane);
    p0_weight<3>(A, WSP(bf16_t, OFF_WDN0), 1024, 4096, scr, gw, NGW, lane);
    p0_weight<4>(A, WSP(bf16_t, OFF_WRK), 2048, 1024, scr, gw, NGW, lane);
    p0_weight<5>(A, WSP(bf16_t, OFF_WVL), 1792, 1024, scr, gw, NGW, lane);
    p0_weight<6>(A, WSP(bf16_t, OFF_W2T), 1024, 128, scr, gw, NGW, lane);
    p0_weight<7>(A, WSP(bf16_t, OFF_A2T), 1024, 128, scr, gw, NGW, lane);
    p0_weight<8>(A, WSP(bf16_t, OFF_G2T), 1024, 256, scr, gw, NGW, lane);
    p0_weight<9>(A, WSP(bf16_t, OFF_WO1), 1024, 1024, scr, gw, NGW, lane);
    p0_weight<10>(A, WSP(bf16_t, OFF_WUP1), 4096, 1024, scr, gw, NGW, lane);
    p0_weight<11>(A, WSP(bf16_t, OFF_WDN1), 1024, 4096, scr, gw, NGW, lane);
    float* rc = WSP(float, OFF_ROPE); float* rsn = rc + 2048 * 32;
    for (int idx = blockIdx.x * NTHR + tid; idx < 2048 * 32; idx += gridDim.x * NTHR) {
        const int t = idx >> 5, d = idx & 31;
        double inv = 1.0; for (int i = 0; i < d; ++i) inv *= 0.74989420933245582730;
        const double ang = (double)t * inv;
        const double q = rint(ang * 0.63661977236758134308); const double r = (ang - q * 1.5707963267948966192) - q * 6.123233995736766036e-17;
        const double r2 = r * r;
        double sn = 1.0, cs = 1.0, ts = 1.0, tc = 1.0;
#pragma unroll
        for (int i = 1; i <= 9; ++i) { tc *= -r2 / (double)((2 * i - 1) * (2 * i)); ts *= -r2 / (double)((2 * i) * (2 * i + 1)); cs += tc; sn += ts; }
        sn *= r;
        const int qi = ((int)q) & 3;
        const double c = (qi == 0) ? cs : (qi == 1) ? -sn : (qi == 2) ? -cs : sn;
        const double s = (qi == 0) ? sn : (qi == 1) ? cs : (qi == 2) ? -sn : -cs;
        rc[idx] = (float)c; rsn[idx] = (float)s;
    }
    bf16_t* H0 = WSP(bf16_t, OFF_H0);
    for (int m = gw; m < MTOK; m += NGW) rms_row_to_bf16(A.in[IN_X] + (size_t)m * DM, A.in[IN_MIXN], H0 + (size_t)m * DM, lane);
}

struct Unit { int pm, pn; };
struct Gemm { const bf16_t* A; const bf16_t* A2; int pn2; const bf16_t* Bt; int M, N, K; };
constexpr int NXCD = 8, WGM = 8;
struct StaticOrder {
    int nM, nN, nwg, G, c;
    __device__ void init(int M, int N, int G_, int c_) { nM = M / 256; nN = N / 256; nwg = nM * nN; G = G_; c = c_; }
    __device__ bool next(int i, Unit& u) const {
        const long L = (long)i * G + c; if (L >= nwg) return false;
        int wgid = (int)L; { const int q = nwg / NXCD, r = nwg % NXCD, xcd = wgid % NXCD, off = wgid / NXCD; wgid = (xcd < r ? xcd * (q + 1) : r * (q + 1) + (xcd - r) * q) + off; }
        const int nig = WGM * nN, gid = wgid / nig, fm = gid * WGM, gsz = (nM - fm) < WGM ? (nM - fm) : WGM;
        u.pm = fm + ((wgid % nig) % gsz); u.pn = (wgid % nig) / gsz; return true;
    }
};
typedef f32x4 AccT[2][2][4][2];

template <class Epi> __device__ __forceinline__ void gemm_naive(const Gemm g, const Epi& E) {
    const int tid = opaque_tid(), wave = tid >> 6, lane = tid & 63, wr = wave >> 2, wc = wave & 3, fr = lane & 15, fq = lane >> 4;
    StaticOrder S; S.init(g.M, g.N, gridDim.x, blockIdx.x);
    Unit u;
    for (int i = 0; S.next(i, u); ++i) {
        AccT acc;
#pragma unroll
        for (int a = 0; a < 2; ++a)
#pragma unroll
            for (int b = 0; b < 2; ++b)
#pragma unroll
                for (int m = 0; m < 4; ++m)
#pragma unroll
                    for (int n = 0; n < 2; ++n) acc[a][b][m][n] = (f32x4){0.f, 0.f, 0.f, 0.f};
        const bf16_t* Ab = (u.pn >= g.pn2 ? g.A2 : g.A) + (size_t)(u.pm * 256 + wr * 64 + fr) * g.K;
        const bf16_t* Bb = g.Bt + (size_t)(u.pn * 256 + wc * 32) * g.K;
        for (int k0 = 0; k0 < g.K; k0 += 8) {
            bf16x8 af[2][4];
#pragma unroll
            for (int ai = 0; ai < 2; ++ai)
#pragma unroll
                for (int m = 0; m < 4; ++m) af[ai][m] = *(const bf16x8*)(Ab + (size_t)(ai * 128 + m * 16) * g.K + k0);
#pragma unroll
            for (int bj = 0; bj < 2; ++bj)
#pragma unroll
                for (int n = 0; n < 2; ++n)
#pragma unroll
                    for (int c = 0; c < 4; ++c) {
                        const int col = bj * 128 + (Epi::PERM ? 8 * fq + 4 * n + c : 16 * n + 4 * fq + c);
                        const bf16x8 b = *(const bf16x8*)(Bb + (size_t)col * g.K + k0);
                        float bf[8];
#pragma unroll
                        for (int e = 0; e < 8; ++e) bf[e] = bf2f((bf16_t)b[e]);
#pragma unroll
                        for (int ai = 0; ai < 2; ++ai)
#pragma unroll
                            for (int m = 0; m < 4; ++m) { float s = acc[ai][bj][m][n][c];
#pragma unroll
                                for (int e = 0; e < 8; ++e) s += bf2f((bf16_t)af[ai][m][e]) * bf[e];
                                acc[ai][bj][m][n][c] = s; }
                        asm volatile("" ::: "memory");
                    }
        }
        E(acc, u, wr, wc, fr, fq);
    }
}

struct EpiInProj {
    static constexpr bool PERM = true;
    bf16_t *Q, *K, *V, *QI, *KI; float* WI; const float* rope;
    __device__ __forceinline__ void operator()(const AccT& acc, const Unit& u, int wr, int wc, int fr, int fq) const {
        const int pn = u.pn;
#pragma unroll
        for (int ai = 0; ai < 2; ++ai)
#pragma unroll
            for (int m = 0; m < 4; ++m) {
                const int row = u.pm * 256 + ai * 128 + wr * 64 + m * 16 + fr, t = row & (SEQ - 1);
#pragma unroll
                for (int bj = 0; bj < 2; ++bj) {
                    const int cl = bj * 128 + wc * 32 + fq * 8;
                    f32x4 v0 = acc[ai][bj][m][0], v1 = acc[ai][bj][m][1];
                    const bool rot = (pn <= 4) || pn == 6 || pn == 7 || (pn == 8 && cl < 64);
                    if (rot) {
                        const int d0 = (cl & 63) >> 1;
                        const f32x4 c = *(const f32x4*)(rope + t * 32 + d0), s = *(const f32x4*)(rope + 2048 * 32 + t * 32 + d0);
                        f32x4 a0, a1;
                        a0.x = v0.x * c.x - v0.y * s.x; a0.y = v0.y * c.x + v0.x * s.x;
                        a0.z = v0.z * c.y - v0.w * s.y; a0.w = v0.w * c.y + v0.z * s.y;
                        a1.x = v1.x * c.z - v1.y * s.z; a1.y = v1.y * c.z + v1.x * s.z;
                        a1.z = v1.z * c.w - v1.w * s.w; a1.w = v1.w * c.w + v1.z * s.w;
                        v0 = a0; v1 = a1;
                    }
                    if (pn < 4) { v0 = v0 * QSCALE; v1 = v1 * QSCALE; }
                    u32x4 w; w.x = pk2(v0.x, v0.y); w.y = pk2(v0.z, v0.w); w.z = pk2(v1.x, v1.y); w.w = pk2(v1.z, v1.w);
                    if (pn < 4) *(u32x4*)(Q + (size_t)row * 1024 + pn * 256 + cl) = w;
                    else if (pn == 4) *(u32x4*)(K + (size_t)row * 256 + cl) = w;
                    else if (pn == 5) *(u32x4*)(V + (size_t)row * 256 + cl) = w;
                    else if (pn < 8) *(u32x4*)(QI + (size_t)row * 512 + (pn - 6) * 256 + cl) = w;
                    else { if (cl < 64) *(u32x4*)(KI + (size_t)row * 64 + cl) = w;
                           else if (cl == 64) { *(f32x4*)(WI + (size_t)row * 8) = v0 * WI_SCALE; *(f32x4*)(WI + (size_t)row * 8 + 4) = v1 * WI_SCALE; } }
                }
            }
    }
};
struct EpiResid {
    static constexpr bool PERM = false;
    const float* xin; float* xout; bf16_t* xb; float* ssq;
    __device__ __forceinline__ void operator()(const AccT& acc, const Unit& u, int wr, int wc, int fr, int fq) const {
#pragma unroll
        for (int ai = 0; ai < 2; ++ai)
#pragma unroll
            for (int m = 0; m < 4; ++m) {
                const int row = u.pm * 256 + ai * 128 + wr * 64 + m * 16 + fr; float s = 0.f;
#pragma unroll
                for (int bj = 0; bj < 2; ++bj)
#pragma unroll
                    for (int n = 0; n < 2; ++n) {
                        const size_t off = (size_t)row * DM + u.pn * 256 + bj * 128 + wc * 32 + n * 16 + fq * 4;
                        const f32x4 x = *(const f32x4*)(xin + off) + acc[ai][bj][m][n];
                        *(f32x4*)(xout + off) = x;
                        if (xb) { u32x2 w; w.x = pk2(x.x, x.y); w.y = pk2(x.z, x.w); *(u32x2*)(xb + off) = w; }
                        s += (x.x * x.x + x.y * x.y) + (x.z * x.z + x.w * x.w);
                    }
                if (ssq) { s += __shfl_xor(s, 16); s += __shfl_xor(s, 32); if (fq == 0) atomicAdd(ssq + row, s); }
            }
    }
};
struct EpiUp {
    static constexpr bool PERM = true;
    bf16_t* U; const float* ssq;
    __device__ __forceinline__ void operator()(const AccT& acc, const Unit& u, int wr, int wc, int fr, int fq) const {
#pragma unroll
        for (int ai = 0; ai < 2; ++ai)
#pragma unroll
            for (int m = 0; m < 4; ++m) {
                const int row = u.pm * 256 + ai * 128 + wr * 64 + m * 16 + fr;
                const float rs = rsqrtf(ssq[row] * (1.f / DM) + NORM_EPS);
#pragma unroll
                for (int bj = 0; bj < 2; ++bj) {
                    f32x4 v0 = acc[ai][bj][m][0] * rs, v1 = acc[ai][bj][m][1] * rs;
#pragma unroll
                    for (int c = 0; c < 4; ++c) { const float a = fmaxf(v0[c], 0.f), b = fmaxf(v1[c], 0.f); v0[c] = a * a; v1[c] = b * b; }
                    u32x4 w; w.x = pk2(v0.x, v0.y); w.y = pk2(v0.z, v0.w); w.z = pk2(v1.x, v1.y); w.w = pk2(v1.z, v1.w);
                    *(u32x4*)(U + (size_t)row * FF + u.pn * 256 + bj * 128 + wc * 32 + fq * 8) = w;
                }
            }
    }
};
struct EpiStore {
    static constexpr bool PERM = true;
    bf16_t* b0; int ld0; int split; bf16_t* b1; int ld1;
    __device__ __forceinline__ void operator()(const AccT& acc, const Unit& u, int wr, int wc, int fr, int fq) const {
        bf16_t* base = u.pn < split ? b0 + u.pn * 256 : b1 + (u.pn - split) * 256; const int ld = u.pn < split ? ld0 : ld1;
#pragma unroll
        for (int ai = 0; ai < 2; ++ai)
#pragma unroll
            for (int m = 0; m < 4; ++m) {
                const int row = u.pm * 256 + ai * 128 + wr * 64 + m * 16 + fr;
#pragma unroll
                for (int bj = 0; bj < 2; ++bj) {
                    const f32x4 v0 = acc[ai][bj][m][0], v1 = acc[ai][bj][m][1];
                    u32x4 w; w.x = pk2(v0.x, v0.y); w.y = pk2(v0.z, v0.w); w.z = pk2(v1.x, v1.y); w.w = pk2(v1.z, v1.w);
                    *(u32x4*)(base + (size_t)row * ld + bj * 128 + wc * 32 + fq * 8) = w;
                }
            }
    }
};
struct EpiLoraUp {
    static constexpr bool PERM = true;
    bf16_t* E; bf16_t* AS; const float* w0; const float* a0;
    __device__ __forceinline__ void operator()(const AccT& acc, const Unit& u, int wr, int wc, int fr, int fq) const {
        const bool dec = u.pn < 4; bf16_t* O = dec ? E : AS; const float* bias = dec ? w0 : a0; const float sc = dec ? -0.6065306597126334f : 1.f;
#pragma unroll
        for (int bj = 0; bj < 2; ++bj) {
            const int col = (u.pn & 3) * 256 + bj * 128 + wc * 32 + fq * 8;
            const f32x4 b0 = *(const f32x4*)(bias + col), b1 = *(const f32x4*)(bias + col + 4);
#pragma unroll
            for (int ai = 0; ai < 2; ++ai)
#pragma unroll
                for (int m = 0; m < 4; ++m) {
                    const int row = u.pm * 256 + ai * 128 + wr * 64 + m * 16 + fr;
                    f32x4 v0 = acc[ai][bj][m][0] + b0, v1 = acc[ai][bj][m][1] + b1;
#pragma unroll
                    for (int c = 0; c < 4; ++c) { v0[c] = sc * sigmoidf_(v0[c]); v1[c] = sc * sigmoidf_(v1[c]); }
                    u32x4 w; w.x = pk2(v0.x, v0.y); w.y = pk2(v0.z, v0.w); w.z = pk2(v1.x, v1.y); w.w = pk2(v1.z, v1.w);
                    *(u32x4*)(O + (size_t)row * DM + col) = w;
                    asm volatile("" ::: "memory");
                }
        }
    }
};
struct EpiGatePost {
    static constexpr bool PERM = true;
    bf16_t* AO; const bf16_t* Y; const bf16_t* V; const float* stats; const float* bonus; const float* lnw; const float* lnb;
    __device__ __forceinline__ void operator()(const AccT& acc, const Unit& u, int wr, int wc, int fr, int fq) const {
#pragma unroll
        for (int bj = 0; bj < 2; ++bj) {
            const int col = u.pn * 256 + bj * 128 + wc * 32 + fq * 8, hd = col >> 6;
            const f32x4 w0 = *(const f32x4*)(lnw + col), w1 = *(const f32x4*)(lnw + col + 4), c0 = *(const f32x4*)(lnb + col), c1 = *(const f32x4*)(lnb + col + 4);
#pragma unroll
            for (int ai = 0; ai < 2; ++ai)
#pragma unroll
                for (int m = 0; m < 4; ++m) {
                    const int row = u.pm * 256 + ai * 128 + wr * 64 + m * 16 + fr;
                    const f32x4 st = *(const f32x4*)(stats + ((size_t)row * 16 + hd) * 4);
                    const float mean = (st.x + st.z) * (1.f / 64.f), var = fmaxf((st.y + st.w) * (1.f / 64.f) - mean * mean, 0.f), rstd = rsqrtf(var + LNX_EPS);
                    const float bo = bonus[(size_t)row * 16 + hd];
                    const bf16x8 yv = *(const bf16x8*)(Y + (size_t)row * DM + col), vv = *(const bf16x8*)(V + (size_t)row * DM + col);
                    const f32x4 g0 = acc[ai][bj][m][0], g1 = acc[ai][bj][m][1];
                    float o[8];
#pragma unroll
                    for (int c = 0; c < 4; ++c) {
                        o[c] = ((bf2f((bf16_t)yv[c]) - mean) * rstd * w0[c] + c0[c] + bo * bf2f((bf16_t)vv[c])) * g0[c];
                        o[4 + c] = ((bf2f((bf16_t)yv[4 + c]) - mean) * rstd * w1[c] + c1[c] + bo * bf2f((bf16_t)vv[4 + c])) * g1[c];
                    }
                    u32x4 w; w.x = pk2(o[0], o[1]); w.y = pk2(o[2], o[3]); w.z = pk2(o[4], o[5]); w.w = pk2(o[6], o[7]);
                    *(u32x4*)(AO + (size_t)row * DM + col) = w;
                }
        }
    }
};

#define PG8_LAS __attribute__((address_space(3)))
constexpr int BM = 256, BK = 64, HALF = 128, HTB = HALF * BK * 2  , STAGE_BYTES = 8 * HTB;
__host__ __device__ __forceinline__ int lds_byte(int r, int c) { const int st = (r >> 4) * 2 + (c >> 5), rr = r & 15, cc = c & 31, ob = rr * 64 + cc * 2; return st * 1024 + (ob ^ (((ob >> 9) & 1) << 5)); }
__host__ __device__ __forceinline__ void stage_rc(int b, int& R, int& C) { const int st = b / 1024, sb = b % 1024, swz = sb ^ (((sb >> 9) & 1) << 5); R = (st >> 1) * 16 + swz / 64; C = (st & 1) * 32 + (swz % 64) / 2; }
__host__ __device__ __forceinline__ int perm32(int rho) { const int n = rho >> 4, i = rho & 15; return 8 * (i >> 2) + 4 * n + (i & 3); }
template <class Epi, bool ALIGN_EPI = true, bool SP2 = true>
__device__ __forceinline__ void gemm_fast(PG8_LAS unsigned char* lds, const Gemm g, const Epi& E) {
    StaticOrder S; S.init(g.M, g.N, gridDim.x, blockIdx.x);
    const int tid = opaque_tid(), wid = __builtin_amdgcn_readfirstlane(tid >> 6), lane = tid & 63, wr = wid >> 2, wc = wid & 3, fr = lane & 15, fq = lane >> 4;
    int K_ = g.K; asm volatile("" : "+s"(K_));
    const int K = K_, nt = K / BK;
    unsigned voffA[2], voffB[2];
#pragma unroll
    for (int i = 0; i < 2; ++i) { int R, C; stage_rc(tid * 16 + i * 8192, R, C); const int Rb = Epi::PERM ? ((R & ~31) + perm32(R & 31)) : R;
        voffA[i] = (unsigned)(R * K + C) * 2u; voffB[i] = (unsigned)(Rb * K + C) * 2u; }
    const size_t kstep = (size_t)(BK * 2);
    const size_t hstep = (size_t)HALF * K * 2;
    const size_t tstep = 2 * hstep;
    const unsigned ldsw = (unsigned)wid * 1024u;
    const int aoff = lds_byte(wr * 64 + fr, fq * 8), boff = lds_byte(wc * 32 + fr, fq * 8);
#define PG8_SA(b, h) (((b) * 2 + (h)) * HTB)
#define PG8_SB(b, h) ((4 + (b) * 2 + (h)) * HTB)
#define PG8_STAGE(bufoff, gbase, voff) do { _Pragma("unroll") for (int _i = 0; _i < 2; ++_i) \
        __builtin_amdgcn_global_load_lds((const unsigned*)((const char*)(gbase) + (voff)[_i]), (PG8_LAS unsigned*)(lds + (bufoff) + ldsw + _i * 8192), 16, 0, 0); } while (0)
#define PG8_LDA(dst, b, h) do { _Pragma("unroll") for (int m = 0; m < 4; ++m) _Pragma("unroll") for (int k = 0; k < 2; ++k) dst[m][k] = *(const PG8_LAS bf16x8*)(lds + PG8_SA(b, h) + aoff + m * 2048 + k * 1024); } while (0)
#define PG8_LDB(dst, b, h) do { _Pragma("unroll") for (int n = 0; n < 2; ++n) _Pragma("unroll") for (int k = 0; k < 2; ++k) dst[n][k] = *(const PG8_LAS bf16x8*)(lds + PG8_SB(b, h) + boff + n * 2048 + k * 1024); } while (0)
#define PG8_MMA(ai, bj, At, Bt) do { __builtin_amdgcn_s_setprio(1); _Pragma("unroll") for (int m = 0; m < 4; ++m) _Pragma("unroll") for (int n = 0; n < 2; ++n) _Pragma("unroll") for (int k = 0; k < 2; ++k) \
        acc[ai][bj][m][n] = __builtin_amdgcn_mfma_f32_16x16x32_bf16(Bt[n][k], At[m][k], acc[ai][bj][m][n], 0, 0, 0); __builtin_amdgcn_s_setprio(0); } while (0)
#define PG8_WAIT_V(n) asm volatile("s_waitcnt vmcnt(" #n ")" ::: "memory")
#define PG8_WAIT_L(n) asm volatile("s_waitcnt lgkmcnt(" #n ")" ::: "memory")
#define PG8_BAR __builtin_amdgcn_s_barrier()
#define PG8_SCHED __builtin_amdgcn_sched_barrier(0)
    Unit cur, nxt; int ui = 0;
    if (!S.next(0, cur)) return;
    AccT acc;
#pragma unroll
    for (int a = 0; a < 2; ++a)
#pragma unroll
        for (int b = 0; b < 2; ++b)
#pragma unroll
            for (int m = 0; m < 4; ++m)
#pragma unroll
                for (int n = 0; n < 2; ++n) acc[a][b][m][n] = (f32x4){0.f, 0.f, 0.f, 0.f};
    bf16x8 At[4][2], B0[2][2], B1[2][2];
    const char* cA = (const char*)(cur.pn >= g.pn2 ? g.A2 : g.A) + (size_t)cur.pm * tstep; const char* cB = (const char*)g.Bt + (size_t)cur.pn * tstep;
    if constexpr (SP2) {
        PG8_STAGE(PG8_SB(0, 0), cB, voffB); PG8_STAGE(PG8_SB(0, 1), cB + hstep, voffB); PG8_STAGE(PG8_SA(0, 0), cA, voffA); PG8_STAGE(PG8_SA(0, 1), cA + hstep, voffA);
        if (wr == 1) PG8_BAR;
        PG8_WAIT_V(2); PG8_BAR;
        PG8_STAGE(PG8_SB(1, 0), cB + kstep, voffB); PG8_STAGE(PG8_SA(1, 0), cA + kstep, voffA); PG8_STAGE(PG8_SB(1, 1), cB + hstep + kstep, voffB);
        PG8_WAIT_V(6); PG8_BAR;
    } else {
        PG8_STAGE(PG8_SB(0, 0), cB, voffB); PG8_STAGE(PG8_SA(0, 0), cA, voffA); PG8_STAGE(PG8_SB(0, 1), cB + hstep, voffB); PG8_STAGE(PG8_SA(0, 1), cA + hstep, voffA);
        if (wr == 1) PG8_BAR;
        PG8_WAIT_V(4); PG8_BAR;
        PG8_STAGE(PG8_SB(1, 0), cB + kstep, voffB); PG8_STAGE(PG8_SA(1, 0), cA + kstep, voffA); PG8_STAGE(PG8_SB(1, 1), cB + hstep + kstep, voffB);
        PG8_WAIT_V(6); PG8_BAR;
    }
    for (;;) {
        const bool has_next = S.next(ui + 1, nxt);
        const char* nA = has_next ? (const char*)(nxt.pn >= g.pn2 ? g.A2 : g.A) + (size_t)nxt.pm * tstep : cA; const char* nB = has_next ? (const char*)g.Bt + (size_t)nxt.pn * tstep : cB;
        for (int t = 0; t < nt; t += 2) {
            const bool last = (t == nt - 2);
            const char* a1 = cA + (size_t)(t + 1) * kstep;
            const char* a2 = last ? nA : cA + (size_t)(t + 2) * kstep; const char* b2 = last ? nB : cB + (size_t)(t + 2) * kstep;
            const char* a3 = a2 + kstep; const char* b3 = b2 + kstep;
            if constexpr (SP2) {
            PG8_LDB(B0, 0, 0); PG8_LDB(B1, 0, 1); PG8_SCHED; PG8_LDA(At, 0, 0); PG8_STAGE(PG8_SA(1, 1), a1 + hstep, voffA);
            PG8_WAIT_V(8); PG8_WAIT_L(0); PG8_BAR; PG8_MMA(0, 0, At, B0); PG8_MMA(0, 1, At, B1); PG8_BAR; PG8_SCHED;
            PG8_LDA(At, 0, 1); PG8_STAGE(PG8_SB(0, 0), b2, voffB); PG8_STAGE(PG8_SB(0, 1), b2 + hstep, voffB); PG8_STAGE(PG8_SA(0, 0), a2, voffA);
            PG8_WAIT_V(8); PG8_WAIT_L(0); PG8_BAR; PG8_MMA(1, 0, At, B0); PG8_MMA(1, 1, At, B1); PG8_BAR; PG8_SCHED;
            PG8_LDB(B0, 1, 0); PG8_LDB(B1, 1, 1); PG8_SCHED; PG8_LDA(At, 1, 0); PG8_STAGE(PG8_SA(0, 1), a2 + hstep, voffA);
            PG8_WAIT_V(8); PG8_WAIT_L(0); PG8_BAR; PG8_MMA(0, 0, At, B0); PG8_MMA(0, 1, At, B1); PG8_BAR; PG8_SCHED;
            PG8_LDA(At, 1, 1); PG8_STAGE(PG8_SB(1, 0), b3, voffB); PG8_STAGE(PG8_SB(1, 1), b3 + hstep, voffB); PG8_STAGE(PG8_SA(1, 0), a3, voffA);
            PG8_WAIT_V(8); PG8_WAIT_L(0); PG8_BAR; PG8_MMA(1, 0, At, B0); PG8_MMA(1, 1, At, B1); PG8_BAR; PG8_SCHED;
            } else {
            PG8_LDB(B0, 0, 0); PG8_SCHED; PG8_LDA(At, 0, 0); PG8_STAGE(PG8_SA(1, 1), a1 + hstep, voffA);
            PG8_WAIT_L(8); PG8_BAR; PG8_WAIT_L(0); PG8_MMA(0, 0, At, B0); PG8_BAR; PG8_SCHED;
            PG8_LDB(B1, 0, 1); PG8_STAGE(PG8_SB(0, 0), b2, voffB);
            PG8_BAR; PG8_WAIT_L(0); PG8_MMA(0, 1, At, B1); PG8_BAR;
            PG8_LDA(At, 0, 1); PG8_STAGE(PG8_SA(0, 0), a2, voffA);
            PG8_BAR; PG8_WAIT_L(0); PG8_MMA(1, 0, At, B0); PG8_BAR; PG8_SCHED;
            PG8_STAGE(PG8_SB(0, 1), b2 + hstep, voffB);
            PG8_WAIT_V(6); PG8_BAR; PG8_MMA(1, 1, At, B1); PG8_BAR;
            PG8_LDB(B0, 1, 0); PG8_SCHED; PG8_LDA(At, 1, 0); PG8_STAGE(PG8_SA(0, 1), a2 + hstep, voffA);
            PG8_WAIT_L(8); PG8_BAR; PG8_WAIT_L(0); PG8_MMA(0, 0, At, B0); PG8_BAR; PG8_SCHED;
            PG8_LDB(B1, 1, 1); PG8_STAGE(PG8_SB(1, 0), b3, voffB);
            PG8_BAR; PG8_WAIT_L(0); PG8_MMA(0, 1, At, B1); PG8_BAR;
            PG8_LDA(At, 1, 1); PG8_STAGE(PG8_SA(1, 0), a3, voffA);
            PG8_BAR; PG8_WAIT_L(0); PG8_MMA(1, 0, At, B0); PG8_BAR; PG8_SCHED;
            PG8_STAGE(PG8_SB(1, 1), b3 + hstep, voffB);
            PG8_WAIT_V(6); PG8_BAR; PG8_MMA(1, 1, At, B1); PG8_BAR;
            }
        }
        if constexpr (ALIGN_EPI) { if (wr == 0) PG8_BAR; }
        E(acc, cur, wr, wc, fr, fq);
        if (!has_next) break;
#pragma unroll
        for (int a = 0; a < 2; ++a)
#pragma unroll
            for (int b = 0; b < 2; ++b)
#pragma unroll
                for (int m = 0; m < 4; ++m)
#pragma unroll
                    for (int n = 0; n < 2; ++n) acc[a][b][m][n] = (f32x4){0.f, 0.f, 0.f, 0.f};
        cur = nxt; cA = nA; cB = nB; ++ui;
        if constexpr (ALIGN_EPI) { if (wr == 1) PG8_BAR; }
    }
    PG8_WAIT_V(0);
    if constexpr (!ALIGN_EPI) { if (wr == 0) PG8_BAR; }
    PG8_BAR;
#undef PG8_SA
#undef PG8_SB
#undef PG8_STAGE
#undef PG8_LDA
#undef PG8_LDB
#undef PG8_MMA
#undef PG8_WAIT_V
#undef PG8_WAIT_L
#undef PG8_BAR
#undef PG8_SCHED
}

template <class Epi> __device__ __forceinline__ void gemm_phase(unsigned char* lds, const Gemm g, const Epi& E) {
#if FAST_GEMM
    gemm_fast<Epi>((PG8_LAS unsigned char*)lds, g, E);
#else
    gemm_naive<Epi>(g, E);
#endif
}

__device__ __forceinline__ void p2_naive(const Args& A, unsigned char* lds, size_t mask_off = OFF_MASK) {
    const int tid = opaque_tid(), lane = tid & 63, wave = tid >> 6;
    float* sc = (float*)lds; float* qf = sc + 2048; float* wf = qf + 512;
    const bf16_t* QI = WSP(bf16_t, OFF_QI); const bf16_t* KI = WSP(bf16_t, OFF_KI); const float* WI = WSP(float, OFF_WI); unsigned* MASK = WSP(unsigned, mask_off);
    for (int m = blockIdx.x; m < MTOK; m += gridDim.x) {
        const int t = m & (SEQ - 1), b0 = m - t, nk = t + 1;
        unsigned* mrow = MASK + (size_t)m * 64;
        if (t < 256) { if (tid < 64) { const int lo = tid * 32; mrow[tid] = (nk >= lo + 32) ? 0xffffffffu : (nk <= lo ? 0u : ((1u << (nk - lo)) - 1u)); } continue; }
        __syncthreads();
        qf[tid] = bf2f(QI[(size_t)m * 512 + tid]);
        if (tid < 8) wf[tid] = WI[(size_t)m * 8 + tid];
        __syncthreads();
        for (int s = tid; s < nk; s += NTHR) {
            const bf16_t* kr = KI + (size_t)(b0 + s) * 64; float kf[64];
#pragma unroll
            for (int c = 0; c < 8; ++c) { const bf16x8 kv = *(const bf16x8*)(kr + 8 * c);
#pragma unroll
                for (int e = 0; e < 8; ++e) kf[8 * c + e] = bf2f((bf16_t)kv[e]); }
            float score = 0.f;
#pragma unroll
            for (int h = 0; h < 8; ++h) { float d = 0.f;
#pragma unroll
                for (int e = 0; e < 64; ++e) d += qf[h * 64 + e] * kf[e];
                score += wf[h] * fmaxf(d, 0.f); }
            sc[s] = score;
        }
        __syncthreads();
#pragma unroll 1
        for (int j = 0; j < 4; ++j) {
            const int base = 512 * j + 64 * wave;
            if (base >= nk) { if (lane < 2) mrow[(base >> 5) + lane] = 0u; continue; }
            const int s = base + lane; const bool valid = s < nk; const float my = valid ? sc[s] : 0.f; int cnt = 0;
            for (int s2 = 0; s2 < nk; ++s2) { const float o = sc[s2]; cnt += ((o > my) || (o == my && s2 < s)) ? 1 : 0; }
            const unsigned long long bal = __ballot(valid && cnt < 256);
            if (lane == 0) { mrow[base >> 5] = (unsigned)bal; mrow[(base >> 5) + 1] = (unsigned)(bal >> 32); }
        }
    }
}

__device__ __forceinline__ void p3_naive(const Args& A, unsigned char* lds) {
    const int tid = opaque_tid(), lane = tid & 63, wave = tid >> 6;
    float* lg = (float*)lds; float* qf = lg + 2048; float* red = qf + 1024; unsigned* mw = (unsigned*)(red + 1024);
    bf16_t* QO = WSP(bf16_t, OFF_QO); const bf16_t* K = WSP(bf16_t, OFF_K); const bf16_t* V = WSP(bf16_t, OFF_V); const unsigned* MASK = WSP(unsigned, OFF_MASK);
    for (int m = blockIdx.x; m < MTOK; m += gridDim.x) {
        const int t = m & (SEQ - 1), b0 = m - t, nk = t + 1;
        __syncthreads();
        qf[tid] = bf2f(QO[(size_t)m * 1024 + tid]); qf[tid + 512] = bf2f(QO[(size_t)m * 1024 + 512 + tid]);
        if (tid < 64) mw[tid] = MASK[(size_t)m * 64 + tid];
        __syncthreads();
#pragma unroll 1
        for (int hd = 0; hd < 16; ++hd) {
            const int n = hd >> 2; float mx = -INFINITY;
            for (int s = tid; s < nk; s += NTHR) {
                float v = -INFINITY;
                if ((mw[s >> 5] >> (s & 31)) & 1u) {
                    const bf16_t* kr = K + (size_t)(b0 + s) * 256 + n * 64; float d = 0.f;
#pragma unroll
                    for (int c = 0; c < 8; ++c) { const bf16x8 kv = *(const bf16x8*)(kr + 8 * c);
#pragma unroll
                        for (int e = 0; e < 8; ++e) d += qf[hd * 64 + 8 * c + e] * bf2f((bf16_t)kv[e]); }
                    v = d;
                }
                lg[s] = v; mx = fmaxf(mx, v);
            }
            mx = block_max(mx, red, wave, lane);
            float sm = 0.f;
            for (int s = tid; s < nk; s += NTHR) { const float p = exp2f(lg[s] - mx); lg[s] = p; sm += p; }
            sm = block_sum(sm, red, wave, lane);
            float acc = 0.f;
            for (int s = wave; s < nk; s += NWAVES) { const float p = lg[s]; if (p != 0.f) acc += p * bf2f(V[(size_t)(b0 + s) * 256 + n * 64 + lane]); }
            __syncthreads();
            red[16 + wave * 64 + lane] = acc;
            __syncthreads();
            if (tid < 64) { float o = 0.f;
#pragma unroll
                for (int p = 0; p < NWAVES; ++p) o += red[16 + p * 64 + tid];
                QO[(size_t)m * 1024 + hd * 64 + tid] = (bf16_t)f2bf(o / sm); }
            __syncthreads();
        }
    }
}

__device__ __forceinline__ void p7_prep(const Args& A) {
    const int tid = opaque_tid(), lane = tid & 63, wave = tid >> 6;
    const int gw = blockIdx.x * NWAVES + wave, NGW = gridDim.x * NWAVES;
    const float* X = A.out; const float* g = A.in[IN_MIXN] + DM; const float* mu = A.in[IN_MU];
    bf16_t* XSR = WSP(bf16_t, OFF_XSR); bf16_t* XSK = WSP(bf16_t, OFF_XSK); bf16_t* XSV = WSP(bf16_t, OFF_XSV); bf16_t* H1 = WSP(bf16_t, OFF_H1);
    f32x4 gg[4], mr[4], mk[4], mv[4];
#pragma unroll
    for (int j = 0; j < 4; ++j) { gg[j] = ((const f32x4*)g)[lane + 64 * j]; mr[j] = ((const f32x4*)mu)[lane + 64 * j]; mk[j] = ((const f32x4*)(mu + DM))[lane + 64 * j]; mv[j] = ((const f32x4*)(mu + 2 * DM))[lane + 64 * j]; }
    for (int run = gw; run < MTOK / 16; run += NGW) {
        const int r0 = run * 16; f32x4 hp[4];
#pragma unroll 1
        for (int i = -1; i < 16; ++i) {
            const int row = r0 + i; f32x4 h[4];
            if (i < 0 && (r0 & (SEQ - 1)) == 0) {
#pragma unroll
                for (int j = 0; j < 4; ++j) hp[j] = (f32x4){0.f, 0.f, 0.f, 0.f};
                continue;
            }
            const f32x4* xr = (const f32x4*)(X + (size_t)row * DM) + lane; float s = 0.f;
#pragma unroll
            for (int j = 0; j < 4; ++j) { h[j] = xr[64 * j]; s += (h[j].x * h[j].x + h[j].y * h[j].y) + (h[j].z * h[j].z + h[j].w * h[j].w); }
            const float rs = rsqrtf(wave_sum(s) * (1.f / DM) + NORM_EPS);
#pragma unroll
            for (int j = 0; j < 4; ++j) h[j] = h[j] * rs * gg[j];
            if (i >= 0) {
#pragma unroll
                for (int j = 0; j < 4; ++j) {
                    const f32x4 xx = hp[j] - h[j];
                    const f32x4 a = h[j] + xx * mr[j], b = h[j] + xx * mk[j], c = h[j] + xx * mv[j];
                    const size_t off = (size_t)row * DM + 4 * lane + 256 * j;
                    u32x2 w; w.x = pk2(a.x, a.y); w.y = pk2(a.z, a.w); *(u32x2*)(XSR + off) = w;
                    w.x = pk2(b.x, b.y); w.y = pk2(b.z, b.w); *(u32x2*)(XSK + off) = w;
                    w.x = pk2(c.x, c.y); w.y = pk2(c.z, c.w); *(u32x2*)(XSV + off) = w;
                    w.x = pk2(h[j].x, h[j].y); w.y = pk2(h[j].z, h[j].w); *(u32x2*)(H1 + off) = w;
                }
            }
#pragma unroll
            for (int j = 0; j < 4; ++j) hp[j] = h[j];
        }
    }
}
__device__ __forceinline__ void p10_loramid(const Args& A) {
    const bf16_t* P = WSP(bf16_t, OFF_P); bf16_t* AW = WSP(bf16_t, OFF_AW); bf16_t* AA = WSP(bf16_t, OFF_AA); bf16_t* AG = WSP(bf16_t, OFF_AG);
    const size_t total = (size_t)MTOK * 512;
    for (size_t idx = (size_t)blockIdx.x * NTHR + threadIdx.x; idx < total; idx += (size_t)gridDim.x * NTHR) {
        const int m = (int)(idx >> 9), j = (int)(idx & 511); const bool first = (m & (SEQ - 1)) == 0;
        const bf16_t* p0 = P + (size_t)m * 768; const bf16_t* pm = p0 - 768;
        if (j < 128) {
            float v = 0.f; if (j < 64) { const float x = bf2f(p0[j]) + (first ? 0.f : bf2f(pm[64 + j])); const float e = __expf(-2.f * fabsf(x)); const float th = (1.f - e) / (1.f + e); v = x < 0.f ? -th : th; }
            AW[(size_t)m * 128 + j] = (bf16_t)f2bf(v);
        } else if (j < 256) {
            const int jj = j - 128; float v = 0.f; if (jj < 64) v = bf2f(p0[128 + jj]) + (first ? 0.f : bf2f(pm[192 + jj]));
            AA[(size_t)m * 128 + jj] = (bf16_t)f2bf(v);
        } else {
            const int jj = j - 256; float v = 0.f; if (jj < 160) { const float x = bf2f(p0[256 + jj]) + (first ? 0.f : bf2f(pm[416 + jj])); v = sigmoidf_(x); }
            AG[(size_t)m * 256 + jj] = (bf16_t)f2bf(v);
        }
    }
}
__device__ __forceinline__ void p12_naive(const Args& A, unsigned char* lds) {
    const int tid = opaque_tid(), lane = tid & 63, wave = tid >> 6;
    const int gw = blockIdx.x * NWAVES + wave, NGW = gridDim.x * NWAVES;
    float* sh = (float*)lds + wave * 320;
    const bf16_t* R = WSP(bf16_t, OFF_R); const bf16_t* KR = WSP(bf16_t, OFF_KR); const bf16_t* VV = WSP(bf16_t, OFF_VV); const bf16_t* E = WSP(bf16_t, OFF_E); const bf16_t* AS = WSP(bf16_t, OFF_A);
    bf16_t* Y = WSP(bf16_t, OFF_Y);
    for (int it = gw; it < BATCH * 16; it += NGW) {
        const int b = it >> 4, h = it & 15;
        float S[64];
#pragma unroll
        for (int j = 0; j < 64; ++j) S[j] = 0.f;
        const float kkw = A.in[IN_KK][h * 64 + lane], kaw = A.in[IN_KA][h * 64 + lane];
        const size_t base = (size_t)b * SEQ * DM + h * 64 + lane;
        bf16_t rn = R[base], kn = KR[base], vn = VV[base], en = E[base], an = AS[base];
#pragma unroll 1
        for (int t = 0; t < SEQ; ++t) {
            const float r = bf2f(rn), k = bf2f(kn), v = bf2f(vn), e = bf2f(en), a = bf2f(an);
            if (t + 1 < SEQ) { const size_t ix = base + (size_t)(t + 1) * DM; rn = R[ix]; kn = KR[ix]; vn = VV[ix]; en = E[ix]; an = AS[ix]; }
            float kk = k * kkw; const float ss = wave_sum(kk * kk); kk *= rsqrtf(fmaxf(ss, 1e-24f));
            const float kt = k * (1.f + (a - 1.f) * kaw), bb = kk * a, w = __expf(e);
            sh[lane] = -kk; sh[64 + lane] = w; sh[128 + lane] = bb; sh[192 + lane] = kt; sh[256 + lane] = r;
            LDS_WAIT();
            float sa = 0.f;
#pragma unroll
            for (int j = 0; j < 64; ++j) sa += S[j] * sh[j];
            float y = 0.f;
#pragma unroll
            for (int j = 0; j < 64; ++j) { S[j] = S[j] * sh[64 + j] + sa * sh[128 + j] + v * sh[192 + j]; y += S[j] * sh[256 + j]; }
            Y[base + (size_t)t * DM] = (bf16_t)f2bf(y);
            LDS_WAIT();
        }
    }
}
__device__ __forceinline__ void p12b_stats(const Args& A) {
    const int tid = opaque_tid(), lane = tid & 63, wave = tid >> 6;
    const int gw = blockIdx.x * NWAVES + wave, NGW = gridDim.x * NWAVES;
    const bf16_t* R = WSP(bf16_t, OFF_R); const bf16_t* KR = WSP(bf16_t, OFF_KR); const bf16_t* AS = WSP(bf16_t, OFF_A); const bf16_t* Y = WSP(bf16_t, OFF_Y);
    float* ST = WSP(float, OFF_STATS); float* BO = WSP(float, OFF_BONUS);
    for (int it = gw; it < MTOK * 16; it += NGW) {
        const int h = it & 15; const size_t ix = (size_t)(it >> 4) * DM + h * 64 + lane;
        const float y = bf2f(Y[ix]), r = bf2f(R[ix]), k = bf2f(KR[ix]), a = bf2f(AS[ix]);
        const float kt = k * (1.f + (a - 1.f) * A.in[IN_KA][h * 64 + lane]);
        const float s1 = wave_sum(y), s2 = wave_sum(y * y), bo = wave_sum(r * kt * A.in[IN_RK][h * 64 + lane]);
        if (lane == 0) { *(f32x4*)(ST + (size_t)it * 4) = (f32x4){s1, s2, 0.f, 0.f}; BO[it] = bo; }
    }
}

template <int CTRL> __device__ __forceinline__ float dppf(float v) { return __int_as_float(__builtin_amdgcn_mov_dpp(__float_as_int(v), CTRL, 0xF, 0xF, false)); }
template <int CTRL> __device__ __forceinline__ int dppi(int v) { return __builtin_amdgcn_mov_dpp(v, CTRL, 0xF, 0xF, false); }
__device__ __forceinline__ float row16_allsum(float v) { v += dppf<0xB1>(v); v += dppf<0x4E>(v); v += dppf<0x124>(v); v += dppf<0x128>(v); return v; }
__device__ __forceinline__ float ffma_s(float a, float b, float c) { float r; asm("v_fma_f32 %0, %1, %2, %3" : "=v"(r) : "v"(a), "v"(b), "v"(c)); return r; }
__device__ __forceinline__ float fmul_s(float a, float b) { float r; asm("v_mul_f32_e32 %0, %1, %2" : "=v"(r) : "v"(a), "v"(b)); return r; }
__device__ __forceinline__ float row16_allsum_fused(float v) {
    float a, b, c, d;
    asm("s_nop 1\n\tv_add_f32_dpp %0, %1, %1 quad_perm:[1,0,3,2] row_mask:0xf bank_mask:0xf" : "=v"(a) : "v"(v));
    asm("s_nop 1\n\tv_add_f32_dpp %0, %1, %1 quad_perm:[2,3,0,1] row_mask:0xf bank_mask:0xf" : "=v"(b) : "v"(a));
    asm("s_nop 1\n\tv_add_f32_dpp %0, %1, %1 row_ror:4 row_mask:0xf bank_mask:0xf" : "=v"(c) : "v"(b));
    asm("s_nop 1\n\tv_add_f32_dpp %0, %1, %1 row_ror:8 row_mask:0xf bank_mask:0xf" : "=v"(d) : "v"(c));
    return d;
}
__device__ __forceinline__ int row16_allsum_i(int v) { v += dppi<0xB1>(v); v += dppi<0x4E>(v); v += dppi<0x124>(v); v += dppi<0x128>(v); return v; }
__device__ __forceinline__ int wave_allsum_i(int v) {
    v = row16_allsum_i(v);
    return __builtin_amdgcn_readlane(v, 0) + __builtin_amdgcn_readlane(v, 16) + __builtin_amdgcn_readlane(v, 32) + __builtin_amdgcn_readlane(v, 48);
}

constexpr int P2_LD = 2052;
__device__ __forceinline__ void p2_fast(const Args& A, unsigned char* lds) {
    const int tid = opaque_tid(), lane = tid & 63, wave = __builtin_amdgcn_readfirstlane(tid >> 6), fr = lane & 15, fq = lane >> 4;
    float* sc = (float*)lds;
    const bf16_t* QI = WSP(bf16_t, OFF_QI); const bf16_t* KI = WSP(bf16_t, OFF_KI); const float* WI = WSP(float, OFF_WI); unsigned* MASK = WSP(unsigned, OFF_MASK);
    for (int it = blockIdx.x; it < 1024; it += gridDim.x) {
        const int q = it >> 8, c = it & 255, b = c & 7, s5 = c >> 3;
        const int tt = (q == 0) ? s5 : (q == 1) ? 63 - s5 : (q == 2) ? 64 + s5 : 127 - s5;
        const int t0 = 16 * tt, m0 = b * SEQ + t0;
        if (t0 >= 256 - 15) {
            bf16x8 qf[8][2]; float wv[8];
#pragma unroll
            for (int h = 0; h < 8; ++h) {
#pragma unroll
                for (int ks = 0; ks < 2; ++ks) qf[h][ks] = *(const bf16x8*)(QI + (size_t)(m0 + fr) * 512 + h * 64 + ks * 32 + fq * 8);
                wv[h] = WI[(size_t)(m0 + fr) * 8 + h];
            }
            const bf16_t* kbase = KI + (size_t)(b * SEQ + fr) * 64 + fq * 8;
            bf16x8 ka0 = *(const bf16x8*)(kbase + (size_t)wave * 16 * 64), ka1 = *(const bf16x8*)(kbase + (size_t)wave * 16 * 64 + 32);
#pragma unroll 1
            for (int kt = wave; kt <= tt; kt += NWAVES) {
                const bf16x8 a0 = ka0, a1 = ka1;
                if (kt + NWAVES <= tt) { ka0 = *(const bf16x8*)(kbase + (size_t)(kt + NWAVES) * 16 * 64); ka1 = *(const bf16x8*)(kbase + (size_t)(kt + NWAVES) * 16 * 64 + 32); }
                f32x4 acc = {0.f, 0.f, 0.f, 0.f};
#pragma unroll
                for (int h = 0; h < 8; ++h) {
                    f32x4 d = __builtin_amdgcn_mfma_f32_16x16x32_bf16(a0, qf[h][0], (f32x4){0.f, 0.f, 0.f, 0.f}, 0, 0, 0);
                    d = __builtin_amdgcn_mfma_f32_16x16x32_bf16(a1, qf[h][1], d, 0, 0, 0);
#pragma unroll
                    for (int e = 0; e < 4; ++e) acc[e] += wv[h] * fmaxf(d[e], 0.f);
                }
                *(f32x4*)(sc + fr * P2_LD + kt * 16 + 4 * fq) = acc;
            }
        }
        __syncthreads();
#pragma unroll 1
        for (int rr = 2 * wave; rr < 2 * wave + 2; ++rr) {
            const int t = t0 + rr, nk = t + 1;
            unsigned long long* mrow = (unsigned long long*)(MASK + (size_t)(m0 + rr) * 64);
            if (t < 256) {
                if (lane < 32) { const int lo = lane * 64; mrow[lane] = (nk >= lo + 64) ? ~0ull : (nk <= lo ? 0ull : ((1ull << (nk - lo)) - 1ull)); }
                continue;
            }
            const int nj = (nk + 63) >> 6;
            float x[32];
            const float* srow = sc + rr * P2_LD + lane;
#pragma unroll
            for (int j = 0; j < 32; ++j) x[j] = (j < nj && lane + 64 * j < nk) ? srow[64 * j] : -INFINITY;
            float mx = x[0], mn = (lane < nk) ? x[0] : INFINITY;
#pragma unroll
            for (int j = 1; j < 32; ++j) { mx = fmaxf(mx, x[j]); mn = fminf(mn, (j < nj && lane + 64 * j < nk) ? x[j] : INFINITY); }
            mx = wave_max(mx); mn = -wave_max(-mn);
            mx = __int_as_float(__builtin_amdgcn_readfirstlane(__float_as_int(mx))); mn = __int_as_float(__builtin_amdgcn_readfirstlane(__float_as_int(mn)));
#define P2_COUNT_GE(thr, out) do { int c_ = 0; \
                _Pragma("unroll") for (int g_ = 0; g_ < 4; ++g_) if (nj > 8 * g_) { _Pragma("unroll") for (int j_ = 0; j_ < 8; ++j_) c_ += (x[8 * g_ + j_] >= (thr)) ? 1 : 0; } \
                (out) = wave_allsum_i(c_); } while (0)
            float lo = mn, hi = mx, thr = 0.f; int c_hi; bool exact = false;
            P2_COUNT_GE(mx, c_hi);
            if (c_hi >= 256) { lo = mx; c_hi = 0; }
            else {
#pragma unroll 1
                for (;;) {
                    const float mid = lo + (hi - lo) * 0.5f;
                    if (!(mid > lo && mid < hi)) break;
                    int cm; P2_COUNT_GE(mid, cm);
                    if (cm == 256) { exact = true; thr = mid; break; }
                    if (cm > 256) lo = mid; else { hi = mid; c_hi = cm; }
                }
            }
            unsigned long long mine = 0ull;
            if (exact) {
#pragma unroll
                for (int j = 0; j < 32; ++j) { const unsigned long long bal = __ballot(x[j] >= thr); if (lane == j) mine = bal; }
            } else {
                int need = 256 - c_hi;
#pragma unroll
                for (int j = 0; j < 32; ++j) {
                    const bool eq = (x[j] == lo); const unsigned long long beq = __ballot(eq);
                    const int pre = __builtin_amdgcn_mbcnt_hi((unsigned)(beq >> 32), __builtin_amdgcn_mbcnt_lo((unsigned)beq, 0));
                    const unsigned long long bal = __ballot((x[j] > lo) || (eq && pre < need));
                    need -= __popcll(beq); need = need < 0 ? 0 : need;
                    if (lane == j) mine = bal;
                }
            }
            if (lane < 32) mrow[lane] = mine;
#undef P2_COUNT_GE
        }
        __syncthreads();
    }
}

constexpr int SC_TC = 32, SC_BUF_F = 5 * SC_TC * 64 + SC_TC * 32;
__device__ __forceinline__ void p12_fast(const Args& A, unsigned char* lds) {
    const int tid = opaque_tid(), lane = tid & 63, wave = __builtin_amdgcn_readfirstlane(tid >> 6);
    const int kq = lane & 15, row = 4 * wave + (lane >> 4), tl = tid >> 4;
    float* fl = (float*)lds; float* ybuf = fl + 2 * SC_BUF_F;
    const bf16_t* R = WSP(bf16_t, OFF_R); const bf16_t* KR = WSP(bf16_t, OFF_KR); const bf16_t* VV = WSP(bf16_t, OFF_VV); const bf16_t* E = WSP(bf16_t, OFF_E); const bf16_t* AS = WSP(bf16_t, OFF_A);
    bf16_t* Y = WSP(bf16_t, OFF_Y); float* ST = WSP(float, OFF_STATS); float* BO = WSP(float, OFF_BONUS);
    for (int it = blockIdx.x; it < BATCH * 16 * 2; it += gridDim.x) {
        const int half = it & 1, h = (it >> 1) & 15, b = it >> 5;
        const f32x4 kkw = *(const f32x4*)(A.in[IN_KK] + h * 64 + 4 * kq), kaw = *(const f32x4*)(A.in[IN_KA] + h * 64 + 4 * kq), rkw = *(const f32x4*)(A.in[IN_RK] + h * 64 + 4 * kq);
        const size_t gbase = ((size_t)b * SEQ + tl) * DM + h * 64 + 4 * kq;
        u32x2 pr, pk, pv, pe, pa;
#define SC_PREFETCH(c) do { const size_t gi_ = gbase + (size_t)(c) * SC_TC * DM; pr = *(const u32x2*)(R + gi_); pk = *(const u32x2*)(KR + gi_); pv = *(const u32x2*)(VV + gi_); pe = *(const u32x2*)(E + gi_); pa = *(const u32x2*)(AS + gi_); } while (0)
#define SC_UNPK(p, o) do { o[0] = __uint_as_float(p.x << 16); o[1] = __uint_as_float(p.x & 0xffff0000u); o[2] = __uint_as_float(p.y << 16); o[3] = __uint_as_float(p.y & 0xffff0000u); } while (0)
#define SC_DERIVE(c) do { float* bf_ = fl + ((c) & 1) * SC_BUF_F; float r_[4], k_[4], v_[4], e_[4], a_[4]; SC_UNPK(pr, r_); SC_UNPK(pk, k_); SC_UNPK(pv, v_); SC_UNPK(pe, e_); SC_UNPK(pa, a_); \
            f32x4 kkv_, w_, n_, b_, kt_, rr_; float ss_ = 0.f, bo_ = 0.f; \
            _Pragma("unroll") for (int i_ = 0; i_ < 4; ++i_) { kkv_[i_] = k_[i_] * kkw[i_]; ss_ += kkv_[i_] * kkv_[i_]; } \
            ss_ = row16_allsum(ss_); const float inv_ = rsqrtf(fmaxf(ss_, 1e-24f)); \
            _Pragma("unroll") for (int i_ = 0; i_ < 4; ++i_) { n_[i_] = -kkv_[i_] * inv_; b_[i_] = -n_[i_] * a_[i_]; kt_[i_] = k_[i_] * (1.f + (a_[i_] - 1.f) * kaw[i_]); w_[i_] = __expf(e_[i_]); rr_[i_] = r_[i_]; bo_ += r_[i_] * kt_[i_] * rkw[i_]; } \
            bo_ = row16_allsum(bo_); \
            if (half == 0 && kq == 0) BO[((size_t)b * SEQ + (c) * SC_TC + tl) * 16 + h] = bo_; \
            float* d_ = bf_ + tl * 64 + 4 * kq; *(f32x4*)(d_) = w_; *(f32x4*)(d_ + 2048) = n_; *(f32x4*)(d_ + 4096) = b_; *(f32x4*)(d_ + 6144) = kt_; *(f32x4*)(d_ + 8192) = rr_; \
            if ((kq >> 3) == half) *(f32x4*)(bf_ + 10240 + tl * 32 + 4 * (kq & 7)) = (f32x4){v_[0], v_[1], v_[2], v_[3]}; } while (0)
        __syncthreads();
        SC_PREFETCH(0); SC_DERIVE(0);
        __syncthreads();
        float S0 = 0.f, S1 = 0.f, S2 = 0.f, S3 = 0.f;
#pragma unroll 1
        for (int c = 0; c < SEQ / SC_TC; ++c) {
            if (c + 1 < SEQ / SC_TC) SC_PREFETCH(c + 1);
            const float* bf = fl + (c & 1) * SC_BUF_F + 4 * kq; const float* vb = fl + (c & 1) * SC_BUF_F + 10240 + row; float* yb = ybuf + (c & 1) * 1024 + row;
#define SC_LOAD(P, tt_) do { P##w = *(const f32x4*)(bf + (tt_) * 64); P##n = *(const f32x4*)(bf + (tt_) * 64 + 2048); P##b = *(const f32x4*)(bf + (tt_) * 64 + 4096); P##k = *(const f32x4*)(bf + (tt_) * 64 + 6144); P##r = *(const f32x4*)(bf + (tt_) * 64 + 8192); P##v = vb[(tt_) * 32]; } while (0)
#define SC_STEP(P, tt_) do { \
                float p_ = fmul_s(S0, P##n.x); p_ = ffma_s(S1, P##n.y, p_); p_ = ffma_s(S2, P##n.z, p_); p_ = ffma_s(S3, P##n.w, p_); \
                float t0_ = fmul_s(S0, P##w.x), t1_ = fmul_s(S1, P##w.y), t2_ = fmul_s(S2, P##w.z), t3_ = fmul_s(S3, P##w.w); \
                t0_ = ffma_s(P##v, P##k.x, t0_); t1_ = ffma_s(P##v, P##k.y, t1_); t2_ = ffma_s(P##v, P##k.z, t2_); t3_ = ffma_s(P##v, P##k.w, t3_); \
                const float sa_ = row16_allsum_fused(p_); \
                S0 = ffma_s(sa_, P##b.x, t0_); S1 = ffma_s(sa_, P##b.y, t1_); S2 = ffma_s(sa_, P##b.z, t2_); S3 = ffma_s(sa_, P##b.w, t3_); \
                float qy_ = fmul_s(S0, P##r.x); qy_ = ffma_s(S1, P##r.y, qy_); qy_ = ffma_s(S2, P##r.z, qy_); qy_ = ffma_s(S3, P##r.w, qy_); \
                const float y_ = row16_allsum_fused(qy_); \
                if (kq == 0) yb[(tt_) * 32] = y_; } while (0)
            f32x4 Aw, An, Ab, Ak, Ar, Bw, Bn, Bb, Bk, Br; float Av, Bv;
            SC_LOAD(A, 0);
#pragma unroll 1
            for (int tt = 0; tt < SC_TC; tt += 2) {
                SC_LOAD(B, tt + 1);
                SC_STEP(A, tt);
                if (tt + 2 < SC_TC) SC_LOAD(A, tt + 2);
                SC_STEP(B, tt + 1);
            }
#undef SC_LOAD
#undef SC_STEP
            if (c + 1 < SEQ / SC_TC) SC_DERIVE(c + 1);
            __syncthreads();
            {
                const int j = tid & 15; const float* ys = ybuf + (c & 1) * 1024 + tl * 32 + 2 * j;
                const float y0 = ys[0], y1 = ys[1];
                const float s1 = row16_allsum(y0 + y1), s2 = row16_allsum(y0 * y0 + y1 * y1);
                const size_t m = (size_t)b * SEQ + c * SC_TC + tl;
                *(unsigned*)(Y + m * DM + h * 64 + 32 * half + 2 * j) = pk2(y0, y1);
                if (j == 0) *(f32x2*)(ST + (m * 16 + h) * 4 + 2 * half) = (f32x2){s1, s2};
            }
        }
#undef SC_PREFETCH
#undef SC_UNPK
#undef SC_DERIVE
    }
}

namespace attn_body {
using bf16=__hip_bfloat16;
using bf16x8=__attribute__((ext_vector_type(8)))short;
using s16x4=__attribute__((ext_vector_type(4)))short;
using f32x16=__attribute__((ext_vector_type(16)))float;
using u32x4=__attribute__((ext_vector_type(4)))unsigned;
constexpr int BATCH=8,NHEAD=16,SEQ=2048,D=64,DM=NHEAD*D,KP=256;
constexpr int NW=8,QBLK=32,QB=QBLK*NW,KVBLK=64,NQB=SEQ/QB;
constexpr int ATTN_PITCH=DM, ATTN_UNIT_ROWS=QB;
__device__ __forceinline__ int crow(int r,int hi){return (r&3)+8*(r>>2)+4*hi;}
#define SBAR() __builtin_amdgcn_sched_barrier(0)
__device__ __forceinline__ void bmask(f32x16&p0,f32x16&p1,unsigned long long mw,int hi){
  const float NEG=-INFINITY; const unsigned lo=(unsigned)mw>>(4*hi), hw=(unsigned)(mw>>32)>>(4*hi);
  #pragma unroll
  for(int r=0;r<16;++r){const int c=(r&3)+8*(r>>2); if(!((lo>>c)&1u))p0[r]=NEG; if(!((hw>>c)&1u))p1[r]=NEG;}
}

constexpr int NSLOT=3, SLOTB=8192;
constexpr int LDS_K=0, LDS_V=NSLOT*SLOTB, LDS_WS=2*NSLOT*SLOTB, LDS_OST=LDS_WS+NW*64*4, LDS_MSK=LDS_OST+NW*4096, LDS_BYTES=LDS_MSK+64*256;
constexpr float C2=0.125f*1.4426950408889634f;
__device__ __forceinline__ void glds16(const void*gsrc,unsigned lds_dst){unsigned keep;
  asm volatile("s_mov_b32 %0, m0\n\ts_mov_b32 m0, %2\n\ts_nop 0\n\tglobal_load_lds_dwordx4 %1, off\n\ts_mov_b32 m0, %0":"=&s"(keep):"v"(gsrc),"s"(lds_dst):"memory");}
__device__ __forceinline__ float max3f(float a,float b,float c){float r;asm("v_max3_f32 %0, %1, %2, %3":"=v"(r):"v"(a),"v"(b),"v"(c));return r;}
__device__ __forceinline__ float max2f(float a,float b){float r;asm("v_max_f32_e32 %0, %1, %2":"=v"(r):"v"(a),"v"(b));return r;}
__device__ __forceinline__ float fadd_s(float a,float b){float r;asm("v_add_f32_e32 %0, %1, %2":"=v"(r):"v"(a),"v"(b));return r;}
__device__ __forceinline__ float fsub_s(float a,float b){float r;asm("v_sub_f32_e32 %0, %1, %2":"=v"(r):"v"(a),"v"(b));return r;}
typedef float f32x2_t __attribute__((ext_vector_type(2))); typedef __bf16 bf16x2_t __attribute__((ext_vector_type(2)));
__device__ __forceinline__ unsigned cvtpk_s(float lo,float hi){f32x2_t v={lo,hi};bf16x2_t b=__builtin_convertvector(v,bf16x2_t);return __builtin_bit_cast(unsigned,b);}
#define WAIT_BAR(N) asm volatile("s_waitcnt vmcnt(" #N ") lgkmcnt(0)\n\ts_barrier":::"memory")

__device__ __forceinline__ void qkt(f32x16&p0,f32x16&p1,const char*Kslot,const bf16x8*qr,const f32x16&negm,int r32,int hi){
  const char*kb=Kslot+hi*1024+r32*16;
  #pragma unroll
  for(int d0=0;d0<4;++d0){
    const bf16x8 b0=*reinterpret_cast<const bf16x8*>(kb+d0*2048);
    const bf16x8 b1=*reinterpret_cast<const bf16x8*>(kb+d0*2048+512);
    if(d0==0){p0=__builtin_amdgcn_mfma_f32_32x32x16_bf16(b0,qr[0],negm,0,0,0);p1=__builtin_amdgcn_mfma_f32_32x32x16_bf16(b1,qr[0],negm,0,0,0);}
    else{p0=__builtin_amdgcn_mfma_f32_32x32x16_bf16(b0,qr[d0],p0,0,0,0);p1=__builtin_amdgcn_mfma_f32_32x32x16_bf16(b1,qr[d0],p1,0,0,0);}}
}
typedef __attribute__((address_space(3))) const char* lds_cptr;
typedef short v4i16_t __attribute__((ext_vector_type(4)));
__device__ __forceinline__ void kload8(bf16x8*kf,lds_cptr kp){
  kf[0]=*(const __attribute__((address_space(3))) bf16x8*)(kp);      kf[1]=*(const __attribute__((address_space(3))) bf16x8*)(kp+512);
  kf[2]=*(const __attribute__((address_space(3))) bf16x8*)(kp+2048); kf[3]=*(const __attribute__((address_space(3))) bf16x8*)(kp+2560);
  kf[4]=*(const __attribute__((address_space(3))) bf16x8*)(kp+4096); kf[5]=*(const __attribute__((address_space(3))) bf16x8*)(kp+4608);
  kf[6]=*(const __attribute__((address_space(3))) bf16x8*)(kp+6144); kf[7]=*(const __attribute__((address_space(3))) bf16x8*)(kp+6656);
}
__device__ __forceinline__ void kload2(bf16x8*kf,lds_cptr kp,int j){ kf[2*j]=*(const __attribute__((address_space(3))) bf16x8*)(kp+j*2048); kf[2*j+1]=*(const __attribute__((address_space(3))) bf16x8*)(kp+j*2048+512); }
__device__ __forceinline__ s16x4 vtr(lds_cptr p){ return __builtin_bit_cast(s16x4,__builtin_amdgcn_ds_read_tr16_b64_v4i16((__attribute__((address_space(3))) v4i16_t*)p)); }
__device__ __forceinline__ float rowmax(const f32x16&p0,const f32x16&p1){
  float a=max3f(p0[0],p0[1],p1[0]),b=max3f(p0[2],p0[3],p1[1]);a=max3f(a,p1[2],p1[3]);
  #pragma unroll
  for(int r=4;r<16;r+=4){a=max3f(a,p0[r],p0[r+1]);b=max3f(b,p0[r+2],p0[r+3]);a=max3f(a,p1[r],p1[r+1]);b=max3f(b,p1[r+2],p1[r+3]);}
  const float m=max2f(a,b);
  auto rr=__builtin_amdgcn_permlane32_swap(__float_as_uint(m),__float_as_uint(m),false,false);
  return max2f(__uint_as_float(rr[0]),__uint_as_float(rr[1]));
}
__device__ __forceinline__ void pv(f32x16*o,int vb,bf16x8 pa0,bf16x8 pa1,bf16x8 pa2,bf16x8 pa3){
  #pragma unroll
  for(int d0=0;d0<2;++d0){s16x4 lo[4],hi[4];
    #pragma unroll
    for(int ks=0;ks<4;++ks){
      asm volatile("ds_read_b64_tr_b16 %0,%1 offset:%c2":"=&v"(lo[ks]):"v"(vb),"i"(d0*4096+ks*1024):"memory");
      asm volatile("ds_read_b64_tr_b16 %0,%1 offset:%c2":"=&v"(hi[ks]):"v"(vb),"i"(d0*4096+ks*1024+512):"memory");}
    asm volatile("s_waitcnt lgkmcnt(0)":::"memory");SBAR();
    #define PK(k) (bf16x8){lo[k][0],lo[k][1],lo[k][2],lo[k][3],hi[k][0],hi[k][1],hi[k][2],hi[k][3]}
    o[d0]=__builtin_amdgcn_mfma_f32_32x32x16_bf16(pa0,PK(0),o[d0],0,0,0);
    o[d0]=__builtin_amdgcn_mfma_f32_32x32x16_bf16(pa1,PK(1),o[d0],0,0,0);
    o[d0]=__builtin_amdgcn_mfma_f32_32x32x16_bf16(pa2,PK(2),o[d0],0,0,0);
    o[d0]=__builtin_amdgcn_mfma_f32_32x32x16_bf16(pa3,PK(3),o[d0],0,0,0);
    #undef PK
  }
}

#ifndef ATTN_STORE16
#define ATTN_STORE16(p,v) (*(u32x4*)(p)=(v))
#endif
template<int THRL> __device__ __forceinline__ void attn_unit(int b,int n,int qt,const bf16*Q,const bf16*__restrict__ K,const bf16*__restrict__ V,bf16*O,const unsigned*__restrict__ MASK,char*shm){
  const int tid=opaque_tid(),lane=tid&63,r32=lane&31,hi=lane>>5; const int wid=__builtin_amdgcn_readfirstlane(tid>>6);
  const long rowbase=(long)b*SEQ; const int q0=qt*64;
  const int hq=4*n+(wid>>1), tok0=q0+32*(wid&1);
  const bf16*Qw=Q+(rowbase+tok0)*DM+hq*D;
  const bf16*Kh=K+rowbase*KP+n*D,*Vh=V+rowbase*KP+n*D;
  const unsigned lds0=(unsigned)(uintptr_t)shm;
  float*wsf=(float*)(shm+LDS_WS)+wid*64;
  const bf16*ksrc=Kh+(long)lane*KP+wid*8;
  const bf16*vsrc=Vh+(long)(16*(wid&3)+(lane>>2))*KP+(wid>>2)*32+(lane&3)*8;
  const unsigned kdst=lds0+LDS_K+wid*1024, vdst=lds0+LDS_V+wid*1024;
  #define DMA_K(t,slot) glds16(ksrc+(long)(t)*KVBLK*KP,(unsigned)__builtin_amdgcn_readfirstlane(kdst+(slot)))
  #define DMA_V(t,slot) glds16(vsrc+(long)(t)*KVBLK*KP,(unsigned)__builtin_amdgcn_readfirstlane(vdst+(slot)))
  const int vb0=(int)(lds0+LDS_V)+((lane>>4)&1)*32+(lane&3)*8+(4*hi+((lane&15)>>2))*64;
  const char*Kbase=shm+LDS_K; bf16x8 kf[8];
  const lds_cptr shm3=(lds_cptr)shm; const lds_cptr kp0=shm3+LDS_K+hi*1024+r32*16; const lds_cptr vp0=shm3+LDS_V+((lane>>4)&1)*32+(lane&3)*8+(4*hi+((lane&15)>>2))*64;
  const int nt0=qt+1; const int NT=nt0<4?4:((nt0+1)&~1);
  DMA_K(0,0);DMA_V(0,0);DMA_K(1,SLOTB);
  bf16x8 qr[4];
  #pragma unroll
  for(int d0=0;d0<4;++d0)qr[d0]=*reinterpret_cast<const bf16x8*>(&Qw[(long)r32*DM+d0*16+hi*8]);
  { const int tk=tid>>3,pc=tid&7; const u32x4*ms=(const u32x4*)(MASK+((size_t)(rowbase+q0+tk))*64+pc*8); const u32x4 m0=ms[0],m1=ms[1];
    __attribute__((address_space(3))) u32x4*md=(__attribute__((address_space(3))) u32x4*)((__attribute__((address_space(3))) char*)shm+LDS_MSK+tk*256+pc*32); md[0]=m0; md[1]=m1; }
  const __attribute__((address_space(3))) unsigned long long*mskrow=(const __attribute__((address_space(3))) unsigned long long*)((__attribute__((address_space(3))) char*)shm+LDS_MSK+(32*(wid&1)+r32)*256);
  float mhat=0.f,l_reg=0.f;f32x16 o[2];o[0]=f32x16{};o[1]=f32x16{};f32x16 negm=f32x16{};asm volatile("":"+v"(negm));
  #define CMASK(P0,P1,t) bmask(P0,P1,mw_,hi)
  bool resc=false;
  #define START(P0,P1) do{ const float rm=max2f(rowmax(P0,P1),-1000.f); resc=false; \
    { const float dl=rm; mhat=fadd_s(mhat,dl); \
      _Pragma("unroll") for(int r=0;r<16;++r){P0[r]=fsub_s(P0[r],dl);P1[r]=fsub_s(P1[r],dl);} \
      _Pragma("unroll") for(int r=0;r<16;++r)negm[r]=-mhat; asm volatile("":"+v"(negm)); } \
    _Pragma("unroll") for(int r=0;r<16;++r)P0[r]=__builtin_amdgcn_exp2f(P0[r]); }while(0)
  #define RESC() do{ if(resc){ asm volatile("s_waitcnt lgkmcnt(0)":::"memory"); \
      _Pragma("unroll") for(int d_=0;d_<2;++d_) _Pragma("unroll") for(int r=0;r<16;++r)o[d_][r]*=wsf[crow(r,hi)]; } }while(0)
  f32x16 pA0,pA1,pB0,pB1;
  int sl_prev=0,sl_cur=0,sl_next=SLOTB;
  #define ROT() do{sl_prev=sl_cur;sl_cur=sl_next;sl_next=(sl_next==(NSLOT-1)*SLOTB)?0:sl_next+SLOTB;}while(0)
  DMA_K(2,2*SLOTB);
  WAIT_BAR(3);
  qkt(pA0,pA1,Kbase,qr,negm,r32,hi);asm volatile("s_nop 15\n\ts_nop 7":"+v"(pA0),"+v"(pA1));{const unsigned long long mw_=mskrow[0];CMASK(pA0,pA1,0);}
  START(pA0,pA1);
  _Pragma("unroll") for(int r=0;r<16;++r)pA1[r]=__builtin_amdgcn_exp2f(pA1[r]);
  WAIT_BAR(0);
  DMA_K(3,0);DMA_V(1,SLOTB);
  ROT();
  kload8(kf,kp0+sl_cur);
  WAIT_BAR(2);
  s16x4 vlo[8],vhi[8]; u32x4 pw0,pw1,pw2,pw3;
  #define PKW(P,B) cvtpk_s(P[B],P[B+1])
  #define PAF(k) __builtin_bit_cast(bf16x8,pw##k)
  #define VFR(i) (bf16x8){vlo[i][0],vlo[i][1],vlo[i][2],vlo[i][3],vhi[i][0],vhi[i][1],vhi[i][2],vhi[i][3]}
  #define PIN(x) asm volatile("":"+v"(x))
  #define MX3(a,b,c) __builtin_fmaxf(__builtin_fmaxf((a),(b)),(c))
  #define GAPA(MF,A0,A1,A2,A3,W0,W1,PW) do{ MF; sacc+=A0; sacc+=A1; sacc+=A2; sacc+=A3; PIN(sacc); W0; W1; PIN(PW); SBAR(); }while(0)
  #define EX(v) __builtin_amdgcn_exp2f(v)
  #define GAPB(MF,X,B) do{ MF; X[B]=EX(X[B]); X[B+1]=EX(X[B+1]); X[B+2]=EX(X[B+2]); X[B+3]=EX(X[B+3]); PIN(X); SBAR(); }while(0)
  #define VRD(i) do{ vlo[i]=vtr(vp_+(((i)>>2)*4096+((i)&3)*1024)); vhi[i]=vtr(vp_+(((i)>>2)*4096+((i)&3)*1024+512)); }while(0)
  #define KRD(G,j) do{ if(G){ kload2(kf,kp0+sl_next,j); SBAR(); } }while(0)
  #define STEP(C0,C1,P0,P1,t,GK,GV,GL) do{ SBAR(); \
    const lds_cptr vp_=vp0+sl_prev; const unsigned long long mw_=mskrow[(t)]; \
    VRD(0); SBAR(); float sacc=(P0[0]+P0[1]); \
    GAPA(C0=__builtin_amdgcn_mfma_f32_32x32x16_bf16(kf[0],qr[0],negm,0,0,0), P0[2],P0[3],P0[4],P0[5],     pw0[0]=PKW(P0,0), pw0[1]=PKW(P0,2), pw0); \
    VRD(4); SBAR(); GAPA(C1=__builtin_amdgcn_mfma_f32_32x32x16_bf16(kf[1],qr[0],negm,0,0,0), P0[6],P0[7],P0[8],P0[9],     pw0[2]=PKW(P0,4), pw0[3]=PKW(P0,6), pw0); \
    VRD(1); SBAR(); GAPA(C0=__builtin_amdgcn_mfma_f32_32x32x16_bf16(kf[2],qr[1],C0,0,0,0),   P0[10],P0[11],P0[12],P0[13], pw1[0]=PKW(P0,8), pw1[1]=PKW(P0,10), pw1); \
    VRD(5); SBAR(); GAPA(C1=__builtin_amdgcn_mfma_f32_32x32x16_bf16(kf[3],qr[1],C1,0,0,0),   P0[14],P0[15],P1[0],P1[1],   pw1[2]=PKW(P0,12),pw1[3]=PKW(P0,14), pw1); \
    VRD(2); SBAR(); GAPA(C0=__builtin_amdgcn_mfma_f32_32x32x16_bf16(kf[4],qr[2],C0,0,0,0),   P1[2],P1[3],P1[4],P1[5],     pw2[0]=PKW(P1,0), pw2[1]=PKW(P1,2), pw2); \
    VRD(6); SBAR(); GAPA(C1=__builtin_amdgcn_mfma_f32_32x32x16_bf16(kf[5],qr[2],C1,0,0,0),   P1[6],P1[7],P1[8],P1[9],     pw2[2]=PKW(P1,4), pw2[3]=PKW(P1,6), pw2); \
    VRD(3); SBAR(); GAPA(C0=__builtin_amdgcn_mfma_f32_32x32x16_bf16(kf[6],qr[3],C0,0,0,0),   P1[10],P1[11],P1[12],P1[13], pw3[0]=PKW(P1,8), pw3[1]=PKW(P1,10), pw3); \
    VRD(7); SBAR(); GAPA(C1=__builtin_amdgcn_mfma_f32_32x32x16_bf16(kf[7],qr[3],C1,0,0,0),   P1[14],P1[15],0.f,0.f,       pw3[2]=PKW(P1,12),pw3[3]=PKW(P1,14), pw3); \
    l_reg+=sacc; \
    if(GK){DMA_K((t)+3,sl_cur);} if(GV){DMA_V((t)+1,sl_next);} \
    CMASK(C0,C1,t); \
    { float a=MX3(C0[0],C0[1],C1[0]),b=MX3(C0[2],C0[3],C1[1]); a=MX3(a,C1[2],C1[3]); \
      _Pragma("unroll") for(int r=4;r<16;r+=4){a=MX3(a,C0[r],C0[r+1]);b=MX3(b,C0[r+2],C0[r+3]);a=MX3(a,C1[r],C1[r+1]);b=MX3(b,C1[r+2],C1[r+3]);} \
      float rm=__builtin_fmaxf(a,b); { auto rr=__builtin_amdgcn_permlane32_swap(__float_as_uint(rm),__float_as_uint(rm),false,false); rm=__builtin_fmaxf(__uint_as_float(rr[0]),__uint_as_float(rr[1])); } \
      resc=false; \
      if(__builtin_expect(__any(rm>(float)THRL),0)){ const float dl=__builtin_fmaxf(rm,0.f); mhat+=dl; \
        _Pragma("unroll") for(int r=0;r<16;++r){C0[r]-=dl;C1[r]-=dl;} \
        _Pragma("unroll") for(int r=0;r<16;++r)negm[r]=-mhat; asm volatile("":"+v"(negm)); \
        const float f=__builtin_amdgcn_exp2f(-dl); l_reg*=f; if(hi==0)wsf[r32]=f; resc=true; } } \
    SBAR(); \
    GAPB(o[0]=__builtin_amdgcn_mfma_f32_32x32x16_bf16(PAF(0),VFR(0),o[0],0,0,0), C0,0); \
    GAPB(o[1]=__builtin_amdgcn_mfma_f32_32x32x16_bf16(PAF(0),VFR(4),o[1],0,0,0), C0,4); \
    KRD(GL,0); GAPB(o[0]=__builtin_amdgcn_mfma_f32_32x32x16_bf16(PAF(1),VFR(1),o[0],0,0,0), C0,8); \
    KRD(GL,1); GAPB(o[1]=__builtin_amdgcn_mfma_f32_32x32x16_bf16(PAF(1),VFR(5),o[1],0,0,0), C0,12); \
    KRD(GL,2); GAPB(o[0]=__builtin_amdgcn_mfma_f32_32x32x16_bf16(PAF(2),VFR(2),o[0],0,0,0), C1,0); \
    KRD(GL,3); GAPB(o[1]=__builtin_amdgcn_mfma_f32_32x32x16_bf16(PAF(2),VFR(6),o[1],0,0,0), C1,4); \
    GAPB(o[0]=__builtin_amdgcn_mfma_f32_32x32x16_bf16(PAF(3),VFR(3),o[0],0,0,0), C1,8); \
    GAPB(o[1]=__builtin_amdgcn_mfma_f32_32x32x16_bf16(PAF(3),VFR(7),o[1],0,0,0), C1,12); \
    }while(0)
  int t=1;
  for(;t+5<NT;t+=2){
    STEP(pB0,pB1,pA0,pA1,t,true,true,true);     WAIT_BAR(2); RESC(); ROT();
    STEP(pA0,pA1,pB0,pB1,t+1,true,true,true);   WAIT_BAR(2); RESC(); ROT();
  }
  #define ENDW(tt) do{ if((tt)+3<NT){WAIT_BAR(2);} else if((tt)+2<NT){WAIT_BAR(1);} else {WAIT_BAR(0);} }while(0)
  for(;t+1<NT;t+=2){
    STEP(pB0,pB1,pA0,pA1,t,(t+3<NT),(t+1<NT),(t+1<NT));       ENDW(t);   RESC(); ROT();
    STEP(pA0,pA1,pB0,pB1,t+1,(t+4<NT),(t+2<NT),(t+2<NT));     ENDW(t+1); RESC(); ROT();
  }
  STEP(pB0,pB1,pA0,pA1,NT-1,false,false,false); RESC();
  { float sacc=pB0[0]+pB0[1]; _Pragma("unroll") for(int r=2;r<16;++r)sacc+=pB0[r]; _Pragma("unroll") for(int r=0;r<16;++r)sacc+=pB1[r]; l_reg+=sacc;
    pw0=(u32x4){PKW(pB0,0),PKW(pB0,2),PKW(pB0,4),PKW(pB0,6)};pw1=(u32x4){PKW(pB0,8),PKW(pB0,10),PKW(pB0,12),PKW(pB0,14)};pw2=(u32x4){PKW(pB1,0),PKW(pB1,2),PKW(pB1,4),PKW(pB1,6)};pw3=(u32x4){PKW(pB1,8),PKW(pB1,10),PKW(pB1,12),PKW(pB1,14)};
    SBAR(); pv(o,vb0+sl_cur,PAF(0),PAF(1),PAF(2),PAF(3)); }
  #undef PKW
  #undef PAF
  #undef VFR
  #undef PIN
  #undef MX3
  #undef GAPA
  #undef GAPB
  #undef EX
  #undef VRD
  #undef KRD
  #undef STEP
  #undef ENDW
  {auto rr=__builtin_amdgcn_permlane32_swap(__float_as_uint(l_reg),__float_as_uint(l_reg),false,false);l_reg=__uint_as_float(rr[0])+__uint_as_float(rr[1]);}
  if(hi==0)wsf[32+r32]=l_reg;asm volatile("s_waitcnt lgkmcnt(0)":::"memory");
  float rli[16];
  #pragma unroll
  for(int r=0;r<16;++r)rli[r]=__builtin_amdgcn_rcpf(wsf[32+crow(r,hi)]);
  bf16*Ow=O+(rowbase+tok0)*DM+hq*D;
  { bf16*stg=(bf16*)(shm+LDS_OST)+wid*2048;
    #pragma unroll
    for(int r=0;r<16;++r){const int orow=crow(r,hi);
      #pragma unroll
      for(int d0=0;d0<2;++d0)stg[orow*64+d0*32+r32]=__float2bfloat16(o[d0][r]*rli[r]);}
    asm volatile("s_waitcnt lgkmcnt(0)":::"memory");
    #pragma unroll
    for(int i=0;i<4;++i){const int row=i*8+(lane>>3),ch=lane&7; const u32x4 v=*(const u32x4*)(stg+row*64+ch*8); ATTN_STORE16(Ow+(long)row*DM+ch*8,v);} }
  asm volatile("s_waitcnt lgkmcnt(0)\n\ts_barrier":::"memory");
  #undef DMA_K
  #undef DMA_V
  #undef CMASK
  #undef START
  #undef RESC
  #undef ROT
}
constexpr int ATTN_LDS_BYTES=LDS_BYTES;
struct AttnTensors { const bf16* Q; const bf16* K; const bf16* V; bf16* O; const unsigned* MASK; };
struct AttnUnit { int bn; int qt; };
struct StaticOrder {
  int vcu, G;
  __device__ __forceinline__ explicit StaticOrder(int grid,int block):vcu((grid%8==0)?(block%8)*(grid/8)+block/8:block),G(grid){}
  __device__ __forceinline__ bool next(int i,AttnUnit&u)const{
    if(G==256){ if(i>=4)return false; const int s=vcu&7; u.bn=vcu>>3; u.qt=(i==0)?31-s:(i==1)?16+s:(i==2)?15-s:s; return true; }
    const int id=vcu+i*G; if(id>=1024)return false; u.bn=id>>5; u.qt=31-(id&31); return true; }
};
template<class Sched,int THRL=8> __device__ __forceinline__ void attn_phase(char*lds,const AttnTensors&T,const Sched&S){
  AttnUnit u;
  for(int i=0;S.next(i,u);++i){ attn_unit<THRL>(u.bn>>2,u.bn&3,u.qt,T.Q,T.K,T.V,T.O,T.MASK,lds); }
}
#undef SBAR
#undef WAIT_BAR
}


constexpr int CH = 16, NCHUNK = SEQ / CH;
constexpr size_t OFF_SM = 84 * MiB, OFF_WC = 3 * MiB;
__device__ __forceinline__ unsigned char* arr_base(const Args& A, int arr) { return A.ws + (arr == 0 ? OFF_R : arr == 1 ? OFF_KR : arr == 2 ? OFF_E : OFF_A); }
__device__ __forceinline__ unsigned char* piece_ptr(const Args& A, int blk, int lane, int m0, int h) {
    const int pidx = blk * 64 + lane, p7 = pidx & 127, t = p7 >> 3, seg = p7 & 7;
    return arr_base(A, pidx >> 7) + ((size_t)(m0 + t) * DM + h * 64 + seg * 8) * 2;
}
__device__ __forceinline__ unsigned cvtpk(float lo, float hi) { typedef float f2_ __attribute__((ext_vector_type(2))); typedef __bf16 b2_ __attribute__((ext_vector_type(2))); f2_ v = {lo, hi}; b2_ b = __builtin_convertvector(v, b2_); return __builtin_bit_cast(unsigned, b); }
__device__ __forceinline__ float quad_allsum(float v) { v += dppf<0xB1>(v); v += dppf<0x4E>(v); return v; }
__device__ __forceinline__ bf16x8 mk8(unsigned a, unsigned b, unsigned c, unsigned d) { u32x4 w = {a, b, c, d}; return __builtin_bit_cast(bf16x8, w); }

__device__ __forceinline__ void p12_chunk_prep(const Args& A, unsigned char* lds) {
    const int tid = opaque_tid(), lane = tid & 63, wave = __builtin_amdgcn_readfirstlane(tid >> 6), q = lane >> 4, c = lane & 15;
    unsigned char* wl = lds + wave * 14336;
    bf16_t* arr = (bf16_t*)wl;
    bf16_t* bkb = (bf16_t*)(wl + 8192);
    float* gs = (float*)(wl + 12288);
    float* invs = (float*)(wl + 13312);
    const bf16_t* R = WSP(bf16_t, OFF_R); const bf16_t* KR = WSP(bf16_t, OFF_KR); const bf16_t* E = WSP(bf16_t, OFF_E); const bf16_t* AS = WSP(bf16_t, OFF_A);
    float* BO = WSP(float, OFF_BONUS); float* WC = WSP(float, OFF_WC); unsigned char* SM = A.ws + OFF_SM;
    const int gw = blockIdx.x * NWAVES + wave, NGW = gridDim.x * NWAVES;
#pragma unroll 1
    for (int item = gw; item < BATCH * 16 * NCHUNK; item += NGW) {
        const int bh = item >> 7, ch = item & 127, b = bh >> 4, h = bh & 15, m0 = b * SEQ + ch * CH;
        {
            const int t = lane >> 2, sg = lane & 3; const size_t go = (size_t)(m0 + t) * DM + h * 64 + sg * 16;
            const u32x4 r0 = *(const u32x4*)(R + go), r1 = *(const u32x4*)(R + go + 8), k0 = *(const u32x4*)(KR + go), k1 = *(const u32x4*)(KR + go + 8);
            const u32x4 e0 = *(const u32x4*)(E + go), e1 = *(const u32x4*)(E + go + 8), a0 = *(const u32x4*)(AS + go), a1 = *(const u32x4*)(AS + go + 8);
            u32x4* d = (u32x4*)(arr + t * 64 + sg * 16);
            d[0] = r0; d[1] = r1; d[128] = k0; d[129] = k1; d[256] = e0; d[257] = e1; d[384] = a0; d[385] = a1;
            float ss = 0.f, bo = 0.f;
#pragma unroll
            for (int w = 0; w < 8; ++w) {
                const unsigned rw = w < 4 ? r0[w & 3] : r1[w & 3], kw = w < 4 ? k0[w & 3] : k1[w & 3], aw = w < 4 ? a0[w & 3] : a1[w & 3];
                const int kk0 = h * 64 + sg * 16 + 2 * w;
#pragma unroll
                for (int p = 0; p < 2; ++p) {
                    const float rv = p ? __uint_as_float(rw & 0xffff0000u) : __uint_as_float(rw << 16), kv = p ? __uint_as_float(kw & 0xffff0000u) : __uint_as_float(kw << 16), av = p ? __uint_as_float(aw & 0xffff0000u) : __uint_as_float(aw << 16);
                    const float kkv = kv * A.in[IN_KK][kk0 + p]; ss += kkv * kkv;
                    bo += rv * (kv * (1.f + (av - 1.f) * A.in[IN_KA][kk0 + p])) * A.in[IN_RK][kk0 + p];
                }
            }
            ss = quad_allsum(ss); bo = quad_allsum(bo);
            if (sg == 0) { invs[t] = rsqrtf(fmaxf(ss, 1e-24f)); BO[(size_t)(m0 + t) * 16 + h] = bo; }
        }
        LDS_WAIT();
        float wc;
        {
            const float kkw = A.in[IN_KK][h * 64 + lane], kaw = A.in[IN_KA][h * 64 + lane];
            float Ecum = 0.f, ep_prev = 1.f; float bt[16], ktl[16];
#pragma unroll
            for (int t = 0; t < 16; ++t) {
                const float r = bf2f(arr[t * 64 + lane]), k = bf2f(arr[1024 + t * 64 + lane]), e = bf2f(arr[2048 + t * 64 + lane]), a = bf2f(arr[3072 + t * 64 + lane]);
                const float n = -(k * kkw) * invs[t], bb = -n * a, kt = k * (1.f + (a - 1.f) * kaw);
                Ecum += e; const float ep = __expf(Ecum), em = __builtin_amdgcn_rcpf(ep);
                bt[t] = bb * em; ktl[t] = kt * em;
                arr[t * 64 + lane] = (bf16_t)f2bf(r * ep); arr[1024 + t * 64 + lane] = (bf16_t)f2bf(n * ep_prev);
                arr[2048 + t * 64 + lane] = (bf16_t)f2bf(bt[t]); arr[3072 + t * 64 + lane] = (bf16_t)f2bf(ktl[t]);
                ep_prev = ep;
            }
            wc = ep_prev;
            u32x4* bd = (u32x4*)(bkb + lane * 16); u32x4* kd = (u32x4*)(bkb + 1024 + lane * 16);
            bd[0] = (u32x4){cvtpk(bt[0] * wc, bt[1] * wc), cvtpk(bt[2] * wc, bt[3] * wc), cvtpk(bt[4] * wc, bt[5] * wc), cvtpk(bt[6] * wc, bt[7] * wc)};
            bd[1] = (u32x4){cvtpk(bt[8] * wc, bt[9] * wc), cvtpk(bt[10] * wc, bt[11] * wc), cvtpk(bt[12] * wc, bt[13] * wc), cvtpk(bt[14] * wc, bt[15] * wc)};
            kd[0] = (u32x4){cvtpk(ktl[0] * wc, ktl[1] * wc), cvtpk(ktl[2] * wc, ktl[3] * wc), cvtpk(ktl[4] * wc, ktl[5] * wc), cvtpk(ktl[6] * wc, ktl[7] * wc)};
            kd[1] = (u32x4){cvtpk(ktl[8] * wc, ktl[9] * wc), cvtpk(ktl[10] * wc, ktl[11] * wc), cvtpk(ktl[12] * wc, ktl[13] * wc), cvtpk(ktl[14] * wc, ktl[15] * wc)};
        }
        LDS_WAIT();
        f32x4 gnb = {0.f, 0.f, 0.f, 0.f}, gnk = gnb, grb = gnb, grk = gnb;
#pragma unroll
        for (int ks = 0; ks < 2; ++ks) {
            const int o = c * 64 + ks * 32 + q * 8;
            const bf16x8 Ab = *(const bf16x8*)(arr + 2048 + o), Ak = *(const bf16x8*)(arr + 3072 + o), Bn = *(const bf16x8*)(arr + 1024 + o), Br = *(const bf16x8*)(arr + o);
            gnb = __builtin_amdgcn_mfma_f32_16x16x32_bf16(Ab, Bn, gnb, 0, 0, 0); gnk = __builtin_amdgcn_mfma_f32_16x16x32_bf16(Ak, Bn, gnk, 0, 0, 0);
            grb = __builtin_amdgcn_mfma_f32_16x16x32_bf16(Ab, Br, grb, 0, 0, 0); grk = __builtin_amdgcn_mfma_f32_16x16x32_bf16(Ak, Br, grk, 0, 0, 0);
        }
#pragma unroll
        for (int rg = 0; rg < 4; ++rg) { const int sI = 4 * q + rg; if (!(sI < c)) { gnb[rg] = 0.f; gnk[rg] = 0.f; } if (!(sI <= c)) { grb[rg] = 0.f; grk[rg] = 0.f; } gs[sI * 16 + c] = gnb[rg]; }
        LDS_WAIT();
        {
            float Tc[16];
#pragma unroll
            for (int sI = 15; sI >= 0; --sI) {
                float acc = (sI == c) ? 1.f : 0.f;
#pragma unroll
                for (int j = sI + 1; j < 16; ++j) acc += gs[sI * 16 + j] * Tc[j];
                Tc[sI] = acc;
            }
            LDS_WAIT();
            if (q == 0) {
#pragma unroll
                for (int j = 0; j < 4; ++j) *(f32x4*)(gs + c * 16 + 4 * j) = (f32x4){Tc[4 * j], Tc[4 * j + 1], Tc[4 * j + 2], Tc[4 * j + 3]};
            }
        }
        LDS_WAIT();
#pragma unroll
        for (int blk = 0; blk < 4; ++blk) {
            const int ks = blk & 1; const bf16_t* src = arr + (blk < 2 ? 1024 : 0) + c * 64 + ks * 32 + 4 * q;
            const u32x2 lo = *(const u32x2*)src, hi = *(const u32x2*)(src + 16);
            *(u32x4*)piece_ptr(A, blk, lane, m0, h) = (u32x4){lo.x, lo.y, hi.x, hi.y};
        }
#pragma unroll
        for (int ct = 0; ct < 4; ++ct) {
            const u32x2 lo = *(const u32x2*)(bkb + (16 * ct + c) * 16 + 4 * q), hi = *(const u32x2*)(bkb + 1024 + (16 * ct + c) * 16 + 4 * q);
            *(u32x4*)piece_ptr(A, 4 + ct, lane, m0, h) = (u32x4){lo.x, lo.y, hi.x, hi.y};
        }
        {
            unsigned char* sm = SM + (size_t)item * 2048;
            *(u32x2*)(sm + lane * 8) = (u32x2){cvtpk(gnk[0], gnk[1]), cvtpk(gnk[2], gnk[3])};
            const f32x4 tv = *(const f32x4*)(gs + c * 16 + 4 * q);
            *(u32x2*)(sm + 512 + lane * 8) = (u32x2){cvtpk(tv[0], tv[1]), cvtpk(tv[2], tv[3])};
            *(u32x4*)(sm + 1024 + lane * 16) = (u32x4){cvtpk(grb[0], grb[1]), cvtpk(grb[2], grb[3]), cvtpk(grk[0], grk[1]), cvtpk(grk[2], grk[3])};
            WC[(size_t)item * 64 + lane] = wc;
        }
        LDS_WAIT();
    }
}

__device__ __forceinline__ void p13_chunk_scan(const Args& A, unsigned char* lds) {
    const int tid = opaque_tid(), lane = tid & 63, wave = __builtin_amdgcn_readfirstlane(tid >> 6), q = lane >> 4, c = lane & 15;
    float* part = (float*)lds;
    const bf16_t* VV = WSP(bf16_t, OFF_VV); bf16_t* Y = WSP(bf16_t, OFF_R); float* ST = WSP(float, OFF_STATS); const float* WC = WSP(float, OFF_WC); const unsigned char* SM = A.ws + OFF_SM;
    const bool act = wave < 4; const int rt = wave & 3;
#pragma unroll 1
    for (int it = blockIdx.x; it < BATCH * 16; it += gridDim.x) {
        const int b = it >> 4, h = it & 15;
        f32x4 St[4];
#pragma unroll
        for (int i = 0; i < 4; ++i) St[i] = (f32x4){0.f, 0.f, 0.f, 0.f};
        bf16x8 n0, n1, r0, r1, bk0, bk1, bk2, bk3, gr; u32x2 gnk, tt; unsigned short v0, v1, v2, v3; f32x4 w0, w1, w2, w3;
#define CS_LOAD(chn) do { const int m0_ = b * SEQ + (chn) * CH; const size_t item_ = (size_t)it * NCHUNK + (chn); \
            n0 = *(const bf16x8*)piece_ptr(A, 0, lane, m0_, h); n1 = *(const bf16x8*)piece_ptr(A, 1, lane, m0_, h); r0 = *(const bf16x8*)piece_ptr(A, 2, lane, m0_, h); r1 = *(const bf16x8*)piece_ptr(A, 3, lane, m0_, h); \
            bk0 = *(const bf16x8*)piece_ptr(A, 4, lane, m0_, h); bk1 = *(const bf16x8*)piece_ptr(A, 5, lane, m0_, h); bk2 = *(const bf16x8*)piece_ptr(A, 6, lane, m0_, h); bk3 = *(const bf16x8*)piece_ptr(A, 7, lane, m0_, h); \
            const unsigned char* sm_ = SM + item_ * 2048; gnk = *(const u32x2*)(sm_ + lane * 8); tt = *(const u32x2*)(sm_ + 512 + lane * 8); gr = *(const bf16x8*)(sm_ + 1024 + lane * 16); \
            const bf16_t* vp_ = VV + (size_t)(m0_ + 4 * q) * DM + h * 64 + 16 * rt + c; v0 = vp_[0]; v1 = vp_[DM]; v2 = vp_[2 * DM]; v3 = vp_[3 * DM]; \
            const float* wp_ = WC + item_ * 64 + 4 * q; w0 = *(const f32x4*)(wp_); w1 = *(const f32x4*)(wp_ + 16); w2 = *(const f32x4*)(wp_ + 32); w3 = *(const f32x4*)(wp_ + 48); } while (0)
        __syncthreads();
        if (act) CS_LOAD(0);
        __syncthreads();
#pragma unroll 1
        for (int ch = 0; ch < NCHUNK; ++ch) {
            if (act) {
                const int m0 = b * SEQ + ch * CH;
                const bf16x8 cn0 = n0, cn1 = n1, cr0 = r0, cr1 = r1, cb0 = bk0, cb1 = bk1, cb2 = bk2, cb3 = bk3, cgr = gr; const u32x2 cgnk = gnk, ctt = tt;
                const unsigned vlo = (unsigned)v0 | ((unsigned)v1 << 16), vhi = (unsigned)v2 | ((unsigned)v3 << 16); const f32x4 cw0 = w0, cw1 = w1, cw2 = w2, cw3 = w3;
                if (ch + 1 < NCHUNK) CS_LOAD(ch + 1);
                const f32x4 z = {0.f, 0.f, 0.f, 0.f};
                const bf16x8 bS0 = mk8(cvtpk(St[0][0], St[0][1]), cvtpk(St[0][2], St[0][3]), cvtpk(St[1][0], St[1][1]), cvtpk(St[1][2], St[1][3]));
                const bf16x8 bS1 = mk8(cvtpk(St[2][0], St[2][1]), cvtpk(St[2][2], St[2][3]), cvtpk(St[3][0], St[3][1]), cvtpk(St[3][2], St[3][3]));
                f32x4 X = __builtin_amdgcn_mfma_f32_16x16x32_bf16(cn0, bS0, z, 0, 0, 0);
                X = __builtin_amdgcn_mfma_f32_16x16x32_bf16(cn1, bS1, X, 0, 0, 0);
                X = __builtin_amdgcn_mfma_f32_16x16x32_bf16(mk8(cgnk.x, cgnk.y, 0u, 0u), mk8(vlo, vhi, 0u, 0u), X, 0, 0, 0);
                const f32x4 U = __builtin_amdgcn_mfma_f32_16x16x32_bf16(mk8(ctt.x, ctt.y, 0u, 0u), mk8(cvtpk(X[0], X[1]), cvtpk(X[2], X[3]), 0u, 0u), z, 0, 0, 0);
                const bf16x8 bUV = mk8(cvtpk(U[0], U[1]), cvtpk(U[2], U[3]), vlo, vhi);
                f32x4 Yt = __builtin_amdgcn_mfma_f32_16x16x32_bf16(cr0, bS0, z, 0, 0, 0);
                Yt = __builtin_amdgcn_mfma_f32_16x16x32_bf16(cr1, bS1, Yt, 0, 0, 0);
                Yt = __builtin_amdgcn_mfma_f32_16x16x32_bf16(cgr, bUV, Yt, 0, 0, 0);
                St[0] = __builtin_amdgcn_mfma_f32_16x16x32_bf16(cb0, bUV, St[0] * cw0, 0, 0, 0);
                St[1] = __builtin_amdgcn_mfma_f32_16x16x32_bf16(cb1, bUV, St[1] * cw1, 0, 0, 0);
                St[2] = __builtin_amdgcn_mfma_f32_16x16x32_bf16(cb2, bUV, St[2] * cw2, 0, 0, 0);
                St[3] = __builtin_amdgcn_mfma_f32_16x16x32_bf16(cb3, bUV, St[3] * cw3, 0, 0, 0);
                bf16_t* yp = Y + (size_t)(m0 + 4 * q) * DM + h * 64 + 16 * rt + c;
#pragma unroll
                for (int rg = 0; rg < 4; ++rg) {
                    yp[(size_t)rg * DM] = (bf16_t)f2bf(Yt[rg]);
                    const float s1 = row16_allsum(Yt[rg]), s2 = row16_allsum(Yt[rg] * Yt[rg]);
                    if (c == 0) *(f32x2*)(part + (((ch & 1) * 4 + rt) * 16 + 4 * q + rg) * 2) = (f32x2){s1, s2};
                }
            }
            __syncthreads();
            if (wave == 0 && lane < 16) {
                const float* pp = part + ((ch & 1) * 4 * 16 + lane) * 2; float s1 = 0.f, s2 = 0.f;
#pragma unroll
                for (int w = 0; w < 4; ++w) { s1 += pp[w * 32]; s2 += pp[w * 32 + 1]; }
                *(f32x4*)(ST + ((size_t)(b * SEQ + ch * CH + lane) * 16 + h) * 4) = (f32x4){s1, s2, 0.f, 0.f};
            }
        }
#undef CS_LOAD
    }
}

__device__ __forceinline__ void p18_final(const Args& A) {
    const int tid = opaque_tid(), lane = tid & 63, wave = tid >> 6;
    const int gw = blockIdx.x * NWAVES + wave, NGW = gridDim.x * NWAVES;
    const f32x4* gr = (const f32x4*)A.in[IN_FINN] + lane;
    for (int m = gw; m < MTOK; m += NGW) {
        f32x4* xr = (f32x4*)(A.out + (size_t)m * DM) + lane; f32x4 v[4]; float s = 0.f;
#pragma unroll
        for (int j = 0; j < 4; ++j) { v[j] = xr[64 * j]; s += (v[j].x * v[j].x + v[j].y * v[j].y) + (v[j].z * v[j].z + v[j].w * v[j].w); }
        const float rs = rsqrtf(wave_sum(s) * (1.f / DM) + NORM_EPS);
#pragma unroll
        for (int j = 0; j < 4; ++j) xr[64 * j] = v[j] * rs * gr[64 * j];
    }
}

typedef GAS unsigned gu32;
#define RLX_AGENT __ATOMIC_RELAXED, __HIP_MEMORY_SCOPE_AGENT
constexpr int CW_BAR = 4096;
constexpr int RING_BYTES = 131072, LDSCTL_OFF = RING_BYTES, MISC_OFF = LDSCTL_OFF + 320;
#define XB_TMO      128
#define XB_XCNT(j)  (256  + 64 * (j))
#define XB_XSUB(j)  (1280 + 64 * (j))
#define XB_XGEN(j)  (2304 + 64 * (j))
#define XB_TOP      3328
#define XB_TOPGEN   3392
#define XCD_BAR_WORDS 3456
#define XB_SPIN_CAP (1u << 18)

__device__ __forceinline__ unsigned xb_ld(unsigned* p)              { return __hip_atomic_load(p, __ATOMIC_RELAXED, __HIP_MEMORY_SCOPE_AGENT); }
__device__ __forceinline__ unsigned xb_add(unsigned* p, unsigned v) { return __hip_atomic_fetch_add(p, v, __ATOMIC_RELAXED, __HIP_MEMORY_SCOPE_AGENT); }
__device__ __forceinline__ unsigned xb_xcc_id() { return (unsigned)__builtin_amdgcn_s_getreg((3 << 11) | 20) & 0xFu; }
#define XB_SPIN(cond, bar) do { unsigned _sp = 0; while (cond) { __builtin_amdgcn_s_sleep(1); \
    if ((++_sp & 255u) == 0u) { if (xb_ld(&(bar)[XB_TMO])) break; if (_sp > XB_SPIN_CAP) { atomicAdd(&(bar)[XB_TMO], 1u); break; } } } } while (0)

struct XcdBarrier {
    unsigned* bar; unsigned x;
    volatile LAS unsigned* st;
};

__device__ __forceinline__ XcdBarrier xcd_barrier_post(unsigned* bar, volatile LAS unsigned* st) {
    XcdBarrier b; b.bar = bar; b.x = xb_xcc_id(); b.st = st;
    if (threadIdx.x == 0) (void)xb_add(&bar[XB_XCNT(b.x)], 1u);
    return b;
}
__device__ __forceinline__ void xcd_barrier_complete(unsigned* bar, unsigned x, unsigned& nloc, unsigned& nx) {
    const unsigned G = gridDim.x * gridDim.y * gridDim.z;
    unsigned sum, cnt, mine, sp = 0u;
    for (;;) {
        sum = 0u; cnt = 0u; mine = 0u;
#pragma unroll
        for (unsigned j = 0; j < 16; ++j) { const unsigned c = xb_ld(&bar[XB_XCNT(j)]); sum += c; cnt += (c > 0u) ? 1u : 0u; mine = (j == x) ? c : mine; }
        if (sum == G) break;
        __builtin_amdgcn_s_sleep(1);
        if ((++sp & 255u) == 0u) { if (xb_ld(&bar[XB_TMO])) break; if (sp > XB_SPIN_CAP) { atomicAdd(&bar[XB_TMO], 1u); break; } }
    }
    nloc = mine > 0u ? mine : 1u; nx = cnt > 0u ? cnt : 1u;
}

__device__ __forceinline__ void xcd_barrier(const XcdBarrier& b) {
    asm volatile("s_waitcnt vmcnt(0)" ::: "memory");
    __syncthreads();
    if (threadIdx.x == 0) {
        unsigned* bar = b.bar;
        __builtin_amdgcn_s_waitcnt(0);
        unsigned nloc = b.st[0], nx = b.st[1];
        if (nloc == 0u) { xcd_barrier_complete(bar, b.x, nloc, nx); b.st[0] = nloc; b.st[1] = nx; }
        const unsigned old = xb_add(&bar[XB_XSUB(b.x)], 1u);
        const unsigned gen = old / nloc;
        if (old + 1u == (gen + 1u) * nloc) {
            __builtin_amdgcn_fence(__ATOMIC_RELEASE, "agent");
            asm volatile("s_waitcnt vmcnt(0)" ::: "memory");
            const unsigned og = xb_add(&bar[XB_TOP], 1u);
            const unsigned tg = og / nx;
            if (og + 1u == (tg + 1u) * nx) xb_add(&bar[XB_TOPGEN], 1u);
            else XB_SPIN(xb_ld(&bar[XB_TOPGEN]) == tg, bar);
            __builtin_amdgcn_fence(__ATOMIC_ACQUIRE, "agent");
            xb_add(&bar[XB_XGEN(b.x)], 1u);
            asm volatile("s_waitcnt vmcnt(0)" ::: "memory");
        } else {
            XB_SPIN(xb_ld(&bar[XB_XGEN(b.x)]) == gen, bar);
            __builtin_amdgcn_fence(__ATOMIC_ACQUIRE, "agent");
            asm volatile("s_waitcnt vmcnt(0)" ::: "memory");
        }
    }
    __syncthreads();
}

constexpr int N_PHASES = 19;
template <int LO, int HI> __global__ void __launch_bounds__(NTHR, 2) mk_fwd(Args A) {
    extern __shared__ __attribute__((aligned(16))) unsigned char lds[];
#define IN(k) (LO <= (k) && (k) < HI)
    constexpr bool FUSED = (HI - LO) > 1;
    XcdBarrier bar; bar.bar = nullptr; bar.x = 0; bar.st = nullptr;
    if constexpr (FUSED) {
        for (int u = threadIdx.x; u < (LDS_BYTES - LDSCTL_OFF) / 4; u += NTHR) ((LAS unsigned*)((LAS unsigned char*)lds + LDSCTL_OFF))[u] = 0u;
        __syncthreads();
        bar = xcd_barrier_post(WSP(unsigned, OFF_CTL) + CW_BAR, (volatile LAS unsigned*)((LAS unsigned char*)lds + MISC_OFF) + 8);
    }
#define SEAM(k) do { if constexpr (FUSED && IN(k) && IN((k) + 1)) { if ((k) == 0) cg::this_grid().sync(); else xcd_barrier(bar); } } while (0)
    if constexpr (IN(0)) p0_prologue(A, lds);
    if constexpr (FUSED && IN(0) && ((REP_MASK >> 0) & 1u)) xcd_barrier(bar);
    if constexpr (FUSED && IN(0) && ((REP_MASK >> 0) & 1u)) p0_prologue(A, lds);
    SEAM(0);
    if constexpr (IN(1)) {
        Gemm g{WSP(bf16_t, OFF_H0), WSP(bf16_t, OFF_H0), 1 << 30, WSP(bf16_t, OFF_WIN), MTOK, 2304, DM};
        EpiInProj E{WSP(bf16_t, OFF_QO), WSP(bf16_t, OFF_K), WSP(bf16_t, OFF_V), WSP(bf16_t, OFF_QI), WSP(bf16_t, OFF_KI), WSP(float, OFF_WI), WSP(float, OFF_ROPE)};
        gemm_phase(lds, g, E);
    }
    SEAM(1);
    if constexpr (IN(2)) { if (FAST_TOPK) p2_fast(A, lds); else p2_naive(A, lds);
#if DBG_TOPK
        __syncthreads(); p2_naive(A, lds, 160 * MiB);
#endif
    }
    if constexpr (FUSED && IN(2) && ((REP_MASK >> 2) & 1u)) xcd_barrier(bar);
    if constexpr (FUSED && IN(2) && ((REP_MASK >> 2) & 1u)) { if (FAST_TOPK) p2_fast(A, lds); else p2_naive(A, lds);
#if DBG_TOPK
        __syncthreads(); p2_naive(A, lds, 160 * MiB);
#endif
    }
    SEAM(2);
    if constexpr (IN(3)) {
#if DBG_TOPK
        {
            const int lane_ = threadIdx.x & 63, gw_ = blockIdx.x * NWAVES + (threadIdx.x >> 6);
            const unsigned* M1 = WSP(unsigned, OFF_MASK); const unsigned* M2 = WSP(unsigned, 160 * MiB); unsigned rows_ = 0, bits_ = 0, bad1_ = 0, bad2_ = 0;
            for (int m = gw_; m < MTOK; m += gridDim.x * NWAVES) { const unsigned d = M1[(size_t)m * 64 + lane_] ^ M2[(size_t)m * 64 + lane_]; const int nb = wave_allsum_i(__popc(d)); if (nb) { rows_ += 1; bits_ += nb; }
                const int t_ = m & (SEQ - 1), ex_ = t_ + 1 < 256 ? t_ + 1 : 256; if (wave_allsum_i(__popc(M1[(size_t)m * 64 + lane_])) != ex_) bad1_ += 1; if (wave_allsum_i(__popc(M2[(size_t)m * 64 + lane_])) != ex_) bad2_ += 1; }
            if (lane_ == 0) { atomicAdd(WSP(unsigned, OFF_CTL) + 1000, rows_); atomicAdd(WSP(unsigned, OFF_CTL) + 1001, bits_); atomicAdd(WSP(unsigned, OFF_CTL) + 1002, bad1_); atomicAdd(WSP(unsigned, OFF_CTL) + 1003, bad2_); }
        }
#endif
        if (FAST_ATTN) {
            static_assert(attn_body::ATTN_LDS_BYTES <= RING_BYTES, "attention LDS");
            const attn_body::AttnTensors AT{(const attn_body::bf16*)WSP(bf16_t, OFF_QO), (const attn_body::bf16*)WSP(bf16_t, OFF_K), (const attn_body::bf16*)WSP(bf16_t, OFF_V), (attn_body::bf16*)WSP(bf16_t, OFF_QO), WSP(unsigned, OFF_MASK)};
            const attn_body::StaticOrder S((int)gridDim.x, (int)blockIdx.x);
            attn_body::attn_phase<attn_body::StaticOrder>((char*)lds, AT, S);
        } else p3_naive(A, lds);
    }
    if constexpr (FUSED && REP_123 && IN(3)) xcd_barrier(bar);
    if constexpr (FUSED && REP_123 && IN(3)) {
        Gemm g{WSP(bf16_t, OFF_H0), WSP(bf16_t, OFF_H0), 1 << 30, WSP(bf16_t, OFF_WIN), MTOK, 2304, DM};
        EpiInProj E{WSP(bf16_t, OFF_QO), WSP(bf16_t, OFF_K), WSP(bf16_t, OFF_V), WSP(bf16_t, OFF_QI), WSP(bf16_t, OFF_KI), WSP(float, OFF_WI), WSP(float, OFF_ROPE)};
        gemm_phase(lds, g, E);
    }
    if constexpr (FUSED && REP_123 && IN(3)) xcd_barrier(bar);
    if constexpr (FUSED && REP_123 && IN(3)) { if (FAST_TOPK) p2_fast(A, lds); else p2_naive(A, lds);
#if DBG_TOPK
        __syncthreads(); p2_naive(A, lds, 160 * MiB);
#endif
    }
    if constexpr (FUSED && REP_123 && IN(3)) xcd_barrier(bar);
    if constexpr (FUSED && REP_123 && IN(3)) {
#if DBG_TOPK
        {
            const int lane_ = threadIdx.x & 63, gw_ = blockIdx.x * NWAVES + (threadIdx.x >> 6);
            const unsigned* M1 = WSP(unsigned, OFF_MASK); const unsigned* M2 = WSP(unsigned, 160 * MiB); unsigned rows_ = 0, bits_ = 0, bad1_ = 0, bad2_ = 0;
            for (int m = gw_; m < MTOK; m += gridDim.x * NWAVES) { const unsigned d = M1[(size_t)m * 64 + lane_] ^ M2[(size_t)m * 64 + lane_]; const int nb = wave_allsum_i(__popc(d)); if (nb) { rows_ += 1; bits_ += nb; }
                const int t_ = m & (SEQ - 1), ex_ = t_ + 1 < 256 ? t_ + 1 : 256; if (wave_allsum_i(__popc(M1[(size_t)m * 64 + lane_])) != ex_) bad1_ += 1; if (wave_allsum_i(__popc(M2[(size_t)m * 64 + lane_])) != ex_) bad2_ += 1; }
            if (lane_ == 0) { atomicAdd(WSP(unsigned, OFF_CTL) + 1000, rows_); atomicAdd(WSP(unsigned, OFF_CTL) + 1001, bits_); atomicAdd(WSP(unsigned, OFF_CTL) + 1002, bad1_); atomicAdd(WSP(unsigned, OFF_CTL) + 1003, bad2_); }
        }
#endif
        if (FAST_ATTN) {
            static_assert(attn_body::ATTN_LDS_BYTES <= RING_BYTES, "attention LDS");
            const attn_body::AttnTensors AT{(const attn_body::bf16*)WSP(bf16_t, OFF_QO), (const attn_body::bf16*)WSP(bf16_t, OFF_K), (const attn_body::bf16*)WSP(bf16_t, OFF_V), (attn_body::bf16*)WSP(bf16_t, OFF_QO), WSP(unsigned, OFF_MASK)};
            const attn_body::StaticOrder S((int)gridDim.x, (int)blockIdx.x);
            attn_body::attn_phase<attn_body::StaticOrder>((char*)lds, AT, S);
        } else p3_naive(A, lds);
    }
    SEAM(3);
    if constexpr (IN(4)) {
        Gemm g{WSP(bf16_t, OFF_QO), WSP(bf16_t, OFF_QO), 1 << 30, WSP(bf16_t, OFF_WO0), MTOK, DM, DM};
        EpiResid E{A.in[IN_X], A.out, WSP(bf16_t, OFF_XB), WSP(float, OFF_SSQ0)};
        gemm_phase(lds, g, E);
    }
    SEAM(4);
    if constexpr (IN(5)) {
        Gemm g{WSP(bf16_t, OFF_XB), WSP(bf16_t, OFF_XB), 1 << 30, WSP(bf16_t, OFF_WUP0), MTOK, FF, DM};
        EpiUp E{WSP(bf16_t, OFF_U), WSP(float, OFF_SSQ0)};
        gemm_phase(lds, g, E);
    }
    if constexpr (FUSED && IN(5) && ((REP_MASK >> 5) & 1u)) xcd_barrier(bar);
    if constexpr (FUSED && IN(5) && ((REP_MASK >> 5) & 1u)) {
        Gemm g{WSP(bf16_t, OFF_XB), WSP(bf16_t, OFF_XB), 1 << 30, WSP(bf16_t, OFF_WUP0), MTOK, FF, DM};
        EpiUp E{WSP(bf16_t, OFF_U), WSP(float, OFF_SSQ0)};
        gemm_phase(lds, g, E);
    }
    SEAM(5);
    if constexpr (IN(6)) {
        Gemm g{WSP(bf16_t, OFF_U), WSP(bf16_t, OFF_U), 1 << 30, WSP(bf16_t, OFF_WDN0), MTOK, DM, FF};
        EpiResid E{A.out, A.out, nullptr, nullptr};
        gemm_phase(lds, g, E);
    }
    SEAM(6);
    if constexpr (IN(7)) p7_prep(A);
    if constexpr (FUSED && IN(7) && ((REP_MASK >> 7) & 1u)) xcd_barrier(bar);
    if constexpr (FUSED && IN(7) && ((REP_MASK >> 7) & 1u)) p7_prep(A);
    SEAM(7);
    if constexpr (IN(8)) {
        Gemm g{WSP(bf16_t, OFF_XSR), WSP(bf16_t, OFF_XSK), 4, WSP(bf16_t, OFF_WRK), MTOK, 2048, DM};
        EpiStore E{WSP(bf16_t, OFF_R), DM, 4, WSP(bf16_t, OFF_KR), DM};
        gemm_phase(lds, g, E);
    }
    if constexpr (FUSED && IN(8) && ((REP_MASK >> 8) & 1u)) xcd_barrier(bar);
    if constexpr (FUSED && IN(8) && ((REP_MASK >> 8) & 1u)) {
        Gemm g{WSP(bf16_t, OFF_XSR), WSP(bf16_t, OFF_XSK), 4, WSP(bf16_t, OFF_WRK), MTOK, 2048, DM};
        EpiStore E{WSP(bf16_t, OFF_R), DM, 4, WSP(bf16_t, OFF_KR), DM};
        gemm_phase(lds, g, E);
    }
    SEAM(8);
    if constexpr (IN(9)) {
        Gemm g{WSP(bf16_t, OFF_XSV), WSP(bf16_t, OFF_H1), 4, WSP(bf16_t, OFF_WVL), MTOK, 1792, DM};
        EpiStore E{WSP(bf16_t, OFF_VV), DM, 4, WSP(bf16_t, OFF_P), 768};
        gemm_phase(lds, g, E);
    }
    if constexpr (FUSED && IN(9) && ((REP_MASK >> 9) & 1u)) xcd_barrier(bar);
    if constexpr (FUSED && IN(9) && ((REP_MASK >> 9) & 1u)) {
        Gemm g{WSP(bf16_t, OFF_XSV), WSP(bf16_t, OFF_H1), 4, WSP(bf16_t, OFF_WVL), MTOK, 1792, DM};
        EpiStore E{WSP(bf16_t, OFF_VV), DM, 4, WSP(bf16_t, OFF_P), 768};
        gemm_phase(lds, g, E);
    }
    SEAM(9);
    if constexpr (IN(10)) p10_loramid(A);
    if constexpr (FUSED && IN(10) && ((REP_MASK >> 10) & 1u)) xcd_barrier(bar);
    if constexpr (FUSED && IN(10) && ((REP_MASK >> 10) & 1u)) p10_loramid(A);
    SEAM(10);
    if constexpr (IN(11)) {
        Gemm g{WSP(bf16_t, OFF_AW), WSP(bf16_t, OFF_AA), 4, WSP(bf16_t, OFF_W2T), MTOK, 2048, 128};
        EpiLoraUp E{WSP(bf16_t, OFF_E), WSP(bf16_t, OFF_A), A.in[IN_W0], A.in[IN_A0]};
        gemm_phase(lds, g, E);
    }
    if constexpr (FUSED && IN(11) && ((REP_MASK >> 11) & 1u)) xcd_barrier(bar);
    if constexpr (FUSED && IN(11) && ((REP_MASK >> 11) & 1u)) {
        Gemm g{WSP(bf16_t, OFF_AW), WSP(bf16_t, OFF_AA), 4, WSP(bf16_t, OFF_W2T), MTOK, 2048, 128};
        EpiLoraUp E{WSP(bf16_t, OFF_E), WSP(bf16_t, OFF_A), A.in[IN_W0], A.in[IN_A0]};
        gemm_phase(lds, g, E);
    }
    SEAM(11);
    if constexpr (IN(12)) { if (CHUNK_SCAN) p12_chunk_prep(A, lds); else if (FAST_SCAN) p12_fast(A, lds); else p12_naive(A, lds); }
    if constexpr (FUSED && IN(12) && ((REP_MASK >> 12) & 1u)) xcd_barrier(bar);
    if constexpr (FUSED && IN(12) && ((REP_MASK >> 12) & 1u)) { if (FAST_SCAN) p12_fast(A, lds); else p12_naive(A, lds); }
    SEAM(12);
    if constexpr (IN(13)) { if (CHUNK_SCAN) p13_chunk_scan(A, lds); else if (!FAST_SCAN) p12b_stats(A); }
    SEAM(13);
    if constexpr (IN(14)) {
        Gemm g{WSP(bf16_t, OFF_AG), WSP(bf16_t, OFF_AG), 1 << 30, WSP(bf16_t, OFF_G2T), MTOK, DM, 256};
        EpiGatePost E{WSP(bf16_t, OFF_AO), WSP(bf16_t, CHUNK_SCAN ? OFF_R : OFF_Y), WSP(bf16_t, OFF_VV), WSP(float, OFF_STATS), WSP(float, OFF_BONUS), A.in[IN_LNW], A.in[IN_LNB]};
        gemm_phase(lds, g, E);
    }
    if constexpr (FUSED && IN(14) && ((REP_MASK >> 14) & 1u)) xcd_barrier(bar);
    if constexpr (FUSED && IN(14) && ((REP_MASK >> 14) & 1u)) {
        Gemm g{WSP(bf16_t, OFF_AG), WSP(bf16_t, OFF_AG), 1 << 30, WSP(bf16_t, OFF_G2T), MTOK, DM, 256};
        EpiGatePost E{WSP(bf16_t, OFF_AO), WSP(bf16_t, CHUNK_SCAN ? OFF_R : OFF_Y), WSP(bf16_t, OFF_VV), WSP(float, OFF_STATS), WSP(float, OFF_BONUS), A.in[IN_LNW], A.in[IN_LNB]};
        gemm_phase(lds, g, E);
    }
    SEAM(14);
    if constexpr (IN(15)) {
        Gemm g{WSP(bf16_t, OFF_AO), WSP(bf16_t, OFF_AO), 1 << 30, WSP(bf16_t, OFF_WO1), MTOK, DM, DM};
        EpiResid E{A.out, A.out, WSP(bf16_t, OFF_XB), WSP(float, OFF_SSQ1)};
        gemm_phase(lds, g, E);
    }
    SEAM(15);
    if constexpr (IN(16)) {
        Gemm g{WSP(bf16_t, OFF_XB), WSP(bf16_t, OFF_XB), 1 << 30, WSP(bf16_t, OFF_WUP1), MTOK, FF, DM};
        EpiUp E{WSP(bf16_t, OFF_U), WSP(float, OFF_SSQ1)};
        gemm_phase(lds, g, E);
    }
    if constexpr (FUSED && IN(16) && ((REP_MASK >> 16) & 1u)) xcd_barrier(bar);
    if constexpr (FUSED && IN(16) && ((REP_MASK >> 16) & 1u)) {
        Gemm g{WSP(bf16_t, OFF_XB), WSP(bf16_t, OFF_XB), 1 << 30, WSP(bf16_t, OFF_WUP1), MTOK, FF, DM};
        EpiUp E{WSP(bf16_t, OFF_U), WSP(float, OFF_SSQ1)};
        gemm_phase(lds, g, E);
    }
    SEAM(16);
    if constexpr (IN(17)) {
        Gemm g{WSP(bf16_t, OFF_U), WSP(bf16_t, OFF_U), 1 << 30, WSP(bf16_t, OFF_WDN1), MTOK, DM, FF};
        EpiResid E{A.out, A.out, nullptr, nullptr};
        gemm_phase(lds, g, E);
    }
    SEAM(17);
    if constexpr (IN(18)) {
        p18_final(A);
#if DBG_TOPK
        {   __syncthreads(); const float sc_ = 1.f + (float)WSP(unsigned, OFF_CTL)[1000 + DBG_WHICH] * DBG_UNIT;
            const int gw_ = blockIdx.x * NWAVES + (threadIdx.x >> 6), lane_ = threadIdx.x & 63;
            for (int m = gw_; m < MTOK; m += gridDim.x * NWAVES) for (int j = 0; j < 16; ++j) A.out[(size_t)m * DM + lane_ + 64 * j] *= sc_; }
#endif
    }
#undef IN
#undef SEAM
}

template <int P> static void launch_all(int grid, hipStream_t stream, const Args& a) {
    if constexpr (P < N_PHASES) {
        static bool attr_done = false;
        if (!attr_done) { (void)hipFuncSetAttribute((const void*)mk_fwd<P, P + 1>, hipFuncAttributeMaxDynamicSharedMemorySize, LDS_BYTES); attr_done = true; }
        hipLaunchKernelGGL((mk_fwd<P, P + 1>), dim3(grid), dim3(NTHR), LDS_BYTES, stream, a);
        launch_all<P + 1>(grid, stream, a);
    }
}
extern "C" void kernel_launch(void* const* d_in, const int* in_sizes, int n_in, void* d_out, int out_size, void* d_ws, size_t ws_size, hipStream_t stream) {
    static int grid = 0;
    if (grid == 0) {
        if (n_in != N_IN || out_size != MTOK * DM || ws_size < WS_END) { fprintf(stderr, "kernel_launch: unexpected shapes (n_in %d out %d ws %zu)\n", n_in, out_size, ws_size); grid = -1; return; }
        int dev = 0, cus = 0;
        (void)hipGetDevice(&dev); (void)hipDeviceGetAttribute(&cus, hipDeviceAttributeMultiprocessorCount, dev);
        grid = cus > 0 ? cus : 256;
    }
    if (grid < 0) return;
    (void)hipMemsetAsync((char*)d_ws + OFF_CTL, 0, CTL_BYTES, stream);
    Args a{};
    for (int i = 0; i < N_IN; ++i) a.in[i] = (const float*)d_in[i];
    a.out = (float*)d_out; a.ws = (unsigned char*)d_ws;
#if ONE_LAUNCH
    static bool attr_done = false;
    if (!attr_done) {
        (void)hipFuncSetAttribute((const void*)mk_fwd<0, N_PHASES>, hipFuncAttributeMaxDynamicSharedMemorySize, LDS_BYTES);
        int per_cu = 0;
        if (hipOccupancyMaxActiveBlocksPerMultiprocessor(&per_cu, (const void*)mk_fwd<0, N_PHASES>, NTHR, LDS_BYTES) != hipSuccess || per_cu < 1)
            fprintf(stderr, "kernel_launch: occupancy query reports %d blocks per CU\n", per_cu);
        (void)hipGetLastError();
        attr_done = true;
    }
    void* kargs[] = {(void*)&a};
    hipError_t e = hipLaunchCooperativeKernel((const void*)mk_fwd<0, N_PHASES>, dim3(grid), dim3(NTHR), kargs, LDS_BYTES, stream);
    if (e != hipSuccess) fprintf(stderr, "kernel_launch: cooperative launch failed: %s (grid %d)\n", hipGetErrorString(e), grid);
#else
    launch_all<0>(grid, stream, a);
#endif
}
```

```cpp
#include <hip/hip_runtime.h>
#include <hip/hip_cooperative_groups.h>
#include <hip/hip_bf16.h>
#include <cmath>
#include <cstdio>
#include <cstdint>
namespace cg = cooperative_groups;

#ifndef ONE_LAUNCH
#define ONE_LAUNCH 1
#endif
#ifndef DBG_TOPK
#define DBG_TOPK 0
#define DBG_WHICH 2
#define DBG_UNIT 0.001f
#endif
#ifndef REP_MASK
#define REP_MASK 0u
#endif
#ifndef REP_123
#define REP_123 0
#endif
#ifndef DBG_TS
#define DBG_TS 0
#define DBG_TS_A 12
#define DBG_TS_B 13
#endif
#ifndef PROBE_P2
#define PROBE_P2 0
#endif
#ifndef DEFER_W
#define DEFER_W 1
#endif
#ifndef CHUNK_SCAN
#define CHUNK_SCAN 1
#endif
#ifndef FAST_ATTN
#define FAST_ATTN 1
#endif
#ifndef FAST_TOPK
#define FAST_TOPK 1
#endif
#ifndef FAST_SCAN
#define FAST_SCAN 1
#endif
#ifndef FAST_GEMM
#define FAST_GEMM 1
#endif

#define LAS __attribute__((address_space(3)))
#define GAS __attribute__((address_space(1)))
typedef unsigned short bf16_t;
typedef short bf16x8 __attribute__((ext_vector_type(8)));
typedef float f32x4 __attribute__((ext_vector_type(4)));
typedef float f32x2 __attribute__((ext_vector_type(2)));
typedef unsigned u32x4 __attribute__((ext_vector_type(4)));
typedef unsigned u32x2 __attribute__((ext_vector_type(2)));

constexpr int BATCH = 8, SEQ = 2048, DM = 1024, MTOK = BATCH * SEQ, FF = 4096;
constexpr int NWAVES = 8, NTHR = 512;
constexpr int LDS_BYTES = 147456;
constexpr float NORM_EPS = 1e-6f, LNX_EPS = 64e-5f;
constexpr float QSCALE = 0.125f * 1.4426950408889634f;
constexpr float WI_SCALE = 0.044194173824159216f;

enum { IN_X = 0, IN_MIXN, IN_MLPN, IN_WUP, IN_WDN, IN_FINN, IN_WIN, IN_WO, IN_MU, IN_WRKV, IN_W0, IN_W1, IN_W2, IN_A0, IN_A1, IN_A2,
       IN_G1, IN_G2, IN_KK, IN_KA, IN_RK, IN_LNW, IN_LNB, IN_WO1, N_IN };

constexpr size_t MiB = 1u << 20;
constexpr size_t OFF_CTL = 0, CTL_BYTES = 1 * MiB;
constexpr size_t OFF_SSQ0 = 256 * 1024, OFF_SSQ1 = 320 * 1024;
constexpr size_t OFF_ROPE = 1 * MiB;
constexpr size_t OFF_WIN = 2 * MiB, OFF_WO0 = 7 * MiB, OFF_WUP0 = 9 * MiB, OFF_WDN0 = 17 * MiB, OFF_WRK = 25 * MiB, OFF_WVL = 29 * MiB;
constexpr size_t OFF_W2T = 33 * MiB, OFF_A2T = 33 * MiB + 256 * 1024, OFF_G2T = 33 * MiB + 512 * 1024, OFF_WO1 = 34 * MiB, OFF_WUP1 = 36 * MiB, OFF_WDN1 = 44 * MiB;
constexpr size_t OFF_BONUS = 2 * MiB;
constexpr size_t OFF_H0 = 52 * MiB, OFF_QO = 84 * MiB, OFF_K = 116 * MiB, OFF_V = 124 * MiB, OFF_QI = 132 * MiB, OFF_KI = 148 * MiB, OFF_WI = 150 * MiB, OFF_MASK = 152 * MiB;
constexpr size_t OFF_XB = 52 * MiB, OFF_U = 84 * MiB;
constexpr size_t OFF_XSR = 52 * MiB, OFF_XSK = 84 * MiB, OFF_XSV = 116 * MiB, OFF_H1 = 148 * MiB, OFF_R = 180 * MiB, OFF_KR = 212 * MiB;
constexpr size_t OFF_VV = 52 * MiB, OFF_P = 84 * MiB, OFF_AW = 108 * MiB, OFF_AA = 112 * MiB, OFF_AG = 244 * MiB;
constexpr size_t OFF_E = 116 * MiB, OFF_A = 148 * MiB, OFF_Y = 84 * MiB, OFF_STATS = 252 * MiB, OFF_AO = 116 * MiB;
constexpr size_t WS_END = 256 * MiB;

struct Args { const float* in[N_IN]; float* out; unsigned char* ws; int ph_lo, ph_hi; };
#define WSP(T, off) ((T*)(A.ws + (off)))

__device__ __forceinline__ float bf2f(bf16_t u) { return __uint_as_float((unsigned)u << 16); }
__device__ __forceinline__ unsigned f2bf(float f) { unsigned u = __float_as_uint(f); return (u + 0x7fffu + ((u >> 16) & 1u)) >> 16; }
__device__ __forceinline__ unsigned pk2(float lo, float hi) { return f2bf(lo) | (f2bf(hi) << 16); }
__device__ __forceinline__ float wave_sum(float v) {
#pragma unroll
    for (int o = 1; o < 64; o <<= 1) v += __shfl_xor(v, o);
    return v;
}
__device__ __forceinline__ float wave_max(float v) {
#pragma unroll
    for (int o = 1; o < 64; o <<= 1) v = fmaxf(v, __shfl_xor(v, o));
    return v;
}
#define LDS_WAIT() asm volatile("s_waitcnt lgkmcnt(0)" ::: "memory")
__device__ __forceinline__ int opaque_tid() { int t = threadIdx.x; asm volatile("" : "+v"(t)); return t; }
__device__ __forceinline__ float sigmoidf_(float z) { return __builtin_amdgcn_rcpf(1.f + __expf(-z)); }

__device__ __forceinline__ float block_sum(float v, float* red, int wave, int lane) {
    v = wave_sum(v); __syncthreads(); if (lane == 0) red[wave] = v; __syncthreads();
    float s = 0.f;
#pragma unroll
    for (int i = 0; i < NWAVES; ++i) s += red[i];
    return s;
}
__device__ __forceinline__ float block_max(float v, float* red, int wave, int lane) {
    v = wave_max(v); __syncthreads(); if (lane == 0) red[wave] = v; __syncthreads();
    float s = red[0];
#pragma unroll
    for (int i = 1; i < NWAVES; ++i) s = fmaxf(s, red[i]);
    return s;
}

template <int ID> __device__ __forceinline__ float wval(const Args& A, int n, int k) {
    if constexpr (ID == 0) {
        int col;
        if (n < 1280 || (n >= 1536 && n < 2112)) { const int hd = n >> 6, j = n & 63; col = (hd << 6) + (j >> 1) + ((j & 1) << 5); }
        else if (n < 2120) col = n; else return 0.f;
        return A.in[IN_WIN][(size_t)k * 2120 + col];
    } else if constexpr (ID == 1) { return A.in[IN_WO][(size_t)k * 1024 + n];
    } else if constexpr (ID == 2) { return A.in[IN_WUP][(size_t)k * 4096 + n] * A.in[IN_MLPN][k];
    } else if constexpr (ID == 3) { return A.in[IN_WDN][(size_t)k * 1024 + n];
    } else if constexpr (ID == 4) { return A.in[IN_WRKV][(size_t)(n >> 10) * 1048576 + (size_t)k * 1024 + (n & 1023)];
    } else if constexpr (ID == 5) {
        if (n < 1024) return A.in[IN_WRKV][(size_t)2 * 1048576 + (size_t)k * 1024 + n];
        const int j = n - 1024; const float* mu = A.in[IN_MU];
        if (j < 128) { const float m = mu[3 * 1024 + k], w = A.in[IN_W1][k * 64 + (j & 63)]; return (j < 64 ? 1.f - m : m) * w; }
        if (j < 256) { const float m = mu[4 * 1024 + k], w = A.in[IN_A1][k * 64 + (j & 63)]; return (j < 192 ? 1.f - m : m) * w; }
        if (j < 576) { const float m = mu[5 * 1024 + k]; const int jj = j - 256, c = jj < 160 ? jj : jj - 160; const float w = A.in[IN_G1][k * 160 + c]; return (jj < 160 ? 1.f - m : m) * w; }
        return 0.f;
    } else if constexpr (ID == 6) { return k < 64 ? A.in[IN_W2][(size_t)k * 1024 + n] : 0.f;
    } else if constexpr (ID == 7) { return k < 64 ? A.in[IN_A2][(size_t)k * 1024 + n] : 0.f;
    } else if constexpr (ID == 8) { return k < 160 ? A.in[IN_G2][(size_t)k * 1024 + n] : 0.f;
    } else if constexpr (ID == 9) { return A.in[IN_WO1][(size_t)k * 1024 + n];
    } else if constexpr (ID == 10) { return A.in[IN_WUP][(size_t)4194304 + (size_t)k * 4096 + n] * A.in[IN_MLPN][1024 + k];
    } else { return A.in[IN_WDN][(size_t)4194304 + (size_t)k * 1024 + n]; }
}
template <int ID> __device__ __forceinline__ void p0_weight(const Args& A, bf16_t* dst, int N, int K, float* scr, int gw, int NGW, int lane) {
    const int nblk = N / 32, nitems = (K / 64) * nblk;
    for (int it = gw; it < nitems; it += NGW) {
        const int kb = it / nblk, nb = it % nblk, k0 = 64 * kb, n0 = 32 * nb;
#pragma unroll 8
        for (int i = 0; i < 32; ++i) { const int kk = 2 * i + (lane >> 5); scr[kk * 33 + (lane & 31)] = wval<ID>(A, n0 + (lane & 31), k0 + kk); }
        LDS_WAIT();
        const int c = lane & 7;
#pragma unroll
        for (int j = 0; j < 4; ++j) { const int n = (lane >> 3) + 8 * j; const float* s = scr + (8 * c) * 33 + n;
            u32x4 o; o.x = pk2(s[0 * 33], s[1 * 33]); o.y = pk2(s[2 * 33], s[3 * 33]); o.z = pk2(s[4 * 33], s[5 * 33]); o.w = pk2(s[6 * 33], s[7 * 33]);
            *(u32x4*)(dst + (size_t)(n0 + n) * K + k0 + 8 * c) = o; }
        LDS_WAIT();
    }
}
__device__ __forceinline__ void rms_row_to_bf16(const float* xrow, const float* g, bf16_t* orow, int lane) {
    const f32x4* xr = (const f32x4*)xrow + lane; const f32x4* gr = (const f32x4*)g + lane;
    f32x4 v[4]; float s = 0.f;
#pragma unroll
    for (int j = 0; j < 4; ++j) { v[j] = xr[64 * j]; s += (v[j].x * v[j].x + v[j].y * v[j].y) + (v[j].z * v[j].z + v[j].w * v[j].w); }
    const float rs = rsqrtf(wave_sum(s) * (1.f / DM) + NORM_EPS);
    u32x2* o8 = (u32x2*)orow + lane;
#pragma unroll
    for (int j = 0; j < 4; ++j) { const f32x4 gg = gr[64 * j]; u32x2 w; w.x = pk2(v[j].x * rs * gg.x, v[j].y * rs * gg.y); w.y = pk2(v[j].z * rs * gg.z, v[j].w * rs * gg.w); o8[64 * j] = w; }
}
__device__ __forceinline__ void p0_prologue(const Args& A, unsigned char* lds) {
    const int tid = opaque_tid(), lane = tid & 63, wave = tid >> 6;
    float* scr = (float*)(lds + wave * 16384);
    const int gw = blockIdx.x * NWAVES + wave, NGW = gridDim.x * NWAVES;
    p0_weight<0>(A, WSP(bf16_t, OFF_WIN), 2304, 1024, scr, gw, NGW, lane);
    p0_weight<1>(A, WSP(bf16_t, OFF_WO0), 1024, 1024, scr, gw, NGW, lane);
    p0_weight<2>(A, WSP(bf16_t, OFF_WUP0), 4096, 1024, scr, gw, NGW, lane);
    p0_weight<3>(A, WSP(bf16_t, OFF_WDN0), 1024, 4096, scr, gw, NGW, lane);
    p0_weight<4>(A, WSP(bf16_t, OFF_WRK), 2048, 1024, scr, gw, NGW, lane);
    p0_weight<5>(A, WSP(bf16_t, OFF_WVL), 1792, 1024, scr, gw, NGW, lane);
    p0_weight<6>(A, WSP(bf16_t, OFF_W2T), 1024, 128, scr, gw, NGW, lane);
    p0_weight<7>(A, WSP(bf16_t, OFF_A2T), 1024, 128, scr, gw, NGW, lane);
    p0_weight<8>(A, WSP(bf16_t, OFF_G2T), 1024, 256, scr, gw, NGW, lane);
    if (!(DEFER_W && gridDim.x > BATCH * 16)) {
        p0_weight<9>(A, WSP(bf16_t, OFF_WO1), 1024, 1024, scr, gw, NGW, lane);
        p0_weight<10>(A, WSP(bf16_t, OFF_WUP1), 4096, 1024, scr, gw, NGW, lane);
        p0_weight<11>(A, WSP(bf16_t, OFF_WDN1), 1024, 4096, scr, gw, NGW, lane);
    }
    float* rc = WSP(float, OFF_ROPE); float* rsn = rc + 2048 * 32;
    for (int idx = blockIdx.x * NTHR + tid; idx < 2048 * 32; idx += gridDim.x * NTHR) {
        const int t = idx >> 5, d = idx & 31;
        double inv = 1.0; for (int i = 0; i < d; ++i) inv *= 0.74989420933245582730;
        const double ang = (double)t * inv;
        const double q = rint(ang * 0.63661977236758134308); const double r = (ang - q * 1.5707963267948966192) - q * 6.123233995736766036e-17;
        const double r2 = r * r;
        double sn = 1.0, cs = 1.0, ts = 1.0, tc = 1.0;
#pragma unroll
        for (int i = 1; i <= 9; ++i) { tc *= -r2 / (double)((2 * i - 1) * (2 * i)); ts *= -r2 / (double)((2 * i) * (2 * i + 1)); cs += tc; sn += ts; }
        sn *= r;
        const int qi = ((int)q) & 3;
        const double c = (qi == 0) ? cs : (qi == 1) ? -sn : (qi == 2) ? -cs : sn;
        const double s = (qi == 0) ? sn : (qi == 1) ? cs : (qi == 2) ? -sn : -cs;
        rc[idx] = (float)c; rsn[idx] = (float)s;
    }
    bf16_t* H0 = WSP(bf16_t, OFF_H0);
    for (int m = gw; m < MTOK; m += NGW) rms_row_to_bf16(A.in[IN_X] + (size_t)m * DM, A.in[IN_MIXN], H0 + (size_t)m * DM, lane);
}

struct Unit { int pm, pn; };
struct Gemm { const bf16_t* A; const bf16_t* A2; int pn2; const bf16_t* Bt; int M, N, K; };
constexpr int NXCD = 8, WGM = 8;
struct StaticOrder {
    int nM, nN, nwg, G, c;
    __device__ void init(int M, int N, int G_, int c_) { nM = M / 256; nN = N / 256; nwg = nM * nN; G = G_; c = c_; }
    __device__ bool next(int i, Unit& u) const {
        const long L = (long)i * G + c; if (L >= nwg) return false;
        int wgid = (int)L; { const int q = nwg / NXCD, r = nwg % NXCD, xcd = wgid % NXCD, off = wgid / NXCD; wgid = (xcd < r ? xcd * (q + 1) : r * (q + 1) + (xcd - r) * q) + off; }
        const int nig = WGM * nN, gid = wgid / nig, fm = gid * WGM, gsz = (nM - fm) < WGM ? (nM - fm) : WGM;
        u.pm = fm + ((wgid % nig) % gsz); u.pn = (wgid % nig) / gsz; return true;
    }
};
typedef f32x4 AccT[2][2][4][2];

template <class Epi> __device__ __forceinline__ void gemm_naive(const Gemm g, const Epi& E) {
    const int tid = opaque_tid(), wave = tid >> 6, lane = tid & 63, wr = wave >> 2, wc = wave & 3, fr = lane & 15, fq = lane >> 4;
    StaticOrder S; S.init(g.M, g.N, gridDim.x, blockIdx.x);
    Unit u;
    for (int i = 0; S.next(i, u); ++i) {
        AccT acc;
#pragma unroll
        for (int a = 0; a < 2; ++a)
#pragma unroll
            for (int b = 0; b < 2; ++b)
#pragma unroll
                for (int m = 0; m < 4; ++m)
#pragma unroll
                    for (int n = 0; n < 2; ++n) acc[a][b][m][n] = (f32x4){0.f, 0.f, 0.f, 0.f};
        const bf16_t* Ab = (u.pn >= g.pn2 ? g.A2 : g.A) + (size_t)(u.pm * 256 + wr * 64 + fr) * g.K;
        const bf16_t* Bb = g.Bt + (size_t)(u.pn * 256 + wc * 32) * g.K;
        for (int k0 = 0; k0 < g.K; k0 += 8) {
            bf16x8 af[2][4];
#pragma unroll
            for (int ai = 0; ai < 2; ++ai)
#pragma unroll
                for (int m = 0; m < 4; ++m) af[ai][m] = *(const bf16x8*)(Ab + (size_t)(ai * 128 + m * 16) * g.K + k0);
#pragma unroll
            for (int bj = 0; bj < 2; ++bj)
#pragma unroll
                for (int n = 0; n < 2; ++n)
#pragma unroll
                    for (int c = 0; c < 4; ++c) {
                        const int col = bj * 128 + (Epi::PERM ? 8 * fq + 4 * n + c : 16 * n + 4 * fq + c);
                        const bf16x8 b = *(const bf16x8*)(Bb + (size_t)col * g.K + k0);
                        float bf[8];
#pragma unroll
                        for (int e = 0; e < 8; ++e) bf[e] = bf2f((bf16_t)b[e]);
#pragma unroll
                        for (int ai = 0; ai < 2; ++ai)
#pragma unroll
                            for (int m = 0; m < 4; ++m) { float s = acc[ai][bj][m][n][c];
#pragma unroll
                                for (int e = 0; e < 8; ++e) s += bf2f((bf16_t)af[ai][m][e]) * bf[e];
                                acc[ai][bj][m][n][c] = s; }
                        asm volatile("" ::: "memory");
                    }
        }
        E(acc, u, wr, wc, fr, fq);
    }
}

struct EpiInProj {
    static constexpr bool PERM = true;
    bf16_t *Q, *K, *V, *QI, *KI; float* WI; const float* rope;
    __device__ __forceinline__ void operator()(const AccT& acc, const Unit& u, int wr, int wc, int fr, int fq) const {
        const int pn = u.pn;
#pragma unroll
        for (int ai = 0; ai < 2; ++ai)
#pragma unroll
            for (int m = 0; m < 4; ++m) {
                const int row = u.pm * 256 + ai * 128 + wr * 64 + m * 16 + fr, t = row & (SEQ - 1);
#pragma unroll
                for (int bj = 0; bj < 2; ++bj) {
                    const int cl = bj * 128 + wc * 32 + fq * 8;
                    f32x4 v0 = acc[ai][bj][m][0], v1 = acc[ai][bj][m][1];
                    const bool rot = (pn <= 4) || pn == 6 || pn == 7 || (pn == 8 && cl < 64);
                    if (rot) {
                        const int d0 = (cl & 63) >> 1;
                        const f32x4 c = *(const f32x4*)(rope + t * 32 + d0), s = *(const f32x4*)(rope + 2048 * 32 + t * 32 + d0);
                        f32x4 a0, a1;
                        a0.x = v0.x * c.x - v0.y * s.x; a0.y = v0.y * c.x + v0.x * s.x;
                        a0.z = v0.z * c.y - v0.w * s.y; a0.w = v0.w * c.y + v0.z * s.y;
                        a1.x = v1.x * c.z - v1.y * s.z; a1.y = v1.y * c.z + v1.x * s.z;
                        a1.z = v1.z * c.w - v1.w * s.w; a1.w = v1.w * c.w + v1.z * s.w;
                        v0 = a0; v1 = a1;
                    }
                    if (pn < 4) { v0 = v0 * QSCALE; v1 = v1 * QSCALE; }
                    u32x4 w; w.x = pk2(v0.x, v0.y); w.y = pk2(v0.z, v0.w); w.z = pk2(v1.x, v1.y); w.w = pk2(v1.z, v1.w);
                    if (pn < 4) *(u32x4*)(Q + (size_t)row * 1024 + pn * 256 + cl) = w;
                    else if (pn == 4) *(u32x4*)(K + (size_t)row * 256 + cl) = w;
                    else if (pn == 5) *(u32x4*)(V + (size_t)row * 256 + cl) = w;
                    else if (pn < 8) *(u32x4*)(QI + (size_t)row * 512 + (pn - 6) * 256 + cl) = w;
                    else { if (cl < 64) *(u32x4*)(KI + (size_t)row * 64 + cl) = w;
                           else if (cl == 64) { *(f32x4*)(WI + (size_t)row * 8) = v0 * WI_SCALE; *(f32x4*)(WI + (size_t)row * 8 + 4) = v1 * WI_SCALE; } }
                }
            }
    }
};
struct EpiResid {
    static constexpr bool PERM = false;
    const float* xin; float* xout; bf16_t* xb; float* ssq;
    __device__ __forceinline__ void operator()(const AccT& acc, const Unit& u, int wr, int wc, int fr, int fq) const {
#pragma unroll
        for (int ai = 0; ai < 2; ++ai)
#pragma unroll
            for (int m = 0; m < 4; ++m) {
                const int row = u.pm * 256 + ai * 128 + wr * 64 + m * 16 + fr; float s = 0.f;
#pragma unroll
                for (int bj = 0; bj < 2; ++bj)
#pragma unroll
                    for (int n = 0; n < 2; ++n) {
                        const size_t off = (size_t)row * DM + u.pn * 256 + bj * 128 + wc * 32 + n * 16 + fq * 4;
                        const f32x4 x = *(const f32x4*)(xin + off) + acc[ai][bj][m][n];
                        *(f32x4*)(xout + off) = x;
                        if (xb) { u32x2 w; w.x = pk2(x.x, x.y); w.y = pk2(x.z, x.w); *(u32x2*)(xb + off) = w; }
                        s += (x.x * x.x + x.y * x.y) + (x.z * x.z + x.w * x.w);
                    }
                if (ssq) { s += __shfl_xor(s, 16); s += __shfl_xor(s, 32); if (fq == 0) atomicAdd(ssq + row, s); }
            }
    }
};
struct EpiUp {
    static constexpr bool PERM = true;
    bf16_t* U; const float* ssq;
    __device__ __forceinline__ void operator()(const AccT& acc, const Unit& u, int wr, int wc, int fr, int fq) const {
#pragma unroll
        for (int ai = 0; ai < 2; ++ai)
#pragma unroll
            for (int m = 0; m < 4; ++m) {
                const int row = u.pm * 256 + ai * 128 + wr * 64 + m * 16 + fr;
                const float rs = rsqrtf(ssq[row] * (1.f / DM) + NORM_EPS);
#pragma unroll
                for (int bj = 0; bj < 2; ++bj) {
                    f32x4 v0 = acc[ai][bj][m][0] * rs, v1 = acc[ai][bj][m][1] * rs;
#pragma unroll
                    for (int c = 0; c < 4; ++c) { const float a = fmaxf(v0[c], 0.f), b = fmaxf(v1[c], 0.f); v0[c] = a * a; v1[c] = b * b; }
                    u32x4 w; w.x = pk2(v0.x, v0.y); w.y = pk2(v0.z, v0.w); w.z = pk2(v1.x, v1.y); w.w = pk2(v1.z, v1.w);
                    *(u32x4*)(U + (size_t)row * FF + u.pn * 256 + bj * 128 + wc * 32 + fq * 8) = w;
                }
            }
    }
};
struct EpiStore {
    static constexpr bool PERM = true;
    bf16_t* b0; int ld0; int split; bf16_t* b1; int ld1;
    __device__ __forceinline__ void operator()(const AccT& acc, const Unit& u, int wr, int wc, int fr, int fq) const {
        bf16_t* base = u.pn < split ? b0 + u.pn * 256 : b1 + (u.pn - split) * 256; const int ld = u.pn < split ? ld0 : ld1;
#pragma unroll
        for (int ai = 0; ai < 2; ++ai)
#pragma unroll
            for (int m = 0; m < 4; ++m) {
                const int row = u.pm * 256 + ai * 128 + wr * 64 + m * 16 + fr;
#pragma unroll
                for (int bj = 0; bj < 2; ++bj) {
                    const f32x4 v0 = acc[ai][bj][m][0], v1 = acc[ai][bj][m][1];
                    u32x4 w; w.x = pk2(v0.x, v0.y); w.y = pk2(v0.z, v0.w); w.z = pk2(v1.x, v1.y); w.w = pk2(v1.z, v1.w);
                    *(u32x4*)(base + (size_t)row * ld + bj * 128 + wc * 32 + fq * 8) = w;
                }
            }
    }
};
struct EpiLoraUp {
    static constexpr bool PERM = true;
    bf16_t* E; bf16_t* AS; const float* w0; const float* a0;
    __device__ __forceinline__ void operator()(const AccT& acc, const Unit& u, int wr, int wc, int fr, int fq) const {
        const bool dec = u.pn < 4; bf16_t* O = dec ? E : AS; const float* bias = dec ? w0 : a0; const float sc = dec ? -0.6065306597126334f : 1.f;
#pragma unroll
        for (int bj = 0; bj < 2; ++bj) {
            const int col = (u.pn & 3) * 256 + bj * 128 + wc * 32 + fq * 8;
            const f32x4 b0 = *(const f32x4*)(bias + col), b1 = *(const f32x4*)(bias + col + 4);
#pragma unroll
            for (int ai = 0; ai < 2; ++ai)
#pragma unroll
                for (int m = 0; m < 4; ++m) {
                    const int row = u.pm * 256 + ai * 128 + wr * 64 + m * 16 + fr;
                    f32x4 v0 = acc[ai][bj][m][0] + b0, v1 = acc[ai][bj][m][1] + b1;
#pragma unroll
                    for (int c = 0; c < 4; ++c) { v0[c] = sc * sigmoidf_(v0[c]); v1[c] = sc * sigmoidf_(v1[c]); }
                    u32x4 w; w.x = pk2(v0.x, v0.y); w.y = pk2(v0.z, v0.w); w.z = pk2(v1.x, v1.y); w.w = pk2(v1.z, v1.w);
                    *(u32x4*)(O + (size_t)row * DM + col) = w;
                    asm volatile("" ::: "memory");
                }
        }
    }
};
struct EpiGatePost {
    static constexpr bool PERM = true;
    bf16_t* AO; const bf16_t* Y; const bf16_t* V; const float* stats; const float* bonus; const float* lnw; const float* lnb;
    __device__ __forceinline__ void operator()(const AccT& acc, const Unit& u, int wr, int wc, int fr, int fq) const {
#pragma unroll
        for (int bj = 0; bj < 2; ++bj) {
            const int col = u.pn * 256 + bj * 128 + wc * 32 + fq * 8, hd = col >> 6;
            const f32x4 w0 = *(const f32x4*)(lnw + col), w1 = *(const f32x4*)(lnw + col + 4), c0 = *(const f32x4*)(lnb + col), c1 = *(const f32x4*)(lnb + col + 4);
#pragma unroll
            for (int ai = 0; ai < 2; ++ai)
#pragma unroll
                for (int m = 0; m < 4; ++m) {
                    const int row = u.pm * 256 + ai * 128 + wr * 64 + m * 16 + fr;
                    const f32x4 st = *(const f32x4*)(stats + ((size_t)row * 16 + hd) * 4);
                    const float mean = (st.x + st.z) * (1.f / 64.f), var = fmaxf((st.y + st.w) * (1.f / 64.f) - mean * mean, 0.f), rstd = rsqrtf(var + LNX_EPS);
                    const float bo = bonus[(size_t)row * 16 + hd];
                    const bf16x8 yv = *(const bf16x8*)(Y + (size_t)row * DM + col), vv = *(const bf16x8*)(V + (size_t)row * DM + col);
                    const f32x4 g0 = acc[ai][bj][m][0], g1 = acc[ai][bj][m][1];
                    float o[8];
#pragma unroll
                    for (int c = 0; c < 4; ++c) {
                        o[c] = ((bf2f((bf16_t)yv[c]) - mean) * rstd * w0[c] + c0[c] + bo * bf2f((bf16_t)vv[c])) * g0[c];
                        o[4 + c] = ((bf2f((bf16_t)yv[4 + c]) - mean) * rstd * w1[c] + c1[c] + bo * bf2f((bf16_t)vv[4 + c])) * g1[c];
                    }
                    u32x4 w; w.x = pk2(o[0], o[1]); w.y = pk2(o[2], o[3]); w.z = pk2(o[4], o[5]); w.w = pk2(o[6], o[7]);
                    *(u32x4*)(AO + (size_t)row * DM + col) = w;
                }
        }
    }
};

#define PG8_LAS __attribute__((address_space(3)))
constexpr int BM = 256, BK = 64, HALF = 128, HTB = HALF * BK * 2  , STAGE_BYTES = 8 * HTB;
__host__ __device__ __forceinline__ int lds_byte(int r, int c) { const int st = (r >> 4) * 2 + (c >> 5), rr = r & 15, cc = c & 31, ob = rr * 64 + cc * 2; return st * 1024 + (ob ^ (((ob >> 9) & 1) << 5)); }
__host__ __device__ __forceinline__ void stage_rc(int b, int& R, int& C) { const int st = b / 1024, sb = b % 1024, swz = sb ^ (((sb >> 9) & 1) << 5); R = (st >> 1) * 16 + swz / 64; C = (st & 1) * 32 + (swz % 64) / 2; }
__host__ __device__ __forceinline__ int perm32(int rho) { const int n = rho >> 4, i = rho & 15; return 8 * (i >> 2) + 4 * n + (i & 3); }
template <class Epi, bool ALIGN_EPI = true, bool SP2 = true>
__device__ __forceinline__ void gemm_fast(PG8_LAS unsigned char* lds, const Gemm g, const Epi& E) {
    StaticOrder S; S.init(g.M, g.N, gridDim.x, blockIdx.x);
    const int tid = opaque_tid(), wid = __builtin_amdgcn_readfirstlane(tid >> 6), lane = tid & 63, wr = wid >> 2, wc = wid & 3, fr = lane & 15, fq = lane >> 4;
    int K_ = g.K; asm volatile("" : "+s"(K_));
    const int K = K_, nt = K / BK;
    unsigned voffA[2], voffB[2];
#pragma unroll
    for (int i = 0; i < 2; ++i) { int R, C; stage_rc(tid * 16 + i * 8192, R, C); const int Rb = Epi::PERM ? ((R & ~31) + perm32(R & 31)) : R;
        voffA[i] = (unsigned)(R * K + C) * 2u; voffB[i] = (unsigned)(Rb * K + C) * 2u; }
    const size_t kstep = (size_t)(BK * 2);
    const size_t hstep = (size_t)HALF * K * 2;
    const size_t tstep = 2 * hstep;
    const unsigned ldsw = (unsigned)wid * 1024u;
    const int aoff = lds_byte(wr * 64 + fr, fq * 8), boff = lds_byte(wc * 32 + fr, fq * 8);
#define PG8_SA(b, h) (((b) * 2 + (h)) * HTB)
#define PG8_SB(b, h) ((4 + (b) * 2 + (h)) * HTB)
#define PG8_STAGE(bufoff, gbase, voff) do { _Pragma("unroll") for (int _i = 0; _i < 2; ++_i) \
        __builtin_amdgcn_global_load_lds((const unsigned*)((const char*)(gbase) + (voff)[_i]), (PG8_LAS unsigned*)(lds + (bufoff) + ldsw + _i * 8192), 16, 0, 0); } while (0)
#define PG8_LDA(dst, b, h) do { _Pragma("unroll") for (int m = 0; m < 4; ++m) _Pragma("unroll") for (int k = 0; k < 2; ++k) dst[m][k] = *(const PG8_LAS bf16x8*)(lds + PG8_SA(b, h) + aoff + m * 2048 + k * 1024); } while (0)
#define PG8_LDB(dst, b, h) do { _Pragma("unroll") for (int n = 0; n < 2; ++n) _Pragma("unroll") for (int k = 0; k < 2; ++k) dst[n][k] = *(const PG8_LAS bf16x8*)(lds + PG8_SB(b, h) + boff + n * 2048 + k * 1024); } while (0)
#define PG8_MMA(ai, bj, At, Bt) do { __builtin_amdgcn_s_setprio(1); _Pragma("unroll") for (int m = 0; m < 4; ++m) _Pragma("unroll") for (int n = 0; n < 2; ++n) _Pragma("unroll") for (int k = 0; k < 2; ++k) \
        acc[ai][bj][m][n] = __builtin_amdgcn_mfma_f32_16x16x32_bf16(Bt[n][k], At[m][k], acc[ai][bj][m][n], 0, 0, 0); __builtin_amdgcn_s_setprio(0); } while (0)
#define PG8_WAIT_V(n) asm volatile("s_waitcnt vmcnt(" #n ")" ::: "memory")
#define PG8_WAIT_L(n) asm volatile("s_waitcnt lgkmcnt(" #n ")" ::: "memory")
#define PG8_BAR __builtin_amdgcn_s_barrier()
#define PG8_SCHED __builtin_amdgcn_sched_barrier(0)
    Unit cur, nxt; int ui = 0;
    if (!S.next(0, cur)) return;
    AccT acc;
#pragma unroll
    for (int a = 0; a < 2; ++a)
#pragma unroll
        for (int b = 0; b < 2; ++b)
#pragma unroll
            for (int m = 0; m < 4; ++m)
#pragma unroll
                for (int n = 0; n < 2; ++n) acc[a][b][m][n] = (f32x4){0.f, 0.f, 0.f, 0.f};
    bf16x8 At[4][2], B0[2][2], B1[2][2];
    const char* cA = (const char*)(cur.pn >= g.pn2 ? g.A2 : g.A) + (size_t)cur.pm * tstep; const char* cB = (const char*)g.Bt + (size_t)cur.pn * tstep;
    if constexpr (SP2) {
        PG8_STAGE(PG8_SB(0, 0), cB, voffB); PG8_STAGE(PG8_SB(0, 1), cB + hstep, voffB); PG8_STAGE(PG8_SA(0, 0), cA, voffA); PG8_STAGE(PG8_SA(0, 1), cA + hstep, voffA);
        if (wr == 1) PG8_BAR;
        PG8_WAIT_V(2); PG8_BAR;
        PG8_STAGE(PG8_SB(1, 0), cB + kstep, voffB); PG8_STAGE(PG8_SA(1, 0), cA + kstep, voffA); PG8_STAGE(PG8_SB(1, 1), cB + hstep + kstep, voffB);
        PG8_WAIT_V(6); PG8_BAR;
    } else {
        PG8_STAGE(PG8_SB(0, 0), cB, voffB); PG8_STAGE(PG8_SA(0, 0), cA, voffA); PG8_STAGE(PG8_SB(0, 1), cB + hstep, voffB); PG8_STAGE(PG8_SA(0, 1), cA + hstep, voffA);
        if (wr == 1) PG8_BAR;
        PG8_WAIT_V(4); PG8_BAR;
        PG8_STAGE(PG8_SB(1, 0), cB + kstep, voffB); PG8_STAGE(PG8_SA(1, 0), cA + kstep, voffA); PG8_STAGE(PG8_SB(1, 1), cB + hstep + kstep, voffB);
        PG8_WAIT_V(6); PG8_BAR;
    }
    for (;;) {
        const bool has_next = S.next(ui + 1, nxt);
        const char* nA = has_next ? (const char*)(nxt.pn >= g.pn2 ? g.A2 : g.A) + (size_t)nxt.pm * tstep : cA; const char* nB = has_next ? (const char*)g.Bt + (size_t)nxt.pn * tstep : cB;
        for (int t = 0; t < nt; t += 2) {
            const bool last = (t == nt - 2);
            const char* a1 = cA + (size_t)(t + 1) * kstep;
            const char* a2 = last ? nA : cA + (size_t)(t + 2) * kstep; const char* b2 = last ? nB : cB + (size_t)(t + 2) * kstep;
            const char* a3 = a2 + kstep; const char* b3 = b2 + kstep;
            if constexpr (SP2) {
            PG8_LDB(B0, 0, 0); PG8_LDB(B1, 0, 1); PG8_SCHED; PG8_LDA(At, 0, 0); PG8_STAGE(PG8_SA(1, 1), a1 + hstep, voffA);
            PG8_WAIT_V(8); PG8_WAIT_L(0); PG8_BAR; PG8_MMA(0, 0, At, B0); PG8_MMA(0, 1, At, B1); PG8_BAR; PG8_SCHED;
            PG8_LDA(At, 0, 1); PG8_STAGE(PG8_SB(0, 0), b2, voffB); PG8_STAGE(PG8_SB(0, 1), b2 + hstep, voffB); PG8_STAGE(PG8_SA(0, 0), a2, voffA);
            PG8_WAIT_V(8); PG8_WAIT_L(0); PG8_BAR; PG8_MMA(1, 0, At, B0); PG8_MMA(1, 1, At, B1); PG8_BAR; PG8_SCHED;
            PG8_LDB(B0, 1, 0); PG8_LDB(B1, 1, 1); PG8_SCHED; PG8_LDA(At, 1, 0); PG8_STAGE(PG8_SA(0, 1), a2 + hstep, voffA);
            PG8_WAIT_V(8); PG8_WAIT_L(0); PG8_BAR; PG8_MMA(0, 0, At, B0); PG8_MMA(0, 1, At, B1); PG8_BAR; PG8_SCHED;
            PG8_LDA(At, 1, 1); PG8_STAGE(PG8_SB(1, 0), b3, voffB); PG8_STAGE(PG8_SB(1, 1), b3 + hstep, voffB); PG8_STAGE(PG8_SA(1, 0), a3, voffA);
            PG8_WAIT_V(8); PG8_WAIT_L(0); PG8_BAR; PG8_MMA(1, 0, At, B0); PG8_MMA(1, 1, At, B1); PG8_BAR; PG8_SCHED;
            } else {
            PG8_LDB(B0, 0, 0); PG8_SCHED; PG8_LDA(At, 0, 0); PG8_STAGE(PG8_SA(1, 1), a1 + hstep, voffA);
            PG8_WAIT_L(8); PG8_BAR; PG8_WAIT_L(0); PG8_MMA(0, 0, At, B0); PG8_BAR; PG8_SCHED;
            PG8_LDB(B1, 0, 1); PG8_STAGE(PG8_SB(0, 0), b2, voffB);
            PG8_BAR; PG8_WAIT_L(0); PG8_MMA(0, 1, At, B1); PG8_BAR;
            PG8_LDA(At, 0, 1); PG8_STAGE(PG8_SA(0, 0), a2, voffA);
            PG8_BAR; PG8_WAIT_L(0); PG8_MMA(1, 0, At, B0); PG8_BAR; PG8_SCHED;
            PG8_STAGE(PG8_SB(0, 1), b2 + hstep, voffB);
            PG8_WAIT_V(6); PG8_BAR; PG8_MMA(1, 1, At, B1); PG8_BAR;
            PG8_LDB(B0, 1, 0); PG8_SCHED; PG8_LDA(At, 1, 0); PG8_STAGE(PG8_SA(0, 1), a2 + hstep, voffA);
            PG8_WAIT_L(8); PG8_BAR; PG8_WAIT_L(0); PG8_MMA(0, 0, At, B0); PG8_BAR; PG8_SCHED;
            PG8_LDB(B1, 1, 1); PG8_STAGE(PG8_SB(1, 0), b3, voffB);
            PG8_BAR; PG8_WAIT_L(0); PG8_MMA(0, 1, At, B1); PG8_BAR;
            PG8_LDA(At, 1, 1); PG8_STAGE(PG8_SA(1, 0), a3, voffA);
            PG8_BAR; PG8_WAIT_L(0); PG8_MMA(1, 0, At, B0); PG8_BAR; PG8_SCHED;
            PG8_STAGE(PG8_SB(1, 1), b3 + hstep, voffB);
            PG8_WAIT_V(6); PG8_BAR; PG8_MMA(1, 1, At, B1); PG8_BAR;
            }
        }
        if constexpr (ALIGN_EPI) { if (wr == 0) PG8_BAR; }
        E(acc, cur, wr, wc, fr, fq);
        if (!has_next) break;
#pragma unroll
        for (int a = 0; a < 2; ++a)
#pragma unroll
            for (int b = 0; b < 2; ++b)
#pragma unroll
                for (int m = 0; m < 4; ++m)
#pragma unroll
                    for (int n = 0; n < 2; ++n) acc[a][b][m][n] = (f32x4){0.f, 0.f, 0.f, 0.f};
        cur = nxt; cA = nA; cB = nB; ++ui;
        if constexpr (ALIGN_EPI) { if (wr == 1) PG8_BAR; }
    }
    PG8_WAIT_V(0);
    if constexpr (!ALIGN_EPI) { if (wr == 0) PG8_BAR; }
    PG8_BAR;
#undef PG8_SA
#undef PG8_SB
#undef PG8_STAGE
#undef PG8_LDA
#undef PG8_LDB
#undef PG8_MMA
#undef PG8_WAIT_V
#undef PG8_WAIT_L
#undef PG8_BAR
#undef PG8_SCHED
}

template <class Epi> __device__ __forceinline__ void gemm_phase(unsigned char* lds, const Gemm g, const Epi& E) {
#if FAST_GEMM
    gemm_fast<Epi>((PG8_LAS unsigned char*)lds, g, E);
#else
    gemm_naive<Epi>(g, E);
#endif
}

__device__ __forceinline__ void p2_naive(const Args& A, unsigned char* lds, size_t mask_off = OFF_MASK) {
    const int tid = opaque_tid(), lane = tid & 63, wave = tid >> 6;
    float* sc = (float*)lds; float* qf = sc + 2048; float* wf = qf + 512;
    const bf16_t* QI = WSP(bf16_t, OFF_QI); const bf16_t* KI = WSP(bf16_t, OFF_KI); const float* WI = WSP(float, OFF_WI); unsigned* MASK = WSP(unsigned, mask_off);
    for (int m = blockIdx.x; m < MTOK; m += gridDim.x) {
        const int t = m & (SEQ - 1), b0 = m - t, nk = t + 1;
        unsigned* mrow = MASK + (size_t)m * 64;
        if (t < 256) { if (tid < 64) { const int lo = tid * 32; mrow[tid] = (nk >= lo + 32) ? 0xffffffffu : (nk <= lo ? 0u : ((1u << (nk - lo)) - 1u)); } continue; }
        __syncthreads();
        qf[tid] = bf2f(QI[(size_t)m * 512 + tid]);
        if (tid < 8) wf[tid] = WI[(size_t)m * 8 + tid];
        __syncthreads();
        for (int s = tid; s < nk; s += NTHR) {
            const bf16_t* kr = KI + (size_t)(b0 + s) * 64; float kf[64];
#pragma unroll
            for (int c = 0; c < 8; ++c) { const bf16x8 kv = *(const bf16x8*)(kr + 8 * c);
#pragma unroll
                for (int e = 0; e < 8; ++e) kf[8 * c + e] = bf2f((bf16_t)kv[e]); }
            float score = 0.f;
#pragma unroll
            for (int h = 0; h < 8; ++h) { float d = 0.f;
#pragma unroll
                for (int e = 0; e < 64; ++e) d += qf[h * 64 + e] * kf[e];
                score += wf[h] * fmaxf(d, 0.f); }
            sc[s] = score;
        }
        __syncthreads();
#pragma unroll 1
        for (int j = 0; j < 4; ++j) {
            const int base = 512 * j + 64 * wave;
            if (base >= nk) { if (lane < 2) mrow[(base >> 5) + lane] = 0u; continue; }
            const int s = base + lane; const bool valid = s < nk; const float my = valid ? sc[s] : 0.f; int cnt = 0;
            for (int s2 = 0; s2 < nk; ++s2) { const float o = sc[s2]; cnt += ((o > my) || (o == my && s2 < s)) ? 1 : 0; }
            const unsigned long long bal = __ballot(valid && cnt < 256);
            if (lane == 0) { mrow[base >> 5] = (unsigned)bal; mrow[(base >> 5) + 1] = (unsigned)(bal >> 32); }
        }
    }
}

__device__ __forceinline__ void p3_naive(const Args& A, unsigned char* lds) {
    const int tid = opaque_tid(), lane = tid & 63, wave = tid >> 6;
    float* lg = (float*)lds; float* qf = lg + 2048; float* red = qf + 1024; unsigned* mw = (unsigned*)(red + 1024);
    bf16_t* QO = WSP(bf16_t, OFF_QO); const bf16_t* K = WSP(bf16_t, OFF_K); const bf16_t* V = WSP(bf16_t, OFF_V); const unsigned* MASK = WSP(unsigned, OFF_MASK);
    for (int m = blockIdx.x; m < MTOK; m += gridDim.x) {
        const int t = m & (SEQ - 1), b0 = m - t, nk = t + 1;
        __syncthreads();
        qf[tid] = bf2f(QO[(size_t)m * 1024 + tid]); qf[tid + 512] = bf2f(QO[(size_t)m * 1024 + 512 + tid]);
        if (tid < 64) mw[tid] = MASK[(size_t)m * 64 + tid];
        __syncthreads();
#pragma unroll 1
        for (int hd = 0; hd < 16; ++hd) {
            const int n = hd >> 2; float mx = -INFINITY;
            for (int s = tid; s < nk; s += NTHR) {
                float v = -INFINITY;
                if ((mw[s >> 5] >> (s & 31)) & 1u) {
                    const bf16_t* kr = K + (size_t)(b0 + s) * 256 + n * 64; float d = 0.f;
#pragma unroll
                    for (int c = 0; c < 8; ++c) { const bf16x8 kv = *(const bf16x8*)(kr + 8 * c);
#pragma unroll
                        for (int e = 0; e < 8; ++e) d += qf[hd * 64 + 8 * c + e] * bf2f((bf16_t)kv[e]); }
                    v = d;
                }
                lg[s] = v; mx = fmaxf(mx, v);
            }
            mx = block_max(mx, red, wave, lane);
            float sm = 0.f;
            for (int s = tid; s < nk; s += NTHR) { const float p = exp2f(lg[s] - mx); lg[s] = p; sm += p; }
            sm = block_sum(sm, red, wave, lane);
            float acc = 0.f;
            for (int s = wave; s < nk; s += NWAVES) { const float p = lg[s]; if (p != 0.f) acc += p * bf2f(V[(size_t)(b0 + s) * 256 + n * 64 + lane]); }
            __syncthreads();
            red[16 + wave * 64 + lane] = acc;
            __syncthreads();
            if (tid < 64) { float o = 0.f;
#pragma unroll
                for (int p = 0; p < NWAVES; ++p) o += red[16 + p * 64 + tid];
                QO[(size_t)m * 1024 + hd * 64 + tid] = (bf16_t)f2bf(o / sm); }
            __syncthreads();
        }
    }
}

__device__ __forceinline__ void p7_prep(const Args& A) {
    const int tid = opaque_tid(), lane = tid & 63, wave = tid >> 6;
    const int gw = blockIdx.x * NWAVES + wave, NGW = gridDim.x * NWAVES;
    const float* X = A.out; const float* g = A.in[IN_MIXN] + DM; const float* mu = A.in[IN_MU];
    bf16_t* XSR = WSP(bf16_t, OFF_XSR); bf16_t* XSK = WSP(bf16_t, OFF_XSK); bf16_t* XSV = WSP(bf16_t, OFF_XSV); bf16_t* H1 = WSP(bf16_t, OFF_H1);
    f32x4 gg[4], mr[4], mk[4], mv[4];
#pragma unroll
    for (int j = 0; j < 4; ++j) { gg[j] = ((const f32x4*)g)[lane + 64 * j]; mr[j] = ((const f32x4*)mu)[lane + 64 * j]; mk[j] = ((const f32x4*)(mu + DM))[lane + 64 * j]; mv[j] = ((const f32x4*)(mu + 2 * DM))[lane + 64 * j]; }
    for (int run = gw; run < MTOK / 16; run += NGW) {
        const int r0 = run * 16; f32x4 hp[4];
#pragma unroll 1
        for (int i = -1; i < 16; ++i) {
            const int row = r0 + i; f32x4 h[4];
            if (i < 0 && (r0 & (SEQ - 1)) == 0) {
#pragma unroll
                for (int j = 0; j < 4; ++j) hp[j] = (f32x4){0.f, 0.f, 0.f, 0.f};
                continue;
            }
            const f32x4* xr = (const f32x4*)(X + (size_t)row * DM) + lane; float s = 0.f;
#pragma unroll
            for (int j = 0; j < 4; ++j) { h[j] = xr[64 * j]; s += (h[j].x * h[j].x + h[j].y * h[j].y) + (h[j].z * h[j].z + h[j].w * h[j].w); }
            const float rs = rsqrtf(wave_sum(s) * (1.f / DM) + NORM_EPS);
#pragma unroll
            for (int j = 0; j < 4; ++j) h[j] = h[j] * rs * gg[j];
            if (i >= 0) {
#pragma unroll
                for (int j = 0; j < 4; ++j) {
                    const f32x4 xx = hp[j] - h[j];
                    const f32x4 a = h[j] + xx * mr[j], b = h[j] + xx * mk[j], c = h[j] + xx * mv[j];
                    const size_t off = (size_t)row * DM + 4 * lane + 256 * j;
                    u32x2 w; w.x = pk2(a.x, a.y); w.y = pk2(a.z, a.w); *(u32x2*)(XSR + off) = w;
                    w.x = pk2(b.x, b.y); w.y = pk2(b.z, b.w); *(u32x2*)(XSK + off) = w;
                    w.x = pk2(c.x, c.y); w.y = pk2(c.z, c.w); *(u32x2*)(XSV + off) = w;
                    w.x = pk2(h[j].x, h[j].y); w.y = pk2(h[j].z, h[j].w); *(u32x2*)(H1 + off) = w;
                }
            }
#pragma unroll
            for (int j = 0; j < 4; ++j) hp[j] = h[j];
        }
    }
}
__device__ __forceinline__ void p10_loramid(const Args& A) {
    const bf16_t* P = WSP(bf16_t, OFF_P); bf16_t* AW = WSP(bf16_t, OFF_AW); bf16_t* AA = WSP(bf16_t, OFF_AA); bf16_t* AG = WSP(bf16_t, OFF_AG);
    const size_t total = (size_t)MTOK * 512;
    for (size_t idx = (size_t)blockIdx.x * NTHR + threadIdx.x; idx < total; idx += (size_t)gridDim.x * NTHR) {
        const int m = (int)(idx >> 9), j = (int)(idx & 511); const bool first = (m & (SEQ - 1)) == 0;
        const bf16_t* p0 = P + (size_t)m * 768; const bf16_t* pm = p0 - 768;
        if (j < 128) {
            float v = 0.f; if (j < 64) { const float x = bf2f(p0[j]) + (first ? 0.f : bf2f(pm[64 + j])); const float e = __expf(-2.f * fabsf(x)); const float th = (1.f - e) / (1.f + e); v = x < 0.f ? -th : th; }
            AW[(size_t)m * 128 + j] = (bf16_t)f2bf(v);
        } else if (j < 256) {
            const int jj = j - 128; float v = 0.f; if (jj < 64) v = bf2f(p0[128 + jj]) + (first ? 0.f : bf2f(pm[192 + jj]));
            AA[(size_t)m * 128 + jj] = (bf16_t)f2bf(v);
        } else {
            const int jj = j - 256; float v = 0.f; if (jj < 160) { const float x = bf2f(p0[256 + jj]) + (first ? 0.f : bf2f(pm[416 + jj])); v = sigmoidf_(x); }
            AG[(size_t)m * 256 + jj] = (bf16_t)f2bf(v);
        }
    }
}
__device__ __forceinline__ void p12_naive(const Args& A, unsigned char* lds) {
    const int tid = opaque_tid(), lane = tid & 63, wave = tid >> 6;
    const int gw = blockIdx.x * NWAVES + wave, NGW = gridDim.x * NWAVES;
    float* sh = (float*)lds + wave * 320;
    const bf16_t* R = WSP(bf16_t, OFF_R); const bf16_t* KR = WSP(bf16_t, OFF_KR); const bf16_t* VV = WSP(bf16_t, OFF_VV); const bf16_t* E = WSP(bf16_t, OFF_E); const bf16_t* AS = WSP(bf16_t, OFF_A);
    bf16_t* Y = WSP(bf16_t, OFF_Y);
    for (int it = gw; it < BATCH * 16; it += NGW) {
        const int b = it >> 4, h = it & 15;
        float S[64];
#pragma unroll
        for (int j = 0; j < 64; ++j) S[j] = 0.f;
        const float kkw = A.in[IN_KK][h * 64 + lane], kaw = A.in[IN_KA][h * 64 + lane];
        const size_t base = (size_t)b * SEQ * DM + h * 64 + lane;
        bf16_t rn = R[base], kn = KR[base], vn = VV[base], en = E[base], an = AS[base];
#pragma unroll 1
        for (int t = 0; t < SEQ; ++t) {
            const float r = bf2f(rn), k = bf2f(kn), v = bf2f(vn), e = bf2f(en), a = bf2f(an);
            if (t + 1 < SEQ) { const size_t ix = base + (size_t)(t + 1) * DM; rn = R[ix]; kn = KR[ix]; vn = VV[ix]; en = E[ix]; an = AS[ix]; }
            float kk = k * kkw; const float ss = wave_sum(kk * kk); kk *= rsqrtf(fmaxf(ss, 1e-24f));
            const float kt = k * (1.f + (a - 1.f) * kaw), bb = kk * a, w = __expf(e);
            sh[lane] = -kk; sh[64 + lane] = w; sh[128 + lane] = bb; sh[192 + lane] = kt; sh[256 + lane] = r;
            LDS_WAIT();
            float sa = 0.f;
#pragma unroll
            for (int j = 0; j < 64; ++j) sa += S[j] * sh[j];
            float y = 0.f;
#pragma unroll
            for (int j = 0; j < 64; ++j) { S[j] = S[j] * sh[64 + j] + sa * sh[128 + j] + v * sh[192 + j]; y += S[j] * sh[256 + j]; }
            Y[base + (size_t)t * DM] = (bf16_t)f2bf(y);
            LDS_WAIT();
        }
    }
}
__device__ __forceinline__ void p12b_stats(const Args& A) {
    const int tid = opaque_tid(), lane = tid & 63, wave = tid >> 6;
    const int gw = blockIdx.x * NWAVES + wave, NGW = gridDim.x * NWAVES;
    const bf16_t* R = WSP(bf16_t, OFF_R); const bf16_t* KR = WSP(bf16_t, OFF_KR); const bf16_t* AS = WSP(bf16_t, OFF_A); const bf16_t* Y = WSP(bf16_t, OFF_Y);
    float* ST = WSP(float, OFF_STATS); float* BO = WSP(float, OFF_BONUS);
    for (int it = gw; it < MTOK * 16; it += NGW) {
        const int h = it & 15; const size_t ix = (size_t)(it >> 4) * DM + h * 64 + lane;
        const float y = bf2f(Y[ix]), r = bf2f(R[ix]), k = bf2f(KR[ix]), a = bf2f(AS[ix]);
        const float kt = k * (1.f + (a - 1.f) * A.in[IN_KA][h * 64 + lane]);
        const float s1 = wave_sum(y), s2 = wave_sum(y * y), bo = wave_sum(r * kt * A.in[IN_RK][h * 64 + lane]);
        if (lane == 0) { *(f32x4*)(ST + (size_t)it * 4) = (f32x4){s1, s2, 0.f, 0.f}; BO[it] = bo; }
    }
}

template <int CTRL> __device__ __forceinline__ float dppf(float v) { return __int_as_float(__builtin_amdgcn_mov_dpp(__float_as_int(v), CTRL, 0xF, 0xF, false)); }
template <int CTRL> __device__ __forceinline__ int dppi(int v) { return __builtin_amdgcn_mov_dpp(v, CTRL, 0xF, 0xF, false); }
__device__ __forceinline__ float row16_allsum(float v) { v += dppf<0xB1>(v); v += dppf<0x4E>(v); v += dppf<0x124>(v); v += dppf<0x128>(v); return v; }
__device__ __forceinline__ float ffma_s(float a, float b, float c) { float r; asm("v_fma_f32 %0, %1, %2, %3" : "=v"(r) : "v"(a), "v"(b), "v"(c)); return r; }
__device__ __forceinline__ float fmul_s(float a, float b) { float r; asm("v_mul_f32_e32 %0, %1, %2" : "=v"(r) : "v"(a), "v"(b)); return r; }
__device__ __forceinline__ float row16_allsum_fused(float v) {
    float a, b, c, d;
    asm("s_nop 1\n\tv_add_f32_dpp %0, %1, %1 quad_perm:[1,0,3,2] row_mask:0xf bank_mask:0xf" : "=v"(a) : "v"(v));
    asm("s_nop 1\n\tv_add_f32_dpp %0, %1, %1 quad_perm:[2,3,0,1] row_mask:0xf bank_mask:0xf" : "=v"(b) : "v"(a));
    asm("s_nop 1\n\tv_add_f32_dpp %0, %1, %1 row_ror:4 row_mask:0xf bank_mask:0xf" : "=v"(c) : "v"(b));
    asm("s_nop 1\n\tv_add_f32_dpp %0, %1, %1 row_ror:8 row_mask:0xf bank_mask:0xf" : "=v"(d) : "v"(c));
    return d;
}
__device__ __forceinline__ int row16_allsum_i(int v) { v += dppi<0xB1>(v); v += dppi<0x4E>(v); v += dppi<0x124>(v); v += dppi<0x128>(v); return v; }
__device__ __forceinline__ int wave_allsum_i(int v) {
    v = row16_allsum_i(v);
    return __builtin_amdgcn_readlane(v, 0) + __builtin_amdgcn_readlane(v, 16) + __builtin_amdgcn_readlane(v, 32) + __builtin_amdgcn_readlane(v, 48);
}

constexpr int P2_LD = 2052;
template <int MODE = 0> __device__ __forceinline__ void p2_fast(const Args& A, unsigned char* lds) {
    const int tid = opaque_tid(), lane = tid & 63, wave = __builtin_amdgcn_readfirstlane(tid >> 6), fr = lane & 15, fq = lane >> 4;
    float* sc = (float*)lds;
    const bf16_t* QI = WSP(bf16_t, OFF_QI); const bf16_t* KI = WSP(bf16_t, OFF_KI); const float* WI = WSP(float, OFF_WI); unsigned* MASK = WSP(unsigned, MODE == 0 ? OFF_MASK : 160 * MiB);
    for (int it = blockIdx.x; it < 1024; it += gridDim.x) {
        const int q = it >> 8, c = it & 255, b = c & 7, s5 = c >> 3;
        const int tt = (q == 0) ? s5 : (q == 1) ? 63 - s5 : (q == 2) ? 64 + s5 : 127 - s5;
        const int t0 = 16 * tt, m0 = b * SEQ + t0;
        if (t0 >= 256 - 15) {
            bf16x8 qf[8][2]; float wv[8];
#pragma unroll
            for (int h = 0; h < 8; ++h) {
#pragma unroll
                for (int ks = 0; ks < 2; ++ks) qf[h][ks] = *(const bf16x8*)(QI + (size_t)(m0 + fr) * 512 + h * 64 + ks * 32 + fq * 8);
                wv[h] = WI[(size_t)(m0 + fr) * 8 + h];
            }
            const bf16_t* kbase = KI + (size_t)(b * SEQ + fr) * 64 + fq * 8;
            bf16x8 ka0 = *(const bf16x8*)(kbase + (size_t)wave * 16 * 64), ka1 = *(const bf16x8*)(kbase + (size_t)wave * 16 * 64 + 32);
#pragma unroll 1
            for (int kt = wave; kt <= tt; kt += NWAVES) {
                const bf16x8 a0 = ka0, a1 = ka1;
                if (kt + NWAVES <= tt) { ka0 = *(const bf16x8*)(kbase + (size_t)(kt + NWAVES) * 16 * 64); ka1 = *(const bf16x8*)(kbase + (size_t)(kt + NWAVES) * 16 * 64 + 32); }
                f32x4 acc = {0.f, 0.f, 0.f, 0.f};
#pragma unroll
                for (int h = 0; h < 8; ++h) {
                    f32x4 d = __builtin_amdgcn_mfma_f32_16x16x32_bf16(a0, qf[h][0], (f32x4){0.f, 0.f, 0.f, 0.f}, 0, 0, 0);
                    d = __builtin_amdgcn_mfma_f32_16x16x32_bf16(a1, qf[h][1], d, 0, 0, 0);
#pragma unroll
                    for (int e = 0; e < 4; ++e) acc[e] += wv[h] * fmaxf(d[e], 0.f);
                }
                *(f32x4*)(sc + fr * P2_LD + kt * 16 + 4 * fq) = acc;
            }
        }
        __syncthreads();
#pragma unroll 1
        for (int rr = 2 * wave; rr < 2 * wave + (MODE == 1 ? 0 : 2); ++rr) {
            const int t = t0 + rr, nk = t + 1;
            unsigned long long* mrow = (unsigned long long*)(MASK + (size_t)(m0 + rr) * 64);
            if (t < 256) {
                if (lane < 32) { const int lo = lane * 64; mrow[lane] = (nk >= lo + 64) ? ~0ull : (nk <= lo ? 0ull : ((1ull << (nk - lo)) - 1ull)); }
                continue;
            }
            const int nj = (nk + 63) >> 6;
            float x[32];
            const float* srow = sc + rr * P2_LD + lane;
#pragma unroll
            for (int j = 0; j < 32; ++j) x[j] = srow[64 * j];
            float mx = -INFINITY, mn = INFINITY;
#pragma unroll
            for (int j = 0; j < 32; ++j) { const bool ok = lane + 64 * j < nk; mn = fminf(mn, ok ? x[j] : INFINITY); x[j] = ok ? x[j] : -INFINITY; mx = fmaxf(mx, x[j]); }
            mx = wave_max(mx); mn = -wave_max(-mn);
            mx = __int_as_float(__builtin_amdgcn_readfirstlane(__float_as_int(mx))); mn = __int_as_float(__builtin_amdgcn_readfirstlane(__float_as_int(mn)));
#define P2_COUNT_GE(thr, out) do { int c_ = 0;     \
                _Pragma("unroll") for (int g_ = 0; g_ < 4; ++g_) if (nj > 8 * g_) { _Pragma("unroll") for (int j_ = 0; j_ < 8; ++j_) c_ += __popcll(__ballot(x[8 * g_ + j_] >= (thr))); } \
                (out) = c_; } while (0)
            float lo = mn, hi = mx, thr = 0.f; int c_hi; bool exact = false;
            P2_COUNT_GE(mx, c_hi);
            if (c_hi >= 256) { lo = mx; c_hi = 0; }
            else {
#pragma unroll 1
                for (int iter_ = 0;; ++iter_) {
                    if (MODE == 3 && iter_ >= 6) break;
                    const float mid = lo + (hi - lo) * 0.5f;
                    if (!(mid > lo && mid < hi)) break;
                    int cm; P2_COUNT_GE(mid, cm);
                    if (cm == 256) { exact = true; thr = mid; break; }
                    if (cm > 256) lo = mid; else { hi = mid; c_hi = cm; }
                }
            }
            unsigned long long mine = 0ull;
            if (exact) {
#pragma unroll
                for (int j = 0; j < 32; ++j) { const unsigned long long bal = __ballot(x[j] >= thr); if (lane == j) mine = bal; }
            } else {
                int need = 256 - c_hi;
#pragma unroll
                for (int j = 0; j < 32; ++j) {
                    const bool eq = (x[j] == lo); const unsigned long long beq = __ballot(eq);
                    const int pre = __builtin_amdgcn_mbcnt_hi((unsigned)(beq >> 32), __builtin_amdgcn_mbcnt_lo((unsigned)beq, 0));
                    const unsigned long long bal = __ballot((x[j] > lo) || (eq && pre < need));
                    need -= __popcll(beq); need = need < 0 ? 0 : need;
                    if (lane == j) mine = bal;
                }
            }
            if (lane < 32) mrow[lane] = mine;
#undef P2_COUNT_GE
        }
        __syncthreads();
    }
}

constexpr int SC_TC = 32, SC_BUF_F = 5 * SC_TC * 64 + SC_TC * 32;
__device__ __forceinline__ void p12_fast(const Args& A, unsigned char* lds) {
    const int tid = opaque_tid(), lane = tid & 63, wave = __builtin_amdgcn_readfirstlane(tid >> 6);
    const int kq = lane & 15, row = 4 * wave + (lane >> 4), tl = tid >> 4;
    float* fl = (float*)lds; float* ybuf = fl + 2 * SC_BUF_F;
    const bf16_t* R = WSP(bf16_t, OFF_R); const bf16_t* KR = WSP(bf16_t, OFF_KR); const bf16_t* VV = WSP(bf16_t, OFF_VV); const bf16_t* E = WSP(bf16_t, OFF_E); const bf16_t* AS = WSP(bf16_t, OFF_A);
    bf16_t* Y = WSP(bf16_t, OFF_Y); float* ST = WSP(float, OFF_STATS); float* BO = WSP(float, OFF_BONUS);
    for (int it = blockIdx.x; it < BATCH * 16 * 2; it += gridDim.x) {
        const int half = it & 1, h = (it >> 1) & 15, b = it >> 5;
        const f32x4 kkw = *(const f32x4*)(A.in[IN_KK] + h * 64 + 4 * kq), kaw = *(const f32x4*)(A.in[IN_KA] + h * 64 + 4 * kq), rkw = *(const f32x4*)(A.in[IN_RK] + h * 64 + 4 * kq);
        const size_t gbase = ((size_t)b * SEQ + tl) * DM + h * 64 + 4 * kq;
        u32x2 pr, pk, pv, pe, pa;
#define SC_PREFETCH(c) do { const size_t gi_ = gbase + (size_t)(c) * SC_TC * DM; pr = *(const u32x2*)(R + gi_); pk = *(const u32x2*)(KR + gi_); pv = *(const u32x2*)(VV + gi_); pe = *(const u32x2*)(E + gi_); pa = *(const u32x2*)(AS + gi_); } while (0)
#define SC_UNPK(p, o) do { o[0] = __uint_as_float(p.x << 16); o[1] = __uint_as_float(p.x & 0xffff0000u); o[2] = __uint_as_float(p.y << 16); o[3] = __uint_as_float(p.y & 0xffff0000u); } while (0)
#define SC_DERIVE(c) do { float* bf_ = fl + ((c) & 1) * SC_BUF_F; float r_[4], k_[4], v_[4], e_[4], a_[4]; SC_UNPK(pr, r_); SC_UNPK(pk, k_); SC_UNPK(pv, v_); SC_UNPK(pe, e_); SC_UNPK(pa, a_); \
            f32x4 kkv_, w_, n_, b_, kt_, rr_; float ss_ = 0.f, bo_ = 0.f; \
            _Pragma("unroll") for (int i_ = 0; i_ < 4; ++i_) { kkv_[i_] = k_[i_] * kkw[i_]; ss_ += kkv_[i_] * kkv_[i_]; } \
            ss_ = row16_allsum(ss_); const float inv_ = rsqrtf(fmaxf(ss_, 1e-24f)); \
            _Pragma("unroll") for (int i_ = 0; i_ < 4; ++i_) { n_[i_] = -kkv_[i_] * inv_; b_[i_] = -n_[i_] * a_[i_]; kt_[i_] = k_[i_] * (1.f + (a_[i_] - 1.f) * kaw[i_]); w_[i_] = __expf(e_[i_]); rr_[i_] = r_[i_]; bo_ += r_[i_] * kt_[i_] * rkw[i_]; } \
            bo_ = row16_allsum(bo_); \
            if (half == 0 && kq == 0) BO[((size_t)b * SEQ + (c) * SC_TC + tl) * 16 + h] = bo_; \
            float* d_ = bf_ + tl * 64 + 4 * kq; *(f32x4*)(d_) = w_; *(f32x4*)(d_ + 2048) = n_; *(f32x4*)(d_ + 4096) = b_; *(f32x4*)(d_ + 6144) = kt_; *(f32x4*)(d_ + 8192) = rr_; \
            if ((kq >> 3) == half) *(f32x4*)(bf_ + 10240 + tl * 32 + 4 * (kq & 7)) = (f32x4){v_[0], v_[1], v_[2], v_[3]}; } while (0)
        __syncthreads();
        SC_PREFETCH(0); SC_DERIVE(0);
        __syncthreads();
        float S0 = 0.f, S1 = 0.f, S2 = 0.f, S3 = 0.f;
#pragma unroll 1
        for (int c = 0; c < SEQ / SC_TC; ++c) {
            if (c + 1 < SEQ / SC_TC) SC_PREFETCH(c + 1);
            const float* bf = fl + (c & 1) * SC_BUF_F + 4 * kq; const float* vb = fl + (c & 1) * SC_BUF_F + 10240 + row; float* yb = ybuf + (c & 1) * 1024 + row;
#define SC_LOAD(P, tt_) do { P##w = *(const f32x4*)(bf + (tt_) * 64); P##n = *(const f32x4*)(bf + (tt_) * 64 + 2048); P##b = *(const f32x4*)(bf + (tt_) * 64 + 4096); P##k = *(const f32x4*)(bf + (tt_) * 64 + 6144); P##r = *(const f32x4*)(bf + (tt_) * 64 + 8192); P##v = vb[(tt_) * 32]; } while (0)
#define SC_STEP(P, tt_) do { \
                float p_ = fmul_s(S0, P##n.x); p_ = ffma_s(S1, P##n.y, p_); p_ = ffma_s(S2, P##n.z, p_); p_ = ffma_s(S3, P##n.w, p_); \
                float t0_ = fmul_s(S0, P##w.x), t1_ = fmul_s(S1, P##w.y), t2_ = fmul_s(S2, P##w.z), t3_ = fmul_s(S3, P##w.w); \
                t0_ = ffma_s(P##v, P##k.x, t0_); t1_ = ffma_s(P##v, P##k.y, t1_); t2_ = ffma_s(P##v, P##k.z, t2_); t3_ = ffma_s(P##v, P##k.w, t3_); \
                const float sa_ = row16_allsum_fused(p_); \
                S0 = ffma_s(sa_, P##b.x, t0_); S1 = ffma_s(sa_, P##b.y, t1_); S2 = ffma_s(sa_, P##b.z, t2_); S3 = ffma_s(sa_, P##b.w, t3_); \
                float qy_ = fmul_s(S0, P##r.x); qy_ = ffma_s(S1, P##r.y, qy_); qy_ = ffma_s(S2, P##r.z, qy_); qy_ = ffma_s(S3, P##r.w, qy_); \
                const float y_ = row16_allsum_fused(qy_); \
                if (kq == 0) yb[(tt_) * 32] = y_; } while (0)
            f32x4 Aw, An, Ab, Ak, Ar, Bw, Bn, Bb, Bk, Br; float Av, Bv;
            SC_LOAD(A, 0);
#pragma unroll 1
            for (int tt = 0; tt < SC_TC; tt += 2) {
                SC_LOAD(B, tt + 1);
                SC_STEP(A, tt);
                if (tt + 2 < SC_TC) SC_LOAD(A, tt + 2);
                SC_STEP(B, tt + 1);
            }
#undef SC_LOAD
#undef SC_STEP
            if (c + 1 < SEQ / SC_TC) SC_DERIVE(c + 1);
            __syncthreads();
            {
                const int j = tid & 15; const float* ys = ybuf + (c & 1) * 1024 + tl * 32 + 2 * j;
                const float y0 = ys[0], y1 = ys[1];
                const float s1 = row16_allsum(y0 + y1), s2 = row16_allsum(y0 * y0 + y1 * y1);
                const size_t m = (size_t)b * SEQ + c * SC_TC + tl;
                *(unsigned*)(Y + m * DM + h * 64 + 32 * half + 2 * j) = pk2(y0, y1);
                if (j == 0) *(f32x2*)(ST + (m * 16 + h) * 4 + 2 * half) = (f32x2){s1, s2};
            }
        }
#undef SC_PREFETCH
#undef SC_UNPK
#undef SC_DERIVE
    }
}

namespace attn_body {
using bf16=__hip_bfloat16;
using bf16x8=__attribute__((ext_vector_type(8)))short;
using s16x4=__attribute__((ext_vector_type(4)))short;
using f32x16=__attribute__((ext_vector_type(16)))float;
using u32x4=__attribute__((ext_vector_type(4)))unsigned;
constexpr int BATCH=8,NHEAD=16,SEQ=2048,D=64,DM=NHEAD*D,KP=256;
constexpr int NW=8,QBLK=32,QB=QBLK*NW,KVBLK=64,NQB=SEQ/QB;
constexpr int ATTN_PITCH=DM, ATTN_UNIT_ROWS=QB;
__device__ __forceinline__ int crow(int r,int hi){return (r&3)+8*(r>>2)+4*hi;}
#define SBAR() __builtin_amdgcn_sched_barrier(0)
__device__ __forceinline__ void bmask(f32x16&p0,f32x16&p1,unsigned long long mw,int hi){
  const unsigned lo=(unsigned)mw>>(4*hi), hw=(unsigned)(mw>>32)>>(4*hi);
  #pragma unroll
  for(int r=0;r<16;++r){const int c=(r&3)+8*(r>>2); const int m0=__builtin_amdgcn_sbfe((int)lo,c,1), m1=__builtin_amdgcn_sbfe((int)hw,c,1);
    p0[r]=__int_as_float((__float_as_int(p0[r])&m0)|((int)0xff800000&~m0)); p1[r]=__int_as_float((__float_as_int(p1[r])&m1)|((int)0xff800000&~m1));}
}

constexpr int NSLOT=3, SLOTB=8192;
constexpr int LDS_K=0, LDS_V=NSLOT*SLOTB, LDS_WS=2*NSLOT*SLOTB, LDS_OST=LDS_WS+NW*64*4, LDS_MSK=LDS_OST+NW*4096, LDS_BYTES=LDS_MSK+64*256;
constexpr float C2=0.125f*1.4426950408889634f;
__device__ __forceinline__ void glds16(const void*gsrc,unsigned lds_dst){unsigned keep;
  asm volatile("s_mov_b32 %0, m0\n\ts_mov_b32 m0, %2\n\ts_nop 0\n\tglobal_load_lds_dwordx4 %1, off\n\ts_mov_b32 m0, %0":"=&s"(keep):"v"(gsrc),"s"(lds_dst):"memory");}
__device__ __forceinline__ float max3f(float a,float b,float c){float r;asm("v_max3_f32 %0, %1, %2, %3":"=v"(r):"v"(a),"v"(b),"v"(c));return r;}
__device__ __forceinline__ float max2f(float a,float b){float r;asm("v_max_f32_e32 %0, %1, %2":"=v"(r):"v"(a),"v"(b));return r;}
__device__ __forceinline__ float fadd_s(float a,float b){float r;asm("v_add_f32_e32 %0, %1, %2":"=v"(r):"v"(a),"v"(b));return r;}
__device__ __forceinline__ float fsub_s(float a,float b){float r;asm("v_sub_f32_e32 %0, %1, %2":"=v"(r):"v"(a),"v"(b));return r;}
typedef float f32x2_t __attribute__((ext_vector_type(2))); typedef __bf16 bf16x2_t __attribute__((ext_vector_type(2)));
__device__ __forceinline__ unsigned cvtpk_s(float lo,float hi){f32x2_t v={lo,hi};bf16x2_t b=__builtin_convertvector(v,bf16x2_t);return __builtin_bit_cast(unsigned,b);}
#define WAIT_BAR(N) asm volatile("s_waitcnt vmcnt(" #N ") lgkmcnt(0)\n\ts_barrier":::"memory")

__device__ __forceinline__ void qkt(f32x16&p0,f32x16&p1,const char*Kslot,const bf16x8*qr,const f32x16&negm,int r32,int hi){
  const char*kb=Kslot+hi*1024+r32*16;
  #pragma unroll
  for(int d0=0;d0<4;++d0){
    const bf16x8 b0=*reinterpret_cast<const bf16x8*>(kb+d0*2048);
    const bf16x8 b1=*reinterpret_cast<const bf16x8*>(kb+d0*2048+512);
    if(d0==0){p0=__builtin_amdgcn_mfma_f32_32x32x16_bf16(b0,qr[0],negm,0,0,0);p1=__builtin_amdgcn_mfma_f32_32x32x16_bf16(b1,qr[0],negm,0,0,0);}
    else{p0=__builtin_amdgcn_mfma_f32_32x32x16_bf16(b0,qr[d0],p0,0,0,0);p1=__builtin_amdgcn_mfma_f32_32x32x16_bf16(b1,qr[d0],p1,0,0,0);}}
}
typedef __attribute__((address_space(3))) const char* lds_cptr;
typedef short v4i16_t __attribute__((ext_vector_type(4)));
__device__ __forceinline__ void kload8(bf16x8*kf,lds_cptr kp){
  kf[0]=*(const __attribute__((address_space(3))) bf16x8*)(kp);      kf[1]=*(const __attribute__((address_space(3))) bf16x8*)(kp+512);
  kf[2]=*(const __attribute__((address_space(3))) bf16x8*)(kp+2048); kf[3]=*(const __attribute__((address_space(3))) bf16x8*)(kp+2560);
  kf[4]=*(const __attribute__((address_space(3))) bf16x8*)(kp+4096); kf[5]=*(const __attribute__((address_space(3))) bf16x8*)(kp+4608);
  kf[6]=*(const __attribute__((address_space(3))) bf16x8*)(kp+6144); kf[7]=*(const __attribute__((address_space(3))) bf16x8*)(kp+6656);
}
__device__ __forceinline__ void kload2(bf16x8*kf,lds_cptr kp,int j){ kf[2*j]=*(const __attribute__((address_space(3))) bf16x8*)(kp+j*2048); kf[2*j+1]=*(const __attribute__((address_space(3))) bf16x8*)(kp+j*2048+512); }
__device__ __forceinline__ s16x4 vtr(lds_cptr p){ return __builtin_bit_cast(s16x4,__builtin_amdgcn_ds_read_tr16_b64_v4i16((__attribute__((address_space(3))) v4i16_t*)p)); }
__device__ __forceinline__ float rowmax(const f32x16&p0,const f32x16&p1){
  float a=max3f(p0[0],p0[1],p1[0]),b=max3f(p0[2],p0[3],p1[1]);a=max3f(a,p1[2],p1[3]);
  #pragma unroll
  for(int r=4;r<16;r+=4){a=max3f(a,p0[r],p0[r+1]);b=max3f(b,p0[r+2],p0[r+3]);a=max3f(a,p1[r],p1[r+1]);b=max3f(b,p1[r+2],p1[r+3]);}
  const float m=max2f(a,b);
  auto rr=__builtin_amdgcn_permlane32_swap(__float_as_uint(m),__float_as_uint(m),false,false);
  return max2f(__uint_as_float(rr[0]),__uint_as_float(rr[1]));
}
__device__ __forceinline__ void pv(f32x16*o,int vb,bf16x8 pa0,bf16x8 pa1,bf16x8 pa2,bf16x8 pa3){
  #pragma unroll
  for(int d0=0;d0<2;++d0){s16x4 lo[4],hi[4];
    #pragma unroll
    for(int ks=0;ks<4;++ks){
      asm volatile("ds_read_b64_tr_b16 %0,%1 offset:%c2":"=&v"(lo[ks]):"v"(vb),"i"(d0*4096+ks*1024):"memory");
      asm volatile("ds_read_b64_tr_b16 %0,%1 offset:%c2":"=&v"(hi[ks]):"v"(vb),"i"(d0*4096+ks*1024+512):"memory");}
    asm volatile("s_waitcnt lgkmcnt(0)":::"memory");SBAR();
    #define PK(k) (bf16x8){lo[k][0],lo[k][1],lo[k][2],lo[k][3],hi[k][0],hi[k][1],hi[k][2],hi[k][3]}
    o[d0]=__builtin_amdgcn_mfma_f32_32x32x16_bf16(pa0,PK(0),o[d0],0,0,0);
    o[d0]=__builtin_amdgcn_mfma_f32_32x32x16_bf16(pa1,PK(1),o[d0],0,0,0);
    o[d0]=__builtin_amdgcn_mfma_f32_32x32x16_bf16(pa2,PK(2),o[d0],0,0,0);
    o[d0]=__builtin_amdgcn_mfma_f32_32x32x16_bf16(pa3,PK(3),o[d0],0,0,0);
    #undef PK
  }
}

#ifndef ATTN_STORE16
#define ATTN_STORE16(p,v) (*(u32x4*)(p)=(v))
#endif
template<int THRL> __device__ __forceinline__ void attn_unit(int b,int n,int qt,const bf16*Q,const bf16*__restrict__ K,const bf16*__restrict__ V,bf16*O,const unsigned*__restrict__ MASK,char*shm){
  const int tid=opaque_tid(),lane=tid&63,r32=lane&31,hi=lane>>5; const int wid=__builtin_amdgcn_readfirstlane(tid>>6);
  const long rowbase=(long)b*SEQ; const int q0=qt*64;
  const int hq=4*n+(wid>>1), tok0=q0+32*(wid&1);
  const bf16*Qw=Q+(rowbase+tok0)*DM+hq*D;
  const bf16*Kh=K+rowbase*KP+n*D,*Vh=V+rowbase*KP+n*D;
  const unsigned lds0=(unsigned)(uintptr_t)shm;
  float*wsf=(float*)(shm+LDS_WS)+wid*64;
  const bf16*ksrc=Kh+(long)lane*KP+wid*8;
  const bf16*vsrc=Vh+(long)(16*(wid&3)+(lane>>2))*KP+(wid>>2)*32+(lane&3)*8;
  const unsigned kdst=lds0+LDS_K+wid*1024, vdst=lds0+LDS_V+wid*1024;
  #define DMA_K(t,slot) glds16(ksrc+(long)(t)*KVBLK*KP,(unsigned)__builtin_amdgcn_readfirstlane(kdst+(slot)))
  #define DMA_V(t,slot) glds16(vsrc+(long)(t)*KVBLK*KP,(unsigned)__builtin_amdgcn_readfirstlane(vdst+(slot)))
  const int vb0=(int)(lds0+LDS_V)+((lane>>4)&1)*32+(lane&3)*8+(4*hi+((lane&15)>>2))*64;
  const char*Kbase=shm+LDS_K; bf16x8 kf[8];
  const lds_cptr shm3=(lds_cptr)shm; const lds_cptr kp0=shm3+LDS_K+hi*1024+r32*16; const lds_cptr vp0=shm3+LDS_V+((lane>>4)&1)*32+(lane&3)*8+(4*hi+((lane&15)>>2))*64;
  const int nt0=qt+1; const int NT=nt0<4?4:((nt0+1)&~1);
  DMA_K(0,0);DMA_V(0,0);DMA_K(1,SLOTB);
  bf16x8 qr[4];
  #pragma unroll
  for(int d0=0;d0<4;++d0)qr[d0]=*reinterpret_cast<const bf16x8*>(&Qw[(long)r32*DM+d0*16+hi*8]);
  { const int tk=tid>>3,pc=tid&7; const u32x4*ms=(const u32x4*)(MASK+((size_t)(rowbase+q0+tk))*64+pc*8); const u32x4 m0=ms[0],m1=ms[1];
    __attribute__((address_space(3))) u32x4*md=(__attribute__((address_space(3))) u32x4*)((__attribute__((address_space(3))) char*)shm+LDS_MSK+tk*256+pc*32); md[0]=m0; md[1]=m1; }
  const __attribute__((address_space(3))) unsigned long long*mskrow=(const __attribute__((address_space(3))) unsigned long long*)((__attribute__((address_space(3))) char*)shm+LDS_MSK+(32*(wid&1)+r32)*256);
  float mhat=0.f,l_reg=0.f;f32x16 o[2];o[0]=f32x16{};o[1]=f32x16{};f32x16 negm=f32x16{};asm volatile("":"+v"(negm));
  #define CMASK(P0,P1,t) bmask(P0,P1,mw_,hi)
  bool resc=false;
  #define START(P0,P1) do{ const float rm=max2f(rowmax(P0,P1),-1000.f); resc=false; \
    { const float dl=rm; mhat=fadd_s(mhat,dl); \
      _Pragma("unroll") for(int r=0;r<16;++r){P0[r]=fsub_s(P0[r],dl);P1[r]=fsub_s(P1[r],dl);} \
      _Pragma("unroll") for(int r=0;r<16;++r)negm[r]=-mhat; asm volatile("":"+v"(negm)); } \
    _Pragma("unroll") for(int r=0;r<16;++r)P0[r]=__builtin_amdgcn_exp2f(P0[r]); }while(0)
  #define RESC() do{ if(resc){ asm volatile("s_waitcnt lgkmcnt(0)":::"memory"); \
      _Pragma("unroll") for(int d_=0;d_<2;++d_) _Pragma("unroll") for(int r=0;r<16;++r)o[d_][r]*=wsf[crow(r,hi)]; } }while(0)
  f32x16 pA0,pA1,pB0,pB1;
  int sl_prev=0,sl_cur=0,sl_next=SLOTB;
  #define ROT() do{sl_prev=sl_cur;sl_cur=sl_next;sl_next=(sl_next==(NSLOT-1)*SLOTB)?0:sl_next+SLOTB;}while(0)
  DMA_K(2,2*SLOTB);
  WAIT_BAR(3);
  qkt(pA0,pA1,Kbase,qr,negm,r32,hi);asm volatile("s_nop 15\n\ts_nop 7":"+v"(pA0),"+v"(pA1));{const unsigned long long mw_=mskrow[0];CMASK(pA0,pA1,0);}
  START(pA0,pA1);
  _Pragma("unroll") for(int r=0;r<16;++r)pA1[r]=__builtin_amdgcn_exp2f(pA1[r]);
  WAIT_BAR(0);
  DMA_K(3,0);DMA_V(1,SLOTB);
  ROT();
  kload8(kf,kp0+sl_cur);
  WAIT_BAR(2);
  s16x4 vlo[8],vhi[8]; u32x4 pw0,pw1,pw2,pw3;
  #define PKW(P,B) cvtpk_s(P[B],P[B+1])
  #define PAF(k) __builtin_bit_cast(bf16x8,pw##k)
  #define VFR(i) (bf16x8){vlo[i][0],vlo[i][1],vlo[i][2],vlo[i][3],vhi[i][0],vhi[i][1],vhi[i][2],vhi[i][3]}
  #define PIN(x) asm volatile("":"+v"(x))
  #define MX3(a,b,c) __builtin_fmaxf(__builtin_fmaxf((a),(b)),(c))
  #define GAPA(MF,A0,A1,A2,A3,W0,W1,PW) do{ MF; sacc+=A0; sacc+=A1; sacc+=A2; sacc+=A3; PIN(sacc); W0; W1; PIN(PW); SBAR(); }while(0)
  #define EX(v) __builtin_amdgcn_exp2f(v)
  #define GAPB(MF,X,B) do{ MF; X[B]=EX(X[B]); X[B+1]=EX(X[B+1]); X[B+2]=EX(X[B+2]); X[B+3]=EX(X[B+3]); PIN(X); SBAR(); }while(0)
  #define VRD(i) do{ vlo[i]=vtr(vp_+(((i)>>2)*4096+((i)&3)*1024)); vhi[i]=vtr(vp_+(((i)>>2)*4096+((i)&3)*1024+512)); }while(0)
  #define KRD(G,j) do{ if(G){ kload2(kf,kp0+sl_next,j); SBAR(); } }while(0)
  #define STEP(C0,C1,P0,P1,t,GK,GV,GL) do{ SBAR(); \
    const lds_cptr vp_=vp0+sl_prev; const unsigned long long mw_=mskrow[(t)]; \
    VRD(0); SBAR(); float sacc=(P0[0]+P0[1]); \
    GAPA(C0=__builtin_amdgcn_mfma_f32_32x32x16_bf16(kf[0],qr[0],negm,0,0,0), P0[2],P0[3],P0[4],P0[5],     pw0[0]=PKW(P0,0), pw0[1]=PKW(P0,2), pw0); \
    VRD(4); SBAR(); GAPA(C1=__builtin_amdgcn_mfma_f32_32x32x16_bf16(kf[1],qr[0],negm,0,0,0), P0[6],P0[7],P0[8],P0[9],     pw0[2]=PKW(P0,4), pw0[3]=PKW(P0,6), pw0); \
    VRD(1); SBAR(); GAPA(C0=__builtin_amdgcn_mfma_f32_32x32x16_bf16(kf[2],qr[1],C0,0,0,0),   P0[10],P0[11],P0[12],P0[13], pw1[0]=PKW(P0,8), pw1[1]=PKW(P0,10), pw1); \
    VRD(5); SBAR(); GAPA(C1=__builtin_amdgcn_mfma_f32_32x32x16_bf16(kf[3],qr[1],C1,0,0,0),   P0[14],P0[15],P1[0],P1[1],   pw1[2]=PKW(P0,12),pw1[3]=PKW(P0,14), pw1); \
    VRD(2); SBAR(); GAPA(C0=__builtin_amdgcn_mfma_f32_32x32x16_bf16(kf[4],qr[2],C0,0,0,0),   P1[2],P1[3],P1[4],P1[5],     pw2[0]=PKW(P1,0), pw2[1]=PKW(P1,2), pw2); \
    VRD(6); SBAR(); GAPA(C1=__builtin_amdgcn_mfma_f32_32x32x16_bf16(kf[5],qr[2],C1,0,0,0),   P1[6],P1[7],P1[8],P1[9],     pw2[2]=PKW(P1,4), pw2[3]=PKW(P1,6), pw2); \
    VRD(3); SBAR(); GAPA(C0=__builtin_amdgcn_mfma_f32_32x32x16_bf16(kf[6],qr[3],C0,0,0,0),   P1[10],P1[11],P1[12],P1[13], pw3[0]=PKW(P1,8), pw3[1]=PKW(P1,10), pw3); \
    VRD(7); SBAR(); GAPA(C1=__builtin_amdgcn_mfma_f32_32x32x16_bf16(kf[7],qr[3],C1,0,0,0),   P1[14],P1[15],0.f,0.f,       pw3[2]=PKW(P1,12),pw3[3]=PKW(P1,14), pw3); \
    l_reg+=sacc; \
    if(GK){DMA_K((t)+3,sl_cur);} if(GV){DMA_V((t)+1,sl_next);} \
    CMASK(C0,C1,t); \
    { float a=MX3(C0[0],C0[1],C1[0]),b=MX3(C0[2],C0[3],C1[1]); a=MX3(a,C1[2],C1[3]); \
      _Pragma("unroll") for(int r=4;r<16;r+=4){a=MX3(a,C0[r],C0[r+1]);b=MX3(b,C0[r+2],C0[r+3]);a=MX3(a,C1[r],C1[r+1]);b=MX3(b,C1[r+2],C1[r+3]);} \
      float rm=__builtin_fmaxf(a,b); { auto rr=__builtin_amdgcn_permlane32_swap(__float_as_uint(rm),__float_as_uint(rm),false,false); rm=__builtin_fmaxf(__uint_as_float(rr[0]),__uint_as_float(rr[1])); } \
      resc=false; \
      if(__builtin_expect(__any(rm>(float)THRL),0)){ const float dl=__builtin_fmaxf(rm,0.f); mhat+=dl; \
        _Pragma("unroll") for(int r=0;r<16;++r){C0[r]-=dl;C1[r]-=dl;} \
        _Pragma("unroll") for(int r=0;r<16;++r)negm[r]=-mhat; asm volatile("":"+v"(negm)); \
        const float f=__builtin_amdgcn_exp2f(-dl); l_reg*=f; if(hi==0)wsf[r32]=f; resc=true; } } \
    SBAR(); \
    GAPB(o[0]=__builtin_amdgcn_mfma_f32_32x32x16_bf16(PAF(0),VFR(0),o[0],0,0,0), C0,0); \
    GAPB(o[1]=__builtin_amdgcn_mfma_f32_32x32x16_bf16(PAF(0),VFR(4),o[1],0,0,0), C0,4); \
    KRD(GL,0); GAPB(o[0]=__builtin_amdgcn_mfma_f32_32x32x16_bf16(PAF(1),VFR(1),o[0],0,0,0), C0,8); \
    KRD(GL,1); GAPB(o[1]=__builtin_amdgcn_mfma_f32_32x32x16_bf16(PAF(1),VFR(5),o[1],0,0,0), C0,12); \
    KRD(GL,2); GAPB(o[0]=__builtin_amdgcn_mfma_f32_32x32x16_bf16(PAF(2),VFR(2),o[0],0,0,0), C1,0); \
    KRD(GL,3); GAPB(o[1]=__builtin_amdgcn_mfma_f32_32x32x16_bf16(PAF(2),VFR(6),o[1],0,0,0), C1,4); \
    GAPB(o[0]=__builtin_amdgcn_mfma_f32_32x32x16_bf16(PAF(3),VFR(3),o[0],0,0,0), C1,8); \
    GAPB(o[1]=__builtin_amdgcn_mfma_f32_32x32x16_bf16(PAF(3),VFR(7),o[1],0,0,0), C1,12); \
    }while(0)
  int t=1;
  for(;t+5<NT;t+=2){
    STEP(pB0,pB1,pA0,pA1,t,true,true,true);     WAIT_BAR(2); RESC(); ROT();
    STEP(pA0,pA1,pB0,pB1,t+1,true,true,true);   WAIT_BAR(2); RESC(); ROT();
  }
  #define ENDW(tt) do{ if((tt)+3<NT){WAIT_BAR(2);} else if((tt)+2<NT){WAIT_BAR(1);} else {WAIT_BAR(0);} }while(0)
  for(;t+1<NT;t+=2){
    STEP(pB0,pB1,pA0,pA1,t,(t+3<NT),(t+1<NT),(t+1<NT));       ENDW(t);   RESC(); ROT();
    STEP(pA0,pA1,pB0,pB1,t+1,(t+4<NT),(t+2<NT),(t+2<NT));     ENDW(t+1); RESC(); ROT();
  }
  STEP(pB0,pB1,pA0,pA1,NT-1,false,false,false); RESC();
  { float sacc=pB0[0]+pB0[1]; _Pragma("unroll") for(int r=2;r<16;++r)sacc+=pB0[r]; _Pragma("unroll") for(int r=0;r<16;++r)sacc+=pB1[r]; l_reg+=sacc;
    pw0=(u32x4){PKW(pB0,0),PKW(pB0,2),PKW(pB0,4),PKW(pB0,6)};pw1=(u32x4){PKW(pB0,8),PKW(pB0,10),PKW(pB0,12),PKW(pB0,14)};pw2=(u32x4){PKW(pB1,0),PKW(pB1,2),PKW(pB1,4),PKW(pB1,6)};pw3=(u32x4){PKW(pB1,8),PKW(pB1,10),PKW(pB1,12),PKW(pB1,14)};
    SBAR(); pv(o,vb0+sl_cur,PAF(0),PAF(1),PAF(2),PAF(3)); }
  #undef PKW
  #undef PAF
  #undef VFR
  #undef PIN
  #undef MX3
  #undef GAPA
  #undef GAPB
  #undef EX
  #undef VRD
  #undef KRD
  #undef STEP
  #undef ENDW
  {auto rr=__builtin_amdgcn_permlane32_swap(__float_as_uint(l_reg),__float_as_uint(l_reg),false,false);l_reg=__uint_as_float(rr[0])+__uint_as_float(rr[1]);}
  if(hi==0)wsf[32+r32]=l_reg;asm volatile("s_waitcnt lgkmcnt(0)":::"memory");
  float rli[16];
  #pragma unroll
  for(int r=0;r<16;++r)rli[r]=__builtin_amdgcn_rcpf(wsf[32+crow(r,hi)]);
  bf16*Ow=O+(rowbase+tok0)*DM+hq*D;
  { bf16*stg=(bf16*)(shm+LDS_OST)+wid*2048;
    #pragma unroll
    for(int r=0;r<16;++r){const int orow=crow(r,hi);
      #pragma unroll
      for(int d0=0;d0<2;++d0)stg[orow*64+d0*32+r32]=__float2bfloat16(o[d0][r]*rli[r]);}
    asm volatile("s_waitcnt lgkmcnt(0)":::"memory");
    #pragma unroll
    for(int i=0;i<4;++i){const int row=i*8+(lane>>3),ch=lane&7; const u32x4 v=*(const u32x4*)(stg+row*64+ch*8); ATTN_STORE16(Ow+(long)row*DM+ch*8,v);} }
  asm volatile("s_waitcnt lgkmcnt(0)\n\ts_barrier":::"memory");
  #undef DMA_K
  #undef DMA_V
  #undef CMASK
  #undef START
  #undef RESC
  #undef ROT
}
constexpr int ATTN_LDS_BYTES=LDS_BYTES;
struct AttnTensors { const bf16* Q; const bf16* K; const bf16* V; bf16* O; const unsigned* MASK; };
struct AttnUnit { int bn; int qt; };
struct StaticOrder {
  int vcu, G;
  __device__ __forceinline__ explicit StaticOrder(int grid,int block):vcu((grid%8==0)?(block%8)*(grid/8)+block/8:block),G(grid){}
  __device__ __forceinline__ bool next(int i,AttnUnit&u)const{
    if(G==256){ if(i>=4)return false; const int s=vcu&7; u.bn=vcu>>3; u.qt=(i==0)?31-s:(i==1)?16+s:(i==2)?15-s:s; return true; }
    const int id=vcu+i*G; if(id>=1024)return false; u.bn=id>>5; u.qt=31-(id&31); return true; }
};
template<class Sched,int THRL=8> __device__ __forceinline__ void attn_phase(char*lds,const AttnTensors&T,const Sched&S){
  AttnUnit u;
  for(int i=0;S.next(i,u);++i){ attn_unit<THRL>(u.bn>>2,u.bn&3,u.qt,T.Q,T.K,T.V,T.O,T.MASK,lds); }
}
#undef SBAR
#undef WAIT_BAR
}


constexpr int CH = 16, NCHUNK = SEQ / CH;
constexpr size_t OFF_SM = 84 * MiB, OFF_WC = 3 * MiB;
__device__ __forceinline__ unsigned char* arr_base(const Args& A, int arr) { return A.ws + (arr == 0 ? OFF_R : arr == 1 ? OFF_KR : arr == 2 ? OFF_E : OFF_A); }
__device__ __forceinline__ unsigned char* piece_ptr(const Args& A, int blk, int lane, int m0, int h) {
    const int pidx = blk * 64 + lane, p7 = pidx & 127, t = p7 >> 3, seg = p7 & 7;
    return arr_base(A, pidx >> 7) + ((size_t)(m0 + t) * DM + h * 64 + seg * 8) * 2;
}
__device__ __forceinline__ unsigned cvtpk(float lo, float hi) { typedef float f2_ __attribute__((ext_vector_type(2))); typedef __bf16 b2_ __attribute__((ext_vector_type(2))); f2_ v = {lo, hi}; b2_ b = __builtin_convertvector(v, b2_); return __builtin_bit_cast(unsigned, b); }
__device__ __forceinline__ float quad_allsum(float v) { v += dppf<0xB1>(v); v += dppf<0x4E>(v); return v; }
__device__ __forceinline__ bf16x8 mk8(unsigned a, unsigned b, unsigned c, unsigned d) { u32x4 w = {a, b, c, d}; return __builtin_bit_cast(bf16x8, w); }

__device__ __forceinline__ void p12_chunk_prep(const Args& A, unsigned char* lds) {
    const int tid = opaque_tid(), lane = tid & 63, wave = __builtin_amdgcn_readfirstlane(tid >> 6), q = lane >> 4, c = lane & 15;
    unsigned char* wl = lds + wave * 14336;
    bf16_t* arr = (bf16_t*)wl;
    bf16_t* bkb = (bf16_t*)(wl + 8192);
    float* gs = (float*)(wl + 12288);
    float* invs = (float*)(wl + 13312);
    const bf16_t* R = WSP(bf16_t, OFF_R); const bf16_t* KR = WSP(bf16_t, OFF_KR); const bf16_t* E = WSP(bf16_t, OFF_E); const bf16_t* AS = WSP(bf16_t, OFF_A);
    float* BO = WSP(float, OFF_BONUS); float* WC = WSP(float, OFF_WC); unsigned char* SM = A.ws + OFF_SM;
    const int gw = blockIdx.x * NWAVES + wave, NGW = gridDim.x * NWAVES;
    u32x4 nr0, nr1, nk0, nk1, ne0, ne1, na0, na1;
#define P12_LOAD(itm) do { const int bh_ = (itm) >> 7, ch_ = (itm) & 127; const size_t go_ = (size_t)((bh_ >> 4) * SEQ + ch_ * CH + (lane >> 2)) * DM + (bh_ & 15) * 64 + (lane & 3) * 16; \
        nr0 = *(const u32x4*)(R + go_); nr1 = *(const u32x4*)(R + go_ + 8); nk0 = *(const u32x4*)(KR + go_); nk1 = *(const u32x4*)(KR + go_ + 8); \
        ne0 = *(const u32x4*)(E + go_); ne1 = *(const u32x4*)(E + go_ + 8); na0 = *(const u32x4*)(AS + go_); na1 = *(const u32x4*)(AS + go_ + 8); } while (0)
    if (gw < BATCH * 16 * NCHUNK) P12_LOAD(gw);
#pragma unroll 1
    for (int item = gw; item < BATCH * 16 * NCHUNK; item += NGW) {
        const int bh = item >> 7, ch = item & 127, b = bh >> 4, h = bh & 15, m0 = b * SEQ + ch * CH;
        {
            const int t = lane >> 2, sg = lane & 3;
            const u32x4 r0 = nr0, r1 = nr1, k0 = nk0, k1 = nk1, e0 = ne0, e1 = ne1, a0 = na0, a1 = na1;
            if (item + NGW < BATCH * 16 * NCHUNK) P12_LOAD(item + NGW);
            u32x4* d = (u32x4*)(arr + t * 64 + sg * 16);
            d[0] = r0; d[1] = r1; d[128] = k0; d[129] = k1; d[256] = e0; d[257] = e1; d[384] = a0; d[385] = a1;
            float ss = 0.f, bo = 0.f;
#pragma unroll
            for (int w = 0; w < 8; ++w) {
                const unsigned rw = w < 4 ? r0[w & 3] : r1[w & 3], kw = w < 4 ? k0[w & 3] : k1[w & 3], aw = w < 4 ? a0[w & 3] : a1[w & 3];
                const int kk0 = h * 64 + sg * 16 + 2 * w;
#pragma unroll
                for (int p = 0; p < 2; ++p) {
                    const float rv = p ? __uint_as_float(rw & 0xffff0000u) : __uint_as_float(rw << 16), kv = p ? __uint_as_float(kw & 0xffff0000u) : __uint_as_float(kw << 16), av = p ? __uint_as_float(aw & 0xffff0000u) : __uint_as_float(aw << 16);
                    const float kkv = kv * A.in[IN_KK][kk0 + p]; ss += kkv * kkv;
                    bo += rv * (kv * (1.f + (av - 1.f) * A.in[IN_KA][kk0 + p])) * A.in[IN_RK][kk0 + p];
                }
            }
            ss = quad_allsum(ss); bo = quad_allsum(bo);
            if (sg == 0) { invs[t] = rsqrtf(fmaxf(ss, 1e-24f)); BO[(size_t)(m0 + t) * 16 + h] = bo; }
        }
        LDS_WAIT();
        float wc;
        {
            const float kkw = A.in[IN_KK][h * 64 + lane], kaw = A.in[IN_KA][h * 64 + lane];
            float Ecum = 0.f, ep_prev = 1.f; float bt[16], ktl[16];
#pragma unroll
            for (int t = 0; t < 16; ++t) {
                const float r = bf2f(arr[t * 64 + lane]), k = bf2f(arr[1024 + t * 64 + lane]), e = bf2f(arr[2048 + t * 64 + lane]), a = bf2f(arr[3072 + t * 64 + lane]);
                const float n = -(k * kkw) * invs[t], bb = -n * a, kt = k * (1.f + (a - 1.f) * kaw);
                Ecum += e; const float ep = __expf(Ecum), em = __builtin_amdgcn_rcpf(ep);
                bt[t] = bb * em; ktl[t] = kt * em;
                arr[t * 64 + lane] = (bf16_t)f2bf(r * ep); arr[1024 + t * 64 + lane] = (bf16_t)f2bf(n * ep_prev);
                arr[2048 + t * 64 + lane] = (bf16_t)f2bf(bt[t]); arr[3072 + t * 64 + lane] = (bf16_t)f2bf(ktl[t]);
                ep_prev = ep;
            }
            wc = ep_prev;
            u32x4* bd = (u32x4*)(bkb + lane * 16); u32x4* kd = (u32x4*)(bkb + 1024 + lane * 16);
            bd[0] = (u32x4){cvtpk(bt[0] * wc, bt[1] * wc), cvtpk(bt[2] * wc, bt[3] * wc), cvtpk(bt[4] * wc, bt[5] * wc), cvtpk(bt[6] * wc, bt[7] * wc)};
            bd[1] = (u32x4){cvtpk(bt[8] * wc, bt[9] * wc), cvtpk(bt[10] * wc, bt[11] * wc), cvtpk(bt[12] * wc, bt[13] * wc), cvtpk(bt[14] * wc, bt[15] * wc)};
            kd[0] = (u32x4){cvtpk(ktl[0] * wc, ktl[1] * wc), cvtpk(ktl[2] * wc, ktl[3] * wc), cvtpk(ktl[4] * wc, ktl[5] * wc), cvtpk(ktl[6] * wc, ktl[7] * wc)};
            kd[1] = (u32x4){cvtpk(ktl[8] * wc, ktl[9] * wc), cvtpk(ktl[10] * wc, ktl[11] * wc), cvtpk(ktl[12] * wc, ktl[13] * wc), cvtpk(ktl[14] * wc, ktl[15] * wc)};
        }
        LDS_WAIT();
        f32x4 gnb = {0.f, 0.f, 0.f, 0.f}, gnk = gnb, grb = gnb, grk = gnb;
#pragma unroll
        for (int ks = 0; ks < 2; ++ks) {
            const int o = c * 64 + ks * 32 + q * 8;
            const bf16x8 Ab = *(const bf16x8*)(arr + 2048 + o), Ak = *(const bf16x8*)(arr + 3072 + o), Bn = *(const bf16x8*)(arr + 1024 + o), Br = *(const bf16x8*)(arr + o);
            gnb = __builtin_amdgcn_mfma_f32_16x16x32_bf16(Ab, Bn, gnb, 0, 0, 0); gnk = __builtin_amdgcn_mfma_f32_16x16x32_bf16(Ak, Bn, gnk, 0, 0, 0);
            grb = __builtin_amdgcn_mfma_f32_16x16x32_bf16(Ab, Br, grb, 0, 0, 0); grk = __builtin_amdgcn_mfma_f32_16x16x32_bf16(Ak, Br, grk, 0, 0, 0);
        }
#pragma unroll
        for (int rg = 0; rg < 4; ++rg) { const int sI = 4 * q + rg; if (!(sI < c)) { gnb[rg] = 0.f; gnk[rg] = 0.f; } if (!(sI <= c)) { grb[rg] = 0.f; grk[rg] = 0.f; } gs[sI * 16 + c] = gnb[rg]; }
        LDS_WAIT();
        {
            float Tc[16];
#pragma unroll
            for (int sI = 15; sI >= 0; --sI) {
                float acc = (sI == c) ? 1.f : 0.f;
#pragma unroll
                for (int j = sI + 1; j < 16; ++j) acc += gs[sI * 16 + j] * Tc[j];
                Tc[sI] = acc;
            }
            LDS_WAIT();
            if (q == 0) {
#pragma unroll
                for (int j = 0; j < 4; ++j) *(f32x4*)(gs + c * 16 + 4 * j) = (f32x4){Tc[4 * j], Tc[4 * j + 1], Tc[4 * j + 2], Tc[4 * j + 3]};
            }
        }
        LDS_WAIT();
#pragma unroll
        for (int blk = 0; blk < 4; ++blk) {
            const int ks = blk & 1; const bf16_t* src = arr + (blk < 2 ? 1024 : 0) + c * 64 + ks * 32 + 4 * q;
            const u32x2 lo = *(const u32x2*)src, hi = *(const u32x2*)(src + 16);
            *(u32x4*)piece_ptr(A, blk, lane, m0, h) = (u32x4){lo.x, lo.y, hi.x, hi.y};
        }
#pragma unroll
        for (int ct = 0; ct < 4; ++ct) {
            const u32x2 lo = *(const u32x2*)(bkb + (16 * ct + c) * 16 + 4 * q), hi = *(const u32x2*)(bkb + 1024 + (16 * ct + c) * 16 + 4 * q);
            *(u32x4*)piece_ptr(A, 4 + ct, lane, m0, h) = (u32x4){lo.x, lo.y, hi.x, hi.y};
        }
        {
            unsigned char* sm = SM + (size_t)item * 2048;
            *(u32x2*)(sm + lane * 8) = (u32x2){cvtpk(gnk[0], gnk[1]), cvtpk(gnk[2], gnk[3])};
            const f32x4 tv = *(const f32x4*)(gs + c * 16 + 4 * q);
            *(u32x2*)(sm + 512 + lane * 8) = (u32x2){cvtpk(tv[0], tv[1]), cvtpk(tv[2], tv[3])};
            *(u32x4*)(sm + 1024 + lane * 16) = (u32x4){cvtpk(grb[0], grb[1]), cvtpk(grb[2], grb[3]), cvtpk(grk[0], grk[1]), cvtpk(grk[2], grk[3])};
            WC[(size_t)item * 64 + lane] = wc;
        }
        LDS_WAIT();
    }
}

constexpr int CS_SLOT = 12800, CS_PD = 8;
#define CS_BAR() asm volatile("s_waitcnt lgkmcnt(0)\n\ts_barrier" ::: "memory")
__device__ __forceinline__ void p13_chunk_scan(const Args& A, unsigned char* lds) {
    const int tid = opaque_tid(), lane = tid & 63, wave = __builtin_amdgcn_readfirstlane(tid >> 6), q = lane >> 4, c = lane & 15;
    float* part = (float*)lds; unsigned char* slots = lds + 1024;
    const bf16_t* VV = WSP(bf16_t, OFF_VV); bf16_t* Y = WSP(bf16_t, OFF_R); float* ST = WSP(float, OFF_STATS); const float* WC = WSP(float, OFF_WC); const unsigned char* SM = A.ws + OFF_SM;
    if (DEFER_W && (int)gridDim.x > BATCH * 16 && (int)blockIdx.x >= BATCH * 16) {
        float* scr = (float*)(lds + wave * 16384);
        const int gwi = ((int)blockIdx.x - BATCH * 16) * NWAVES + wave, ngwi = ((int)gridDim.x - BATCH * 16) * NWAVES;
        p0_weight<9>(A, WSP(bf16_t, OFF_WO1), 1024, 1024, scr, gwi, ngwi, lane);
        p0_weight<10>(A, WSP(bf16_t, OFF_WUP1), 4096, 1024, scr, gwi, ngwi, lane);
        p0_weight<11>(A, WSP(bf16_t, OFF_WDN1), 1024, 4096, scr, gwi, ngwi, lane);
        return;
    }
#pragma unroll 1
    for (int it = blockIdx.x; it < BATCH * 16; it += gridDim.x) {
        const int b = it >> 4, h = it & 15;
        __syncthreads();
        if (wave >= 4) {
            const int lw = wave - 4;
            const unsigned char* src[4]; int dst[4]; size_t step[4]; bool on[4];
#pragma unroll
            for (int i = 0; i < 4; ++i) { src[i] = A.ws; dst[i] = 0; step[i] = 0; on[i] = false; }
            if (lw < 2) {
#pragma unroll
                for (int i = 0; i < 4; ++i) { src[i] = piece_ptr(A, 4 * lw + i, lane, b * SEQ, h); dst[i] = (4 * lw + i) * 1024 + lane * 16; step[i] = (size_t)CH * DM * 2; on[i] = true; }
            } else if (lw == 2) {
                src[0] = SM + (size_t)it * NCHUNK * 2048 + lane * 32; src[1] = src[0] + 16; dst[0] = 8192 + lane * 32; dst[1] = dst[0] + 16; step[0] = step[1] = 2048; on[0] = on[1] = true;
                src[2] = (const unsigned char*)(WC + (size_t)it * NCHUNK * 64) + (lane & 15) * 16; dst[2] = 10240 + (lane & 15) * 16; step[2] = 256; on[2] = lane < 16;
            } else {
                src[0] = (const unsigned char*)(VV + (size_t)(b * SEQ + (lane >> 2)) * DM + h * 64 + (lane & 3) * 16); src[1] = src[0] + 16; dst[0] = 10496 + (lane >> 2) * 128 + (lane & 3) * 32; dst[1] = dst[0] + 16;
                step[0] = step[1] = (size_t)CH * DM * 2; on[0] = on[1] = true;
            }
            u32x4 ld[CS_PD][4];
#define LD_ISSUE(slotreg, chn) do { _Pragma("unroll") for (int i_ = 0; i_ < 4; ++i_) if (on[i_]) ld[slotreg][i_] = *(const u32x4*)(src[i_] + (size_t)(chn) * step[i_]); } while (0)
#define LD_WRITE(slotreg, chn) do { unsigned char* sl_ = slots + ((chn) % 3) * CS_SLOT; _Pragma("unroll") for (int i_ = 0; i_ < 4; ++i_) if (on[i_]) *(u32x4*)(sl_ + dst[i_]) = ld[slotreg][i_]; } while (0)
#pragma unroll
            for (int u = 0; u < CS_PD; ++u) LD_ISSUE(u, u);
            LD_WRITE(0, 0); LD_ISSUE(0, CS_PD);
            LD_WRITE(1, 1); LD_ISSUE(1, CS_PD + 1);
            CS_BAR();
#pragma unroll 1
            for (int ch = 0; ch < NCHUNK; ch += CS_PD) {
#pragma unroll
                for (int u = 0; u < CS_PD; ++u) {
                    const int cc = ch + u, wn = cc + 2;
                    if (wn < NCHUNK) { LD_WRITE((u + 2) % CS_PD, wn); if (wn + CS_PD < NCHUNK) LD_ISSUE((u + 2) % CS_PD, wn + CS_PD); }
                    CS_BAR();
                }
            }
#undef LD_ISSUE
#undef LD_WRITE
        } else {
            const int rt = wave;
            f32x4 St[4];
#pragma unroll
            for (int i = 0; i < 4; ++i) St[i] = (f32x4){0.f, 0.f, 0.f, 0.f};
            bf16x8 n0, n1, r0, r1, bk0, bk1, bk2, bk3, gr; u32x2 gnk, tt; unsigned short v0, v1, v2, v3; f32x4 w0, w1, w2, w3;
#define CS_LOAD(chn) do { const unsigned char* sl_ = slots + ((chn) % 3) * CS_SLOT; \
            n0 = *(const bf16x8*)(sl_ + lane * 16); n1 = *(const bf16x8*)(sl_ + 1024 + lane * 16); r0 = *(const bf16x8*)(sl_ + 2048 + lane * 16); r1 = *(const bf16x8*)(sl_ + 3072 + lane * 16); \
            bk0 = *(const bf16x8*)(sl_ + 4096 + lane * 16); bk1 = *(const bf16x8*)(sl_ + 5120 + lane * 16); bk2 = *(const bf16x8*)(sl_ + 6144 + lane * 16); bk3 = *(const bf16x8*)(sl_ + 7168 + lane * 16); \
            gnk = *(const u32x2*)(sl_ + 8192 + lane * 8); tt = *(const u32x2*)(sl_ + 8704 + lane * 8); gr = *(const bf16x8*)(sl_ + 9216 + lane * 16); \
            const float* wp_ = (const float*)(sl_ + 10240) + 4 * q; w0 = *(const f32x4*)(wp_); w1 = *(const f32x4*)(wp_ + 16); w2 = *(const f32x4*)(wp_ + 32); w3 = *(const f32x4*)(wp_ + 48); \
            const bf16_t* vp_ = (const bf16_t*)(sl_ + 10496) + (4 * q) * 64 + 16 * rt + c; v0 = vp_[0]; v1 = vp_[64]; v2 = vp_[128]; v3 = vp_[192]; } while (0)
            CS_BAR();
            CS_LOAD(0);
#pragma unroll 1
            for (int ch = 0; ch < NCHUNK; ++ch) {
                const int m0 = b * SEQ + ch * CH;
                const bf16x8 cn0 = n0, cn1 = n1, cr0 = r0, cr1 = r1, cb0 = bk0, cb1 = bk1, cb2 = bk2, cb3 = bk3, cgr = gr; const u32x2 cgnk = gnk, ctt = tt;
                const unsigned vlo = (unsigned)v0 | ((unsigned)v1 << 16), vhi = (unsigned)v2 | ((unsigned)v3 << 16); const f32x4 cw0 = w0, cw1 = w1, cw2 = w2, cw3 = w3;
                if (ch + 1 < NCHUNK) CS_LOAD(ch + 1);
                const f32x4 z = {0.f, 0.f, 0.f, 0.f};
                const bf16x8 bS0 = mk8(cvtpk(St[0][0], St[0][1]), cvtpk(St[0][2], St[0][3]), cvtpk(St[1][0], St[1][1]), cvtpk(St[1][2], St[1][3]));
                const bf16x8 bS1 = mk8(cvtpk(St[2][0], St[2][1]), cvtpk(St[2][2], St[2][3]), cvtpk(St[3][0], St[3][1]), cvtpk(St[3][2], St[3][3]));
                f32x4 X = __builtin_amdgcn_mfma_f32_16x16x32_bf16(cn0, bS0, z, 0, 0, 0);
                X = __builtin_amdgcn_mfma_f32_16x16x32_bf16(cn1, bS1, X, 0, 0, 0);
                X = __builtin_amdgcn_mfma_f32_16x16x32_bf16(mk8(cgnk.x, cgnk.y, 0u, 0u), mk8(vlo, vhi, 0u, 0u), X, 0, 0, 0);
                const f32x4 U = __builtin_amdgcn_mfma_f32_16x16x32_bf16(mk8(ctt.x, ctt.y, 0u, 0u), mk8(cvtpk(X[0], X[1]), cvtpk(X[2], X[3]), 0u, 0u), z, 0, 0, 0);
                const bf16x8 bUV = mk8(cvtpk(U[0], U[1]), cvtpk(U[2], U[3]), vlo, vhi);
                f32x4 Yt = __builtin_amdgcn_mfma_f32_16x16x32_bf16(cr0, bS0, z, 0, 0, 0);
                Yt = __builtin_amdgcn_mfma_f32_16x16x32_bf16(cr1, bS1, Yt, 0, 0, 0);
                Yt = __builtin_amdgcn_mfma_f32_16x16x32_bf16(cgr, bUV, Yt, 0, 0, 0);
                St[0] = __builtin_amdgcn_mfma_f32_16x16x32_bf16(cb0, bUV, St[0] * cw0, 0, 0, 0);
                St[1] = __builtin_amdgcn_mfma_f32_16x16x32_bf16(cb1, bUV, St[1] * cw1, 0, 0, 0);
                St[2] = __builtin_amdgcn_mfma_f32_16x16x32_bf16(cb2, bUV, St[2] * cw2, 0, 0, 0);
                St[3] = __builtin_amdgcn_mfma_f32_16x16x32_bf16(cb3, bUV, St[3] * cw3, 0, 0, 0);
                bf16_t* yp = Y + (size_t)(m0 + 4 * q) * DM + h * 64 + 16 * rt + c;
#pragma unroll
                for (int rg = 0; rg < 4; ++rg) {
                    yp[(size_t)rg * DM] = (bf16_t)f2bf(Yt[rg]);
                    const float s1 = row16_allsum(Yt[rg]), s2 = row16_allsum(Yt[rg] * Yt[rg]);
                    if (c == 0) *(f32x2*)(part + (((ch & 1) * 4 + rt) * 16 + 4 * q + rg) * 2) = (f32x2){s1, s2};
                }
                CS_BAR();
                if (rt == 0 && lane < 16) {
                    const float* pp = part + ((ch & 1) * 4 * 16 + lane) * 2; float s1 = 0.f, s2 = 0.f;
#pragma unroll
                    for (int w = 0; w < 4; ++w) { s1 += pp[w * 32]; s2 += pp[w * 32 + 1]; }
                    *(f32x4*)(ST + ((size_t)(m0 + lane) * 16 + h) * 4) = (f32x4){s1, s2, 0.f, 0.f};
                }
            }
#undef CS_LOAD
        }
    }
}
#undef CS_BAR

__device__ __forceinline__ void p18_final(const Args& A) {
    const int tid = opaque_tid(), lane = tid & 63, wave = tid >> 6;
    const int gw = blockIdx.x * NWAVES + wave, NGW = gridDim.x * NWAVES;
    const f32x4* gr = (const f32x4*)A.in[IN_FINN] + lane;
    for (int m = gw; m < MTOK; m += NGW) {
        f32x4* xr = (f32x4*)(A.out + (size_t)m * DM) + lane; f32x4 v[4]; float s = 0.f;
#pragma unroll
        for (int j = 0; j < 4; ++j) { v[j] = xr[64 * j]; s += (v[j].x * v[j].x + v[j].y * v[j].y) + (v[j].z * v[j].z + v[j].w * v[j].w); }
        const float rs = rsqrtf(wave_sum(s) * (1.f / DM) + NORM_EPS);
#pragma unroll
        for (int j = 0; j < 4; ++j) xr[64 * j] = v[j] * rs * gr[64 * j];
    }
}

typedef GAS unsigned gu32;
#define RLX_AGENT __ATOMIC_RELAXED, __HIP_MEMORY_SCOPE_AGENT
constexpr int CW_BAR = 4096;
constexpr int RING_BYTES = 131072, LDSCTL_OFF = RING_BYTES, MISC_OFF = LDSCTL_OFF + 320;
#define XB_TMO      128
#define XB_XCNT(j)  (256  + 64 * (j))
#define XB_XSUB(j)  (1280 + 64 * (j))
#define XB_XGEN(j)  (2304 + 64 * (j))
#define XB_TOP      3328
#define XB_TOPGEN   3392
#define XCD_BAR_WORDS 3456
#define XB_SPIN_CAP (1u << 18)

__device__ __forceinline__ unsigned xb_ld(unsigned* p)              { return __hip_atomic_load(p, __ATOMIC_RELAXED, __HIP_MEMORY_SCOPE_AGENT); }
__device__ __forceinline__ unsigned xb_add(unsigned* p, unsigned v) { return __hip_atomic_fetch_add(p, v, __ATOMIC_RELAXED, __HIP_MEMORY_SCOPE_AGENT); }
__device__ __forceinline__ unsigned xb_xcc_id() { return (unsigned)__builtin_amdgcn_s_getreg((3 << 11) | 20) & 0xFu; }
#define XB_SPIN(cond, bar) do { unsigned _sp = 0; while (cond) { __builtin_amdgcn_s_sleep(1); \
    if ((++_sp & 255u) == 0u) { if (xb_ld(&(bar)[XB_TMO])) break; if (_sp > XB_SPIN_CAP) { atomicAdd(&(bar)[XB_TMO], 1u); break; } } } } while (0)

struct XcdBarrier {
    unsigned* bar; unsigned x;
    volatile LAS unsigned* st;
};

__device__ __forceinline__ XcdBarrier xcd_barrier_post(unsigned* bar, volatile LAS unsigned* st) {
    XcdBarrier b; b.bar = bar; b.x = xb_xcc_id(); b.st = st;
    if (threadIdx.x == 0) (void)xb_add(&bar[XB_XCNT(b.x)], 1u);
    return b;
}
__device__ __forceinline__ void xcd_barrier_complete(unsigned* bar, unsigned x, unsigned& nloc, unsigned& nx) {
    const unsigned G = gridDim.x * gridDim.y * gridDim.z;
    unsigned sum, cnt, mine, sp = 0u;
    for (;;) {
        sum = 0u; cnt = 0u; mine = 0u;
#pragma unroll
        for (unsigned j = 0; j < 16; ++j) { const unsigned c = xb_ld(&bar[XB_XCNT(j)]); sum += c; cnt += (c > 0u) ? 1u : 0u; mine = (j == x) ? c : mine; }
        if (sum == G) break;
        __builtin_amdgcn_s_sleep(1);
        if ((++sp & 255u) == 0u) { if (xb_ld(&bar[XB_TMO])) break; if (sp > XB_SPIN_CAP) { atomicAdd(&bar[XB_TMO], 1u); break; } }
    }
    nloc = mine > 0u ? mine : 1u; nx = cnt > 0u ? cnt : 1u;
}

__device__ __forceinline__ void xcd_barrier(const XcdBarrier& b) {
    asm volatile("s_waitcnt vmcnt(0)" ::: "memory");
    __syncthreads();
    if (threadIdx.x == 0) {
        unsigned* bar = b.bar;
        __builtin_amdgcn_s_waitcnt(0);
        unsigned nloc = b.st[0], nx = b.st[1];
        if (nloc == 0u) { xcd_barrier_complete(bar, b.x, nloc, nx); b.st[0] = nloc; b.st[1] = nx; }
        const unsigned old = xb_add(&bar[XB_XSUB(b.x)], 1u);
        const unsigned gen = old / nloc;
        if (old + 1u == (gen + 1u) * nloc) {
            __builtin_amdgcn_fence(__ATOMIC_RELEASE, "agent");
            asm volatile("s_waitcnt vmcnt(0)" ::: "memory");
            const unsigned og = xb_add(&bar[XB_TOP], 1u);
            const unsigned tg = og / nx;
            if (og + 1u == (tg + 1u) * nx) xb_add(&bar[XB_TOPGEN], 1u);
            else XB_SPIN(xb_ld(&bar[XB_TOPGEN]) == tg, bar);
            __builtin_amdgcn_fence(__ATOMIC_ACQUIRE, "agent");
            xb_add(&bar[XB_XGEN(b.x)], 1u);
            asm volatile("s_waitcnt vmcnt(0)" ::: "memory");
        } else {
            XB_SPIN(xb_ld(&bar[XB_XGEN(b.x)]) == gen, bar);
            __builtin_amdgcn_fence(__ATOMIC_ACQUIRE, "agent");
            asm volatile("s_waitcnt vmcnt(0)" ::: "memory");
        }
    }
    __syncthreads();
}

constexpr int N_PHASES = 19;
template <int LO, int HI> __global__ void __launch_bounds__(NTHR, 2) mk_fwd(Args A) {
    extern __shared__ __attribute__((aligned(16))) unsigned char lds[];
#define IN(k) (LO <= (k) && (k) < HI)
    constexpr bool FUSED = (HI - LO) > 1;
    XcdBarrier bar; bar.bar = nullptr; bar.x = 0; bar.st = nullptr;
    if constexpr (FUSED) {
        for (int u = threadIdx.x; u < (LDS_BYTES - LDSCTL_OFF) / 4; u += NTHR) ((LAS unsigned*)((LAS unsigned char*)lds + LDSCTL_OFF))[u] = 0u;
        __syncthreads();
        bar = xcd_barrier_post(WSP(unsigned, OFF_CTL) + CW_BAR, (volatile LAS unsigned*)((LAS unsigned char*)lds + MISC_OFF) + 8);
    }
#define SEAM(k) do { if constexpr (FUSED && IN(k) && IN((k) + 1)) { if ((k) == 0) cg::this_grid().sync(); else xcd_barrier(bar); if (DBG_TS && blockIdx.x == 0 && threadIdx.x == 0) ((unsigned long long*)(A.ws + OFF_CTL + 16384))[(k) + 1] = __builtin_amdgcn_s_memrealtime(); } } while (0)
    if (DBG_TS && FUSED && blockIdx.x == 0 && threadIdx.x == 0) ((unsigned long long*)(A.ws + OFF_CTL + 16384))[0] = __builtin_amdgcn_s_memrealtime();
    if constexpr (IN(0)) p0_prologue(A, lds);
    if constexpr (FUSED && IN(0) && ((REP_MASK >> 0) & 1u)) xcd_barrier(bar);
    if constexpr (FUSED && IN(0) && ((REP_MASK >> 0) & 1u)) p0_prologue(A, lds);
    SEAM(0);
    if constexpr (IN(1)) {
        Gemm g{WSP(bf16_t, OFF_H0), WSP(bf16_t, OFF_H0), 1 << 30, WSP(bf16_t, OFF_WIN), MTOK, 2304, DM};
        EpiInProj E{WSP(bf16_t, OFF_QO), WSP(bf16_t, OFF_K), WSP(bf16_t, OFF_V), WSP(bf16_t, OFF_QI), WSP(bf16_t, OFF_KI), WSP(float, OFF_WI), WSP(float, OFF_ROPE)};
        gemm_phase(lds, g, E);
    }
    SEAM(1);
    if constexpr (IN(2)) { if (FAST_TOPK) p2_fast(A, lds); else p2_naive(A, lds);
#if DBG_TOPK
        __syncthreads(); p2_naive(A, lds, 160 * MiB);
#endif
    }
    if constexpr (FUSED && IN(2) && ((REP_MASK >> 2) & 1u)) xcd_barrier(bar);
    if constexpr (FUSED && IN(2) && ((REP_MASK >> 2) & 1u)) { if (FAST_TOPK) p2_fast(A, lds); else p2_naive(A, lds);
#if DBG_TOPK
        __syncthreads(); p2_naive(A, lds, 160 * MiB);
#endif
    }
    if constexpr (FUSED && IN(2) && PROBE_P2 > 0) { xcd_barrier(bar); p2_fast<PROBE_P2>(A, lds); }
    SEAM(2);
    if constexpr (IN(3)) {
#if DBG_TOPK
        {
            const int lane_ = threadIdx.x & 63, gw_ = blockIdx.x * NWAVES + (threadIdx.x >> 6);
            const unsigned* M1 = WSP(unsigned, OFF_MASK); const unsigned* M2 = WSP(unsigned, 160 * MiB); unsigned rows_ = 0, bits_ = 0, bad1_ = 0, bad2_ = 0;
            for (int m = gw_; m < MTOK; m += gridDim.x * NWAVES) { const unsigned d = M1[(size_t)m * 64 + lane_] ^ M2[(size_t)m * 64 + lane_]; const int nb = wave_allsum_i(__popc(d)); if (nb) { rows_ += 1; bits_ += nb; }
                const int t_ = m & (SEQ - 1), ex_ = t_ + 1 < 256 ? t_ + 1 : 256; if (wave_allsum_i(__popc(M1[(size_t)m * 64 + lane_])) != ex_) bad1_ += 1; if (wave_allsum_i(__popc(M2[(size_t)m * 64 + lane_])) != ex_) bad2_ += 1; }
            if (lane_ == 0) { atomicAdd(WSP(unsigned, OFF_CTL) + 1000, rows_); atomicAdd(WSP(unsigned, OFF_CTL) + 1001, bits_); atomicAdd(WSP(unsigned, OFF_CTL) + 1002, bad1_); atomicAdd(WSP(unsigned, OFF_CTL) + 1003, bad2_); }
        }
#endif
        if (FAST_ATTN) {
            static_assert(attn_body::ATTN_LDS_BYTES <= RING_BYTES, "attention LDS");
            const attn_body::AttnTensors AT{(const attn_body::bf16*)WSP(bf16_t, OFF_QO), (const attn_body::bf16*)WSP(bf16_t, OFF_K), (const attn_body::bf16*)WSP(bf16_t, OFF_V), (attn_body::bf16*)WSP(bf16_t, OFF_QO), WSP(unsigned, OFF_MASK)};
            const attn_body::StaticOrder S((int)gridDim.x, (int)blockIdx.x);
            attn_body::attn_phase<attn_body::StaticOrder>((char*)lds, AT, S);
        } else p3_naive(A, lds);
    }
    if constexpr (FUSED && REP_123 && IN(3)) xcd_barrier(bar);
    if constexpr (FUSED && REP_123 && IN(3)) {
        Gemm g{WSP(bf16_t, OFF_H0), WSP(bf16_t, OFF_H0), 1 << 30, WSP(bf16_t, OFF_WIN), MTOK, 2304, DM};
        EpiInProj E{WSP(bf16_t, OFF_QO), WSP(bf16_t, OFF_K), WSP(bf16_t, OFF_V), WSP(bf16_t, OFF_QI), WSP(bf16_t, OFF_KI), WSP(float, OFF_WI), WSP(float, OFF_ROPE)};
        gemm_phase(lds, g, E);
    }
    if constexpr (FUSED && REP_123 && IN(3)) xcd_barrier(bar);
    if constexpr (FUSED && REP_123 && IN(3)) { if (FAST_TOPK) p2_fast(A, lds); else p2_naive(A, lds);
#if DBG_TOPK
        __syncthreads(); p2_naive(A, lds, 160 * MiB);
#endif
    }
    if constexpr (FUSED && REP_123 && IN(3)) xcd_barrier(bar);
    if constexpr (FUSED && REP_123 && IN(3)) {
#if DBG_TOPK
        {
            const int lane_ = threadIdx.x & 63, gw_ = blockIdx.x * NWAVES + (threadIdx.x >> 6);
            const unsigned* M1 = WSP(unsigned, OFF_MASK); const unsigned* M2 = WSP(unsigned, 160 * MiB); unsigned rows_ = 0, bits_ = 0, bad1_ = 0, bad2_ = 0;
            for (int m = gw_; m < MTOK; m += gridDim.x * NWAVES) { const unsigned d = M1[(size_t)m * 64 + lane_] ^ M2[(size_t)m * 64 + lane_]; const int nb = wave_allsum_i(__popc(d)); if (nb) { rows_ += 1; bits_ += nb; }
                const int t_ = m & (SEQ - 1), ex_ = t_ + 1 < 256 ? t_ + 1 : 256; if (wave_allsum_i(__popc(M1[(size_t)m * 64 + lane_])) != ex_) bad1_ += 1; if (wave_allsum_i(__popc(M2[(size_t)m * 64 + lane_])) != ex_) bad2_ += 1; }
            if (lane_ == 0) { atomicAdd(WSP(unsigned, OFF_CTL) + 1000, rows_); atomicAdd(WSP(unsigned, OFF_CTL) + 1001, bits_); atomicAdd(WSP(unsigned, OFF_CTL) + 1002, bad1_); atomicAdd(WSP(unsigned, OFF_CTL) + 1003, bad2_); }
        }
#endif
        if (FAST_ATTN) {
            static_assert(attn_body::ATTN_LDS_BYTES <= RING_BYTES, "attention LDS");
            const attn_body::AttnTensors AT{(const attn_body::bf16*)WSP(bf16_t, OFF_QO), (const attn_body::bf16*)WSP(bf16_t, OFF_K), (const attn_body::bf16*)WSP(bf16_t, OFF_V), (attn_body::bf16*)WSP(bf16_t, OFF_QO), WSP(unsigned, OFF_MASK)};
            const attn_body::StaticOrder S((int)gridDim.x, (int)blockIdx.x);
            attn_body::attn_phase<attn_body::StaticOrder>((char*)lds, AT, S);
        } else p3_naive(A, lds);
    }
    SEAM(3);
    if constexpr (IN(4)) {
        Gemm g{WSP(bf16_t, OFF_QO), WSP(bf16_t, OFF_QO), 1 << 30, WSP(bf16_t, OFF_WO0), MTOK, DM, DM};
        EpiResid E{A.in[IN_X], A.out, WSP(bf16_t, OFF_XB), WSP(float, OFF_SSQ0)};
        gemm_phase(lds, g, E);
    }
    SEAM(4);
    if constexpr (IN(5)) {
        Gemm g{WSP(bf16_t, OFF_XB), WSP(bf16_t, OFF_XB), 1 << 30, WSP(bf16_t, OFF_WUP0), MTOK, FF, DM};
        EpiUp E{WSP(bf16_t, OFF_U), WSP(float, OFF_SSQ0)};
        gemm_phase(lds, g, E);
    }
    if constexpr (FUSED && IN(5) && ((REP_MASK >> 5) & 1u)) xcd_barrier(bar);
    if constexpr (FUSED && IN(5) && ((REP_MASK >> 5) & 1u)) {
        Gemm g{WSP(bf16_t, OFF_XB), WSP(bf16_t, OFF_XB), 1 << 30, WSP(bf16_t, OFF_WUP0), MTOK, FF, DM};
        EpiUp E{WSP(bf16_t, OFF_U), WSP(float, OFF_SSQ0)};
        gemm_phase(lds, g, E);
    }
    SEAM(5);
    if constexpr (IN(6)) {
        Gemm g{WSP(bf16_t, OFF_U), WSP(bf16_t, OFF_U), 1 << 30, WSP(bf16_t, OFF_WDN0), MTOK, DM, FF};
        EpiResid E{A.out, A.out, nullptr, nullptr};
        gemm_phase(lds, g, E);
    }
    SEAM(6);
    if constexpr (IN(7)) p7_prep(A);
    if constexpr (FUSED && IN(7) && ((REP_MASK >> 7) & 1u)) xcd_barrier(bar);
    if constexpr (FUSED && IN(7) && ((REP_MASK >> 7) & 1u)) p7_prep(A);
    SEAM(7);
    if constexpr (IN(8)) {
        Gemm g{WSP(bf16_t, OFF_XSR), WSP(bf16_t, OFF_XSK), 4, WSP(bf16_t, OFF_WRK), MTOK, 2048, DM};
        EpiStore E{WSP(bf16_t, OFF_R), DM, 4, WSP(bf16_t, OFF_KR), DM};
        gemm_phase(lds, g, E);
    }
    if constexpr (FUSED && IN(8) && ((REP_MASK >> 8) & 1u)) xcd_barrier(bar);
    if constexpr (FUSED && IN(8) && ((REP_MASK >> 8) & 1u)) {
        Gemm g{WSP(bf16_t, OFF_XSR), WSP(bf16_t, OFF_XSK), 4, WSP(bf16_t, OFF_WRK), MTOK, 2048, DM};
        EpiStore E{WSP(bf16_t, OFF_R), DM, 4, WSP(bf16_t, OFF_KR), DM};
        gemm_phase(lds, g, E);
    }
    SEAM(8);
    if constexpr (IN(9)) {
        Gemm g{WSP(bf16_t, OFF_XSV), WSP(bf16_t, OFF_H1), 4, WSP(bf16_t, OFF_WVL), MTOK, 1792, DM};
        EpiStore E{WSP(bf16_t, OFF_VV), DM, 4, WSP(bf16_t, OFF_P), 768};
        gemm_phase(lds, g, E);
    }
    if constexpr (FUSED && IN(9) && ((REP_MASK >> 9) & 1u)) xcd_barrier(bar);
    if constexpr (FUSED && IN(9) && ((REP_MASK >> 9) & 1u)) {
        Gemm g{WSP(bf16_t, OFF_XSV), WSP(bf16_t, OFF_H1), 4, WSP(bf16_t, OFF_WVL), MTOK, 1792, DM};
        EpiStore E{WSP(bf16_t, OFF_VV), DM, 4, WSP(bf16_t, OFF_P), 768};
        gemm_phase(lds, g, E);
    }
    SEAM(9);
    if constexpr (IN(10)) p10_loramid(A);
    if constexpr (FUSED && IN(10) && ((REP_MASK >> 10) & 1u)) xcd_barrier(bar);
    if constexpr (FUSED && IN(10) && ((REP_MASK >> 10) & 1u)) p10_loramid(A);
    SEAM(10);
    if constexpr (IN(11)) {
        Gemm g{WSP(bf16_t, OFF_AW), WSP(bf16_t, OFF_AA), 4, WSP(bf16_t, OFF_W2T), MTOK, 2048, 128};
        EpiLoraUp E{WSP(bf16_t, OFF_E), WSP(bf16_t, OFF_A), A.in[IN_W0], A.in[IN_A0]};
        gemm_phase(lds, g, E);
    }
    if constexpr (FUSED && IN(11) && ((REP_MASK >> 11) & 1u)) xcd_barrier(bar);
    if constexpr (FUSED && IN(11) && ((REP_MASK >> 11) & 1u)) {
        Gemm g{WSP(bf16_t, OFF_AW), WSP(bf16_t, OFF_AA), 4, WSP(bf16_t, OFF_W2T), MTOK, 2048, 128};
        EpiLoraUp E{WSP(bf16_t, OFF_E), WSP(bf16_t, OFF_A), A.in[IN_W0], A.in[IN_A0]};
        gemm_phase(lds, g, E);
    }
    SEAM(11);
    if constexpr (IN(12)) { if (CHUNK_SCAN) p12_chunk_prep(A, lds); else if (FAST_SCAN) p12_fast(A, lds); else p12_naive(A, lds); }
    if constexpr (FUSED && IN(12) && ((REP_MASK >> 12) & 1u)) xcd_barrier(bar);
    if constexpr (FUSED && IN(12) && ((REP_MASK >> 12) & 1u)) { if (FAST_SCAN) p12_fast(A, lds); else p12_naive(A, lds); }
    SEAM(12);
    if constexpr (IN(13)) { if (CHUNK_SCAN) p13_chunk_scan(A, lds); else if (!FAST_SCAN) p12b_stats(A); }
    SEAM(13);
    if constexpr (IN(14)) {
        Gemm g{WSP(bf16_t, OFF_AG), WSP(bf16_t, OFF_AG), 1 << 30, WSP(bf16_t, OFF_G2T), MTOK, DM, 256};
        EpiGatePost E{WSP(bf16_t, OFF_AO), WSP(bf16_t, CHUNK_SCAN ? OFF_R : OFF_Y), WSP(bf16_t, OFF_VV), WSP(float, OFF_STATS), WSP(float, OFF_BONUS), A.in[IN_LNW], A.in[IN_LNB]};
        gemm_phase(lds, g, E);
    }
    if constexpr (FUSED && IN(14) && ((REP_MASK >> 14) & 1u)) xcd_barrier(bar);
    if constexpr (FUSED && IN(14) && ((REP_MASK >> 14) & 1u)) {
        Gemm g{WSP(bf16_t, OFF_AG), WSP(bf16_t, OFF_AG), 1 << 30, WSP(bf16_t, OFF_G2T), MTOK, DM, 256};
        EpiGatePost E{WSP(bf16_t, OFF_AO), WSP(bf16_t, CHUNK_SCAN ? OFF_R : OFF_Y), WSP(bf16_t, OFF_VV), WSP(float, OFF_STATS), WSP(float, OFF_BONUS), A.in[IN_LNW], A.in[IN_LNB]};
        gemm_phase(lds, g, E);
    }
    SEAM(14);
    if constexpr (IN(15)) {
        Gemm g{WSP(bf16_t, OFF_AO), WSP(bf16_t, OFF_AO), 1 << 30, WSP(bf16_t, OFF_WO1), MTOK, DM, DM};
        EpiResid E{A.out, A.out, WSP(bf16_t, OFF_XB), WSP(float, OFF_SSQ1)};
        gemm_phase(lds, g, E);
    }
    SEAM(15);
    if constexpr (IN(16)) {
        Gemm g{WSP(bf16_t, OFF_XB), WSP(bf16_t, OFF_XB), 1 << 30, WSP(bf16_t, OFF_WUP1), MTOK, FF, DM};
        EpiUp E{WSP(bf16_t, OFF_U), WSP(float, OFF_SSQ1)};
        gemm_phase(lds, g, E);
    }
    if constexpr (FUSED && IN(16) && ((REP_MASK >> 16) & 1u)) xcd_barrier(bar);
    if constexpr (FUSED && IN(16) && ((REP_MASK >> 16) & 1u)) {
        Gemm g{WSP(bf16_t, OFF_XB), WSP(bf16_t, OFF_XB), 1 << 30, WSP(bf16_t, OFF_WUP1), MTOK, FF, DM};
        EpiUp E{WSP(bf16_t, OFF_U), WSP(float, OFF_SSQ1)};
        gemm_phase(lds, g, E);
    }
    SEAM(16);
    if constexpr (IN(17)) {
        Gemm g{WSP(bf16_t, OFF_U), WSP(bf16_t, OFF_U), 1 << 30, WSP(bf16_t, OFF_WDN1), MTOK, DM, FF};
        EpiResid E{A.out, A.out, nullptr, nullptr};
        gemm_phase(lds, g, E);
    }
    SEAM(17);
    if constexpr (IN(18)) {
        p18_final(A);
#if DBG_TS
        {   __syncthreads(); const unsigned long long* ts_ = (const unsigned long long*)(A.ws + OFF_CTL + 16384);
            const float usA_ = (float)(ts_[DBG_TS_A + 1] - ts_[DBG_TS_A]) * 0.01f;
            if (blockIdx.x == 1 && threadIdx.x == 0) A.out[12345] = usA_ * 0.2f; }
#endif
#if DBG_TOPK
        {   __syncthreads(); const float sc_ = 1.f + (float)WSP(unsigned, OFF_CTL)[1000 + DBG_WHICH] * DBG_UNIT;
            const int gw_ = blockIdx.x * NWAVES + (threadIdx.x >> 6), lane_ = threadIdx.x & 63;
            for (int m = gw_; m < MTOK; m += gridDim.x * NWAVES) for (int j = 0; j < 16; ++j) A.out[(size_t)m * DM + lane_ + 64 * j] *= sc_; }
#endif
    }
#undef IN
#undef SEAM
}

template <int P> static void launch_all(int grid, hipStream_t stream, const Args& a) {
    if constexpr (P < N_PHASES) {
        static bool attr_done = false;
        if (!attr_done) { (void)hipFuncSetAttribute((const void*)mk_fwd<P, P + 1>, hipFuncAttributeMaxDynamicSharedMemorySize, LDS_BYTES); attr_done = true; }
        hipLaunchKernelGGL((mk_fwd<P, P + 1>), dim3(grid), dim3(NTHR), LDS_BYTES, stream, a);
        launch_all<P + 1>(grid, stream, a);
    }
}
extern "C" void kernel_launch(void* const* d_in, const int* in_sizes, int n_in, void* d_out, int out_size, void* d_ws, size_t ws_size, hipStream_t stream) {
    static int grid = 0;
    if (grid == 0) {
        if (n_in != N_IN || out_size != MTOK * DM || ws_size < WS_END) { fprintf(stderr, "kernel_launch: unexpected shapes (n_in %d out %d ws %zu)\n", n_in, out_size, ws_size); grid = -1; return; }
        int dev = 0, cus = 0;
        (void)hipGetDevice(&dev); (void)hipDeviceGetAttribute(&cus, hipDeviceAttributeMultiprocessorCount, dev);
        grid = cus > 0 ? cus : 256;
    }
    if (grid < 0) return;
    (void)hipMemsetAsync((char*)d_ws + OFF_CTL, 0, CTL_BYTES, stream);
    Args a{};
    for (int i = 0; i < N_IN; ++i) a.in[i] = (const float*)d_in[i];
    a.out = (float*)d_out; a.ws = (unsigned char*)d_ws;
#if ONE_LAUNCH
    static bool attr_done = false;
    if (!attr_done) {
        (void)hipFuncSetAttribute((const void*)mk_fwd<0, N_PHASES>, hipFuncAttributeMaxDynamicSharedMemorySize, LDS_BYTES);
        int per_cu = 0;
        if (hipOccupancyMaxActiveBlocksPerMultiprocessor(&per_cu, (const void*)mk_fwd<0, N_PHASES>, NTHR, LDS_BYTES) != hipSuccess || per_cu < 1)
            fprintf(stderr, "kernel_launch: occupancy query reports %d blocks per CU\n", per_cu);
        (void)hipGetLastError();
        attr_done = true;
    }
    void* kargs[] = {(void*)&a};
    hipError_t e = hipLaunchCooperativeKernel((const void*)mk_fwd<0, N_PHASES>, dim3(grid), dim3(NTHR), kargs, LDS_BYTES, stream);
    if (e != hipSuccess) fprintf(stderr, "kernel_launch: cooperative launch failed: %s (grid %d)\n", hipGetErrorString(e), grid);
#else
    launch_all<0>(grid, stream, a);
#endif
}
```

```cpp
#include <hip/hip_runtime.h>
#include <hip/hip_cooperative_groups.h>
#include <hip/hip_bf16.h>
#include <cmath>
#include <cstdio>
#include <cstdint>
namespace cg = cooperative_groups;

#ifndef ONE_LAUNCH
#define ONE_LAUNCH 1
#endif
#ifndef DBG_TOPK
#define DBG_TOPK 0
#define DBG_WHICH 2
#define DBG_UNIT 0.001f
#endif
#ifndef REP_MASK
#define REP_MASK 0u
#endif
#ifndef REP_123
#define REP_123 0
#endif
#ifndef DBG_TS
#define DBG_TS 0
#define DBG_TS_A 12
#define DBG_TS_B 13
#endif
#ifndef PROBE_P2
#define PROBE_P2 0
#endif
#ifndef DEFER_W
#define DEFER_W 1
#endif
#ifndef CHUNK_SCAN
#define CHUNK_SCAN 1
#endif
#ifndef FAST_ATTN
#define FAST_ATTN 1
#endif
#ifndef FAST_TOPK
#define FAST_TOPK 1
#endif
#ifndef FAST_SCAN
#define FAST_SCAN 1
#endif
#ifndef FAST_GEMM
#define FAST_GEMM 1
#endif

#define LAS __attribute__((address_space(3)))
#define GAS __attribute__((address_space(1)))
typedef unsigned short bf16_t;
typedef short bf16x8 __attribute__((ext_vector_type(8)));
typedef float f32x4 __attribute__((ext_vector_type(4)));
typedef float f32x2 __attribute__((ext_vector_type(2)));
typedef unsigned u32x4 __attribute__((ext_vector_type(4)));
typedef unsigned u32x2 __attribute__((ext_vector_type(2)));

constexpr int BATCH = 8, SEQ = 2048, DM = 1024, MTOK = BATCH * SEQ, FF = 4096;
constexpr int NWAVES = 8, NTHR = 512;
constexpr int LDS_BYTES = 147456;
constexpr float NORM_EPS = 1e-6f, LNX_EPS = 64e-5f;
constexpr float QSCALE = 0.125f * 1.4426950408889634f;
constexpr float WI_SCALE = 0.044194173824159216f;

enum { IN_X = 0, IN_MIXN, IN_MLPN, IN_WUP, IN_WDN, IN_FINN, IN_WIN, IN_WO, IN_MU, IN_WRKV, IN_W0, IN_W1, IN_W2, IN_A0, IN_A1, IN_A2,
       IN_G1, IN_G2, IN_KK, IN_KA, IN_RK, IN_LNW, IN_LNB, IN_WO1, N_IN };

constexpr size_t MiB = 1u << 20;
constexpr size_t OFF_CTL = 0, CTL_BYTES = 1 * MiB;
constexpr size_t OFF_SSQ0 = 256 * 1024, OFF_SSQ1 = 320 * 1024;
constexpr size_t OFF_ROPE = 1 * MiB;
constexpr size_t OFF_WIN = 2 * MiB, OFF_WO0 = 7 * MiB, OFF_WUP0 = 9 * MiB, OFF_WDN0 = 17 * MiB, OFF_WRK = 25 * MiB, OFF_WVL = 29 * MiB;
constexpr size_t OFF_W2T = 33 * MiB, OFF_A2T = 33 * MiB + 256 * 1024, OFF_G2T = 33 * MiB + 512 * 1024, OFF_WO1 = 34 * MiB, OFF_WUP1 = 36 * MiB, OFF_WDN1 = 44 * MiB;
constexpr size_t OFF_BONUS = 2 * MiB;
constexpr size_t OFF_H0 = 52 * MiB, OFF_QO = 84 * MiB, OFF_K = 116 * MiB, OFF_V = 124 * MiB, OFF_QI = 132 * MiB, OFF_KI = 148 * MiB, OFF_WI = 150 * MiB, OFF_MASK = 152 * MiB;
constexpr size_t OFF_XB = 52 * MiB, OFF_U = 84 * MiB;
constexpr size_t OFF_XSR = 52 * MiB, OFF_XSK = 84 * MiB, OFF_XSV = 116 * MiB, OFF_H1 = 148 * MiB, OFF_R = 180 * MiB, OFF_KR = 212 * MiB;
constexpr size_t OFF_VV = 52 * MiB, OFF_P = 84 * MiB, OFF_AW = 108 * MiB, OFF_AA = 112 * MiB, OFF_AG = 244 * MiB;
constexpr size_t OFF_E = 116 * MiB, OFF_A = 148 * MiB, OFF_Y = 84 * MiB, OFF_STATS = 252 * MiB, OFF_AO = 116 * MiB;
constexpr size_t WS_END = 256 * MiB;

struct Args { const float* in[N_IN]; float* out; unsigned char* ws; int ph_lo, ph_hi; };
#define WSP(T, off) ((T*)(A.ws + (off)))

__device__ __forceinline__ float bf2f(bf16_t u) { return __uint_as_float((unsigned)u << 16); }
__device__ __forceinline__ unsigned f2bf(float f) { unsigned u = __float_as_uint(f); return (u + 0x7fffu + ((u >> 16) & 1u)) >> 16; }
__device__ __forceinline__ unsigned pk2(float lo, float hi) { return f2bf(lo) | (f2bf(hi) << 16); }
__device__ __forceinline__ float wave_sum(float v) {
#pragma unroll
    for (int o = 1; o < 64; o <<= 1) v += __shfl_xor(v, o);
    return v;
}
__device__ __forceinline__ float wave_max(float v) {
#pragma unroll
    for (int o = 1; o < 64; o <<= 1) v = fmaxf(v, __shfl_xor(v, o));
    return v;
}
#define LDS_WAIT() asm volatile("s_waitcnt lgkmcnt(0)" ::: "memory")
__device__ __forceinline__ int opaque_tid() { int t = threadIdx.x; asm volatile("" : "+v"(t)); return t; }
__device__ __forceinline__ float sigmoidf_(float z) { return __builtin_amdgcn_rcpf(1.f + __expf(-z)); }

__device__ __forceinline__ float block_sum(float v, float* red, int wave, int lane) {
    v = wave_sum(v); __syncthreads(); if (lane == 0) red[wave] = v; __syncthreads();
    float s = 0.f;
#pragma unroll
    for (int i = 0; i < NWAVES; ++i) s += red[i];
    return s;
}
__device__ __forceinline__ float block_max(float v, float* red, int wave, int lane) {
    v = wave_max(v); __syncthreads(); if (lane == 0) red[wave] = v; __syncthreads();
    float s = red[0];
#pragma unroll
    for (int i = 1; i < NWAVES; ++i) s = fmaxf(s, red[i]);
    return s;
}

template <int ID> __device__ __forceinline__ float wval(const Args& A, int n, int k) {
    if constexpr (ID == 0) {
        int col;
        if (n < 1280 || (n >= 1536 && n < 2112)) { const int hd = n >> 6, j = n & 63; col = (hd << 6) + (j >> 1) + ((j & 1) << 5); }
        else if (n < 2120) col = n; else return 0.f;
        return A.in[IN_WIN][(size_t)k * 2120 + col];
    } else if constexpr (ID == 1) { return A.in[IN_WO][(size_t)k * 1024 + n];
    } else if constexpr (ID == 2) { return A.in[IN_WUP][(size_t)k * 4096 + n] * A.in[IN_MLPN][k];
    } else if constexpr (ID == 3) { return A.in[IN_WDN][(size_t)k * 1024 + n];
    } else if constexpr (ID == 4) { return A.in[IN_WRKV][(size_t)(n >> 10) * 1048576 + (size_t)k * 1024 + (n & 1023)];
    } else if constexpr (ID == 5) {
        if (n < 1024) return A.in[IN_WRKV][(size_t)2 * 1048576 + (size_t)k * 1024 + n];
        const int j = n - 1024; const float* mu = A.in[IN_MU];
        if (j < 128) { const float m = mu[3 * 1024 + k], w = A.in[IN_W1][k * 64 + (j & 63)]; return (j < 64 ? 1.f - m : m) * w; }
        if (j < 256) { const float m = mu[4 * 1024 + k], w = A.in[IN_A1][k * 64 + (j & 63)]; return (j < 192 ? 1.f - m : m) * w; }
        if (j < 576) { const float m = mu[5 * 1024 + k]; const int jj = j - 256, c = jj < 160 ? jj : jj - 160; const float w = A.in[IN_G1][k * 160 + c]; return (jj < 160 ? 1.f - m : m) * w; }
        return 0.f;
    } else if constexpr (ID == 6) { return k < 64 ? A.in[IN_W2][(size_t)k * 1024 + n] : 0.f;
    } else if constexpr (ID == 7) { return k < 64 ? A.in[IN_A2][(size_t)k * 1024 + n] : 0.f;
    } else if constexpr (ID == 8) { return k < 160 ? A.in[IN_G2][(size_t)k * 1024 + n] : 0.f;
    } else if constexpr (ID == 9) { return A.in[IN_WO1][(size_t)k * 1024 + n];
    } else if constexpr (ID == 10) { return A.in[IN_WUP][(size_t)4194304 + (size_t)k * 4096 + n] * A.in[IN_MLPN][1024 + k];
    } else { return A.in[IN_WDN][(size_t)4194304 + (size_t)k * 1024 + n]; }
}
template <int ID> __device__ __forceinline__ void p0_weight(const Args& A, bf16_t* dst, int N, int K, float* scr, int gw, int NGW, int lane) {
    const int nblk = N / 32, nitems = (K / 64) * nblk;
    for (int it = gw; it < nitems; it += NGW) {
        const int kb = it / nblk, nb = it % nblk, k0 = 64 * kb, n0 = 32 * nb;
#pragma unroll 8
        for (int i = 0; i < 32; ++i) { const int kk = 2 * i + (lane >> 5); scr[kk * 33 + (lane & 31)] = wval<ID>(A, n0 + (lane & 31), k0 + kk); }
        LDS_WAIT();
        const int c = lane & 7;
#pragma unroll
        for (int j = 0; j < 4; ++j) { const int n = (lane >> 3) + 8 * j; const float* s = scr + (8 * c) * 33 + n;
            u32x4 o; o.x = pk2(s[0 * 33], s[1 * 33]); o.y = pk2(s[2 * 33], s[3 * 33]); o.z = pk2(s[4 * 33], s[5 * 33]); o.w = pk2(s[6 * 33], s[7 * 33]);
            *(u32x4*)(dst + (size_t)(n0 + n) * K + k0 + 8 * c) = o; }
        LDS_WAIT();
    }
}
__device__ __forceinline__ void rms_row_to_bf16(const float* xrow, const float* g, bf16_t* orow, int lane) {
    const f32x4* xr = (const f32x4*)xrow + lane; const f32x4* gr = (const f32x4*)g + lane;
    f32x4 v[4]; float s = 0.f;
#pragma unroll
    for (int j = 0; j < 4; ++j) { v[j] = xr[64 * j]; s += (v[j].x * v[j].x + v[j].y * v[j].y) + (v[j].z * v[j].z + v[j].w * v[j].w); }
    const float rs = rsqrtf(wave_sum(s) * (1.f / DM) + NORM_EPS);
    u32x2* o8 = (u32x2*)orow + lane;
#pragma unroll
    for (int j = 0; j < 4; ++j) { const f32x4 gg = gr[64 * j]; u32x2 w; w.x = pk2(v[j].x * rs * gg.x, v[j].y * rs * gg.y); w.y = pk2(v[j].z * rs * gg.z, v[j].w * rs * gg.w); o8[64 * j] = w; }
}
__device__ __forceinline__ void p0_prologue(const Args& A, unsigned char* lds) {
    const int tid = opaque_tid(), lane = tid & 63, wave = tid >> 6;
    float* scr = (float*)(lds + wave * 16384);
    const int gw = blockIdx.x * NWAVES + wave, NGW = gridDim.x * NWAVES;
    p0_weight<0>(A, WSP(bf16_t, OFF_WIN), 2304, 1024, scr, gw, NGW, lane);
    p0_weight<1>(A, WSP(bf16_t, OFF_WO0), 1024, 1024, scr, gw, NGW, lane);
    p0_weight<2>(A, WSP(bf16_t, OFF_WUP0), 4096, 1024, scr, gw, NGW, lane);
    p0_weight<3>(A, WSP(bf16_t, OFF_WDN0), 1024, 4096, scr, gw, NGW, lane);
    p0_weight<4>(A, WSP(bf16_t, OFF_WRK), 2048, 1024, scr, gw, NGW, lane);
    p0_weight<5>(A, WSP(bf16_t, OFF_WVL), 1792, 1024, scr, gw, NGW, lane);
    p0_weight<6>(A, WSP(bf16_t, OFF_W2T), 1024, 128, scr, gw, NGW, lane);
    p0_weight<7>(A, WSP(bf16_t, OFF_A2T), 1024, 128, scr, gw, NGW, lane);
    p0_weight<8>(A, WSP(bf16_t, OFF_G2T), 1024, 256, scr, gw, NGW, lane);
    if (!(DEFER_W && gridDim.x > BATCH * 16)) {
        p0_weight<9>(A, WSP(bf16_t, OFF_WO1), 1024, 1024, scr, gw, NGW, lane);
        p0_weight<10>(A, WSP(bf16_t, OFF_WUP1), 4096, 1024, scr, gw, NGW, lane);
        p0_weight<11>(A, WSP(bf16_t, OFF_WDN1), 1024, 4096, scr, gw, NGW, lane);
    }
    float* rc = WSP(float, OFF_ROPE); float* rsn = rc + 2048 * 32;
    for (int idx = blockIdx.x * NTHR + tid; idx < 2048 * 32; idx += gridDim.x * NTHR) {
        const int t = idx >> 5, d = idx & 31;
        double inv = 1.0; for (int i = 0; i < d; ++i) inv *= 0.74989420933245582730;
        const double ang = (double)t * inv;
        const double q = rint(ang * 0.63661977236758134308); const double r = (ang - q * 1.5707963267948966192) - q * 6.123233995736766036e-17;
        const double r2 = r * r;
        double sn = 1.0, cs = 1.0, ts = 1.0, tc = 1.0;
#pragma unroll
        for (int i = 1; i <= 9; ++i) { tc *= -r2 / (double)((2 * i - 1) * (2 * i)); ts *= -r2 / (double)((2 * i) * (2 * i + 1)); cs += tc; sn += ts; }
        sn *= r;
        const int qi = ((int)q) & 3;
        const double c = (qi == 0) ? cs : (qi == 1) ? -sn : (qi == 2) ? -cs : sn;
        const double s = (qi == 0) ? sn : (qi == 1) ? cs : (qi == 2) ? -sn : -cs;
        rc[idx] = (float)c; rsn[idx] = (float)s;
    }
    bf16_t* H0 = WSP(bf16_t, OFF_H0);
    for (int m = gw; m < MTOK; m += NGW) rms_row_to_bf16(A.in[IN_X] + (size_t)m * DM, A.in[IN_MIXN], H0 + (size_t)m * DM, lane);
}

struct Unit { int pm, pn; };
struct Gemm { const bf16_t* A; const bf16_t* A2; int pn2; const bf16_t* Bt; int M, N, K; };
constexpr int NXCD = 8, WGM = 8;
struct StaticOrder {
    int nM, nN, nwg, G, c;
    __device__ void init(int M, int N, int G_, int c_) { nM = M / 256; nN = N / 256; nwg = nM * nN; G = G_; c = c_; }
    __device__ bool next(int i, Unit& u) const {
        const long L = (long)i * G + c; if (L >= nwg) return false;
        int wgid = (int)L; { const int q = nwg / NXCD, r = nwg % NXCD, xcd = wgid % NXCD, off = wgid / NXCD; wgid = (xcd < r ? xcd * (q + 1) : r * (q + 1) + (xcd - r) * q) + off; }
        const int nig = WGM * nN, gid = wgid / nig, fm = gid * WGM, gsz = (nM - fm) < WGM ? (nM - fm) : WGM;
        u.pm = fm + ((wgid % nig) % gsz); u.pn = (wgid % nig) / gsz; return true;
    }
};
typedef f32x4 AccT[2][2][4][2];

template <class Epi> __device__ __forceinline__ void gemm_naive(const Gemm g, const Epi& E) {
    const int tid = opaque_tid(), wave = tid >> 6, lane = tid & 63, wr = wave >> 2, wc = wave & 3, fr = lane & 15, fq = lane >> 4;
    StaticOrder S; S.init(g.M, g.N, gridDim.x, blockIdx.x);
    Unit u;
    for (int i = 0; S.next(i, u); ++i) {
        AccT acc;
#pragma unroll
        for (int a = 0; a < 2; ++a)
#pragma unroll
            for (int b = 0; b < 2; ++b)
#pragma unroll
                for (int m = 0; m < 4; ++m)
#pragma unroll
                    for (int n = 0; n < 2; ++n) acc[a][b][m][n] = (f32x4){0.f, 0.f, 0.f, 0.f};
        const bf16_t* Ab = (u.pn >= g.pn2 ? g.A2 : g.A) + (size_t)(u.pm * 256 + wr * 64 + fr) * g.K;
        const bf16_t* Bb = g.Bt + (size_t)(u.pn * 256 + wc * 32) * g.K;
        for (int k0 = 0; k0 < g.K; k0 += 8) {
            bf16x8 af[2][4];
#pragma unroll
            for (int ai = 0; ai < 2; ++ai)
#pragma unroll
                for (int m = 0; m < 4; ++m) af[ai][m] = *(const bf16x8*)(Ab + (size_t)(ai * 128 + m * 16) * g.K + k0);
#pragma unroll
            for (int bj = 0; bj < 2; ++bj)
#pragma unroll
                for (int n = 0; n < 2; ++n)
#pragma unroll
                    for (int c = 0; c < 4; ++c) {
                        const int col = bj * 128 + (Epi::PERM ? 8 * fq + 4 * n + c : 16 * n + 4 * fq + c);
                        const bf16x8 b = *(const bf16x8*)(Bb + (size_t)col * g.K + k0);
                        float bf[8];
#pragma unroll
                        for (int e = 0; e < 8; ++e) bf[e] = bf2f((bf16_t)b[e]);
#pragma unroll
                        for (int ai = 0; ai < 2; ++ai)
#pragma unroll
                            for (int m = 0; m < 4; ++m) { float s = acc[ai][bj][m][n][c];
#pragma unroll
                                for (int e = 0; e < 8; ++e) s += bf2f((bf16_t)af[ai][m][e]) * bf[e];
                                acc[ai][bj][m][n][c] = s; }
                        asm volatile("" ::: "memory");
                    }
        }
        E(acc, u, wr, wc, fr, fq);
    }
}

struct EpiInProj {
    static constexpr bool PERM = true;
    bf16_t *Q, *K, *V, *QI, *KI; float* WI; const float* rope;
    __device__ __forceinline__ void operator()(const AccT& acc, const Unit& u, int wr, int wc, int fr, int fq) const {
        const int pn = u.pn;
#pragma unroll
        for (int ai = 0; ai < 2; ++ai)
#pragma unroll
            for (int m = 0; m < 4; ++m) {
                const int row = u.pm * 256 + ai * 128 + wr * 64 + m * 16 + fr, t = row & (SEQ - 1);
#pragma unroll
                for (int bj = 0; bj < 2; ++bj) {
                    const int cl = bj * 128 + wc * 32 + fq * 8;
                    f32x4 v0 = acc[ai][bj][m][0], v1 = acc[ai][bj][m][1];
                    const bool rot = (pn <= 4) || pn == 6 || pn == 7 || (pn == 8 && cl < 64);
                    if (rot) {
                        const int d0 = (cl & 63) >> 1;
                        const f32x4 c = *(const f32x4*)(rope + t * 32 + d0), s = *(const f32x4*)(rope + 2048 * 32 + t * 32 + d0);
                        f32x4 a0, a1;
                        a0.x = v0.x * c.x - v0.y * s.x; a0.y = v0.y * c.x + v0.x * s.x;
                        a0.z = v0.z * c.y - v0.w * s.y; a0.w = v0.w * c.y + v0.z * s.y;
                        a1.x = v1.x * c.z - v1.y * s.z; a1.y = v1.y * c.z + v1.x * s.z;
                        a1.z = v1.z * c.w - v1.w * s.w; a1.w = v1.w * c.w + v1.z * s.w;
                        v0 = a0; v1 = a1;
                    }
                    if (pn < 4) { v0 = v0 * QSCALE; v1 = v1 * QSCALE; }
                    u32x4 w; w.x = pk2(v0.x, v0.y); w.y = pk2(v0.z, v0.w); w.z = pk2(v1.x, v1.y); w.w = pk2(v1.z, v1.w);
                    if (pn < 4) *(u32x4*)(Q + (size_t)row * 1024 + pn * 256 + cl) = w;
                    else if (pn == 4) *(u32x4*)(K + (size_t)row * 256 + cl) = w;
                    else if (pn == 5) *(u32x4*)(V + (size_t)row * 256 + cl) = w;
                    else if (pn < 8) *(u32x4*)(QI + (size_t)row * 512 + (pn - 6) * 256 + cl) = w;
                    else { if (cl < 64) *(u32x4*)(KI + (size_t)row * 64 + cl) = w;
                           else if (cl == 64) { *(f32x4*)(WI + (size_t)row * 8) = v0 * WI_SCALE; *(f32x4*)(WI + (size_t)row * 8 + 4) = v1 * WI_SCALE; } }
                }
            }
    }
};
struct EpiResid {
    static constexpr bool PERM = false;
    const float* xin; float* xout; bf16_t* xb; float* ssq;
    __device__ __forceinline__ void operator()(const AccT& acc, const Unit& u, int wr, int wc, int fr, int fq) const {
#pragma unroll
        for (int ai = 0; ai < 2; ++ai)
#pragma unroll
            for (int m = 0; m < 4; ++m) {
                const int row = u.pm * 256 + ai * 128 + wr * 64 + m * 16 + fr; float s = 0.f;
#pragma unroll
                for (int bj = 0; bj < 2; ++bj)
#pragma unroll
                    for (int n = 0; n < 2; ++n) {
                        const size_t off = (size_t)row * DM + u.pn * 256 + bj * 128 + wc * 32 + n * 16 + fq * 4;
                        const f32x4 x = *(const f32x4*)(xin + off) + acc[ai][bj][m][n];
                        *(f32x4*)(xout + off) = x;
                        if (xb) { u32x2 w; w.x = pk2(x.x, x.y); w.y = pk2(x.z, x.w); *(u32x2*)(xb + off) = w; }
                        s += (x.x * x.x + x.y * x.y) + (x.z * x.z + x.w * x.w);
                    }
                if (ssq) { s += __shfl_xor(s, 16); s += __shfl_xor(s, 32); if (fq == 0) atomicAdd(ssq + row, s); }
            }
    }
};
struct EpiUp {
    static constexpr bool PERM = true;
    bf16_t* U; const float* ssq;
    __device__ __forceinline__ void operator()(const AccT& acc, const Unit& u, int wr, int wc, int fr, int fq) const {
#pragma unroll
        for (int ai = 0; ai < 2; ++ai)
#pragma unroll
            for (int m = 0; m < 4; ++m) {
                const int row = u.pm * 256 + ai * 128 + wr * 64 + m * 16 + fr;
                const float rs = rsqrtf(ssq[row] * (1.f / DM) + NORM_EPS);
#pragma unroll
                for (int bj = 0; bj < 2; ++bj) {
                    f32x4 v0 = acc[ai][bj][m][0] * rs, v1 = acc[ai][bj][m][1] * rs;
#pragma unroll
                    for (int c = 0; c < 4; ++c) { const float a = fmaxf(v0[c], 0.f), b = fmaxf(v1[c], 0.f); v0[c] = a * a; v1[c] = b * b; }
                    u32x4 w; w.x = pk2(v0.x, v0.y); w.y = pk2(v0.z, v0.w); w.z = pk2(v1.x, v1.y); w.w = pk2(v1.z, v1.w);
                    *(u32x4*)(U + (size_t)row * FF + u.pn * 256 + bj * 128 + wc * 32 + fq * 8) = w;
                }
            }
    }
};
struct EpiStore {
    static constexpr bool PERM = true;
    bf16_t* b0; int ld0; int split; bf16_t* b1; int ld1;
    __device__ __forceinline__ void operator()(const AccT& acc, const Unit& u, int wr, int wc, int fr, int fq) const {
        bf16_t* base = u.pn < split ? b0 + u.pn * 256 : b1 + (u.pn - split) * 256; const int ld = u.pn < split ? ld0 : ld1;
#pragma unroll
        for (int ai = 0; ai < 2; ++ai)
#pragma unroll
            for (int m = 0; m < 4; ++m) {
                const int row = u.pm * 256 + ai * 128 + wr * 64 + m * 16 + fr;
#pragma unroll
                for (int bj = 0; bj < 2; ++bj) {
                    const f32x4 v0 = acc[ai][bj][m][0], v1 = acc[ai][bj][m][1];
                    u32x4 w; w.x = pk2(v0.x, v0.y); w.y = pk2(v0.z, v0.w); w.z = pk2(v1.x, v1.y); w.w = pk2(v1.z, v1.w);
                    *(u32x4*)(base + (size_t)row * ld + bj * 128 + wc * 32 + fq * 8) = w;
                }
            }
    }
};
struct EpiLoraUp {
    static constexpr bool PERM = true;
    bf16_t* E; bf16_t* AS; const float* w0; const float* a0;
    __device__ __forceinline__ void operator()(const AccT& acc, const Unit& u, int wr, int wc, int fr, int fq) const {
        const bool dec = u.pn < 4; bf16_t* O = dec ? E : AS; const float* bias = dec ? w0 : a0; const float sc = dec ? -0.6065306597126334f : 1.f;
#pragma unroll
        for (int bj = 0; bj < 2; ++bj) {
            const int col = (u.pn & 3) * 256 + bj * 128 + wc * 32 + fq * 8;
            const f32x4 b0 = *(const f32x4*)(bias + col), b1 = *(const f32x4*)(bias + col + 4);
#pragma unroll
            for (int ai = 0; ai < 2; ++ai)
#pragma unroll
                for (int m = 0; m < 4; ++m) {
                    const int row = u.pm * 256 + ai * 128 + wr * 64 + m * 16 + fr;
                    f32x4 v0 = acc[ai][bj][m][0] + b0, v1 = acc[ai][bj][m][1] + b1;
#pragma unroll
                    for (int c = 0; c < 4; ++c) { v0[c] = sc * sigmoidf_(v0[c]); v1[c] = sc * sigmoidf_(v1[c]); }
                    u32x4 w; w.x = pk2(v0.x, v0.y); w.y = pk2(v0.z, v0.w); w.z = pk2(v1.x, v1.y); w.w = pk2(v1.z, v1.w);
                    *(u32x4*)(O + (size_t)row * DM + col) = w;
                    asm volatile("" ::: "memory");
                }
        }
    }
};
struct EpiGatePost {
    static constexpr bool PERM = true;
    bf16_t* AO; const bf16_t* Y; const bf16_t* V; const float* stats; const float* bonus; const float* lnw; const float* lnb;
    __device__ __forceinline__ void operator()(const AccT& acc, const Unit& u, int wr, int wc, int fr, int fq) const {
#pragma unroll
        for (int bj = 0; bj < 2; ++bj) {
            const int col = u.pn * 256 + bj * 128 + wc * 32 + fq * 8, hd = col >> 6;
            const f32x4 w0 = *(const f32x4*)(lnw + col), w1 = *(const f32x4*)(lnw + col + 4), c0 = *(const f32x4*)(lnb + col), c1 = *(const f32x4*)(lnb + col + 4);
#pragma unroll
            for (int ai = 0; ai < 2; ++ai)
#pragma unroll
                for (int m = 0; m < 4; ++m) {
                    const int row = u.pm * 256 + ai * 128 + wr * 64 + m * 16 + fr;
                    const f32x4 st = *(const f32x4*)(stats + ((size_t)row * 16 + hd) * 4);
                    const float mean = (st.x + st.z) * (1.f / 64.f), var = fmaxf((st.y + st.w) * (1.f / 64.f) - mean * mean, 0.f), rstd = rsqrtf(var + LNX_EPS);
                    const float bo = bonus[(size_t)row * 16 + hd];
                    const bf16x8 yv = *(const bf16x8*)(Y + (size_t)row * DM + col), vv = *(const bf16x8*)(V + (size_t)row * DM + col);
                    const f32x4 g0 = acc[ai][bj][m][0], g1 = acc[ai][bj][m][1];
                    float o[8];
#pragma unroll
                    for (int c = 0; c < 4; ++c) {
                        o[c] = ((bf2f((bf16_t)yv[c]) - mean) * rstd * w0[c] + c0[c] + bo * bf2f((bf16_t)vv[c])) * g0[c];
                        o[4 + c] = ((bf2f((bf16_t)yv[4 + c]) - mean) * rstd * w1[c] + c1[c] + bo * bf2f((bf16_t)vv[4 + c])) * g1[c];
                    }
                    u32x4 w; w.x = pk2(o[0], o[1]); w.y = pk2(o[2], o[3]); w.z = pk2(o[4], o[5]); w.w = pk2(o[6], o[7]);
                    *(u32x4*)(AO + (size_t)row * DM + col) = w;
                }
        }
    }
};

#define PG8_LAS __attribute__((address_space(3)))
constexpr int BM = 256, BK = 64, HALF = 128, HTB = HALF * BK * 2  , STAGE_BYTES = 8 * HTB;
__host__ __device__ __forceinline__ int lds_byte(int r, int c) { const int st = (r >> 4) * 2 + (c >> 5), rr = r & 15, cc = c & 31, ob = rr * 64 + cc * 2; return st * 1024 + (ob ^ (((ob >> 9) & 1) << 5)); }
__host__ __device__ __forceinline__ void stage_rc(int b, int& R, int& C) { const int st = b / 1024, sb = b % 1024, swz = sb ^ (((sb >> 9) & 1) << 5); R = (st >> 1) * 16 + swz / 64; C = (st & 1) * 32 + (swz % 64) / 2; }
__host__ __device__ __forceinline__ int perm32(int rho) { const int n = rho >> 4, i = rho & 15; return 8 * (i >> 2) + 4 * n + (i & 3); }
template <class Epi, bool ALIGN_EPI = true, bool SP2 = true>
__device__ __forceinline__ void gemm_fast(PG8_LAS unsigned char* lds, const Gemm g, const Epi& E) {
    StaticOrder S; S.init(g.M, g.N, gridDim.x, blockIdx.x);
    const int tid = opaque_tid(), wid = __builtin_amdgcn_readfirstlane(tid >> 6), lane = tid & 63, wr = wid >> 2, wc = wid & 3, fr = lane & 15, fq = lane >> 4;
    int K_ = g.K; asm volatile("" : "+s"(K_));
    const int K = K_, nt = K / BK;
    unsigned voffA[2], voffB[2];
#pragma unroll
    for (int i = 0; i < 2; ++i) { int R, C; stage_rc(tid * 16 + i * 8192, R, C); const int Rb = Epi::PERM ? ((R & ~31) + perm32(R & 31)) : R;
        voffA[i] = (unsigned)(R * K + C) * 2u; voffB[i] = (unsigned)(Rb * K + C) * 2u; }
    const size_t kstep = (size_t)(BK * 2);
    const size_t hstep = (size_t)HALF * K * 2;
    const size_t tstep = 2 * hstep;
    const unsigned ldsw = (unsigned)wid * 1024u;
    const int aoff = lds_byte(wr * 64 + fr, fq * 8), boff = lds_byte(wc * 32 + fr, fq * 8);
#define PG8_SA(b, h) (((b) * 2 + (h)) * HTB)
#define PG8_SB(b, h) ((4 + (b) * 2 + (h)) * HTB)
#define PG8_STAGE(bufoff, gbase, voff) do { _Pragma("unroll") for (int _i = 0; _i < 2; ++_i) \
        __builtin_amdgcn_global_load_lds((const unsigned*)((const char*)(gbase) + (voff)[_i]), (PG8_LAS unsigned*)(lds + (bufoff) + ldsw + _i * 8192), 16, 0, 0); } while (0)
#define PG8_LDA(dst, b, h) do { _Pragma("unroll") for (int m = 0; m < 4; ++m) _Pragma("unroll") for (int k = 0; k < 2; ++k) dst[m][k] = *(const PG8_LAS bf16x8*)(lds + PG8_SA(b, h) + aoff + m * 2048 + k * 1024); } while (0)
#define PG8_LDB(dst, b, h) do { _Pragma("unroll") for (int n = 0; n < 2; ++n) _Pragma("unroll") for (int k = 0; k < 2; ++k) dst[n][k] = *(const PG8_LAS bf16x8*)(lds + PG8_SB(b, h) + boff + n * 2048 + k * 1024); } while (0)
#define PG8_MMA(ai, bj, At, Bt) do { __builtin_amdgcn_s_setprio(1); _Pragma("unroll") for (int m = 0; m < 4; ++m) _Pragma("unroll") for (int n = 0; n < 2; ++n) _Pragma("unroll") for (int k = 0; k < 2; ++k) \
        acc[ai][bj][m][n] = __builtin_amdgcn_mfma_f32_16x16x32_bf16(Bt[n][k], At[m][k], acc[ai][bj][m][n], 0, 0, 0); __builtin_amdgcn_s_setprio(0); } while (0)
#define PG8_WAIT_V(n) asm volatile("s_waitcnt vmcnt(" #n ")" ::: "memory")
#define PG8_WAIT_L(n) asm volatile("s_waitcnt lgkmcnt(" #n ")" ::: "memory")
#define PG8_BAR __builtin_amdgcn_s_barrier()
#define PG8_SCHED __builtin_amdgcn_sched_barrier(0)
    Unit cur, nxt; int ui = 0;
    if (!S.next(0, cur)) return;
    AccT acc;
#pragma unroll
    for (int a = 0; a < 2; ++a)
#pragma unroll
        for (int b = 0; b < 2; ++b)
#pragma unroll
            for (int m = 0; m < 4; ++m)
#pragma unroll
                for (int n = 0; n < 2; ++n) acc[a][b][m][n] = (f32x4){0.f, 0.f, 0.f, 0.f};
    bf16x8 At[4][2], B0[2][2], B1[2][2];
    const char* cA = (const char*)(cur.pn >= g.pn2 ? g.A2 : g.A) + (size_t)cur.pm * tstep; const char* cB = (const char*)g.Bt + (size_t)cur.pn * tstep;
    if constexpr (SP2) {
        PG8_STAGE(PG8_SB(0, 0), cB, voffB); PG8_STAGE(PG8_SB(0, 1), cB + hstep, voffB); PG8_STAGE(PG8_SA(0, 0), cA, voffA); PG8_STAGE(PG8_SA(0, 1), cA + hstep, voffA);
        if (wr == 1) PG8_BAR;
        PG8_WAIT_V(2); PG8_BAR;
        PG8_STAGE(PG8_SB(1, 0), cB + kstep, voffB); PG8_STAGE(PG8_SA(1, 0), cA + kstep, voffA); PG8_STAGE(PG8_SB(1, 1), cB + hstep + kstep, voffB);
        PG8_WAIT_V(6); PG8_BAR;
    } else {
        PG8_STAGE(PG8_SB(0, 0), cB, voffB); PG8_STAGE(PG8_SA(0, 0), cA, voffA); PG8_STAGE(PG8_SB(0, 1), cB + hstep, voffB); PG8_STAGE(PG8_SA(0, 1), cA + hstep, voffA);
        if (wr == 1) PG8_BAR;
        PG8_WAIT_V(4); PG8_BAR;
        PG8_STAGE(PG8_SB(1, 0), cB + kstep, voffB); PG8_STAGE(PG8_SA(1, 0), cA + kstep, voffA); PG8_STAGE(PG8_SB(1, 1), cB + hstep + kstep, voffB);
        PG8_WAIT_V(6); PG8_BAR;
    }
    for (;;) {
        const bool has_next = S.next(ui + 1, nxt);
        const char* nA = has_next ? (const char*)(nxt.pn >= g.pn2 ? g.A2 : g.A) + (size_t)nxt.pm * tstep : cA; const char* nB = has_next ? (const char*)g.Bt + (size_t)nxt.pn * tstep : cB;
        for (int t = 0; t < nt; t += 2) {
            const bool last = (t == nt - 2);
            const char* a1 = cA + (size_t)(t + 1) * kstep;
            const char* a2 = last ? nA : cA + (size_t)(t + 2) * kstep; const char* b2 = last ? nB : cB + (size_t)(t + 2) * kstep;
            const char* a3 = a2 + kstep; const char* b3 = b2 + kstep;
            if constexpr (SP2) {
            PG8_LDB(B0, 0, 0); PG8_LDB(B1, 0, 1); PG8_SCHED; PG8_LDA(At, 0, 0); PG8_STAGE(PG8_SA(1, 1), a1 + hstep, voffA);
            PG8_WAIT_V(8); PG8_WAIT_L(0); PG8_BAR; PG8_MMA(0, 0, At, B0); PG8_MMA(0, 1, At, B1); PG8_BAR; PG8_SCHED;
            PG8_LDA(At, 0, 1); PG8_STAGE(PG8_SB(0, 0), b2, voffB); PG8_STAGE(PG8_SB(0, 1), b2 + hstep, voffB); PG8_STAGE(PG8_SA(0, 0), a2, voffA);
            PG8_WAIT_V(8); PG8_WAIT_L(0); PG8_BAR; PG8_MMA(1, 0, At, B0); PG8_MMA(1, 1, At, B1); PG8_BAR; PG8_SCHED;
            PG8_LDB(B0, 1, 0); PG8_LDB(B1, 1, 1); PG8_SCHED; PG8_LDA(At, 1, 0); PG8_STAGE(PG8_SA(0, 1), a2 + hstep, voffA);
            PG8_WAIT_V(8); PG8_WAIT_L(0); PG8_BAR; PG8_MMA(0, 0, At, B0); PG8_MMA(0, 1, At, B1); PG8_BAR; PG8_SCHED;
            PG8_LDA(At, 1, 1); PG8_STAGE(PG8_SB(1, 0), b3, voffB); PG8_STAGE(PG8_SB(1, 1), b3 + hstep, voffB); PG8_STAGE(PG8_SA(1, 0), a3, voffA);
            PG8_WAIT_V(8); PG8_WAIT_L(0); PG8_BAR; PG8_MMA(1, 0, At, B0); PG8_MMA(1, 1, At, B1); PG8_BAR; PG8_SCHED;
            } else {
            PG8_LDB(B0, 0, 0); PG8_SCHED; PG8_LDA(At, 0, 0); PG8_STAGE(PG8_SA(1, 1), a1 + hstep, voffA);
            PG8_WAIT_L(8); PG8_BAR; PG8_WAIT_L(0); PG8_MMA(0, 0, At, B0); PG8_BAR; PG8_SCHED;
            PG8_LDB(B1, 0, 1); PG8_STAGE(PG8_SB(0, 0), b2, voffB);
            PG8_BAR; PG8_WAIT_L(0); PG8_MMA(0, 1, At, B1); PG8_BAR;
            PG8_LDA(At, 0, 1); PG8_STAGE(PG8_SA(0, 0), a2, voffA);
            PG8_BAR; PG8_WAIT_L(0); PG8_MMA(1, 0, At, B0); PG8_BAR; PG8_SCHED;
            PG8_STAGE(PG8_SB(0, 1), b2 + hstep, voffB);
            PG8_WAIT_V(6); PG8_BAR; PG8_MMA(1, 1, At, B1); PG8_BAR;
            PG8_LDB(B0, 1, 0); PG8_SCHED; PG8_LDA(At, 1, 0); PG8_STAGE(PG8_SA(0, 1), a2 + hstep, voffA);
            PG8_WAIT_L(8); PG8_BAR; PG8_WAIT_L(0); PG8_MMA(0, 0, At, B0); PG8_BAR; PG8_SCHED;
            PG8_LDB(B1, 1, 1); PG8_STAGE(PG8_SB(1, 0), b3, voffB);
            PG8_BAR; PG8_WAIT_L(0); PG8_MMA(0, 1, At, B1); PG8_BAR;
            PG8_LDA(At, 1, 1); PG8_STAGE(PG8_SA(1, 0), a3, voffA);
            PG8_BAR; PG8_WAIT_L(0); PG8_MMA(1, 0, At, B0); PG8_BAR; PG8_SCHED;
            PG8_STAGE(PG8_SB(1, 1), b3 + hstep, voffB);
            PG8_WAIT_V(6); PG8_BAR; PG8_MMA(1, 1, At, B1); PG8_BAR;
            }
        }
        if constexpr (ALIGN_EPI) { if (wr == 0) PG8_BAR; }
        E(acc, cur, wr, wc, fr, fq);
        if (!has_next) break;
#pragma unroll
        for (int a = 0; a < 2; ++a)
#pragma unroll
            for (int b = 0; b < 2; ++b)
#pragma unroll
                for (int m = 0; m < 4; ++m)
#pragma unroll
                    for (int n = 0; n < 2; ++n) acc[a][b][m][n] = (f32x4){0.f, 0.f, 0.f, 0.f};
        cur = nxt; cA = nA; cB = nB; ++ui;
        if constexpr (ALIGN_EPI) { if (wr == 1) PG8_BAR; }
    }
    PG8_WAIT_V(0);
    if constexpr (!ALIGN_EPI) { if (wr == 0) PG8_BAR; }
    PG8_BAR;
#undef PG8_SA
#undef PG8_SB
#undef PG8_STAGE
#undef PG8_LDA
#undef PG8_LDB
#undef PG8_MMA
#undef PG8_WAIT_V
#undef PG8_WAIT_L
#undef PG8_BAR
#undef PG8_SCHED
}

template <class Epi> __device__ __forceinline__ void gemm_phase(unsigned char* lds, const Gemm g, const Epi& E) {
#if FAST_GEMM
    gemm_fast<Epi>((PG8_LAS unsigned char*)lds, g, E);
#else
    gemm_naive<Epi>(g, E);
#endif
}

__device__ __forceinline__ void p2_naive(const Args& A, unsigned char* lds, size_t mask_off = OFF_MASK) {
    const int tid = opaque_tid(), lane = tid & 63, wave = tid >> 6;
    float* sc = (float*)lds; float* qf = sc + 2048; float* wf = qf + 512;
    const bf16_t* QI = WSP(bf16_t, OFF_QI); const bf16_t* KI = WSP(bf16_t, OFF_KI); const float* WI = WSP(float, OFF_WI); unsigned* MASK = WSP(unsigned, mask_off);
    for (int m = blockIdx.x; m < MTOK; m += gridDim.x) {
        const int t = m & (SEQ - 1), b0 = m - t, nk = t + 1;
        unsigned* mrow = MASK + (size_t)m * 64;
        if (t < 256) { if (tid < 64) { const int lo = tid * 32; mrow[tid] = (nk >= lo + 32) ? 0xffffffffu : (nk <= lo ? 0u : ((1u << (nk - lo)) - 1u)); } continue; }
        __syncthreads();
        qf[tid] = bf2f(QI[(size_t)m * 512 + tid]);
        if (tid < 8) wf[tid] = WI[(size_t)m * 8 + tid];
        __syncthreads();
        for (int s = tid; s < nk; s += NTHR) {
            const bf16_t* kr = KI + (size_t)(b0 + s) * 64; float kf[64];
#pragma unroll
            for (int c = 0; c < 8; ++c) { const bf16x8 kv = *(const bf16x8*)(kr + 8 * c);
#pragma unroll
                for (int e = 0; e < 8; ++e) kf[8 * c + e] = bf2f((bf16_t)kv[e]); }
            float score = 0.f;
#pragma unroll
            for (int h = 0; h < 8; ++h) { float d = 0.f;
#pragma unroll
                for (int e = 0; e < 64; ++e) d += qf[h * 64 + e] * kf[e];
                score += wf[h] * fmaxf(d, 0.f); }
            sc[s] = score;
        }
        __syncthreads();
#pragma unroll 1
        for (int j = 0; j < 4; ++j) {
            const int base = 512 * j + 64 * wave;
            if (base >= nk) { if (lane < 2) mrow[(base >> 5) + lane] = 0u; continue; }
            const int s = base + lane; const bool valid = s < nk; const float my = valid ? sc[s] : 0.f; int cnt = 0;
            for (int s2 = 0; s2 < nk; ++s2) { const float o = sc[s2]; cnt += ((o > my) || (o == my && s2 < s)) ? 1 : 0; }
            const unsigned long long bal = __ballot(valid && cnt < 256);
            if (lane == 0) { mrow[base >> 5] = (unsigned)bal; mrow[(base >> 5) + 1] = (unsigned)(bal >> 32); }
        }
    }
}

__device__ __forceinline__ void p3_naive(const Args& A, unsigned char* lds) {
    const int tid = opaque_tid(), lane = tid & 63, wave = tid >> 6;
    float* lg = (float*)lds; float* qf = lg + 2048; float* red = qf + 1024; unsigned* mw = (unsigned*)(red + 1024);
    bf16_t* QO = WSP(bf16_t, OFF_QO); const bf16_t* K = WSP(bf16_t, OFF_K); const bf16_t* V = WSP(bf16_t, OFF_V); const unsigned* MASK = WSP(unsigned, OFF_MASK);
    for (int m = blockIdx.x; m < MTOK; m += gridDim.x) {
        const int t = m & (SEQ - 1), b0 = m - t, nk = t + 1;
        __syncthreads();
        qf[tid] = bf2f(QO[(size_t)m * 1024 + tid]); qf[tid + 512] = bf2f(QO[(size_t)m * 1024 + 512 + tid]);
        if (tid < 64) mw[tid] = MASK[(size_t)m * 64 + tid];
        __syncthreads();
#pragma unroll 1
        for (int hd = 0; hd < 16; ++hd) {
            const int n = hd >> 2; float mx = -INFINITY;
            for (int s = tid; s < nk; s += NTHR) {
                float v = -INFINITY;
                if ((mw[s >> 5] >> (s & 31)) & 1u) {
                    const bf16_t* kr = K + (size_t)(b0 + s) * 256 + n * 64; float d = 0.f;
#pragma unroll
                    for (int c = 0; c < 8; ++c) { const bf16x8 kv = *(const bf16x8*)(kr + 8 * c);
#pragma unroll
                        for (int e = 0; e < 8; ++e) d += qf[hd * 64 + 8 * c + e] * bf2f((bf16_t)kv[e]); }
                    v = d;
                }
                lg[s] = v; mx = fmaxf(mx, v);
            }
            mx = block_max(mx, red, wave, lane);
            float sm = 0.f;
            for (int s = tid; s < nk; s += NTHR) { const float p = exp2f(lg[s] - mx); lg[s] = p; sm += p; }
            sm = block_sum(sm, red, wave, lane);
            float acc = 0.f;
            for (int s = wave; s < nk; s += NWAVES) { const float p = lg[s]; if (p != 0.f) acc += p * bf2f(V[(size_t)(b0 + s) * 256 + n * 64 + lane]); }
            __syncthreads();
            red[16 + wave * 64 + lane] = acc;
            __syncthreads();
            if (tid < 64) { float o = 0.f;
#pragma unroll
                for (int p = 0; p < NWAVES; ++p) o += red[16 + p * 64 + tid];
                QO[(size_t)m * 1024 + hd * 64 + tid] = (bf16_t)f2bf(o / sm); }
            __syncthreads();
        }
    }
}

__device__ __forceinline__ void p7_prep(const Args& A) {
    const int tid = opaque_tid(), lane = tid & 63, wave = tid >> 6;
    const int gw = blockIdx.x * NWAVES + wave, NGW = gridDim.x * NWAVES;
    const float* X = A.out; const float* g = A.in[IN_MIXN] + DM; const float* mu = A.in[IN_MU];
    bf16_t* XSR = WSP(bf16_t, OFF_XSR); bf16_t* XSK = WSP(bf16_t, OFF_XSK); bf16_t* XSV = WSP(bf16_t, OFF_XSV); bf16_t* H1 = WSP(bf16_t, OFF_H1);
    f32x4 gg[4], mr[4], mk[4], mv[4];
#pragma unroll
    for (int j = 0; j < 4; ++j) { gg[j] = ((const f32x4*)g)[lane + 64 * j]; mr[j] = ((const f32x4*)mu)[lane + 64 * j]; mk[j] = ((const f32x4*)(mu + DM))[lane + 64 * j]; mv[j] = ((const f32x4*)(mu + 2 * DM))[lane + 64 * j]; }
    for (int run = gw; run < MTOK / 16; run += NGW) {
        const int r0 = run * 16; f32x4 hp[4];
#pragma unroll 1
        for (int i = -1; i < 16; ++i) {
            const int row = r0 + i; f32x4 h[4];
            if (i < 0 && (r0 & (SEQ - 1)) == 0) {
#pragma unroll
                for (int j = 0; j < 4; ++j) hp[j] = (f32x4){0.f, 0.f, 0.f, 0.f};
                continue;
            }
            const f32x4* xr = (const f32x4*)(X + (size_t)row * DM) + lane; float s = 0.f;
#pragma unroll
            for (int j = 0; j < 4; ++j) { h[j] = xr[64 * j]; s += (h[j].x * h[j].x + h[j].y * h[j].y) + (h[j].z * h[j].z + h[j].w * h[j].w); }
            const float rs = rsqrtf(wave_sum(s) * (1.f / DM) + NORM_EPS);
#pragma unroll
            for (int j = 0; j < 4; ++j) h[j] = h[j] * rs * gg[j];
            if (i >= 0) {
#pragma unroll
                for (int j = 0; j < 4; ++j) {
                    const f32x4 xx = hp[j] - h[j];
                    const f32x4 a = h[j] + xx * mr[j], b = h[j] + xx * mk[j], c = h[j] + xx * mv[j];
                    const size_t off = (size_t)row * DM + 4 * lane + 256 * j;
                    u32x2 w; w.x = pk2(a.x, a.y); w.y = pk2(a.z, a.w); *(u32x2*)(XSR + off) = w;
                    w.x = pk2(b.x, b.y); w.y = pk2(b.z, b.w); *(u32x2*)(XSK + off) = w;
                    w.x = pk2(c.x, c.y); w.y = pk2(c.z, c.w); *(u32x2*)(XSV + off) = w;
                    w.x = pk2(h[j].x, h[j].y); w.y = pk2(h[j].z, h[j].w); *(u32x2*)(H1 + off) = w;
                }
            }
#pragma unroll
            for (int j = 0; j < 4; ++j) hp[j] = h[j];
        }
    }
}
__device__ __forceinline__ void p10_loramid(const Args& A) {
    const bf16_t* P = WSP(bf16_t, OFF_P); bf16_t* AW = WSP(bf16_t, OFF_AW); bf16_t* AA = WSP(bf16_t, OFF_AA); bf16_t* AG = WSP(bf16_t, OFF_AG);
    const size_t total = (size_t)MTOK * 512;
    for (size_t idx = (size_t)blockIdx.x * NTHR + threadIdx.x; idx < total; idx += (size_t)gridDim.x * NTHR) {
        const int m = (int)(idx >> 9), j = (int)(idx & 511); const bool first = (m & (SEQ - 1)) == 0;
        const bf16_t* p0 = P + (size_t)m * 768; const bf16_t* pm = p0 - 768;
        if (j < 128) {
            float v = 0.f; if (j < 64) { const float x = bf2f(p0[j]) + (first ? 0.f : bf2f(pm[64 + j])); const float e = __expf(-2.f * fabsf(x)); const float th = (1.f - e) / (1.f + e); v = x < 0.f ? -th : th; }
            AW[(size_t)m * 128 + j] = (bf16_t)f2bf(v);
        } else if (j < 256) {
            const int jj = j - 128; float v = 0.f; if (jj < 64) v = bf2f(p0[128 + jj]) + (first ? 0.f : bf2f(pm[192 + jj]));
            AA[(size_t)m * 128 + jj] = (bf16_t)f2bf(v);
        } else {
            const int jj = j - 256; float v = 0.f; if (jj < 160) { const float x = bf2f(p0[256 + jj]) + (first ? 0.f : bf2f(pm[416 + jj])); v = sigmoidf_(x); }
            AG[(size_t)m * 256 + jj] = (bf16_t)f2bf(v);
        }
    }
}
__device__ __forceinline__ void p12_naive(const Args& A, unsigned char* lds) {
    const int tid = opaque_tid(), lane = tid & 63, wave = tid >> 6;
    const int gw = blockIdx.x * NWAVES + wave, NGW = gridDim.x * NWAVES;
    float* sh = (float*)lds + wave * 320;
    const bf16_t* R = WSP(bf16_t, OFF_R); const bf16_t* KR = WSP(bf16_t, OFF_KR); const bf16_t* VV = WSP(bf16_t, OFF_VV); const bf16_t* E = WSP(bf16_t, OFF_E); const bf16_t* AS = WSP(bf16_t, OFF_A);
    bf16_t* Y = WSP(bf16_t, OFF_Y);
    for (int it = gw; it < BATCH * 16; it += NGW) {
        const int b = it >> 4, h = it & 15;
        float S[64];
#pragma unroll
        for (int j = 0; j < 64; ++j) S[j] = 0.f;
        const float kkw = A.in[IN_KK][h * 64 + lane], kaw = A.in[IN_KA][h * 64 + lane];
        const size_t base = (size_t)b * SEQ * DM + h * 64 + lane;
        bf16_t rn = R[base], kn = KR[base], vn = VV[base], en = E[base], an = AS[base];
#pragma unroll 1
        for (int t = 0; t < SEQ; ++t) {
            const float r = bf2f(rn), k = bf2f(kn), v = bf2f(vn), e = bf2f(en), a = bf2f(an);
            if (t + 1 < SEQ) { const size_t ix = base + (size_t)(t + 1) * DM; rn = R[ix]; kn = KR[ix]; vn = VV[ix]; en = E[ix]; an = AS[ix]; }
            float kk = k * kkw; const float ss = wave_sum(kk * kk); kk *= rsqrtf(fmaxf(ss, 1e-24f));
            const float kt = k * (1.f + (a - 1.f) * kaw), bb = kk * a, w = __expf(e);
            sh[lane] = -kk; sh[64 + lane] = w; sh[128 + lane] = bb; sh[192 + lane] = kt; sh[256 + lane] = r;
            LDS_WAIT();
            float sa = 0.f;
#pragma unroll
            for (int j = 0; j < 64; ++j) sa += S[j] * sh[j];
            float y = 0.f;
#pragma unroll
            for (int j = 0; j < 64; ++j) { S[j] = S[j] * sh[64 + j] + sa * sh[128 + j] + v * sh[192 + j]; y += S[j] * sh[256 + j]; }
            Y[base + (size_t)t * DM] = (bf16_t)f2bf(y);
            LDS_WAIT();
        }
    }
}
__device__ __forceinline__ void p12b_stats(const Args& A) {
    const int tid = opaque_tid(), lane = tid & 63, wave = tid >> 6;
    const int gw = blockIdx.x * NWAVES + wave, NGW = gridDim.x * NWAVES;
    const bf16_t* R = WSP(bf16_t, OFF_R); const bf16_t* KR = WSP(bf16_t, OFF_KR); const bf16_t* AS = WSP(bf16_t, OFF_A); const bf16_t* Y = WSP(bf16_t, OFF_Y);
    float* ST = WSP(float, OFF_STATS); float* BO = WSP(float, OFF_BONUS);
    for (int it = gw; it < MTOK * 16; it += NGW) {
        const int h = it & 15; const size_t ix = (size_t)(it >> 4) * DM + h * 64 + lane;
        const float y = bf2f(Y[ix]), r = bf2f(R[ix]), k = bf2f(KR[ix]), a = bf2f(AS[ix]);
        const float kt = k * (1.f + (a - 1.f) * A.in[IN_KA][h * 64 + lane]);
        const float s1 = wave_sum(y), s2 = wave_sum(y * y), bo = wave_sum(r * kt * A.in[IN_RK][h * 64 + lane]);
        if (lane == 0) { *(f32x4*)(ST + (size_t)it * 4) = (f32x4){s1, s2, 0.f, 0.f}; BO[it] = bo; }
    }
}

template <int CTRL> __device__ __forceinline__ float dppf(float v) { return __int_as_float(__builtin_amdgcn_mov_dpp(__float_as_int(v), CTRL, 0xF, 0xF, false)); }
template <int CTRL> __device__ __forceinline__ int dppi(int v) { return __builtin_amdgcn_mov_dpp(v, CTRL, 0xF, 0xF, false); }
__device__ __forceinline__ float row16_allsum(float v) { v += dppf<0xB1>(v); v += dppf<0x4E>(v); v += dppf<0x124>(v); v += dppf<0x128>(v); return v; }
__device__ __forceinline__ float ffma_s(float a, float b, float c) { float r; asm("v_fma_f32 %0, %1, %2, %3" : "=v"(r) : "v"(a), "v"(b), "v"(c)); return r; }
__device__ __forceinline__ float fmul_s(float a, float b) { float r; asm("v_mul_f32_e32 %0, %1, %2" : "=v"(r) : "v"(a), "v"(b)); return r; }
__device__ __forceinline__ float row16_allsum_fused(float v) {
    float a, b, c, d;
    asm("s_nop 1\n\tv_add_f32_dpp %0, %1, %1 quad_perm:[1,0,3,2] row_mask:0xf bank_mask:0xf" : "=v"(a) : "v"(v));
    asm("s_nop 1\n\tv_add_f32_dpp %0, %1, %1 quad_perm:[2,3,0,1] row_mask:0xf bank_mask:0xf" : "=v"(b) : "v"(a));
    asm("s_nop 1\n\tv_add_f32_dpp %0, %1, %1 row_ror:4 row_mask:0xf bank_mask:0xf" : "=v"(c) : "v"(b));
    asm("s_nop 1\n\tv_add_f32_dpp %0, %1, %1 row_ror:8 row_mask:0xf bank_mask:0xf" : "=v"(d) : "v"(c));
    return d;
}
__device__ __forceinline__ int row16_allsum_i(int v) { v += dppi<0xB1>(v); v += dppi<0x4E>(v); v += dppi<0x124>(v); v += dppi<0x128>(v); return v; }
__device__ __forceinline__ int wave_allsum_i(int v) {
    v = row16_allsum_i(v);
    return __builtin_amdgcn_readlane(v, 0) + __builtin_amdgcn_readlane(v, 16) + __builtin_amdgcn_readlane(v, 32) + __builtin_amdgcn_readlane(v, 48);
}

constexpr int P2_LD = 2052;
template <int MODE = 0> __device__ __forceinline__ void p2_fast(const Args& A, unsigned char* lds) {
    const int tid = opaque_tid(), lane = tid & 63, wave = __builtin_amdgcn_readfirstlane(tid >> 6), fr = lane & 15, fq = lane >> 4;
    float* sc = (float*)lds;
    const bf16_t* QI = WSP(bf16_t, OFF_QI); const bf16_t* KI = WSP(bf16_t, OFF_KI); const float* WI = WSP(float, OFF_WI); unsigned* MASK = WSP(unsigned, MODE == 0 ? OFF_MASK : 160 * MiB);
    for (int it = blockIdx.x; it < 1024; it += gridDim.x) {
        const int q = it >> 8, c = it & 255, b = c & 7, s5 = c >> 3;
        const int tt = (q == 0) ? s5 : (q == 1) ? 63 - s5 : (q == 2) ? 64 + s5 : 127 - s5;
        const int t0 = 16 * tt, m0 = b * SEQ + t0;
        if (t0 >= 256 - 15) {
            bf16x8 qf[8][2]; float wv[8];
#pragma unroll
            for (int h = 0; h < 8; ++h) {
#pragma unroll
                for (int ks = 0; ks < 2; ++ks) qf[h][ks] = *(const bf16x8*)(QI + (size_t)(m0 + fr) * 512 + h * 64 + ks * 32 + fq * 8);
                wv[h] = WI[(size_t)(m0 + fr) * 8 + h];
            }
            const bf16_t* kbase = KI + (size_t)(b * SEQ + fr) * 64 + fq * 8;
            bf16x8 ka0 = *(const bf16x8*)(kbase + (size_t)wave * 16 * 64), ka1 = *(const bf16x8*)(kbase + (size_t)wave * 16 * 64 + 32);
#pragma unroll 1
            for (int kt = wave; kt <= tt; kt += NWAVES) {
                const bf16x8 a0 = ka0, a1 = ka1;
                if (kt + NWAVES <= tt) { ka0 = *(const bf16x8*)(kbase + (size_t)(kt + NWAVES) * 16 * 64); ka1 = *(const bf16x8*)(kbase + (size_t)(kt + NWAVES) * 16 * 64 + 32); }
                f32x4 acc = {0.f, 0.f, 0.f, 0.f};
#pragma unroll
                for (int h = 0; h < 8; ++h) {
                    f32x4 d = __builtin_amdgcn_mfma_f32_16x16x32_bf16(a0, qf[h][0], (f32x4){0.f, 0.f, 0.f, 0.f}, 0, 0, 0);
                    d = __builtin_amdgcn_mfma_f32_16x16x32_bf16(a1, qf[h][1], d, 0, 0, 0);
#pragma unroll
                    for (int e = 0; e < 4; ++e) acc[e] += wv[h] * fmaxf(d[e], 0.f);
                }
                *(f32x4*)(sc + fr * P2_LD + kt * 16 + 4 * fq) = acc;
            }
        }
        __syncthreads();
#pragma unroll 1
        for (int rr = 2 * wave; rr < 2 * wave + (MODE == 1 ? 0 : 2); ++rr) {
            const int t = t0 + rr, nk = t + 1;
            unsigned long long* mrow = (unsigned long long*)(MASK + (size_t)(m0 + rr) * 64);
            if (t < 256) {
                if (lane < 32) { const int lo = lane * 64; mrow[lane] = (nk >= lo + 64) ? ~0ull : (nk <= lo ? 0ull : ((1ull << (nk - lo)) - 1ull)); }
                continue;
            }
            const int nj = (nk + 63) >> 6;
            float x[32];
            const float* srow = sc + rr * P2_LD + lane;
#pragma unroll
            for (int j = 0; j < 32; ++j) x[j] = srow[64 * j];
            float mx = -INFINITY, mn = INFINITY;
#pragma unroll
            for (int j = 0; j < 32; ++j) { const bool ok = lane + 64 * j < nk; mn = fminf(mn, ok ? x[j] : INFINITY); x[j] = ok ? x[j] : -INFINITY; mx = fmaxf(mx, x[j]); }
            mx = wave_max(mx); mn = -wave_max(-mn);
            mx = __int_as_float(__builtin_amdgcn_readfirstlane(__float_as_int(mx))); mn = __int_as_float(__builtin_amdgcn_readfirstlane(__float_as_int(mn)));
#define P2_COUNT_GE(thr, out) do { int c_ = 0; const float th_ = (thr);     \
                _Pragma("unroll") for (int g_ = 0; g_ < 4; ++g_) if (nj > 8 * g_) { unsigned long long m_[8]; \
                    asm("v_cmp_ge_f32_e64 %0, %8, %16\n\tv_cmp_ge_f32_e64 %1, %9, %16\n\tv_cmp_ge_f32_e64 %2, %10, %16\n\tv_cmp_ge_f32_e64 %3, %11, %16\n\tv_cmp_ge_f32_e64 %4, %12, %16\n\tv_cmp_ge_f32_e64 %5, %13, %16\n\tv_cmp_ge_f32_e64 %6, %14, %16\n\tv_cmp_ge_f32_e64 %7, %15, %16" \
                        : "=&s"(m_[0]), "=&s"(m_[1]), "=&s"(m_[2]), "=&s"(m_[3]), "=&s"(m_[4]), "=&s"(m_[5]), "=&s"(m_[6]), "=&s"(m_[7]) \
                        : "v"(x[8 * g_]), "v"(x[8 * g_ + 1]), "v"(x[8 * g_ + 2]), "v"(x[8 * g_ + 3]), "v"(x[8 * g_ + 4]), "v"(x[8 * g_ + 5]), "v"(x[8 * g_ + 6]), "v"(x[8 * g_ + 7]), "v"(th_)); \
                    _Pragma("unroll") for (int j_ = 0; j_ < 8; ++j_) c_ += __popcll(m_[j_]); } \
                (out) = c_; } while (0)
            float lo = mn, hi = mx, thr = 0.f; int c_hi; bool exact = false;
            P2_COUNT_GE(mx, c_hi);
            if (c_hi >= 256) { lo = mx; c_hi = 0; }
            else {
#pragma unroll 1
                for (int iter_ = 0;; ++iter_) {
                    if (MODE == 3 && iter_ >= 6) break;
                    const float mid = lo + (hi - lo) * 0.5f;
                    if (!(mid > lo && mid < hi)) break;
                    int cm; P2_COUNT_GE(mid, cm);
                    if (cm == 256) { exact = true; thr = mid; break; }
                    if (cm > 256) lo = mid; else { hi = mid; c_hi = cm; }
                }
            }
            unsigned long long mine = 0ull;
            if (exact) {
#pragma unroll
                for (int j = 0; j < 32; ++j) { const unsigned long long bal = __ballot(x[j] >= thr); if (lane == j) mine = bal; }
            } else {
                int need = 256 - c_hi;
#pragma unroll
                for (int j = 0; j < 32; ++j) {
                    const bool eq = (x[j] == lo); const unsigned long long beq = __ballot(eq);
                    const int pre = __builtin_amdgcn_mbcnt_hi((unsigned)(beq >> 32), __builtin_amdgcn_mbcnt_lo((unsigned)beq, 0));
                    const unsigned long long bal = __ballot((x[j] > lo) || (eq && pre < need));
                    need -= __popcll(beq); need = need < 0 ? 0 : need;
                    if (lane == j) mine = bal;
                }
            }
            if (lane < 32) mrow[lane] = mine;
#undef P2_COUNT_GE
        }
        __syncthreads();
    }
}

constexpr int SC_TC = 32, SC_BUF_F = 5 * SC_TC * 64 + SC_TC * 32;
__device__ __forceinline__ void p12_fast(const Args& A, unsigned char* lds) {
    const int tid = opaque_tid(), lane = tid & 63, wave = __builtin_amdgcn_readfirstlane(tid >> 6);
    const int kq = lane & 15, row = 4 * wave + (lane >> 4), tl = tid >> 4;
    float* fl = (float*)lds; float* ybuf = fl + 2 * SC_BUF_F;
    const bf16_t* R = WSP(bf16_t, OFF_R); const bf16_t* KR = WSP(bf16_t, OFF_KR); const bf16_t* VV = WSP(bf16_t, OFF_VV); const bf16_t* E = WSP(bf16_t, OFF_E); const bf16_t* AS = WSP(bf16_t, OFF_A);
    bf16_t* Y = WSP(bf16_t, OFF_Y); float* ST = WSP(float, OFF_STATS); float* BO = WSP(float, OFF_BONUS);
    for (int it = blockIdx.x; it < BATCH * 16 * 2; it += gridDim.x) {
        const int half = it & 1, h = (it >> 1) & 15, b = it >> 5;
        const f32x4 kkw = *(const f32x4*)(A.in[IN_KK] + h * 64 + 4 * kq), kaw = *(const f32x4*)(A.in[IN_KA] + h * 64 + 4 * kq), rkw = *(const f32x4*)(A.in[IN_RK] + h * 64 + 4 * kq);
        const size_t gbase = ((size_t)b * SEQ + tl) * DM + h * 64 + 4 * kq;
        u32x2 pr, pk, pv, pe, pa;
#define SC_PREFETCH(c) do { const size_t gi_ = gbase + (size_t)(c) * SC_TC * DM; pr = *(const u32x2*)(R + gi_); pk = *(const u32x2*)(KR + gi_); pv = *(const u32x2*)(VV + gi_); pe = *(const u32x2*)(E + gi_); pa = *(const u32x2*)(AS + gi_); } while (0)
#define SC_UNPK(p, o) do { o[0] = __uint_as_float(p.x << 16); o[1] = __uint_as_float(p.x & 0xffff0000u); o[2] = __uint_as_float(p.y << 16); o[3] = __uint_as_float(p.y & 0xffff0000u); } while (0)
#define SC_DERIVE(c) do { float* bf_ = fl + ((c) & 1) * SC_BUF_F; float r_[4], k_[4], v_[4], e_[4], a_[4]; SC_UNPK(pr, r_); SC_UNPK(pk, k_); SC_UNPK(pv, v_); SC_UNPK(pe, e_); SC_UNPK(pa, a_); \
            f32x4 kkv_, w_, n_, b_, kt_, rr_; float ss_ = 0.f, bo_ = 0.f; \
            _Pragma("unroll") for (int i_ = 0; i_ < 4; ++i_) { kkv_[i_] = k_[i_] * kkw[i_]; ss_ += kkv_[i_] * kkv_[i_]; } \
            ss_ = row16_allsum(ss_); const float inv_ = rsqrtf(fmaxf(ss_, 1e-24f)); \
            _Pragma("unroll") for (int i_ = 0; i_ < 4; ++i_) { n_[i_] = -kkv_[i_] * inv_; b_[i_] = -n_[i_] * a_[i_]; kt_[i_] = k_[i_] * (1.f + (a_[i_] - 1.f) * kaw[i_]); w_[i_] = __expf(e_[i_]); rr_[i_] = r_[i_]; bo_ += r_[i_] * kt_[i_] * rkw[i_]; } \
            bo_ = row16_allsum(bo_); \
            if (half == 0 && kq == 0) BO[((size_t)b * SEQ + (c) * SC_TC + tl) * 16 + h] = bo_; \
            float* d_ = bf_ + tl * 64 + 4 * kq; *(f32x4*)(d_) = w_; *(f32x4*)(d_ + 2048) = n_; *(f32x4*)(d_ + 4096) = b_; *(f32x4*)(d_ + 6144) = kt_; *(f32x4*)(d_ + 8192) = rr_; \
            if ((kq >> 3) == half) *(f32x4*)(bf_ + 10240 + tl * 32 + 4 * (kq & 7)) = (f32x4){v_[0], v_[1], v_[2], v_[3]}; } while (0)
        __syncthreads();
        SC_PREFETCH(0); SC_DERIVE(0);
        __syncthreads();
        float S0 = 0.f, S1 = 0.f, S2 = 0.f, S3 = 0.f;
#pragma unroll 1
        for (int c = 0; c < SEQ / SC_TC; ++c) {
            if (c + 1 < SEQ / SC_TC) SC_PREFETCH(c + 1);
            const float* bf = fl + (c & 1) * SC_BUF_F + 4 * kq; const float* vb = fl + (c & 1) * SC_BUF_F + 10240 + row; float* yb = ybuf + (c & 1) * 1024 + row;
#define SC_LOAD(P, tt_) do { P##w = *(const f32x4*)(bf + (tt_) * 64); P##n = *(const f32x4*)(bf + (tt_) * 64 + 2048); P##b = *(const f32x4*)(bf + (tt_) * 64 + 4096); P##k = *(const f32x4*)(bf + (tt_) * 64 + 6144); P##r = *(const f32x4*)(bf + (tt_) * 64 + 8192); P##v = vb[(tt_) * 32]; } while (0)
#define SC_STEP(P, tt_) do { \
                float p_ = fmul_s(S0, P##n.x); p_ = ffma_s(S1, P##n.y, p_); p_ = ffma_s(S2, P##n.z, p_); p_ = ffma_s(S3, P##n.w, p_); \
                float t0_ = fmul_s(S0, P##w.x), t1_ = fmul_s(S1, P##w.y), t2_ = fmul_s(S2, P##w.z), t3_ = fmul_s(S3, P##w.w); \
                t0_ = ffma_s(P##v, P##k.x, t0_); t1_ = ffma_s(P##v, P##k.y, t1_); t2_ = ffma_s(P##v, P##k.z, t2_); t3_ = ffma_s(P##v, P##k.w, t3_); \
                const float sa_ = row16_allsum_fused(p_); \
                S0 = ffma_s(sa_, P##b.x, t0_); S1 = ffma_s(sa_, P##b.y, t1_); S2 = ffma_s(sa_, P##b.z, t2_); S3 = ffma_s(sa_, P##b.w, t3_); \
                float qy_ = fmul_s(S0, P##r.x); qy_ = ffma_s(S1, P##r.y, qy_); qy_ = ffma_s(S2, P##r.z, qy_); qy_ = ffma_s(S3, P##r.w, qy_); \
                const float y_ = row16_allsum_fused(qy_); \
                if (kq == 0) yb[(tt_) * 32] = y_; } while (0)
            f32x4 Aw, An, Ab, Ak, Ar, Bw, Bn, Bb, Bk, Br; float Av, Bv;
            SC_LOAD(A, 0);
#pragma unroll 1
            for (int tt = 0; tt < SC_TC; tt += 2) {
                SC_LOAD(B, tt + 1);
                SC_STEP(A, tt);
                if (tt + 2 < SC_TC) SC_LOAD(A, tt + 2);
                SC_STEP(B, tt + 1);
            }
#undef SC_LOAD
#undef SC_STEP
            if (c + 1 < SEQ / SC_TC) SC_DERIVE(c + 1);
            __syncthreads();
            {
                const int j = tid & 15; const float* ys = ybuf + (c & 1) * 1024 + tl * 32 + 2 * j;
                const float y0 = ys[0], y1 = ys[1];
                const float s1 = row16_allsum(y0 + y1), s2 = row16_allsum(y0 * y0 + y1 * y1);
                const size_t m = (size_t)b * SEQ + c * SC_TC + tl;
                *(unsigned*)(Y + m * DM + h * 64 + 32 * half + 2 * j) = pk2(y0, y1);
                if (j == 0) *(f32x2*)(ST + (m * 16 + h) * 4 + 2 * half) = (f32x2){s1, s2};
            }
        }
#undef SC_PREFETCH
#undef SC_UNPK
#undef SC_DERIVE
    }
}

namespace attn_body {
using bf16=__hip_bfloat16;
using bf16x8=__attribute__((ext_vector_type(8)))short;
using s16x4=__attribute__((ext_vector_type(4)))short;
using f32x16=__attribute__((ext_vector_type(16)))float;
using u32x4=__attribute__((ext_vector_type(4)))unsigned;
constexpr int BATCH=8,NHEAD=16,SEQ=2048,D=64,DM=NHEAD*D,KP=256;
constexpr int NW=8,QBLK=32,QB=QBLK*NW,KVBLK=64,NQB=SEQ/QB;
constexpr int ATTN_PITCH=DM, ATTN_UNIT_ROWS=QB;
__device__ __forceinline__ int crow(int r,int hi){return (r&3)+8*(r>>2)+4*hi;}
#define SBAR() __builtin_amdgcn_sched_barrier(0)
__device__ __forceinline__ void bmask(f32x16&p0,f32x16&p1,unsigned long long mw,int hi){
  const unsigned lo=(unsigned)mw>>(4*hi), hw=(unsigned)(mw>>32)>>(4*hi);
  #pragma unroll
  for(int r=0;r<16;++r){const int c=(r&3)+8*(r>>2); const int m0=__builtin_amdgcn_sbfe((int)lo,c,1), m1=__builtin_amdgcn_sbfe((int)hw,c,1);
    p0[r]=__int_as_float((__float_as_int(p0[r])&m0)|((int)0xff800000&~m0)); p1[r]=__int_as_float((__float_as_int(p1[r])&m1)|((int)0xff800000&~m1));}
}

constexpr int NSLOT=3, SLOTB=8192;
constexpr int LDS_K=0, LDS_V=NSLOT*SLOTB, LDS_WS=2*NSLOT*SLOTB, LDS_OST=LDS_WS+NW*64*4, LDS_MSK=LDS_OST+NW*4096, LDS_BYTES=LDS_MSK+64*256;
constexpr float C2=0.125f*1.4426950408889634f;
__device__ __forceinline__ void glds16(const void*gsrc,unsigned lds_dst){unsigned keep;
  asm volatile("s_mov_b32 %0, m0\n\ts_mov_b32 m0, %2\n\ts_nop 0\n\tglobal_load_lds_dwordx4 %1, off\n\ts_mov_b32 m0, %0":"=&s"(keep):"v"(gsrc),"s"(lds_dst):"memory");}
__device__ __forceinline__ float max3f(float a,float b,float c){float r;asm("v_max3_f32 %0, %1, %2, %3":"=v"(r):"v"(a),"v"(b),"v"(c));return r;}
__device__ __forceinline__ float max2f(float a,float b){float r;asm("v_max_f32_e32 %0, %1, %2":"=v"(r):"v"(a),"v"(b));return r;}
__device__ __forceinline__ float fadd_s(float a,float b){float r;asm("v_add_f32_e32 %0, %1, %2":"=v"(r):"v"(a),"v"(b));return r;}
__device__ __forceinline__ float fsub_s(float a,float b){float r;asm("v_sub_f32_e32 %0, %1, %2":"=v"(r):"v"(a),"v"(b));return r;}
typedef float f32x2_t __attribute__((ext_vector_type(2))); typedef __bf16 bf16x2_t __attribute__((ext_vector_type(2)));
__device__ __forceinline__ unsigned cvtpk_s(float lo,float hi){f32x2_t v={lo,hi};bf16x2_t b=__builtin_convertvector(v,bf16x2_t);return __builtin_bit_cast(unsigned,b);}
#define WAIT_BAR(N) asm volatile("s_waitcnt vmcnt(" #N ") lgkmcnt(0)\n\ts_barrier":::"memory")

__device__ __forceinline__ void qkt(f32x16&p0,f32x16&p1,const char*Kslot,const bf16x8*qr,const f32x16&negm,int r32,int hi){
  const char*kb=Kslot+hi*1024+r32*16;
  #pragma unroll
  for(int d0=0;d0<4;++d0){
    const bf16x8 b0=*reinterpret_cast<const bf16x8*>(kb+d0*2048);
    const bf16x8 b1=*reinterpret_cast<const bf16x8*>(kb+d0*2048+512);
    if(d0==0){p0=__builtin_amdgcn_mfma_f32_32x32x16_bf16(b0,qr[0],negm,0,0,0);p1=__builtin_amdgcn_mfma_f32_32x32x16_bf16(b1,qr[0],negm,0,0,0);}
    else{p0=__builtin_amdgcn_mfma_f32_32x32x16_bf16(b0,qr[d0],p0,0,0,0);p1=__builtin_amdgcn_mfma_f32_32x32x16_bf16(b1,qr[d0],p1,0,0,0);}}
}
typedef __attribute__((address_space(3))) const char* lds_cptr;
typedef short v4i16_t __attribute__((ext_vector_type(4)));
__device__ __forceinline__ void kload8(bf16x8*kf,lds_cptr kp){
  kf[0]=*(const __attribute__((address_space(3))) bf16x8*)(kp);      kf[1]=*(const __attribute__((address_space(3))) bf16x8*)(kp+512);
  kf[2]=*(const __attribute__((address_space(3))) bf16x8*)(kp+2048); kf[3]=*(const __attribute__((address_space(3))) bf16x8*)(kp+2560);
  kf[4]=*(const __attribute__((address_space(3))) bf16x8*)(kp+4096); kf[5]=*(const __attribute__((address_space(3))) bf16x8*)(kp+4608);
  kf[6]=*(const __attribute__((address_space(3))) bf16x8*)(kp+6144); kf[7]=*(const __attribute__((address_space(3))) bf16x8*)(kp+6656);
}
__device__ __forceinline__ void kload2(bf16x8*kf,lds_cptr kp,int j){ kf[2*j]=*(const __attribute__((address_space(3))) bf16x8*)(kp+j*2048); kf[2*j+1]=*(const __attribute__((address_space(3))) bf16x8*)(kp+j*2048+512); }
__device__ __forceinline__ s16x4 vtr(lds_cptr p){ return __builtin_bit_cast(s16x4,__builtin_amdgcn_ds_read_tr16_b64_v4i16((__attribute__((address_space(3))) v4i16_t*)p)); }
__device__ __forceinline__ float rowmax(const f32x16&p0,const f32x16&p1){
  float a=max3f(p0[0],p0[1],p1[0]),b=max3f(p0[2],p0[3],p1[1]);a=max3f(a,p1[2],p1[3]);
  #pragma unroll
  for(int r=4;r<16;r+=4){a=max3f(a,p0[r],p0[r+1]);b=max3f(b,p0[r+2],p0[r+3]);a=max3f(a,p1[r],p1[r+1]);b=max3f(b,p1[r+2],p1[r+3]);}
  const float m=max2f(a,b);
  auto rr=__builtin_amdgcn_permlane32_swap(__float_as_uint(m),__float_as_uint(m),false,false);
  return max2f(__uint_as_float(rr[0]),__uint_as_float(rr[1]));
}
__device__ __forceinline__ void pv(f32x16*o,int vb,bf16x8 pa0,bf16x8 pa1,bf16x8 pa2,bf16x8 pa3){
  #pragma unroll
  for(int d0=0;d0<2;++d0){s16x4 lo[4],hi[4];
    #pragma unroll
    for(int ks=0;ks<4;++ks){
      asm volatile("ds_read_b64_tr_b16 %0,%1 offset:%c2":"=&v"(lo[ks]):"v"(vb),"i"(d0*4096+ks*1024):"memory");
      asm volatile("ds_read_b64_tr_b16 %0,%1 offset:%c2":"=&v"(hi[ks]):"v"(vb),"i"(d0*4096+ks*1024+512):"memory");}
    asm volatile("s_waitcnt lgkmcnt(0)":::"memory");SBAR();
    #define PK(k) (bf16x8){lo[k][0],lo[k][1],lo[k][2],lo[k][3],hi[k][0],hi[k][1],hi[k][2],hi[k][3]}
    o[d0]=__builtin_amdgcn_mfma_f32_32x32x16_bf16(pa0,PK(0),o[d0],0,0,0);
    o[d0]=__builtin_amdgcn_mfma_f32_32x32x16_bf16(pa1,PK(1),o[d0],0,0,0);
    o[d0]=__builtin_amdgcn_mfma_f32_32x32x16_bf16(pa2,PK(2),o[d0],0,0,0);
    o[d0]=__builtin_amdgcn_mfma_f32_32x32x16_bf16(pa3,PK(3),o[d0],0,0,0);
    #undef PK
  }
}

#ifndef ATTN_STORE16
#define ATTN_STORE16(p,v) (*(u32x4*)(p)=(v))
#endif
template<int THRL> __device__ __forceinline__ void attn_unit(int b,int n,int qt,const bf16*Q,const bf16*__restrict__ K,const bf16*__restrict__ V,bf16*O,const unsigned*__restrict__ MASK,char*shm){
  const int tid=opaque_tid(),lane=tid&63,r32=lane&31,hi=lane>>5; const int wid=__builtin_amdgcn_readfirstlane(tid>>6);
  const long rowbase=(long)b*SEQ; const int q0=qt*64;
  const int hq=4*n+(wid>>1), tok0=q0+32*(wid&1);
  const bf16*Qw=Q+(rowbase+tok0)*DM+hq*D;
  const bf16*Kh=K+rowbase*KP+n*D,*Vh=V+rowbase*KP+n*D;
  const unsigned lds0=(unsigned)(uintptr_t)shm;
  float*wsf=(float*)(shm+LDS_WS)+wid*64;
  const bf16*ksrc=Kh+(long)lane*KP+wid*8;
  const bf16*vsrc=Vh+(long)(16*(wid&3)+(lane>>2))*KP+(wid>>2)*32+(lane&3)*8;
  const unsigned kdst=lds0+LDS_K+wid*1024, vdst=lds0+LDS_V+wid*1024;
  #define DMA_K(t,slot) glds16(ksrc+(long)(t)*KVBLK*KP,(unsigned)__builtin_amdgcn_readfirstlane(kdst+(slot)))
  #define DMA_V(t,slot) glds16(vsrc+(long)(t)*KVBLK*KP,(unsigned)__builtin_amdgcn_readfirstlane(vdst+(slot)))
  const int vb0=(int)(lds0+LDS_V)+((lane>>4)&1)*32+(lane&3)*8+(4*hi+((lane&15)>>2))*64;
  const char*Kbase=shm+LDS_K; bf16x8 kf[8];
  const lds_cptr shm3=(lds_cptr)shm; const lds_cptr kp0=shm3+LDS_K+hi*1024+r32*16; const lds_cptr vp0=shm3+LDS_V+((lane>>4)&1)*32+(lane&3)*8+(4*hi+((lane&15)>>2))*64;
  const int nt0=qt+1; const int NT=nt0<4?4:((nt0+1)&~1);
  DMA_K(0,0);DMA_V(0,0);DMA_K(1,SLOTB);
  bf16x8 qr[4];
  #pragma unroll
  for(int d0=0;d0<4;++d0)qr[d0]=*reinterpret_cast<const bf16x8*>(&Qw[(long)r32*DM+d0*16+hi*8]);
  { const int tk=tid>>3,pc=tid&7; const u32x4*ms=(const u32x4*)(MASK+((size_t)(rowbase+q0+tk))*64+pc*8); const u32x4 m0=ms[0],m1=ms[1];
    __attribute__((address_space(3))) u32x4*md=(__attribute__((address_space(3))) u32x4*)((__attribute__((address_space(3))) char*)shm+LDS_MSK+tk*256+pc*32); md[0]=m0; md[1]=m1; }
  const __attribute__((address_space(3))) unsigned long long*mskrow=(const __attribute__((address_space(3))) unsigned long long*)((__attribute__((address_space(3))) char*)shm+LDS_MSK+(32*(wid&1)+r32)*256);
  float mhat=0.f,l_reg=0.f;f32x16 o[2];o[0]=f32x16{};o[1]=f32x16{};f32x16 negm=f32x16{};asm volatile("":"+v"(negm));
  #define CMASK(P0,P1,t) bmask(P0,P1,mw_,hi)
  bool resc=false;
  #define START(P0,P1) do{ const float rm=max2f(rowmax(P0,P1),-1000.f); resc=false; \
    { const float dl=rm; mhat=fadd_s(mhat,dl); \
      _Pragma("unroll") for(int r=0;r<16;++r){P0[r]=fsub_s(P0[r],dl);P1[r]=fsub_s(P1[r],dl);} \
      _Pragma("unroll") for(int r=0;r<16;++r)negm[r]=-mhat; asm volatile("":"+v"(negm)); } \
    _Pragma("unroll") for(int r=0;r<16;++r)P0[r]=__builtin_amdgcn_exp2f(P0[r]); }while(0)
  #define RESC() do{ if(resc){ asm volatile("s_waitcnt lgkmcnt(0)":::"memory"); \
      _Pragma("unroll") for(int d_=0;d_<2;++d_) _Pragma("unroll") for(int r=0;r<16;++r)o[d_][r]*=wsf[crow(r,hi)]; } }while(0)
  f32x16 pA0,pA1,pB0,pB1;
  int sl_prev=0,sl_cur=0,sl_next=SLOTB;
  #define ROT() do{sl_prev=sl_cur;sl_cur=sl_next;sl_next=(sl_next==(NSLOT-1)*SLOTB)?0:sl_next+SLOTB;}while(0)
  DMA_K(2,2*SLOTB);
  WAIT_BAR(3);
  qkt(pA0,pA1,Kbase,qr,negm,r32,hi);asm volatile("s_nop 15\n\ts_nop 7":"+v"(pA0),"+v"(pA1));{const unsigned long long mw_=mskrow[0];CMASK(pA0,pA1,0);}
  START(pA0,pA1);
  _Pragma("unroll") for(int r=0;r<16;++r)pA1[r]=__builtin_amdgcn_exp2f(pA1[r]);
  WAIT_BAR(0);
  DMA_K(3,0);DMA_V(1,SLOTB);
  ROT();
  kload8(kf,kp0+sl_cur);
  WAIT_BAR(2);
  s16x4 vlo[8],vhi[8]; u32x4 pw0,pw1,pw2,pw3;
  #define PKW(P,B) cvtpk_s(P[B],P[B+1])
  #define PAF(k) __builtin_bit_cast(bf16x8,pw##k)
  #define VFR(i) (bf16x8){vlo[i][0],vlo[i][1],vlo[i][2],vlo[i][3],vhi[i][0],vhi[i][1],vhi[i][2],vhi[i][3]}
  #define PIN(x) asm volatile("":"+v"(x))
  #define MX3(a,b,c) __builtin_fmaxf(__builtin_fmaxf((a),(b)),(c))
  #define GAPA(MF,A0,A1,A2,A3,W0,W1,PW) do{ MF; sacc+=A0; sacc+=A1; sacc+=A2; sacc+=A3; PIN(sacc); W0; W1; PIN(PW); SBAR(); }while(0)
  #define EX(v) __builtin_amdgcn_exp2f(v)
  #define GAPB(MF,X,B) do{ MF; X[B]=EX(X[B]); X[B+1]=EX(X[B+1]); X[B+2]=EX(X[B+2]); X[B+3]=EX(X[B+3]); PIN(X); SBAR(); }while(0)
  #define VRD(i) do{ vlo[i]=vtr(vp_+(((i)>>2)*4096+((i)&3)*1024)); vhi[i]=vtr(vp_+(((i)>>2)*4096+((i)&3)*1024+512)); }while(0)
  #define KRD(G,j) do{ if(G){ kload2(kf,kp0+sl_next,j); SBAR(); } }while(0)
  #define STEP(C0,C1,P0,P1,t,GK,GV,GL) do{ SBAR(); \
    const lds_cptr vp_=vp0+sl_prev; const unsigned long long mw_=mskrow[(t)]; \
    VRD(0); SBAR(); float sacc=(P0[0]+P0[1]); \
    GAPA(C0=__builtin_amdgcn_mfma_f32_32x32x16_bf16(kf[0],qr[0],negm,0,0,0), P0[2],P0[3],P0[4],P0[5],     pw0[0]=PKW(P0,0), pw0[1]=PKW(P0,2), pw0); \
    VRD(4); SBAR(); GAPA(C1=__builtin_amdgcn_mfma_f32_32x32x16_bf16(kf[1],qr[0],negm,0,0,0), P0[6],P0[7],P0[8],P0[9],     pw0[2]=PKW(P0,4), pw0[3]=PKW(P0,6), pw0); \
    VRD(1); SBAR(); GAPA(C0=__builtin_amdgcn_mfma_f32_32x32x16_bf16(kf[2],qr[1],C0,0,0,0),   P0[10],P0[11],P0[12],P0[13], pw1[0]=PKW(P0,8), pw1[1]=PKW(P0,10), pw1); \
    VRD(5); SBAR(); GAPA(C1=__builtin_amdgcn_mfma_f32_32x32x16_bf16(kf[3],qr[1],C1,0,0,0),   P0[14],P0[15],P1[0],P1[1],   pw1[2]=PKW(P0,12),pw1[3]=PKW(P0,14), pw1); \
    VRD(2); SBAR(); GAPA(C0=__builtin_amdgcn_mfma_f32_32x32x16_bf16(kf[4],qr[2],C0,0,0,0),   P1[2],P1[3],P1[4],P1[5],     pw2[0]=PKW(P1,0), pw2[1]=PKW(P1,2), pw2); \
    VRD(6); SBAR(); GAPA(C1=__builtin_amdgcn_mfma_f32_32x32x16_bf16(kf[5],qr[2],C1,0,0,0),   P1[6],P1[7],P1[8],P1[9],     pw2[2]=PKW(P1,4), pw2[3]=PKW(P1,6), pw2); \
    VRD(3); SBAR(); GAPA(C0=__builtin_amdgcn_mfma_f32_32x32x16_bf16(kf[6],qr[3],C0,0,0,0),   P1[10],P1[11],P1[12],P1[13], pw3[0]=PKW(P1,8), pw3[1]=PKW(P1,10), pw3); \
    VRD(7); SBAR(); GAPA(C1=__builtin_amdgcn_mfma_f32_32x32x16_bf16(kf[7],qr[3],C1,0,0,0),   P1[14],P1[15],0.f,0.f,       pw3[2]=PKW(P1,12),pw3[3]=PKW(P1,14), pw3); \
    l_reg+=sacc; \
    if(GK){DMA_K((t)+3,sl_cur);} if(GV){DMA_V((t)+1,sl_next);} \
    CMASK(C0,C1,t); \
    { float a=MX3(C0[0],C0[1],C1[0]),b=MX3(C0[2],C0[3],C1[1]); a=MX3(a,C1[2],C1[3]); \
      _Pragma("unroll") for(int r=4;r<16;r+=4){a=MX3(a,C0[r],C0[r+1]);b=MX3(b,C0[r+2],C0[r+3]);a=MX3(a,C1[r],C1[r+1]);b=MX3(b,C1[r+2],C1[r+3]);} \
      float rm=__builtin_fmaxf(a,b); { auto rr=__builtin_amdgcn_permlane32_swap(__float_as_uint(rm),__float_as_uint(rm),false,false); rm=__builtin_fmaxf(__uint_as_float(rr[0]),__uint_as_float(rr[1])); } \
      resc=false; \
      if(__builtin_expect(__any(rm>(float)THRL),0)){ const float dl=__builtin_fmaxf(rm,0.f); mhat+=dl; \
        _Pragma("unroll") for(int r=0;r<16;++r){C0[r]-=dl;C1[r]-=dl;} \
        _Pragma("unroll") for(int r=0;r<16;++r)negm[r]=-mhat; asm volatile("":"+v"(negm)); \
        const float f=__builtin_amdgcn_exp2f(-dl); l_reg*=f; if(hi==0)wsf[r32]=f; resc=true; } } \
    SBAR(); \
    GAPB(o[0]=__builtin_amdgcn_mfma_f32_32x32x16_bf16(PAF(0),VFR(0),o[0],0,0,0), C0,0); \
    GAPB(o[1]=__builtin_amdgcn_mfma_f32_32x32x16_bf16(PAF(0),VFR(4),o[1],0,0,0), C0,4); \
    KRD(GL,0); GAPB(o[0]=__builtin_amdgcn_mfma_f32_32x32x16_bf16(PAF(1),VFR(1),o[0],0,0,0), C0,8); \
    KRD(GL,1); GAPB(o[1]=__builtin_amdgcn_mfma_f32_32x32x16_bf16(PAF(1),VFR(5),o[1],0,0,0), C0,12); \
    KRD(GL,2); GAPB(o[0]=__builtin_amdgcn_mfma_f32_32x32x16_bf16(PAF(2),VFR(2),o[0],0,0,0), C1,0); \
    KRD(GL,3); GAPB(o[1]=__builtin_amdgcn_mfma_f32_32x32x16_bf16(PAF(2),VFR(6),o[1],0,0,0), C1,4); \
    GAPB(o[0]=__builtin_amdgcn_mfma_f32_32x32x16_bf16(PAF(3),VFR(3),o[0],0,0,0), C1,8); \
    GAPB(o[1]=__builtin_amdgcn_mfma_f32_32x32x16_bf16(PAF(3),VFR(7),o[1],0,0,0), C1,12); \
    }while(0)
  int t=1;
  for(;t+5<NT;t+=2){
    STEP(pB0,pB1,pA0,pA1,t,true,true,true);     WAIT_BAR(2); RESC(); ROT();
    STEP(pA0,pA1,pB0,pB1,t+1,true,true,true);   WAIT_BAR(2); RESC(); ROT();
  }
  #define ENDW(tt) do{ if((tt)+3<NT){WAIT_BAR(2);} else if((tt)+2<NT){WAIT_BAR(1);} else {WAIT_BAR(0);} }while(0)
  for(;t+1<NT;t+=2){
    STEP(pB0,pB1,pA0,pA1,t,(t+3<NT),(t+1<NT),(t+1<NT));       ENDW(t);   RESC(); ROT();
    STEP(pA0,pA1,pB0,pB1,t+1,(t+4<NT),(t+2<NT),(t+2<NT));     ENDW(t+1); RESC(); ROT();
  }
  STEP(pB0,pB1,pA0,pA1,NT-1,false,false,false); RESC();
  { float sacc=pB0[0]+pB0[1]; _Pragma("unroll") for(int r=2;r<16;++r)sacc+=pB0[r]; _Pragma("unroll") for(int r=0;r<16;++r)sacc+=pB1[r]; l_reg+=sacc;
    pw0=(u32x4){PKW(pB0,0),PKW(pB0,2),PKW(pB0,4),PKW(pB0,6)};pw1=(u32x4){PKW(pB0,8),PKW(pB0,10),PKW(pB0,12),PKW(pB0,14)};pw2=(u32x4){PKW(pB1,0),PKW(pB1,2),PKW(pB1,4),PKW(pB1,6)};pw3=(u32x4){PKW(pB1,8),PKW(pB1,10),PKW(pB1,12),PKW(pB1,14)};
    SBAR(); pv(o,vb0+sl_cur,PAF(0),PAF(1),PAF(2),PAF(3)); }
  #undef PKW
  #undef PAF
  #undef VFR
  #undef PIN
  #undef MX3
  #undef GAPA
  #undef GAPB
  #undef EX
  #undef VRD
  #undef KRD
  #undef STEP
  #undef ENDW
  {auto rr=__builtin_amdgcn_permlane32_swap(__float_as_uint(l_reg),__float_as_uint(l_reg),false,false);l_reg=__uint_as_float(rr[0])+__uint_as_float(rr[1]);}
  if(hi==0)wsf[32+r32]=l_reg;asm volatile("s_waitcnt lgkmcnt(0)":::"memory");
  float rli[16];
  #pragma unroll
  for(int r=0;r<16;++r)rli[r]=__builtin_amdgcn_rcpf(wsf[32+crow(r,hi)]);
  bf16*Ow=O+(rowbase+tok0)*DM+hq*D;
  { bf16*stg=(bf16*)(shm+LDS_OST)+wid*2048;
    #pragma unroll
    for(int r=0;r<16;++r){const int orow=crow(r,hi);
      #pragma unroll
      for(int d0=0;d0<2;++d0)stg[orow*64+d0*32+r32]=__float2bfloat16(o[d0][r]*rli[r]);}
    asm volatile("s_waitcnt lgkmcnt(0)":::"memory");
    #pragma unroll
    for(int i=0;i<4;++i){const int row=i*8+(lane>>3),ch=lane&7; const u32x4 v=*(const u32x4*)(stg+row*64+ch*8); ATTN_STORE16(Ow+(long)row*DM+ch*8,v);} }
  asm volatile("s_waitcnt lgkmcnt(0)\n\ts_barrier":::"memory");
  #undef DMA_K
  #undef DMA_V
  #undef CMASK
  #undef START
  #undef RESC
  #undef ROT
}
constexpr int ATTN_LDS_BYTES=LDS_BYTES;
struct AttnTensors { const bf16* Q; const bf16* K; const bf16* V; bf16* O; const unsigned* MASK; };
struct AttnUnit { int bn; int qt; };
struct StaticOrder {
  int vcu, G;
  __device__ __forceinline__ explicit StaticOrder(int grid,int block):vcu((grid%8==0)?(block%8)*(grid/8)+block/8:block),G(grid){}
  __device__ __forceinline__ bool next(int i,AttnUnit&u)const{
    if(G==256){ if(i>=4)return false; const int s=vcu&7; u.bn=vcu>>3; u.qt=(i==0)?31-s:(i==1)?16+s:(i==2)?15-s:s; return true; }
    const int id=vcu+i*G; if(id>=1024)return false; u.bn=id>>5; u.qt=31-(id&31); return true; }
};
template<class Sched,int THRL=8> __device__ __forceinline__ void attn_phase(char*lds,const AttnTensors&T,const Sched&S){
  AttnUnit u;
  for(int i=0;S.next(i,u);++i){ attn_unit<THRL>(u.bn>>2,u.bn&3,u.qt,T.Q,T.K,T.V,T.O,T.MASK,lds); }
}
#undef SBAR
#undef WAIT_BAR
}


constexpr int CH = 16, NCHUNK = SEQ / CH;
constexpr size_t OFF_SM = 84 * MiB, OFF_WC = 3 * MiB;
__device__ __forceinline__ unsigned char* arr_base(const Args& A, int arr) { return A.ws + (arr == 0 ? OFF_R : arr == 1 ? OFF_KR : arr == 2 ? OFF_E : OFF_A); }
__device__ __forceinline__ unsigned char* piece_ptr(const Args& A, int blk, int lane, int m0, int h) {
    const int pidx = blk * 64 + lane, p7 = pidx & 127, t = p7 >> 3, seg = p7 & 7;
    return arr_base(A, pidx >> 7) + ((size_t)(m0 + t) * DM + h * 64 + seg * 8) * 2;
}
__device__ __forceinline__ unsigned cvtpk(float lo, float hi) { typedef float f2_ __attribute__((ext_vector_type(2))); typedef __bf16 b2_ __attribute__((ext_vector_type(2))); f2_ v = {lo, hi}; b2_ b = __builtin_convertvector(v, b2_); return __builtin_bit_cast(unsigned, b); }
__device__ __forceinline__ float quad_allsum(float v) { v += dppf<0xB1>(v); v += dppf<0x4E>(v); return v; }
__device__ __forceinline__ bf16x8 mk8(unsigned a, unsigned b, unsigned c, unsigned d) { u32x4 w = {a, b, c, d}; return __builtin_bit_cast(bf16x8, w); }

__device__ __forceinline__ void p12_chunk_prep(const Args& A, unsigned char* lds) {
    const int tid = opaque_tid(), lane = tid & 63, wave = __builtin_amdgcn_readfirstlane(tid >> 6), q = lane >> 4, c = lane & 15;
    unsigned char* wl = lds + wave * 14336;
    bf16_t* arr = (bf16_t*)wl;
    bf16_t* bkb = (bf16_t*)(wl + 8192);
    float* gs = (float*)(wl + 12288);
    float* invs = (float*)(wl + 13312);
    const bf16_t* R = WSP(bf16_t, OFF_R); const bf16_t* KR = WSP(bf16_t, OFF_KR); const bf16_t* E = WSP(bf16_t, OFF_E); const bf16_t* AS = WSP(bf16_t, OFF_A);
    float* BO = WSP(float, OFF_BONUS); float* WC = WSP(float, OFF_WC); unsigned char* SM = A.ws + OFF_SM;
    const int gw = blockIdx.x * NWAVES + wave, NGW = gridDim.x * NWAVES;
    u32x4 nr0, nr1, nk0, nk1, ne0, ne1, na0, na1;
#define P12_LOAD(itm) do { const int bh_ = (itm) >> 7, ch_ = (itm) & 127; const size_t go_ = (size_t)((bh_ >> 4) * SEQ + ch_ * CH + (lane >> 2)) * DM + (bh_ & 15) * 64 + (lane & 3) * 16; \
        nr0 = *(const u32x4*)(R + go_); nr1 = *(const u32x4*)(R + go_ + 8); nk0 = *(const u32x4*)(KR + go_); nk1 = *(const u32x4*)(KR + go_ + 8); \
        ne0 = *(const u32x4*)(E + go_); ne1 = *(const u32x4*)(E + go_ + 8); na0 = *(const u32x4*)(AS + go_); na1 = *(const u32x4*)(AS + go_ + 8); } while (0)
    if (gw < BATCH * 16 * NCHUNK) P12_LOAD(gw);
#pragma unroll 1
    for (int item = gw; item < BATCH * 16 * NCHUNK; item += NGW) {
        const int bh = item >> 7, ch = item & 127, b = bh >> 4, h = bh & 15, m0 = b * SEQ + ch * CH;
        {
            const int t = lane >> 2, sg = lane & 3;
            const u32x4 r0 = nr0, r1 = nr1, k0 = nk0, k1 = nk1, e0 = ne0, e1 = ne1, a0 = na0, a1 = na1;
            if (item + NGW < BATCH * 16 * NCHUNK) P12_LOAD(item + NGW);
            u32x4* d = (u32x4*)(arr + t * 64 + sg * 16);
            d[0] = r0; d[1] = r1; d[128] = k0; d[129] = k1; d[256] = e0; d[257] = e1; d[384] = a0; d[385] = a1;
            float ss = 0.f, bo = 0.f;
#pragma unroll
            for (int w = 0; w < 8; ++w) {
                const unsigned rw = w < 4 ? r0[w & 3] : r1[w & 3], kw = w < 4 ? k0[w & 3] : k1[w & 3], aw = w < 4 ? a0[w & 3] : a1[w & 3];
                const int kk0 = h * 64 + sg * 16 + 2 * w;
#pragma unroll
                for (int p = 0; p < 2; ++p) {
                    const float rv = p ? __uint_as_float(rw & 0xffff0000u) : __uint_as_float(rw << 16), kv = p ? __uint_as_float(kw & 0xffff0000u) : __uint_as_float(kw << 16), av = p ? __uint_as_float(aw & 0xffff0000u) : __uint_as_float(aw << 16);
                    const float kkv = kv * A.in[IN_KK][kk0 + p]; ss += kkv * kkv;
                    bo += rv * (kv * (1.f + (av - 1.f) * A.in[IN_KA][kk0 + p])) * A.in[IN_RK][kk0 + p];
                }
            }
            ss = quad_allsum(ss); bo = quad_allsum(bo);
            if (sg == 0) { invs[t] = rsqrtf(fmaxf(ss, 1e-24f)); BO[(size_t)(m0 + t) * 16 + h] = bo; }
        }
        LDS_WAIT();
        float wc;
        {
            const float kkw = A.in[IN_KK][h * 64 + lane], kaw = A.in[IN_KA][h * 64 + lane];
            float Ecum = 0.f, ep_prev = 1.f; float bt[16], ktl[16];
#pragma unroll
            for (int t = 0; t < 16; ++t) {
                const float r = bf2f(arr[t * 64 + lane]), k = bf2f(arr[1024 + t * 64 + lane]), e = bf2f(arr[2048 + t * 64 + lane]), a = bf2f(arr[3072 + t * 64 + lane]);
                const float n = -(k * kkw) * invs[t], bb = -n * a, kt = k * (1.f + (a - 1.f) * kaw);
                Ecum += e; const float ep = __expf(Ecum), em = __builtin_amdgcn_rcpf(ep);
                bt[t] = bb * em; ktl[t] = kt * em;
                arr[t * 64 + lane] = (bf16_t)f2bf(r * ep); arr[1024 + t * 64 + lane] = (bf16_t)f2bf(n * ep_prev);
                arr[2048 + t * 64 + lane] = (bf16_t)f2bf(bt[t]); arr[3072 + t * 64 + lane] = (bf16_t)f2bf(ktl[t]);
                ep_prev = ep;
            }
            wc = ep_prev;
            u32x4* bd = (u32x4*)(bkb + lane * 16); u32x4* kd = (u32x4*)(bkb + 1024 + lane * 16);
            bd[0] = (u32x4){cvtpk(bt[0] * wc, bt[1] * wc), cvtpk(bt[2] * wc, bt[3] * wc), cvtpk(bt[4] * wc, bt[5] * wc), cvtpk(bt[6] * wc, bt[7] * wc)};
            bd[1] = (u32x4){cvtpk(bt[8] * wc, bt[9] * wc), cvtpk(bt[10] * wc, bt[11] * wc), cvtpk(bt[12] * wc, bt[13] * wc), cvtpk(bt[14] * wc, bt[15] * wc)};
            kd[0] = (u32x4){cvtpk(ktl[0] * wc, ktl[1] * wc), cvtpk(ktl[2] * wc, ktl[3] * wc), cvtpk(ktl[4] * wc, ktl[5] * wc), cvtpk(ktl[6] * wc, ktl[7] * wc)};
            kd[1] = (u32x4){cvtpk(ktl[8] * wc, ktl[9] * wc), cvtpk(ktl[10] * wc, ktl[11] * wc), cvtpk(ktl[12] * wc, ktl[13] * wc), cvtpk(ktl[14] * wc, ktl[15] * wc)};
        }
        LDS_WAIT();
        f32x4 gnb = {0.f, 0.f, 0.f, 0.f}, gnk = gnb, grb = gnb, grk = gnb;
#pragma unroll
        for (int ks = 0; ks < 2; ++ks) {
            const int o = c * 64 + ks * 32 + q * 8;
            const bf16x8 Ab = *(const bf16x8*)(arr + 2048 + o), Ak = *(const bf16x8*)(arr + 3072 + o), Bn = *(const bf16x8*)(arr + 1024 + o), Br = *(const bf16x8*)(arr + o);
            gnb = __builtin_amdgcn_mfma_f32_16x16x32_bf16(Ab, Bn, gnb, 0, 0, 0); gnk = __builtin_amdgcn_mfma_f32_16x16x32_bf16(Ak, Bn, gnk, 0, 0, 0);
            grb = __builtin_amdgcn_mfma_f32_16x16x32_bf16(Ab, Br, grb, 0, 0, 0); grk = __builtin_amdgcn_mfma_f32_16x16x32_bf16(Ak, Br, grk, 0, 0, 0);
        }
#pragma unroll
        for (int rg = 0; rg < 4; ++rg) { const int sI = 4 * q + rg; if (!(sI < c)) { gnb[rg] = 0.f; gnk[rg] = 0.f; } if (!(sI <= c)) { grb[rg] = 0.f; grk[rg] = 0.f; } gs[sI * 16 + c] = gnb[rg]; }
        LDS_WAIT();
        {
            float Tc[16];
#pragma unroll
            for (int sI = 15; sI >= 0; --sI) {
                float acc = (sI == c) ? 1.f : 0.f;
#pragma unroll
                for (int j = sI + 1; j < 16; ++j) acc += gs[sI * 16 + j] * Tc[j];
                Tc[sI] = acc;
            }
            LDS_WAIT();
            if (q == 0) {
#pragma unroll
                for (int j = 0; j < 4; ++j) *(f32x4*)(gs + c * 16 + 4 * j) = (f32x4){Tc[4 * j], Tc[4 * j + 1], Tc[4 * j + 2], Tc[4 * j + 3]};
            }
        }
        LDS_WAIT();
#pragma unroll
        for (int blk = 0; blk < 4; ++blk) {
            const int ks = blk & 1; const bf16_t* src = arr + (blk < 2 ? 1024 : 0) + c * 64 + ks * 32 + 4 * q;
            const u32x2 lo = *(const u32x2*)src, hi = *(const u32x2*)(src + 16);
            *(u32x4*)piece_ptr(A, blk, lane, m0, h) = (u32x4){lo.x, lo.y, hi.x, hi.y};
        }
#pragma unroll
        for (int ct = 0; ct < 4; ++ct) {
            const u32x2 lo = *(const u32x2*)(bkb + (16 * ct + c) * 16 + 4 * q), hi = *(const u32x2*)(bkb + 1024 + (16 * ct + c) * 16 + 4 * q);
            *(u32x4*)piece_ptr(A, 4 + ct, lane, m0, h) = (u32x4){lo.x, lo.y, hi.x, hi.y};
        }
        {
            unsigned char* sm = SM + (size_t)item * 2048;
            *(u32x2*)(sm + lane * 8) = (u32x2){cvtpk(gnk[0], gnk[1]), cvtpk(gnk[2], gnk[3])};
            const f32x4 tv = *(const f32x4*)(gs + c * 16 + 4 * q);
            *(u32x2*)(sm + 512 + lane * 8) = (u32x2){cvtpk(tv[0], tv[1]), cvtpk(tv[2], tv[3])};
            *(u32x4*)(sm + 1024 + lane * 16) = (u32x4){cvtpk(grb[0], grb[1]), cvtpk(grb[2], grb[3]), cvtpk(grk[0], grk[1]), cvtpk(grk[2], grk[3])};
            WC[(size_t)item * 64 + lane] = wc;
        }
        LDS_WAIT();
    }
}

constexpr int CS_SLOT = 12800, CS_PD = 8;
#define CS_BAR() asm volatile("s_waitcnt lgkmcnt(0)\n\ts_barrier" ::: "memory")
__device__ __forceinline__ void p13_chunk_scan(const Args& A, unsigned char* lds) {
    const int tid = opaque_tid(), lane = tid & 63, wave = __builtin_amdgcn_readfirstlane(tid >> 6), q = lane >> 4, c = lane & 15;
    float* part = (float*)lds; unsigned char* slots = lds + 1024;
    const bf16_t* VV = WSP(bf16_t, OFF_VV); bf16_t* Y = WSP(bf16_t, OFF_R); float* ST = WSP(float, OFF_STATS); const float* WC = WSP(float, OFF_WC); const unsigned char* SM = A.ws + OFF_SM;
    if (DEFER_W && (int)gridDim.x > BATCH * 16 && (int)blockIdx.x >= BATCH * 16) {
        float* scr = (float*)(lds + wave * 16384);
        const int gwi = ((int)blockIdx.x - BATCH * 16) * NWAVES + wave, ngwi = ((int)gridDim.x - BATCH * 16) * NWAVES;
        p0_weight<9>(A, WSP(bf16_t, OFF_WO1), 1024, 1024, scr, gwi, ngwi, lane);
        p0_weight<10>(A, WSP(bf16_t, OFF_WUP1), 4096, 1024, scr, gwi, ngwi, lane);
        p0_weight<11>(A, WSP(bf16_t, OFF_WDN1), 1024, 4096, scr, gwi, ngwi, lane);
        return;
    }
#pragma unroll 1
    for (int it = blockIdx.x; it < BATCH * 16; it += gridDim.x) {
        const int b = it >> 4, h = it & 15;
        __syncthreads();
        if (wave >= 4) {
            const int lw = wave - 4;
            const unsigned char* src[4]; int dst[4]; size_t step[4]; bool on[4];
#pragma unroll
            for (int i = 0; i < 4; ++i) { src[i] = A.ws; dst[i] = 0; step[i] = 0; on[i] = false; }
            if (lw < 2) {
#pragma unroll
                for (int i = 0; i < 4; ++i) { src[i] = piece_ptr(A, 4 * lw + i, lane, b * SEQ, h); dst[i] = (4 * lw + i) * 1024 + lane * 16; step[i] = (size_t)CH * DM * 2; on[i] = true; }
            } else if (lw == 2) {
                src[0] = SM + (size_t)it * NCHUNK * 2048 + lane * 32; src[1] = src[0] + 16; dst[0] = 8192 + lane * 32; dst[1] = dst[0] + 16; step[0] = step[1] = 2048; on[0] = on[1] = true;
                src[2] = (const unsigned char*)(WC + (size_t)it * NCHUNK * 64) + (lane & 15) * 16; dst[2] = 10240 + (lane & 15) * 16; step[2] = 256; on[2] = lane < 16;
            } else {
                src[0] = (const unsigned char*)(VV + (size_t)(b * SEQ + (lane >> 2)) * DM + h * 64 + (lane & 3) * 16); src[1] = src[0] + 16; dst[0] = 10496 + (lane >> 2) * 128 + (lane & 3) * 32; dst[1] = dst[0] + 16;
                step[0] = step[1] = (size_t)CH * DM * 2; on[0] = on[1] = true;
            }
            u32x4 ld[CS_PD][4];
#define LD_ISSUE(slotreg, chn) do { _Pragma("unroll") for (int i_ = 0; i_ < 4; ++i_) if (on[i_]) ld[slotreg][i_] = *(const u32x4*)(src[i_] + (size_t)(chn) * step[i_]); } while (0)
#define LD_WRITE(slotreg, chn) do { unsigned char* sl_ = slots + ((chn) % 3) * CS_SLOT; _Pragma("unroll") for (int i_ = 0; i_ < 4; ++i_) if (on[i_]) *(u32x4*)(sl_ + dst[i_]) = ld[slotreg][i_]; } while (0)
#pragma unroll
            for (int u = 0; u < CS_PD; ++u) LD_ISSUE(u, u);
            LD_WRITE(0, 0); LD_ISSUE(0, CS_PD);
            LD_WRITE(1, 1); LD_ISSUE(1, CS_PD + 1);
            CS_BAR();
#pragma unroll 1
            for (int ch = 0; ch < NCHUNK; ch += CS_PD) {
#pragma unroll
                for (int u = 0; u < CS_PD; ++u) {
                    const int cc = ch + u, wn = cc + 2;
                    if (wn < NCHUNK) { LD_WRITE((u + 2) % CS_PD, wn); if (wn + CS_PD < NCHUNK) LD_ISSUE((u + 2) % CS_PD, wn + CS_PD); }
                    CS_BAR();
                }
            }
#undef LD_ISSUE
#undef LD_WRITE
        } else {
            const int rt = wave;
            f32x4 St[4];
#pragma unroll
            for (int i = 0; i < 4; ++i) St[i] = (f32x4){0.f, 0.f, 0.f, 0.f};
            bf16x8 n0, n1, r0, r1, bk0, bk1, bk2, bk3, gr; u32x2 gnk, tt; unsigned short v0, v1, v2, v3; f32x4 w0, w1, w2, w3;
#define CS_LOAD(chn) do { const unsigned char* sl_ = slots + ((chn) % 3) * CS_SLOT; \
            n0 = *(const bf16x8*)(sl_ + lane * 16); n1 = *(const bf16x8*)(sl_ + 1024 + lane * 16); r0 = *(const bf16x8*)(sl_ + 2048 + lane * 16); r1 = *(const bf16x8*)(sl_ + 3072 + lane * 16); \
            bk0 = *(const bf16x8*)(sl_ + 4096 + lane * 16); bk1 = *(const bf16x8*)(sl_ + 5120 + lane * 16); bk2 = *(const bf16x8*)(sl_ + 6144 + lane * 16); bk3 = *(const bf16x8*)(sl_ + 7168 + lane * 16); \
            gnk = *(const u32x2*)(sl_ + 8192 + lane * 8); tt = *(const u32x2*)(sl_ + 8704 + lane * 8); gr = *(const bf16x8*)(sl_ + 9216 + lane * 16); \
            const float* wp_ = (const float*)(sl_ + 10240) + 4 * q; w0 = *(const f32x4*)(wp_); w1 = *(const f32x4*)(wp_ + 16); w2 = *(const f32x4*)(wp_ + 32); w3 = *(const f32x4*)(wp_ + 48); \
            const bf16_t* vp_ = (const bf16_t*)(sl_ + 10496) + (4 * q) * 64 + 16 * rt + c; v0 = vp_[0]; v1 = vp_[64]; v2 = vp_[128]; v3 = vp_[192]; } while (0)
            CS_BAR();
            CS_LOAD(0);
#pragma unroll 1
            for (int ch = 0; ch < NCHUNK; ++ch) {
                const int m0 = b * SEQ + ch * CH;
                const bf16x8 cn0 = n0, cn1 = n1, cr0 = r0, cr1 = r1, cb0 = bk0, cb1 = bk1, cb2 = bk2, cb3 = bk3, cgr = gr; const u32x2 cgnk = gnk, ctt = tt;
                const unsigned vlo = (unsigned)v0 | ((unsigned)v1 << 16), vhi = (unsigned)v2 | ((unsigned)v3 << 16); const f32x4 cw0 = w0, cw1 = w1, cw2 = w2, cw3 = w3;
                if (ch + 1 < NCHUNK) CS_LOAD(ch + 1);
                const f32x4 z = {0.f, 0.f, 0.f, 0.f};
                const bf16x8 bS0 = mk8(cvtpk(St[0][0], St[0][1]), cvtpk(St[0][2], St[0][3]), cvtpk(St[1][0], St[1][1]), cvtpk(St[1][2], St[1][3]));
                const bf16x8 bS1 = mk8(cvtpk(St[2][0], St[2][1]), cvtpk(St[2][2], St[2][3]), cvtpk(St[3][0], St[3][1]), cvtpk(St[3][2], St[3][3]));
                f32x4 X = __builtin_amdgcn_mfma_f32_16x16x32_bf16(cn0, bS0, z, 0, 0, 0);
                X = __builtin_amdgcn_mfma_f32_16x16x32_bf16(cn1, bS1, X, 0, 0, 0);
                X = __builtin_amdgcn_mfma_f32_16x16x32_bf16(mk8(cgnk.x, cgnk.y, 0u, 0u), mk8(vlo, vhi, 0u, 0u), X, 0, 0, 0);
                const f32x4 U = __builtin_amdgcn_mfma_f32_16x16x32_bf16(mk8(ctt.x, ctt.y, 0u, 0u), mk8(cvtpk(X[0], X[1]), cvtpk(X[2], X[3]), 0u, 0u), z, 0, 0, 0);
                const bf16x8 bUV = mk8(cvtpk(U[0], U[1]), cvtpk(U[2], U[3]), vlo, vhi);
                f32x4 Yt = __builtin_amdgcn_mfma_f32_16x16x32_bf16(cr0, bS0, z, 0, 0, 0);
                Yt = __builtin_amdgcn_mfma_f32_16x16x32_bf16(cr1, bS1, Yt, 0, 0, 0);
                Yt = __builtin_amdgcn_mfma_f32_16x16x32_bf16(cgr, bUV, Yt, 0, 0, 0);
                St[0] = __builtin_amdgcn_mfma_f32_16x16x32_bf16(cb0, bUV, St[0] * cw0, 0, 0, 0);
                St[1] = __builtin_amdgcn_mfma_f32_16x16x32_bf16(cb1, bUV, St[1] * cw1, 0, 0, 0);
                St[2] = __builtin_amdgcn_mfma_f32_16x16x32_bf16(cb2, bUV, St[2] * cw2, 0, 0, 0);
                St[3] = __builtin_amdgcn_mfma_f32_16x16x32_bf16(cb3, bUV, St[3] * cw3, 0, 0, 0);
                bf16_t* yp = Y + (size_t)(m0 + 4 * q) * DM + h * 64 + 16 * rt + c;
#pragma unroll
                for (int rg = 0; rg < 4; ++rg) {
                    yp[(size_t)rg * DM] = (bf16_t)f2bf(Yt[rg]);
                    const float s1 = row16_allsum(Yt[rg]), s2 = row16_allsum(Yt[rg] * Yt[rg]);
                    if (c == 0) *(f32x2*)(part + (((ch & 1) * 4 + rt) * 16 + 4 * q + rg) * 2) = (f32x2){s1, s2};
                }
                CS_BAR();
                if (rt == 0 && lane < 16) {
                    const float* pp = part + ((ch & 1) * 4 * 16 + lane) * 2; float s1 = 0.f, s2 = 0.f;
#pragma unroll
                    for (int w = 0; w < 4; ++w) { s1 += pp[w * 32]; s2 += pp[w * 32 + 1]; }
                    *(f32x4*)(ST + ((size_t)(m0 + lane) * 16 + h) * 4) = (f32x4){s1, s2, 0.f, 0.f};
                }
            }
#undef CS_LOAD
        }
    }
}
#undef CS_BAR

__device__ __forceinline__ void p18_final(const Args& A) {
    const int tid = opaque_tid(), lane = tid & 63, wave = tid >> 6;
    const int gw = blockIdx.x * NWAVES + wave, NGW = gridDim.x * NWAVES;
    const f32x4* gr = (const f32x4*)A.in[IN_FINN] + lane;
    for (int m = gw; m < MTOK; m += NGW) {
        f32x4* xr = (f32x4*)(A.out + (size_t)m * DM) + lane; f32x4 v[4]; float s = 0.f;
#pragma unroll
        for (int j = 0; j < 4; ++j) { v[j] = xr[64 * j]; s += (v[j].x * v[j].x + v[j].y * v[j].y) + (v[j].z * v[j].z + v[j].w * v[j].w); }
        const float rs = rsqrtf(wave_sum(s) * (1.f / DM) + NORM_EPS);
#pragma unroll
        for (int j = 0; j < 4; ++j) xr[64 * j] = v[j] * rs * gr[64 * j];
    }
}

typedef GAS unsigned gu32;
#define RLX_AGENT __ATOMIC_RELAXED, __HIP_MEMORY_SCOPE_AGENT
constexpr int CW_BAR = 4096;
constexpr int RING_BYTES = 131072, LDSCTL_OFF = RING_BYTES, MISC_OFF = LDSCTL_OFF + 320;
#define XB_TMO      128
#define XB_XCNT(j)  (256  + 64 * (j))
#define XB_XSUB(j)  (1280 + 64 * (j))
#define XB_XGEN(j)  (2304 + 64 * (j))
#define XB_TOP      3328
#define XB_TOPGEN   3392
#define XCD_BAR_WORDS 3456
#define XB_SPIN_CAP (1u << 18)

__device__ __forceinline__ unsigned xb_ld(unsigned* p)              { return __hip_atomic_load(p, __ATOMIC_RELAXED, __HIP_MEMORY_SCOPE_AGENT); }
__device__ __forceinline__ unsigned xb_add(unsigned* p, unsigned v) { return __hip_atomic_fetch_add(p, v, __ATOMIC_RELAXED, __HIP_MEMORY_SCOPE_AGENT); }
__device__ __forceinline__ unsigned xb_xcc_id() { return (unsigned)__builtin_amdgcn_s_getreg((3 << 11) | 20) & 0xFu; }
#define XB_SPIN(cond, bar) do { unsigned _sp = 0; while (cond) { __builtin_amdgcn_s_sleep(1); \
    if ((++_sp & 255u) == 0u) { if (xb_ld(&(bar)[XB_TMO])) break; if (_sp > XB_SPIN_CAP) { atomicAdd(&(bar)[XB_TMO], 1u); break; } } } } while (0)

struct XcdBarrier {
    unsigned* bar; unsigned x;
    volatile LAS unsigned* st;
};

__device__ __forceinline__ XcdBarrier xcd_barrier_post(unsigned* bar, volatile LAS unsigned* st) {
    XcdBarrier b; b.bar = bar; b.x = xb_xcc_id(); b.st = st;
    if (threadIdx.x == 0) (void)xb_add(&bar[XB_XCNT(b.x)], 1u);
    return b;
}
__device__ __forceinline__ void xcd_barrier_complete(unsigned* bar, unsigned x, unsigned& nloc, unsigned& nx) {
    const unsigned G = gridDim.x * gridDim.y * gridDim.z;
    unsigned sum, cnt, mine, sp = 0u;
    for (;;) {
        sum = 0u; cnt = 0u; mine = 0u;
#pragma unroll
        for (unsigned j = 0; j < 16; ++j) { const unsigned c = xb_ld(&bar[XB_XCNT(j)]); sum += c; cnt += (c > 0u) ? 1u : 0u; mine = (j == x) ? c : mine; }
        if (sum == G) break;
        __builtin_amdgcn_s_sleep(1);
        if ((++sp & 255u) == 0u) { if (xb_ld(&bar[XB_TMO])) break; if (sp > XB_SPIN_CAP) { atomicAdd(&bar[XB_TMO], 1u); break; } }
    }
    nloc = mine > 0u ? mine : 1u; nx = cnt > 0u ? cnt : 1u;
}

__device__ __forceinline__ void xcd_barrier(const XcdBarrier& b) {
    asm volatile("s_waitcnt vmcnt(0)" ::: "memory");
    __syncthreads();
    if (threadIdx.x == 0) {
        unsigned* bar = b.bar;
        __builtin_amdgcn_s_waitcnt(0);
        unsigned nloc = b.st[0], nx = b.st[1];
        if (nloc == 0u) { xcd_barrier_complete(bar, b.x, nloc, nx); b.st[0] = nloc; b.st[1] = nx; }
        const unsigned old = xb_add(&bar[XB_XSUB(b.x)], 1u);
        const unsigned gen = old / nloc;
        if (old + 1u == (gen + 1u) * nloc) {
            __builtin_amdgcn_fence(__ATOMIC_RELEASE, "agent");
            asm volatile("s_waitcnt vmcnt(0)" ::: "memory");
            const unsigned og = xb_add(&bar[XB_TOP], 1u);
            const unsigned tg = og / nx;
            if (og + 1u == (tg + 1u) * nx) xb_add(&bar[XB_TOPGEN], 1u);
            else XB_SPIN(xb_ld(&bar[XB_TOPGEN]) == tg, bar);
            __builtin_amdgcn_fence(__ATOMIC_ACQUIRE, "agent");
            xb_add(&bar[XB_XGEN(b.x)], 1u);
            asm volatile("s_waitcnt vmcnt(0)" ::: "memory");
        } else {
            XB_SPIN(xb_ld(&bar[XB_XGEN(b.x)]) == gen, bar);
            __builtin_amdgcn_fence(__ATOMIC_ACQUIRE, "agent");
            asm volatile("s_waitcnt vmcnt(0)" ::: "memory");
        }
    }
    __syncthreads();
}

constexpr int N_PHASES = 19;
template <int LO, int HI> __global__ void __launch_bounds__(NTHR, 2) mk_fwd(Args A) {
    extern __shared__ __attribute__((aligned(16))) unsigned char lds[];
#define IN(k) (LO <= (k) && (k) < HI)
    constexpr bool FUSED = (HI - LO) > 1;
    XcdBarrier bar; bar.bar = nullptr; bar.x = 0; bar.st = nullptr;
    if constexpr (FUSED) {
        for (int u = threadIdx.x; u < (LDS_BYTES - LDSCTL_OFF) / 4; u += NTHR) ((LAS unsigned*)((LAS unsigned char*)lds + LDSCTL_OFF))[u] = 0u;
        __syncthreads();
        bar = xcd_barrier_post(WSP(unsigned, OFF_CTL) + CW_BAR, (volatile LAS unsigned*)((LAS unsigned char*)lds + MISC_OFF) + 8);
    }
#define SEAM(k) do { if constexpr (FUSED && IN(k) && IN((k) + 1)) { if ((k) == 0) cg::this_grid().sync(); else xcd_barrier(bar); if (DBG_TS && blockIdx.x == 0 && threadIdx.x == 0) ((unsigned long long*)(A.ws + OFF_CTL + 16384))[(k) + 1] = __builtin_amdgcn_s_memrealtime(); } } while (0)
    if (DBG_TS && FUSED && blockIdx.x == 0 && threadIdx.x == 0) ((unsigned long long*)(A.ws + OFF_CTL + 16384))[0] = __builtin_amdgcn_s_memrealtime();
    if constexpr (IN(0)) p0_prologue(A, lds);
    if constexpr (FUSED && IN(0) && ((REP_MASK >> 0) & 1u)) xcd_barrier(bar);
    if constexpr (FUSED && IN(0) && ((REP_MASK >> 0) & 1u)) p0_prologue(A, lds);
    SEAM(0);
    if constexpr (IN(1)) {
        Gemm g{WSP(bf16_t, OFF_H0), WSP(bf16_t, OFF_H0), 1 << 30, WSP(bf16_t, OFF_WIN), MTOK, 2304, DM};
        EpiInProj E{WSP(bf16_t, OFF_QO), WSP(bf16_t, OFF_K), WSP(bf16_t, OFF_V), WSP(bf16_t, OFF_QI), WSP(bf16_t, OFF_KI), WSP(float, OFF_WI), WSP(float, OFF_ROPE)};
        gemm_phase(lds, g, E);
    }
    SEAM(1);
    if constexpr (IN(2)) { if (FAST_TOPK) p2_fast(A, lds); else p2_naive(A, lds);
#if DBG_TOPK
        __syncthreads(); p2_naive(A, lds, 160 * MiB);
#endif
    }
    if constexpr (FUSED && IN(2) && ((REP_MASK >> 2) & 1u)) xcd_barrier(bar);
    if constexpr (FUSED && IN(2) && ((REP_MASK >> 2) & 1u)) { if (FAST_TOPK) p2_fast(A, lds); else p2_naive(A, lds);
#if DBG_TOPK
        __syncthreads(); p2_naive(A, lds, 160 * MiB);
#endif
    }
    if constexpr (FUSED && IN(2) && PROBE_P2 > 0) { xcd_barrier(bar); p2_fast<PROBE_P2>(A, lds); }
    SEAM(2);
    if constexpr (IN(3)) {
#if DBG_TOPK
        {
            const int lane_ = threadIdx.x & 63, gw_ = blockIdx.x * NWAVES + (threadIdx.x >> 6);
            const unsigned* M1 = WSP(unsigned, OFF_MASK); const unsigned* M2 = WSP(unsigned, 160 * MiB); unsigned rows_ = 0, bits_ = 0, bad1_ = 0, bad2_ = 0;
            for (int m = gw_; m < MTOK; m += gridDim.x * NWAVES) { const unsigned d = M1[(size_t)m * 64 + lane_] ^ M2[(size_t)m * 64 + lane_]; const int nb = wave_allsum_i(__popc(d)); if (nb) { rows_ += 1; bits_ += nb; }
                const int t_ = m & (SEQ - 1), ex_ = t_ + 1 < 256 ? t_ + 1 : 256; if (wave_allsum_i(__popc(M1[(size_t)m * 64 + lane_])) != ex_) bad1_ += 1; if (wave_allsum_i(__popc(M2[(size_t)m * 64 + lane_])) != ex_) bad2_ += 1; }
            if (lane_ == 0) { atomicAdd(WSP(unsigned, OFF_CTL) + 1000, rows_); atomicAdd(WSP(unsigned, OFF_CTL) + 1001, bits_); atomicAdd(WSP(unsigned, OFF_CTL) + 1002, bad1_); atomicAdd(WSP(unsigned, OFF_CTL) + 1003, bad2_); }
        }
#endif
        if (FAST_ATTN) {
            static_assert(attn_body::ATTN_LDS_BYTES <= RING_BYTES, "attention LDS");
            const attn_body::AttnTensors AT{(const attn_body::bf16*)WSP(bf16_t, OFF_QO), (const attn_body::bf16*)WSP(bf16_t, OFF_K), (const attn_body::bf16*)WSP(bf16_t, OFF_V), (attn_body::bf16*)WSP(bf16_t, OFF_QO), WSP(unsigned, OFF_MASK)};
            const attn_body::StaticOrder S((int)gridDim.x, (int)blockIdx.x);
            attn_body::attn_phase<attn_body::StaticOrder>((char*)lds, AT, S);
        } else p3_naive(A, lds);
    }
    if constexpr (FUSED && REP_123 && IN(3)) xcd_barrier(bar);
    if constexpr (FUSED && REP_123 && IN(3)) {
        Gemm g{WSP(bf16_t, OFF_H0), WSP(bf16_t, OFF_H0), 1 << 30, WSP(bf16_t, OFF_WIN), MTOK, 2304, DM};
        EpiInProj E{WSP(bf16_t, OFF_QO), WSP(bf16_t, OFF_K), WSP(bf16_t, OFF_V), WSP(bf16_t, OFF_QI), WSP(bf16_t, OFF_KI), WSP(float, OFF_WI), WSP(float, OFF_ROPE)};
        gemm_phase(lds, g, E);
    }
    if constexpr (FUSED && REP_123 && IN(3)) xcd_barrier(bar);
    if constexpr (FUSED && REP_123 && IN(3)) { if (FAST_TOPK) p2_fast(A, lds); else p2_naive(A, lds);
#if DBG_TOPK
        __syncthreads(); p2_naive(A, lds, 160 * MiB);
#endif
    }
    if constexpr (FUSED && REP_123 && IN(3)) xcd_barrier(bar);
    if constexpr (FUSED && REP_123 && IN(3)) {
#if DBG_TOPK
        {
            const int lane_ = threadIdx.x & 63, gw_ = blockIdx.x * NWAVES + (threadIdx.x >> 6);
            const unsigned* M1 = WSP(unsigned, OFF_MASK); const unsigned* M2 = WSP(unsigned, 160 * MiB); unsigned rows_ = 0, bits_ = 0, bad1_ = 0, bad2_ = 0;
            for (int m = gw_; m < MTOK; m += gridDim.x * NWAVES) { const unsigned d = M1[(size_t)m * 64 + lane_] ^ M2[(size_t)m * 64 + lane_]; const int nb = wave_allsum_i(__popc(d)); if (nb) { rows_ += 1; bits_ += nb; }
                const int t_ = m & (SEQ - 1), ex_ = t_ + 1 < 256 ? t_ + 1 : 256; if (wave_allsum_i(__popc(M1[(size_t)m * 64 + lane_])) != ex_) bad1_ += 1; if (wave_allsum_i(__popc(M2[(size_t)m * 64 + lane_])) != ex_) bad2_ += 1; }
            if (lane_ == 0) { atomicAdd(WSP(unsigned, OFF_CTL) + 1000, rows_); atomicAdd(WSP(unsigned, OFF_CTL) + 1001, bits_); atomicAdd(WSP(unsigned, OFF_CTL) + 1002, bad1_); atomicAdd(WSP(unsigned, OFF_CTL) + 1003, bad2_); }
        }
#endif
        if (FAST_ATTN) {
            static_assert(attn_body::ATTN_LDS_BYTES <= RING_BYTES, "attention LDS");
            const attn_body::AttnTensors AT{(const attn_body::bf16*)WSP(bf16_t, OFF_QO), (const attn_body::bf16*)WSP(bf16_t, OFF_K), (const attn_body::bf16*)WSP(bf16_t, OFF_V), (attn_body::bf16*)WSP(bf16_t, OFF_QO), WSP(unsigned, OFF_MASK)};
            const attn_body::StaticOrder S((int)gridDim.x, (int)blockIdx.x);
            attn_body::attn_phase<attn_body::StaticOrder>((char*)lds, AT, S);
        } else p3_naive(A, lds);
    }
    SEAM(3);
    if constexpr (IN(4)) {
        Gemm g{WSP(bf16_t, OFF_QO), WSP(bf16_t, OFF_QO), 1 << 30, WSP(bf16_t, OFF_WO0), MTOK, DM, DM};
        EpiResid E{A.in[IN_X], A.out, WSP(bf16_t, OFF_XB), WSP(float, OFF_SSQ0)};
        gemm_phase(lds, g, E);
    }
    SEAM(4);
    if constexpr (IN(5)) {
        Gemm g{WSP(bf16_t, OFF_XB), WSP(bf16_t, OFF_XB), 1 << 30, WSP(bf16_t, OFF_WUP0), MTOK, FF, DM};
        EpiUp E{WSP(bf16_t, OFF_U), WSP(float, OFF_SSQ0)};
        gemm_phase(lds, g, E);
    }
    if constexpr (FUSED && IN(5) && ((REP_MASK >> 5) & 1u)) xcd_barrier(bar);
    if constexpr (FUSED && IN(5) && ((REP_MASK >> 5) & 1u)) {
        Gemm g{WSP(bf16_t, OFF_XB), WSP(bf16_t, OFF_XB), 1 << 30, WSP(bf16_t, OFF_WUP0), MTOK, FF, DM};
        EpiUp E{WSP(bf16_t, OFF_U), WSP(float, OFF_SSQ0)};
        gemm_phase(lds, g, E);
    }
    SEAM(5);
    if constexpr (IN(6)) {
        Gemm g{WSP(bf16_t, OFF_U), WSP(bf16_t, OFF_U), 1 << 30, WSP(bf16_t, OFF_WDN0), MTOK, DM, FF};
        EpiResid E{A.out, A.out, nullptr, nullptr};
        gemm_phase(lds, g, E);
    }
    SEAM(6);
    if constexpr (IN(7)) p7_prep(A);
    if constexpr (FUSED && IN(7) && ((REP_MASK >> 7) & 1u)) xcd_barrier(bar);
    if constexpr (FUSED && IN(7) && ((REP_MASK >> 7) & 1u)) p7_prep(A);
    SEAM(7);
    if constexpr (IN(8)) {
        Gemm g{WSP(bf16_t, OFF_XSR), WSP(bf16_t, OFF_XSK), 4, WSP(bf16_t, OFF_WRK), MTOK, 2048, DM};
        EpiStore E{WSP(bf16_t, OFF_R), DM, 4, WSP(bf16_t, OFF_KR), DM};
        gemm_phase(lds, g, E);
    }
    if constexpr (FUSED && IN(8) && ((REP_MASK >> 8) & 1u)) xcd_barrier(bar);
    if constexpr (FUSED && IN(8) && ((REP_MASK >> 8) & 1u)) {
        Gemm g{WSP(bf16_t, OFF_XSR), WSP(bf16_t, OFF_XSK), 4, WSP(bf16_t, OFF_WRK), MTOK, 2048, DM};
        EpiStore E{WSP(bf16_t, OFF_R), DM, 4, WSP(bf16_t, OFF_KR), DM};
        gemm_phase(lds, g, E);
    }
    SEAM(8);
    if constexpr (IN(9)) {
        Gemm g{WSP(bf16_t, OFF_XSV), WSP(bf16_t, OFF_H1), 4, WSP(bf16_t, OFF_WVL), MTOK, 1792, DM};
        EpiStore E{WSP(bf16_t, OFF_VV), DM, 4, WSP(bf16_t, OFF_P), 768};
        gemm_phase(lds, g, E);
    }
    if constexpr (FUSED && IN(9) && ((REP_MASK >> 9) & 1u)) xcd_barrier(bar);
    if constexpr (FUSED && IN(9) && ((REP_MASK >> 9) & 1u)) {
        Gemm g{WSP(bf16_t, OFF_XSV), WSP(bf16_t, OFF_H1), 4, WSP(bf16_t, OFF_WVL), MTOK, 1792, DM};
        EpiStore E{WSP(bf16_t, OFF_VV), DM, 4, WSP(bf16_t, OFF_P), 768};
        gemm_phase(lds, g, E);
    }
    SEAM(9);
    if constexpr (IN(10)) p10_loramid(A);
    if constexpr (FUSED && IN(10) && ((REP_MASK >> 10) & 1u)) xcd_barrier(bar);
    if constexpr (FUSED && IN(10) && ((REP_MASK >> 10) & 1u)) p10_loramid(A);
    SEAM(10);
    if constexpr (IN(11)) {
        Gemm g{WSP(bf16_t, OFF_AW), WSP(bf16_t, OFF_AA), 4, WSP(bf16_t, OFF_W2T), MTOK, 2048, 128};
        EpiLoraUp E{WSP(bf16_t, OFF_E), WSP(bf16_t, OFF_A), A.in[IN_W0], A.in[IN_A0]};
        gemm_phase(lds, g, E);
    }
    if constexpr (FUSED && IN(11) && ((REP_MASK >> 11) & 1u)) xcd_barrier(bar);
    if constexpr (FUSED && IN(11) && ((REP_MASK >> 11) & 1u)) {
        Gemm g{WSP(bf16_t, OFF_AW), WSP(bf16_t, OFF_AA), 4, WSP(bf16_t, OFF_W2T), MTOK, 2048, 128};
        EpiLoraUp E{WSP(bf16_t, OFF_E), WSP(bf16_t, OFF_A), A.in[IN_W0], A.in[IN_A0]};
        gemm_phase(lds, g, E);
    }
    SEAM(11);
    if constexpr (IN(12)) { if (CHUNK_SCAN) p12_chunk_prep(A, lds); else if (FAST_SCAN) p12_fast(A, lds); else p12_naive(A, lds); }
    if constexpr (FUSED && IN(12) && ((REP_MASK >> 12) & 1u)) xcd_barrier(bar);
    if constexpr (FUSED && IN(12) && ((REP_MASK >> 12) & 1u)) { if (FAST_SCAN) p12_fast(A, lds); else p12_naive(A, lds); }
    SEAM(12);
    if constexpr (IN(13)) { if (CHUNK_SCAN) p13_chunk_scan(A, lds); else if (!FAST_SCAN) p12b_stats(A); }
    SEAM(13);
    if constexpr (IN(14)) {
        Gemm g{WSP(bf16_t, OFF_AG), WSP(bf16_t, OFF_AG), 1 << 30, WSP(bf16_t, OFF_G2T), MTOK, DM, 256};
        EpiGatePost E{WSP(bf16_t, OFF_AO), WSP(bf16_t, CHUNK_SCAN ? OFF_R : OFF_Y), WSP(bf16_t, OFF_VV), WSP(float, OFF_STATS), WSP(float, OFF_BONUS), A.in[IN_LNW], A.in[IN_LNB]};
        gemm_phase(lds, g, E);
    }
    if constexpr (FUSED && IN(14) && ((REP_MASK >> 14) & 1u)) xcd_barrier(bar);
    if constexpr (FUSED && IN(14) && ((REP_MASK >> 14) & 1u)) {
        Gemm g{WSP(bf16_t, OFF_AG), WSP(bf16_t, OFF_AG), 1 << 30, WSP(bf16_t, OFF_G2T), MTOK, DM, 256};
        EpiGatePost E{WSP(bf16_t, OFF_AO), WSP(bf16_t, CHUNK_SCAN ? OFF_R : OFF_Y), WSP(bf16_t, OFF_VV), WSP(float, OFF_STATS), WSP(float, OFF_BONUS), A.in[IN_LNW], A.in[IN_LNB]};
        gemm_phase(lds, g, E);
    }
    SEAM(14);
    if constexpr (IN(15)) {
        Gemm g{WSP(bf16_t, OFF_AO), WSP(bf16_t, OFF_AO), 1 << 30, WSP(bf16_t, OFF_WO1), MTOK, DM, DM};
        EpiResid E{A.out, A.out, WSP(bf16_t, OFF_XB), WSP(float, OFF_SSQ1)};
        gemm_phase(lds, g, E);
    }
    SEAM(15);
    if constexpr (IN(16)) {
        Gemm g{WSP(bf16_t, OFF_XB), WSP(bf16_t, OFF_XB), 1 << 30, WSP(bf16_t, OFF_WUP1), MTOK, FF, DM};
        EpiUp E{WSP(bf16_t, OFF_U), WSP(float, OFF_SSQ1)};
        gemm_phase(lds, g, E);
    }
    if constexpr (FUSED && IN(16) && ((REP_MASK >> 16) & 1u)) xcd_barrier(bar);
    if constexpr (FUSED && IN(16) && ((REP_MASK >> 16) & 1u)) {
        Gemm g{WSP(bf16_t, OFF_XB), WSP(bf16_t, OFF_XB), 1 << 30, WSP(bf16_t, OFF_WUP1), MTOK, FF, DM};
        EpiUp E{WSP(bf16_t, OFF_U), WSP(float, OFF_SSQ1)};
        gemm_phase(lds, g, E);
    }
    SEAM(16);
    if constexpr (IN(17)) {
        Gemm g{WSP(bf16_t, OFF_U), WSP(bf16_t, OFF_U), 1 << 30, WSP(bf16_t, OFF_WDN1), MTOK, DM, FF};
        EpiResid E{A.out, A.out, nullptr, nullptr};
        gemm_phase(lds, g, E);
    }
    SEAM(17);
    if constexpr (IN(18)) {
        p18_final(A);
#if DBG_TS
        {   __syncthreads(); const unsigned long long* ts_ = (const unsigned long long*)(A.ws + OFF_CTL + 16384);
            const float usA_ = (float)(ts_[DBG_TS_A + 1] - ts_[DBG_TS_A]) * 0.01f;
            if (blockIdx.x == 1 && threadIdx.x == 0) A.out[12345] = usA_ * 0.2f; }
#endif
#if DBG_TOPK
        {   __syncthreads(); const float sc_ = 1.f + (float)WSP(unsigned, OFF_CTL)[1000 + DBG_WHICH] * DBG_UNIT;
            const int gw_ = blockIdx.x * NWAVES + (threadIdx.x >> 6), lane_ = threadIdx.x & 63;
            for (int m = gw_; m < MTOK; m += gridDim.x * NWAVES) for (int j = 0; j < 16; ++j) A.out[(size_t)m * DM + lane_ + 64 * j] *= sc_; }
#endif
    }
#undef IN
#undef SEAM
}

template <int P> static void launch_all(int grid, hipStream_t stream, const Args& a) {
    if constexpr (P < N_PHASES) {
        static bool attr_done = false;
        if (!attr_done) { (void)hipFuncSetAttribute((const void*)mk_fwd<P, P + 1>, hipFuncAttributeMaxDynamicSharedMemorySize, LDS_BYTES); attr_done = true; }
        hipLaunchKernelGGL((mk_fwd<P, P + 1>), dim3(grid), dim3(NTHR), LDS_BYTES, stream, a);
        launch_all<P + 1>(grid, stream, a);
    }
}
extern "C" void kernel_launch(void* const* d_in, const int* in_sizes, int n_in, void* d_out, int out_size, void* d_ws, size_t ws_size, hipStream_t stream) {
    static int grid = 0;
    if (grid == 0) {
        if (n_in != N_IN || out_size != MTOK * DM || ws_size < WS_END) { fprintf(stderr, "kernel_launch: unexpected shapes (n_in %d out %d ws %zu)\n", n_in, out_size, ws_size); grid = -1; return; }
        int dev = 0, cus = 0;
        (void)hipGetDevice(&dev); (void)hipDeviceGetAttribute(&cus, hipDeviceAttributeMultiprocessorCount, dev);
        grid = cus > 0 ? cus : 256;
    }
    if (grid < 0) return;
    (void)hipMemsetAsync((char*)d_ws + OFF_CTL, 0, CTL_BYTES, stream);
    Args a{};
    for (int i = 0; i < N_IN; ++i) a.in[i] = (const float*)d_in[i];
    a.out = (float*)d_out; a.ws = (unsigned char*)d_ws;
#if ONE_LAUNCH
    static bool attr_done = false;
    if (!attr_done) {
        (void)hipFuncSetAttribute((const void*)mk_fwd<0, N_PHASES>, hipFuncAttributeMaxDynamicSharedMemorySize, LDS_BYTES);
        int per_cu = 0;
        if (hipOccupancyMaxActiveBlocksPerMultiprocessor(&per_cu, (const void*)mk_fwd<0, N_PHASES>, NTHR, LDS_BYTES) != hipSuccess || per_cu < 1)
            fprintf(stderr, "kernel_launch: occupancy query reports %d blocks per CU\n", per_cu);
        (void)hipGetLastError();
        attr_done = true;
    }
    void* kargs[] = {(void*)&a};
    hipError_t e = hipLaunchCooperativeKernel((const void*)mk_fwd<0, N_PHASES>, dim3(grid), dim3(NTHR), kargs, LDS_BYTES, stream);
    if (e != hipSuccess) fprintf(stderr, "kernel_launch: cooperative launch failed: %s (grid %d)\n", hipGetErrorString(e), grid);
#else
    launch_all<0>(grid, stream, a);
#endif
}
```

```cpp
#include <hip/hip_runtime.h>
#include <hip/hip_cooperative_groups.h>
#include <hip/hip_bf16.h>
#include <cmath>
#include <cstdio>
#include <cstdint>
namespace cg = cooperative_groups;

#ifndef ONE_LAUNCH
#define ONE_LAUNCH 1
#endif
#ifndef DBG_TOPK
#define DBG_TOPK 0
#define DBG_WHICH 2
#define DBG_UNIT 0.001f
#endif
#ifndef REP_MASK
#define REP_MASK 0u
#endif
#ifndef REP_123
#define REP_123 0
#endif
#ifndef DBG_TS
#define DBG_TS 0
#define DBG_TS_A 12
#define DBG_TS_B 13
#endif
#ifndef PROBE_P2
#define PROBE_P2 0
#endif
#ifndef DEFER_W
#define DEFER_W 1
#endif
#ifndef CHUNK_SCAN
#define CHUNK_SCAN 1
#endif
#ifndef FAST_ATTN
#define FAST_ATTN 1
#endif
#ifndef FAST_TOPK
#define FAST_TOPK 1
#endif
#ifndef FAST_SCAN
#define FAST_SCAN 1
#endif
#ifndef FAST_GEMM
#define FAST_GEMM 1
#endif

#define LAS __attribute__((address_space(3)))
#define GAS __attribute__((address_space(1)))
typedef unsigned short bf16_t;
typedef short bf16x8 __attribute__((ext_vector_type(8)));
typedef float f32x4 __attribute__((ext_vector_type(4)));
typedef float f32x2 __attribute__((ext_vector_type(2)));
typedef unsigned u32x4 __attribute__((ext_vector_type(4)));
typedef unsigned u32x2 __attribute__((ext_vector_type(2)));

constexpr int BATCH = 8, SEQ = 2048, DM = 1024, MTOK = BATCH * SEQ, FF = 4096;
constexpr int NWAVES = 8, NTHR = 512;
constexpr int LDS_BYTES = 147456;
constexpr float NORM_EPS = 1e-6f, LNX_EPS = 64e-5f;
constexpr float QSCALE = 0.125f * 1.4426950408889634f;
constexpr float WI_SCALE = 0.044194173824159216f;

enum { IN_X = 0, IN_MIXN, IN_MLPN, IN_WUP, IN_WDN, IN_FINN, IN_WIN, IN_WO, IN_MU, IN_WRKV, IN_W0, IN_W1, IN_W2, IN_A0, IN_A1, IN_A2,
       IN_G1, IN_G2, IN_KK, IN_KA, IN_RK, IN_LNW, IN_LNB, IN_WO1, N_IN };

constexpr size_t MiB = 1u << 20;
constexpr size_t OFF_CTL = 0, CTL_BYTES = 1 * MiB;
constexpr size_t OFF_SSQ0 = 256 * 1024, OFF_SSQ1 = 320 * 1024;
constexpr size_t OFF_ROPE = 1 * MiB;
constexpr size_t OFF_WIN = 2 * MiB, OFF_WO0 = 7 * MiB, OFF_WUP0 = 9 * MiB, OFF_WDN0 = 17 * MiB, OFF_WRK = 25 * MiB, OFF_WVL = 29 * MiB;
constexpr size_t OFF_W2T = 33 * MiB, OFF_A2T = 33 * MiB + 256 * 1024, OFF_G2T = 33 * MiB + 512 * 1024, OFF_WO1 = 34 * MiB, OFF_WUP1 = 36 * MiB, OFF_WDN1 = 44 * MiB;
constexpr size_t OFF_BONUS = 2 * MiB;
constexpr size_t OFF_H0 = 52 * MiB, OFF_QO = 84 * MiB, OFF_K = 116 * MiB, OFF_V = 124 * MiB, OFF_QI = 132 * MiB, OFF_KI = 148 * MiB, OFF_WI = 150 * MiB, OFF_MASK = 152 * MiB;
constexpr size_t OFF_XB = 52 * MiB, OFF_U = 84 * MiB;
constexpr size_t OFF_XSR = 52 * MiB, OFF_XSK = 84 * MiB, OFF_XSV = 116 * MiB, OFF_H1 = 148 * MiB, OFF_R = 180 * MiB, OFF_KR = 212 * MiB;
constexpr size_t OFF_VV = 52 * MiB, OFF_P = 84 * MiB, OFF_AW = 108 * MiB, OFF_AA = 112 * MiB, OFF_AG = 244 * MiB;
constexpr size_t OFF_E = 116 * MiB, OFF_A = 148 * MiB, OFF_Y = 84 * MiB, OFF_STATS = 252 * MiB, OFF_AO = 116 * MiB;
constexpr size_t WS_END = 256 * MiB;

struct Args { const float* in[N_IN]; float* out; unsigned char* ws; int ph_lo, ph_hi; };
#define WSP(T, off) ((T*)(A.ws + (off)))

__device__ __forceinline__ float bf2f(bf16_t u) { return __uint_as_float((unsigned)u << 16); }
__device__ __forceinline__ unsigned f2bf(float f) { unsigned u = __float_as_uint(f); return (u + 0x7fffu + ((u >> 16) & 1u)) >> 16; }
__device__ __forceinline__ unsigned pk2(float lo, float hi) { return f2bf(lo) | (f2bf(hi) << 16); }
__device__ __forceinline__ float wave_sum(float v) {
#pragma unroll
    for (int o = 1; o < 64; o <<= 1) v += __shfl_xor(v, o);
    return v;
}
__device__ __forceinline__ float wave_max(float v) {
#pragma unroll
    for (int o = 1; o < 64; o <<= 1) v = fmaxf(v, __shfl_xor(v, o));
    return v;
}
#define LDS_WAIT() asm volatile("s_waitcnt lgkmcnt(0)" ::: "memory")
__device__ __forceinline__ int opaque_tid() { int t = threadIdx.x; asm volatile("" : "+v"(t)); return t; }
__device__ __forceinline__ float sigmoidf_(float z) { return __builtin_amdgcn_rcpf(1.f + __expf(-z)); }

__device__ __forceinline__ float block_sum(float v, float* red, int wave, int lane) {
    v = wave_sum(v); __syncthreads(); if (lane == 0) red[wave] = v; __syncthreads();
    float s = 0.f;
#pragma unroll
    for (int i = 0; i < NWAVES; ++i) s += red[i];
    return s;
}
__device__ __forceinline__ float block_max(float v, float* red, int wave, int lane) {
    v = wave_max(v); __syncthreads(); if (lane == 0) red[wave] = v; __syncthreads();
    float s = red[0];
#pragma unroll
    for (int i = 1; i < NWAVES; ++i) s = fmaxf(s, red[i]);
    return s;
}

template <int ID> __device__ __forceinline__ float wval(const Args& A, int n, int k) {
    if constexpr (ID == 0) {
        int col;
        if (n < 1280 || (n >= 1536 && n < 2112)) { const int hd = n >> 6, j = n & 63; col = (hd << 6) + (j >> 1) + ((j & 1) << 5); }
        else if (n < 2120) col = n; else return 0.f;
        return A.in[IN_WIN][(size_t)k * 2120 + col];
    } else if constexpr (ID == 1) { return A.in[IN_WO][(size_t)k * 1024 + n];
    } else if constexpr (ID == 2) { return A.in[IN_WUP][(size_t)k * 4096 + n] * A.in[IN_MLPN][k];
    } else if constexpr (ID == 3) { return A.in[IN_WDN][(size_t)k * 1024 + n];
    } else if constexpr (ID == 4) { return A.in[IN_WRKV][(size_t)(n >> 10) * 1048576 + (size_t)k * 1024 + (n & 1023)];
    } else if constexpr (ID == 5) {
        if (n < 1024) return A.in[IN_WRKV][(size_t)2 * 1048576 + (size_t)k * 1024 + n];
        const int j = n - 1024; const float* mu = A.in[IN_MU];
        if (j < 128) { const float m = mu[3 * 1024 + k], w = A.in[IN_W1][k * 64 + (j & 63)]; return (j < 64 ? 1.f - m : m) * w; }
        if (j < 256) { const float m = mu[4 * 1024 + k], w = A.in[IN_A1][k * 64 + (j & 63)]; return (j < 192 ? 1.f - m : m) * w; }
        if (j < 576) { const float m = mu[5 * 1024 + k]; const int jj = j - 256, c = jj < 160 ? jj : jj - 160; const float w = A.in[IN_G1][k * 160 + c]; return (jj < 160 ? 1.f - m : m) * w; }
        return 0.f;
    } else if constexpr (ID == 6) { return k < 64 ? A.in[IN_W2][(size_t)k * 1024 + n] : 0.f;
    } else if constexpr (ID == 7) { return k < 64 ? A.in[IN_A2][(size_t)k * 1024 + n] : 0.f;
    } else if constexpr (ID == 8) { return k < 160 ? A.in[IN_G2][(size_t)k * 1024 + n] : 0.f;
    } else if constexpr (ID == 9) { return A.in[IN_WO1][(size_t)k * 1024 + n];
    } else if constexpr (ID == 10) { return A.in[IN_WUP][(size_t)4194304 + (size_t)k * 4096 + n] * A.in[IN_MLPN][1024 + k];
    } else { return A.in[IN_WDN][(size_t)4194304 + (size_t)k * 1024 + n]; }
}
template <int ID> __device__ __forceinline__ void p0_weight(const Args& A, bf16_t* dst, int N, int K, float* scr, int gw, int NGW, int lane) {
    const int nblk = N / 32, nitems = (K / 64) * nblk;
    for (int it = gw; it < nitems; it += NGW) {
        const int kb = it / nblk, nb = it % nblk, k0 = 64 * kb, n0 = 32 * nb;
#pragma unroll 8
        for (int i = 0; i < 32; ++i) { const int kk = 2 * i + (lane >> 5); scr[kk * 33 + (lane & 31)] = wval<ID>(A, n0 + (lane & 31), k0 + kk); }
        LDS_WAIT();
        const int c = lane & 7;
#pragma unroll
        for (int j = 0; j < 4; ++j) { const int n = (lane >> 3) + 8 * j; const float* s = scr + (8 * c) * 33 + n;
            u32x4 o; o.x = pk2(s[0 * 33], s[1 * 33]); o.y = pk2(s[2 * 33], s[3 * 33]); o.z = pk2(s[4 * 33], s[5 * 33]); o.w = pk2(s[6 * 33], s[7 * 33]);
            *(u32x4*)(dst + (size_t)(n0 + n) * K + k0 + 8 * c) = o; }
        LDS_WAIT();
    }
}
__device__ __forceinline__ void rms_row_to_bf16(const float* xrow, const float* g, bf16_t* orow, int lane) {
    const f32x4* xr = (const f32x4*)xrow + lane; const f32x4* gr = (const f32x4*)g + lane;
    f32x4 v[4]; float s = 0.f;
#pragma unroll
    for (int j = 0; j < 4; ++j) { v[j] = xr[64 * j]; s += (v[j].x * v[j].x + v[j].y * v[j].y) + (v[j].z * v[j].z + v[j].w * v[j].w); }
    const float rs = rsqrtf(wave_sum(s) * (1.f / DM) + NORM_EPS);
    u32x2* o8 = (u32x2*)orow + lane;
#pragma unroll
    for (int j = 0; j < 4; ++j) { const f32x4 gg = gr[64 * j]; u32x2 w; w.x = pk2(v[j].x * rs * gg.x, v[j].y * rs * gg.y); w.y = pk2(v[j].z * rs * gg.z, v[j].w * rs * gg.w); o8[64 * j] = w; }
}
__device__ __forceinline__ void p0_prologue(const Args& A, unsigned char* lds) {
    const int tid = opaque_tid(), lane = tid & 63, wave = tid >> 6;
    float* scr = (float*)(lds + wave * 16384);
    const int gw = blockIdx.x * NWAVES + wave, NGW = gridDim.x * NWAVES;
    p0_weight<0>(A, WSP(bf16_t, OFF_WIN), 2304, 1024, scr, gw, NGW, lane);
    p0_weight<1>(A, WSP(bf16_t, OFF_WO0), 1024, 1024, scr, gw, NGW, lane);
    p0_weight<2>(A, WSP(bf16_t, OFF_WUP0), 4096, 1024, scr, gw, NGW, lane);
    p0_weight<3>(A, WSP(bf16_t, OFF_WDN0), 1024, 4096, scr, gw, NGW, lane);
    p0_weight<4>(A, WSP(bf16_t, OFF_WRK), 2048, 1024, scr, gw, NGW, lane);
    p0_weight<5>(A, WSP(bf16_t, OFF_WVL), 1792, 1024, scr, gw, NGW, lane);
    p0_weight<6>(A, WSP(bf16_t, OFF_W2T), 1024, 128, scr, gw, NGW, lane);
    p0_weight<7>(A, WSP(bf16_t, OFF_A2T), 1024, 128, scr, gw, NGW, lane);
    p0_weight<8>(A, WSP(bf16_t, OFF_G2T), 1024, 256, scr, gw, NGW, lane);
    if (!(DEFER_W && gridDim.x > BATCH * 16)) {
        p0_weight<9>(A, WSP(bf16_t, OFF_WO1), 1024, 1024, scr, gw, NGW, lane);
        p0_weight<10>(A, WSP(bf16_t, OFF_WUP1), 4096, 1024, scr, gw, NGW, lane);
        p0_weight<11>(A, WSP(bf16_t, OFF_WDN1), 1024, 4096, scr, gw, NGW, lane);
    }
    float* rc = WSP(float, OFF_ROPE); float* rsn = rc + 2048 * 32;
    for (int idx = blockIdx.x * NTHR + tid; idx < 2048 * 32; idx += gridDim.x * NTHR) {
        const int t = idx >> 5, d = idx & 31;
        double inv = 1.0; for (int i = 0; i < d; ++i) inv *= 0.74989420933245582730;
        const double ang = (double)t * inv;
        const double q = rint(ang * 0.63661977236758134308); const double r = (ang - q * 1.5707963267948966192) - q * 6.123233995736766036e-17;
        const double r2 = r * r;
        double sn = 1.0, cs = 1.0, ts = 1.0, tc = 1.0;
#pragma unroll
        for (int i = 1; i <= 9; ++i) { tc *= -r2 / (double)((2 * i - 1) * (2 * i)); ts *= -r2 / (double)((2 * i) * (2 * i + 1)); cs += tc; sn += ts; }
        sn *= r;
        const int qi = ((int)q) & 3;
        const double c = (qi == 0) ? cs : (qi == 1) ? -sn : (qi == 2) ? -cs : sn;
        const double s = (qi == 0) ? sn : (qi == 1) ? cs : (qi == 2) ? -sn : -cs;
        rc[idx] = (float)c; rsn[idx] = (float)s;
    }
    bf16_t* H0 = WSP(bf16_t, OFF_H0);
    for (int m = gw; m < MTOK; m += NGW) rms_row_to_bf16(A.in[IN_X] + (size_t)m * DM, A.in[IN_MIXN], H0 + (size_t)m * DM, lane);
}

struct Unit { int pm, pn; };
struct Gemm { const bf16_t* A; const bf16_t* A2; int pn2; const bf16_t* Bt; int M, N, K; };
constexpr int NXCD = 8, WGM = 8;
struct StaticOrder {
    int nM, nN, nwg, G, c;
    __device__ void init(int M, int N, int G_, int c_) { nM = M / 256; nN = N / 256; nwg = nM * nN; G = G_; c = c_; }
    __device__ bool next(int i, Unit& u) const {
        const long L = (long)i * G + c; if (L >= nwg) return false;
        int wgid = (int)L; { const int q = nwg / NXCD, r = nwg % NXCD, xcd = wgid % NXCD, off = wgid / NXCD; wgid = (xcd < r ? xcd * (q + 1) : r * (q + 1) + (xcd - r) * q) + off; }
        const int nig = WGM * nN, gid = wgid / nig, fm = gid * WGM, gsz = (nM - fm) < WGM ? (nM - fm) : WGM;
        u.pm = fm + ((wgid % nig) % gsz); u.pn = (wgid % nig) / gsz; return true;
    }
};
typedef f32x4 AccT[2][2][4][2];

template <class Epi> __device__ __forceinline__ void gemm_naive(const Gemm g, const Epi& E) {
    const int tid = opaque_tid(), wave = tid >> 6, lane = tid & 63, wr = wave >> 2, wc = wave & 3, fr = lane & 15, fq = lane >> 4;
    StaticOrder S; S.init(g.M, g.N, gridDim.x, blockIdx.x);
    Unit u;
    for (int i = 0; S.next(i, u); ++i) {
        AccT acc;
#pragma unroll
        for (int a = 0; a < 2; ++a)
#pragma unroll
            for (int b = 0; b < 2; ++b)
#pragma unroll
                for (int m = 0; m < 4; ++m)
#pragma unroll
                    for (int n = 0; n < 2; ++n) acc[a][b][m][n] = (f32x4){0.f, 0.f, 0.f, 0.f};
        const bf16_t* Ab = (u.pn >= g.pn2 ? g.A2 : g.A) + (size_t)(u.pm * 256 + wr * 64 + fr) * g.K;
        const bf16_t* Bb = g.Bt + (size_t)(u.pn * 256 + wc * 32) * g.K;
        for (int k0 = 0; k0 < g.K; k0 += 8) {
            bf16x8 af[2][4];
#pragma unroll
            for (int ai = 0; ai < 2; ++ai)
#pragma unroll
                for (int m = 0; m < 4; ++m) af[ai][m] = *(const bf16x8*)(Ab + (size_t)(ai * 128 + m * 16) * g.K + k0);
#pragma unroll
            for (int bj = 0; bj < 2; ++bj)
#pragma unroll
                for (int n = 0; n < 2; ++n)
#pragma unroll
                    for (int c = 0; c < 4; ++c) {
                        const int col = bj * 128 + (Epi::PERM ? 8 * fq + 4 * n + c : 16 * n + 4 * fq + c);
                        const bf16x8 b = *(const bf16x8*)(Bb + (size_t)col * g.K + k0);
                        float bf[8];
#pragma unroll
                        for (int e = 0; e < 8; ++e) bf[e] = bf2f((bf16_t)b[e]);
#pragma unroll
                        for (int ai = 0; ai < 2; ++ai)
#pragma unroll
                            for (int m = 0; m < 4; ++m) { float s = acc[ai][bj][m][n][c];
#pragma unroll
                                for (int e = 0; e < 8; ++e) s += bf2f((bf16_t)af[ai][m][e]) * bf[e];
                                acc[ai][bj][m][n][c] = s; }
                        asm volatile("" ::: "memory");
                    }
        }
        E(acc, u, wr, wc, fr, fq);
    }
}

struct EpiInProj {
    static constexpr bool PERM = true;
    bf16_t *Q, *K, *V, *QI, *KI; float* WI; const float* rope;
    __device__ __forceinline__ void operator()(const AccT& acc, const Unit& u, int wr, int wc, int fr, int fq) const {
        const int pn = u.pn;
#pragma unroll
        for (int ai = 0; ai < 2; ++ai)
#pragma unroll
            for (int m = 0; m < 4; ++m) {
                const int row = u.pm * 256 + ai * 128 + wr * 64 + m * 16 + fr, t = row & (SEQ - 1);
#pragma unroll
                for (int bj = 0; bj < 2; ++bj) {
                    const int cl = bj * 128 + wc * 32 + fq * 8;
                    f32x4 v0 = acc[ai][bj][m][0], v1 = acc[ai][bj][m][1];
                    const bool rot = (pn <= 4) || pn == 6 || pn == 7 || (pn == 8 && cl < 64);
                    if (rot) {
                        const int d0 = (cl & 63) >> 1;
                        const f32x4 c = *(const f32x4*)(rope + t * 32 + d0), s = *(const f32x4*)(rope + 2048 * 32 + t * 32 + d0);
                        f32x4 a0, a1;
                        a0.x = v0.x * c.x - v0.y * s.x; a0.y = v0.y * c.x + v0.x * s.x;
                        a0.z = v0.z * c.y - v0.w * s.y; a0.w = v0.w * c.y + v0.z * s.y;
                        a1.x = v1.x * c.z - v1.y * s.z; a1.y = v1.y * c.z + v1.x * s.z;
                        a1.z = v1.z * c.w - v1.w * s.w; a1.w = v1.w * c.w + v1.z * s.w;
                        v0 = a0; v1 = a1;
                    }
                    if (pn < 4) { v0 = v0 * QSCALE; v1 = v1 * QSCALE; }
                    u32x4 w; w.x = pk2(v0.x, v0.y); w.y = pk2(v0.z, v0.w); w.z = pk2(v1.x, v1.y); w.w = pk2(v1.z, v1.w);
                    if (pn < 4) *(u32x4*)(Q + (size_t)row * 1024 + pn * 256 + cl) = w;
                    else if (pn == 4) *(u32x4*)(K + (size_t)row * 256 + cl) = w;
                    else if (pn == 5) *(u32x4*)(V + (size_t)row * 256 + cl) = w;
                    else if (pn < 8) *(u32x4*)(QI + (size_t)row * 512 + (pn - 6) * 256 + cl) = w;
                    else { if (cl < 64) *(u32x4*)(KI + (size_t)row * 64 + cl) = w;
                           else if (cl == 64) { *(f32x4*)(WI + (size_t)row * 8) = v0 * WI_SCALE; *(f32x4*)(WI + (size_t)row * 8 + 4) = v1 * WI_SCALE; } }
                }
            }
    }
};
struct EpiResid {
    static constexpr bool PERM = false;
    const float* xin; float* xout; bf16_t* xb; float* ssq;
    __device__ __forceinline__ void operator()(const AccT& acc, const Unit& u, int wr, int wc, int fr, int fq) const {
#pragma unroll
        for (int ai = 0; ai < 2; ++ai)
#pragma unroll
            for (int m = 0; m < 4; ++m) {
                const int row = u.pm * 256 + ai * 128 + wr * 64 + m * 16 + fr; float s = 0.f;
#pragma unroll
                for (int bj = 0; bj < 2; ++bj)
#pragma unroll
                    for (int n = 0; n < 2; ++n) {
                        const size_t off = (size_t)row * DM + u.pn * 256 + bj * 128 + wc * 32 + n * 16 + fq * 4;
                        const f32x4 x = *(const f32x4*)(xin + off) + acc[ai][bj][m][n];
                        *(f32x4*)(xout + off) = x;
                        if (xb) { u32x2 w; w.x = pk2(x.x, x.y); w.y = pk2(x.z, x.w); *(u32x2*)(xb + off) = w; }
                        s += (x.x * x.x + x.y * x.y) + (x.z * x.z + x.w * x.w);
                    }
                if (ssq) { s += __shfl_xor(s, 16); s += __shfl_xor(s, 32); if (fq == 0) atomicAdd(ssq + row, s); }
            }
    }
};
struct EpiUp {
    static constexpr bool PERM = true;
    bf16_t* U; const float* ssq;
    __device__ __forceinline__ void operator()(const AccT& acc, const Unit& u, int wr, int wc, int fr, int fq) const {
#pragma unroll
        for (int ai = 0; ai < 2; ++ai)
#pragma unroll
            for (int m = 0; m < 4; ++m) {
                const int row = u.pm * 256 + ai * 128 + wr * 64 + m * 16 + fr;
                const float rs = rsqrtf(ssq[row] * (1.f / DM) + NORM_EPS);
#pragma unroll
                for (int bj = 0; bj < 2; ++bj) {
                    f32x4 v0 = acc[ai][bj][m][0] * rs, v1 = acc[ai][bj][m][1] * rs;
#pragma unroll
                    for (int c = 0; c < 4; ++c) { const float a = fmaxf(v0[c], 0.f), b = fmaxf(v1[c], 0.f); v0[c] = a * a; v1[c] = b * b; }
                    u32x4 w; w.x = pk2(v0.x, v0.y); w.y = pk2(v0.z, v0.w); w.z = pk2(v1.x, v1.y); w.w = pk2(v1.z, v1.w);
                    *(u32x4*)(U + (size_t)row * FF + u.pn * 256 + bj * 128 + wc * 32 + fq * 8) = w;
                }
            }
    }
};
struct EpiStore {
    static constexpr bool PERM = true;
    bf16_t* b0; int ld0; int split; bf16_t* b1; int ld1;
    __device__ __forceinline__ void operator()(const AccT& acc, const Unit& u, int wr, int wc, int fr, int fq) const {
        bf16_t* base = u.pn < split ? b0 + u.pn * 256 : b1 + (u.pn - split) * 256; const int ld = u.pn < split ? ld0 : ld1;
#pragma unroll
        for (int ai = 0; ai < 2; ++ai)
#pragma unroll
            for (int m = 0; m < 4; ++m) {
                const int row = u.pm * 256 + ai * 128 + wr * 64 + m * 16 + fr;
#pragma unroll
                for (int bj = 0; bj < 2; ++bj) {
                    const f32x4 v0 = acc[ai][bj][m][0], v1 = acc[ai][bj][m][1];
                    u32x4 w; w.x = pk2(v0.x, v0.y); w.y = pk2(v0.z, v0.w); w.z = pk2(v1.x, v1.y); w.w = pk2(v1.z, v1.w);
                    *(u32x4*)(base + (size_t)row * ld + bj * 128 + wc * 32 + fq * 8) = w;
                }
            }
    }
};
struct EpiLoraUp {
    static constexpr bool PERM = true;
    bf16_t* E; bf16_t* AS; const float* w0; const float* a0;
    __device__ __forceinline__ void operator()(const AccT& acc, const Unit& u, int wr, int wc, int fr, int fq) const {
        const bool dec = u.pn < 4; bf16_t* O = dec ? E : AS; const float* bias = dec ? w0 : a0; const float sc = dec ? -0.6065306597126334f : 1.f;
#pragma unroll
        for (int bj = 0; bj < 2; ++bj) {
            const int col = (u.pn & 3) * 256 + bj * 128 + wc * 32 + fq * 8;
            const f32x4 b0 = *(const f32x4*)(bias + col), b1 = *(const f32x4*)(bias + col + 4);
#pragma unroll
            for (int ai = 0; ai < 2; ++ai)
#pragma unroll
                for (int m = 0; m < 4; ++m) {
                    const int row = u.pm * 256 + ai * 128 + wr * 64 + m * 16 + fr;
                    f32x4 v0 = acc[ai][bj][m][0] + b0, v1 = acc[ai][bj][m][1] + b1;
#pragma unroll
                    for (int c = 0; c < 4; ++c) { v0[c] = sc * sigmoidf_(v0[c]); v1[c] = sc * sigmoidf_(v1[c]); }
                    u32x4 w; w.x = pk2(v0.x, v0.y); w.y = pk2(v0.z, v0.w); w.z = pk2(v1.x, v1.y); w.w = pk2(v1.z, v1.w);
                    *(u32x4*)(O + (size_t)row * DM + col) = w;
                    asm volatile("" ::: "memory");
                }
        }
    }
};
struct EpiGatePost {
    static constexpr bool PERM = true;
    bf16_t* AO; const bf16_t* Y; const bf16_t* V; const float* stats; const float* bonus; const float* lnw; const float* lnb;
    __device__ __forceinline__ void operator()(const AccT& acc, const Unit& u, int wr, int wc, int fr, int fq) const {
#pragma unroll
        for (int bj = 0; bj < 2; ++bj) {
            const int col = u.pn * 256 + bj * 128 + wc * 32 + fq * 8, hd = col >> 6;
            const f32x4 w0 = *(const f32x4*)(lnw + col), w1 = *(const f32x4*)(lnw + col + 4), c0 = *(const f32x4*)(lnb + col), c1 = *(const f32x4*)(lnb + col + 4);
#pragma unroll
            for (int ai = 0; ai < 2; ++ai)
#pragma unroll
                for (int m = 0; m < 4; ++m) {
                    const int row = u.pm * 256 + ai * 128 + wr * 64 + m * 16 + fr;
                    const f32x4 st = *(const f32x4*)(stats + ((size_t)row * 16 + hd) * 4);
                    const float mean = (st.x + st.z) * (1.f / 64.f), var = fmaxf((st.y + st.w) * (1.f / 64.f) - mean * mean, 0.f), rstd = rsqrtf(var + LNX_EPS);
                    const float bo = bonus[(size_t)row * 16 + hd];
                    const bf16x8 yv = *(const bf16x8*)(Y + (size_t)row * DM + col), vv = *(const bf16x8*)(V + (size_t)row * DM + col);
                    const f32x4 g0 = acc[ai][bj][m][0], g1 = acc[ai][bj][m][1];
                    float o[8];
#pragma unroll
                    for (int c = 0; c < 4; ++c) {
                        o[c] = ((bf2f((bf16_t)yv[c]) - mean) * rstd * w0[c] + c0[c] + bo * bf2f((bf16_t)vv[c])) * g0[c];
                        o[4 + c] = ((bf2f((bf16_t)yv[4 + c]) - mean) * rstd * w1[c] + c1[c] + bo * bf2f((bf16_t)vv[4 + c])) * g1[c];
                    }
                    u32x4 w; w.x = pk2(o[0], o[1]); w.y = pk2(o[2], o[3]); w.z = pk2(o[4], o[5]); w.w = pk2(o[6], o[7]);
                    *(u32x4*)(AO + (size_t)row * DM + col) = w;
                }
        }
    }
};

#define PG8_LAS __attribute__((address_space(3)))
constexpr int BM = 256, BK = 64, HALF = 128, HTB = HALF * BK * 2  , STAGE_BYTES = 8 * HTB;
__host__ __device__ __forceinline__ int lds_byte(int r, int c) { const int st = (r >> 4) * 2 + (c >> 5), rr = r & 15, cc = c & 31, ob = rr * 64 + cc * 2; return st * 1024 + (ob ^ (((ob >> 9) & 1) << 5)); }
__host__ __device__ __forceinline__ void stage_rc(int b, int& R, int& C) { const int st = b / 1024, sb = b % 1024, swz = sb ^ (((sb >> 9) & 1) << 5); R = (st >> 1) * 16 + swz / 64; C = (st & 1) * 32 + (swz % 64) / 2; }
__host__ __device__ __forceinline__ int perm32(int rho) { const int n = rho >> 4, i = rho & 15; return 8 * (i >> 2) + 4 * n + (i & 3); }
template <class Epi, bool ALIGN_EPI = true, bool SP2 = true>
__device__ __forceinline__ void gemm_fast(PG8_LAS unsigned char* lds, const Gemm g, const Epi& E) {
    StaticOrder S; S.init(g.M, g.N, gridDim.x, blockIdx.x);
    const int tid = opaque_tid(), wid = __builtin_amdgcn_readfirstlane(tid >> 6), lane = tid & 63, wr = wid >> 2, wc = wid & 3, fr = lane & 15, fq = lane >> 4;
    int K_ = g.K; asm volatile("" : "+s"(K_));
    const int K = K_, nt = K / BK;
    unsigned voffA[2], voffB[2];
#pragma unroll
    for (int i = 0; i < 2; ++i) { int R, C; stage_rc(tid * 16 + i * 8192, R, C); const int Rb = Epi::PERM ? ((R & ~31) + perm32(R & 31)) : R;
        voffA[i] = (unsigned)(R * K + C) * 2u; voffB[i] = (unsigned)(Rb * K + C) * 2u; }
    const size_t kstep = (size_t)(BK * 2);
    const size_t hstep = (size_t)HALF * K * 2;
    const size_t tstep = 2 * hstep;
    const unsigned ldsw = (unsigned)wid * 1024u;
    const int aoff = lds_byte(wr * 64 + fr, fq * 8), boff = lds_byte(wc * 32 + fr, fq * 8);
#define PG8_SA(b, h) (((b) * 2 + (h)) * HTB)
#define PG8_SB(b, h) ((4 + (b) * 2 + (h)) * HTB)
#define PG8_STAGE(bufoff, gbase, voff) do { _Pragma("unroll") for (int _i = 0; _i < 2; ++_i) \
        __builtin_amdgcn_global_load_lds((const unsigned*)((const char*)(gbase) + (voff)[_i]), (PG8_LAS unsigned*)(lds + (bufoff) + ldsw + _i * 8192), 16, 0, 0); } while (0)
#define PG8_LDA(dst, b, h) do { _Pragma("unroll") for (int m = 0; m < 4; ++m) _Pragma("unroll") for (int k = 0; k < 2; ++k) dst[m][k] = *(const PG8_LAS bf16x8*)(lds + PG8_SA(b, h) + aoff + m * 2048 + k * 1024); } while (0)
#define PG8_LDB(dst, b, h) do { _Pragma("unroll") for (int n = 0; n < 2; ++n) _Pragma("unroll") for (int k = 0; k < 2; ++k) dst[n][k] = *(const PG8_LAS bf16x8*)(lds + PG8_SB(b, h) + boff + n * 2048 + k * 1024); } while (0)
#define PG8_MMA(ai, bj, At, Bt) do { __builtin_amdgcn_s_setprio(1); _Pragma("unroll") for (int m = 0; m < 4; ++m) _Pragma("unroll") for (int n = 0; n < 2; ++n) _Pragma("unroll") for (int k = 0; k < 2; ++k) \
        acc[ai][bj][m][n] = __builtin_amdgcn_mfma_f32_16x16x32_bf16(Bt[n][k], At[m][k], acc[ai][bj][m][n], 0, 0, 0); __builtin_amdgcn_s_setprio(0); } while (0)
#define PG8_WAIT_V(n) asm volatile("s_waitcnt vmcnt(" #n ")" ::: "memory")
#define PG8_WAIT_L(n) asm volatile("s_waitcnt lgkmcnt(" #n ")" ::: "memory")
#define PG8_BAR __builtin_amdgcn_s_barrier()
#define PG8_SCHED __builtin_amdgcn_sched_barrier(0)
    Unit cur, nxt; int ui = 0;
    if (!S.next(0, cur)) return;
    AccT acc;
#pragma unroll
    for (int a = 0; a < 2; ++a)
#pragma unroll
        for (int b = 0; b < 2; ++b)
#pragma unroll
            for (int m = 0; m < 4; ++m)
#pragma unroll
                for (int n = 0; n < 2; ++n) acc[a][b][m][n] = (f32x4){0.f, 0.f, 0.f, 0.f};
    bf16x8 At[4][2], B0[2][2], B1[2][2];
    const char* cA = (const char*)(cur.pn >= g.pn2 ? g.A2 : g.A) + (size_t)cur.pm * tstep; const char* cB = (const char*)g.Bt + (size_t)cur.pn * tstep;
    if constexpr (SP2) {
        PG8_STAGE(PG8_SB(0, 0), cB, voffB); PG8_STAGE(PG8_SB(0, 1), cB + hstep, voffB); PG8_STAGE(PG8_SA(0, 0), cA, voffA); PG8_STAGE(PG8_SA(0, 1), cA + hstep, voffA);
        if (wr == 1) PG8_BAR;
        PG8_WAIT_V(2); PG8_BAR;
        PG8_STAGE(PG8_SB(1, 0), cB + kstep, voffB); PG8_STAGE(PG8_SA(1, 0), cA + kstep, voffA); PG8_STAGE(PG8_SB(1, 1), cB + hstep + kstep, voffB);
        PG8_WAIT_V(6); PG8_BAR;
    } else {
        PG8_STAGE(PG8_SB(0, 0), cB, voffB); PG8_STAGE(PG8_SA(0, 0), cA, voffA); PG8_STAGE(PG8_SB(0, 1), cB + hstep, voffB); PG8_STAGE(PG8_SA(0, 1), cA + hstep, voffA);
        if (wr == 1) PG8_BAR;
        PG8_WAIT_V(4); PG8_BAR;
        PG8_STAGE(PG8_SB(1, 0), cB + kstep, voffB); PG8_STAGE(PG8_SA(1, 0), cA + kstep, voffA); PG8_STAGE(PG8_SB(1, 1), cB + hstep + kstep, voffB);
        PG8_WAIT_V(6); PG8_BAR;
    }
    for (;;) {
        const bool has_next = S.next(ui + 1, nxt);
        const char* nA = has_next ? (const char*)(nxt.pn >= g.pn2 ? g.A2 : g.A) + (size_t)nxt.pm * tstep : cA; const char* nB = has_next ? (const char*)g.Bt + (size_t)nxt.pn * tstep : cB;
        for (int t = 0; t < nt; t += 2) {
            const bool last = (t == nt - 2);
            const char* a1 = cA + (size_t)(t + 1) * kstep;
            const char* a2 = last ? nA : cA + (size_t)(t + 2) * kstep; const char* b2 = last ? nB : cB + (size_t)(t + 2) * kstep;
            const char* a3 = a2 + kstep; const char* b3 = b2 + kstep;
            if constexpr (SP2) {
            PG8_LDB(B0, 0, 0); PG8_LDB(B1, 0, 1); PG8_SCHED; PG8_LDA(At, 0, 0); PG8_STAGE(PG8_SA(1, 1), a1 + hstep, voffA);
            PG8_WAIT_V(8); PG8_WAIT_L(0); PG8_BAR; PG8_MMA(0, 0, At, B0); PG8_MMA(0, 1, At, B1); PG8_BAR; PG8_SCHED;
            PG8_LDA(At, 0, 1); PG8_STAGE(PG8_SB(0, 0), b2, voffB); PG8_STAGE(PG8_SB(0, 1), b2 + hstep, voffB); PG8_STAGE(PG8_SA(0, 0), a2, voffA);
            PG8_WAIT_V(8); PG8_WAIT_L(0); PG8_BAR; PG8_MMA(1, 0, At, B0); PG8_MMA(1, 1, At, B1); PG8_BAR; PG8_SCHED;
            PG8_LDB(B0, 1, 0); PG8_LDB(B1, 1, 1); PG8_SCHED; PG8_LDA(At, 1, 0); PG8_STAGE(PG8_SA(0, 1), a2 + hstep, voffA);
            PG8_WAIT_V(8); PG8_WAIT_L(0); PG8_BAR; PG8_MMA(0, 0, At, B0); PG8_MMA(0, 1, At, B1); PG8_BAR; PG8_SCHED;
            PG8_LDA(At, 1, 1); PG8_STAGE(PG8_SB(1, 0), b3, voffB); PG8_STAGE(PG8_SB(1, 1), b3 + hstep, voffB); PG8_STAGE(PG8_SA(1, 0), a3, voffA);
            PG8_WAIT_V(8); PG8_WAIT_L(0); PG8_BAR; PG8_MMA(1, 0, At, B0); PG8_MMA(1, 1, At, B1); PG8_BAR; PG8_SCHED;
            } else {
            PG8_LDB(B0, 0, 0); PG8_SCHED; PG8_LDA(At, 0, 0); PG8_STAGE(PG8_SA(1, 1), a1 + hstep, voffA);
            PG8_WAIT_L(8); PG8_BAR; PG8_WAIT_L(0); PG8_MMA(0, 0, At, B0); PG8_BAR; PG8_SCHED;
            PG8_LDB(B1, 0, 1); PG8_STAGE(PG8_SB(0, 0), b2, voffB);
            PG8_BAR; PG8_WAIT_L(0); PG8_MMA(0, 1, At, B1); PG8_BAR;
            PG8_LDA(At, 0, 1); PG8_STAGE(PG8_SA(0, 0), a2, voffA);
            PG8_BAR; PG8_WAIT_L(0); PG8_MMA(1, 0, At, B0); PG8_BAR; PG8_SCHED;
            PG8_STAGE(PG8_SB(0, 1), b2 + hstep, voffB);
            PG8_WAIT_V(6); PG8_BAR; PG8_MMA(1, 1, At, B1); PG8_BAR;
            PG8_LDB(B0, 1, 0); PG8_SCHED; PG8_LDA(At, 1, 0); PG8_STAGE(PG8_SA(0, 1), a2 + hstep, voffA);
            PG8_WAIT_L(8); PG8_BAR; PG8_WAIT_L(0); PG8_MMA(0, 0, At, B0); PG8_BAR; PG8_SCHED;
            PG8_LDB(B1, 1, 1); PG8_STAGE(PG8_SB(1, 0), b3, voffB);
            PG8_BAR; PG8_WAIT_L(0); PG8_MMA(0, 1, At, B1); PG8_BAR;
            PG8_LDA(At, 1, 1); PG8_STAGE(PG8_SA(1, 0), a3, voffA);
            PG8_BAR; PG8_WAIT_L(0); PG8_MMA(1, 0, At, B0); PG8_BAR; PG8_SCHED;
            PG8_STAGE(PG8_SB(1, 1), b3 + hstep, voffB);
            PG8_WAIT_V(6); PG8_BAR; PG8_MMA(1, 1, At, B1); PG8_BAR;
            }
        }
        if constexpr (ALIGN_EPI) { if (wr == 0) PG8_BAR; }
        E(acc, cur, wr, wc, fr, fq);
        if (!has_next) break;
#pragma unroll
        for (int a = 0; a < 2; ++a)
#pragma unroll
            for (int b = 0; b < 2; ++b)
#pragma unroll
                for (int m = 0; m < 4; ++m)
#pragma unroll
                    for (int n = 0; n < 2; ++n) acc[a][b][m][n] = (f32x4){0.f, 0.f, 0.f, 0.f};
        cur = nxt; cA = nA; cB = nB; ++ui;
        if constexpr (ALIGN_EPI) { if (wr == 1) PG8_BAR; }
    }
    PG8_WAIT_V(0);
    if constexpr (!ALIGN_EPI) { if (wr == 0) PG8_BAR; }
    PG8_BAR;
#undef PG8_SA
#undef PG8_SB
#undef PG8_STAGE
#undef PG8_LDA
#undef PG8_LDB
#undef PG8_MMA
#undef PG8_WAIT_V
#undef PG8_WAIT_L
#undef PG8_BAR
#undef PG8_SCHED
}

template <class Epi> __device__ __forceinline__ void gemm_phase(unsigned char* lds, const Gemm g, const Epi& E) {
#if FAST_GEMM
    gemm_fast<Epi>((PG8_LAS unsigned char*)lds, g, E);
#else
    gemm_naive<Epi>(g, E);
#endif
}

__device__ __forceinline__ void p2_naive(const Args& A, unsigned char* lds, size_t mask_off = OFF_MASK) {
    const int tid = opaque_tid(), lane = tid & 63, wave = tid >> 6;
    float* sc = (float*)lds; float* qf = sc + 2048; float* wf = qf + 512;
    const bf16_t* QI = WSP(bf16_t, OFF_QI); const bf16_t* KI = WSP(bf16_t, OFF_KI); const float* WI = WSP(float, OFF_WI); unsigned* MASK = WSP(unsigned, mask_off);
    for (int m = blockIdx.x; m < MTOK; m += gridDim.x) {
        const int t = m & (SEQ - 1), b0 = m - t, nk = t + 1;
        unsigned* mrow = MASK + (size_t)m * 64;
        if (t < 256) { if (tid < 64) { const int lo = tid * 32; mrow[tid] = (nk >= lo + 32) ? 0xffffffffu : (nk <= lo ? 0u : ((1u << (nk - lo)) - 1u)); } continue; }
        __syncthreads();
        qf[tid] = bf2f(QI[(size_t)m * 512 + tid]);
        if (tid < 8) wf[tid] = WI[(size_t)m * 8 + tid];
        __syncthreads();
        for (int s = tid; s < nk; s += NTHR) {
            const bf16_t* kr = KI + (size_t)(b0 + s) * 64; float kf[64];
#pragma unroll
            for (int c = 0; c < 8; ++c) { const bf16x8 kv = *(const bf16x8*)(kr + 8 * c);
#pragma unroll
                for (int e = 0; e < 8; ++e) kf[8 * c + e] = bf2f((bf16_t)kv[e]); }
            float score = 0.f;
#pragma unroll
            for (int h = 0; h < 8; ++h) { float d = 0.f;
#pragma unroll
                for (int e = 0; e < 64; ++e) d += qf[h * 64 + e] * kf[e];
                score += wf[h] * fmaxf(d, 0.f); }
            sc[s] = score;
        }
        __syncthreads();
#pragma unroll 1
        for (int j = 0; j < 4; ++j) {
            const int base = 512 * j + 64 * wave;
            if (base >= nk) { if (lane < 2) mrow[(base >> 5) + lane] = 0u; continue; }
            const int s = base + lane; const bool valid = s < nk; const float my = valid ? sc[s] : 0.f; int cnt = 0;
            for (int s2 = 0; s2 < nk; ++s2) { const float o = sc[s2]; cnt += ((o > my) || (o == my && s2 < s)) ? 1 : 0; }
            const unsigned long long bal = __ballot(valid && cnt < 256);
            if (lane == 0) { mrow[base >> 5] = (unsigned)bal; mrow[(base >> 5) + 1] = (unsigned)(bal >> 32); }
        }
    }
}

__device__ __forceinline__ void p3_naive(const Args& A, unsigned char* lds) {
    const int tid = opaque_tid(), lane = tid & 63, wave = tid >> 6;
    float* lg = (float*)lds; float* qf = lg + 2048; float* red = qf + 1024; unsigned* mw = (unsigned*)(red + 1024);
    bf16_t* QO = WSP(bf16_t, OFF_QO); const bf16_t* K = WSP(bf16_t, OFF_K); const bf16_t* V = WSP(bf16_t, OFF_V); const unsigned* MASK = WSP(unsigned, OFF_MASK);
    for (int m = blockIdx.x; m < MTOK; m += gridDim.x) {
        const int t = m & (SEQ - 1), b0 = m - t, nk = t + 1;
        __syncthreads();
        qf[tid] = bf2f(QO[(size_t)m * 1024 + tid]); qf[tid + 512] = bf2f(QO[(size_t)m * 1024 + 512 + tid]);
        if (tid < 64) mw[tid] = MASK[(size_t)m * 64 + tid];
        __syncthreads();
#pragma unroll 1
        for (int hd = 0; hd < 16; ++hd) {
            const int n = hd >> 2; float mx = -INFINITY;
            for (int s = tid; s < nk; s += NTHR) {
                float v = -INFINITY;
                if ((mw[s >> 5] >> (s & 31)) & 1u) {
                    const bf16_t* kr = K + (size_t)(b0 + s) * 256 + n * 64; float d = 0.f;
#pragma unroll
                    for (int c = 0; c < 8; ++c) { const bf16x8 kv = *(const bf16x8*)(kr + 8 * c);
#pragma unroll
                        for (int e = 0; e < 8; ++e) d += qf[hd * 64 + 8 * c + e] * bf2f((bf16_t)kv[e]); }
                    v = d;
                }
                lg[s] = v; mx = fmaxf(mx, v);
            }
            mx = block_max(mx, red, wave, lane);
            float sm = 0.f;
            for (int s = tid; s < nk; s += NTHR) { const float p = exp2f(lg[s] - mx); lg[s] = p; sm += p; }
            sm = block_sum(sm, red, wave, lane);
            float acc = 0.f;
            for (int s = wave; s < nk; s += NWAVES) { const float p = lg[s]; if (p != 0.f) acc += p * bf2f(V[(size_t)(b0 + s) * 256 + n * 64 + lane]); }
            __syncthreads();
            red[16 + wave * 64 + lane] = acc;
            __syncthreads();
            if (tid < 64) { float o = 0.f;
#pragma unroll
                for (int p = 0; p < NWAVES; ++p) o += red[16 + p * 64 + tid];
                QO[(size_t)m * 1024 + hd * 64 + tid] = (bf16_t)f2bf(o / sm); }
            __syncthreads();
        }
    }
}

__device__ __forceinline__ void p7_prep(const Args& A) {
    const int tid = opaque_tid(), lane = tid & 63, wave = tid >> 6;
    const int gw = blockIdx.x * NWAVES + wave, NGW = gridDim.x * NWAVES;
    const float* X = A.out; const float* g = A.in[IN_MIXN] + DM; const float* mu = A.in[IN_MU];
    bf16_t* XSR = WSP(bf16_t, OFF_XSR); bf16_t* XSK = WSP(bf16_t, OFF_XSK); bf16_t* XSV = WSP(bf16_t, OFF_XSV); bf16_t* H1 = WSP(bf16_t, OFF_H1);
    f32x4 gg[4], mr[4], mk[4], mv[4];
#pragma unroll
    for (int j = 0; j < 4; ++j) { gg[j] = ((const f32x4*)g)[lane + 64 * j]; mr[j] = ((const f32x4*)mu)[lane + 64 * j]; mk[j] = ((const f32x4*)(mu + DM))[lane + 64 * j]; mv[j] = ((const f32x4*)(mu + 2 * DM))[lane + 64 * j]; }
    for (int run = gw; run < MTOK / 16; run += NGW) {
        const int r0 = run * 16; f32x4 hp[4];
#pragma unroll 1
        for (int i = -1; i < 16; ++i) {
            const int row = r0 + i; f32x4 h[4];
            if (i < 0 && (r0 & (SEQ - 1)) == 0) {
#pragma unroll
                for (int j = 0; j < 4; ++j) hp[j] = (f32x4){0.f, 0.f, 0.f, 0.f};
                continue;
            }
            const f32x4* xr = (const f32x4*)(X + (size_t)row * DM) + lane; float s = 0.f;
#pragma unroll
            for (int j = 0; j < 4; ++j) { h[j] = xr[64 * j]; s += (h[j].x * h[j].x + h[j].y * h[j].y) + (h[j].z * h[j].z + h[j].w * h[j].w); }
            const float rs = rsqrtf(wave_sum(s) * (1.f / DM) + NORM_EPS);
#pragma unroll
            for (int j = 0; j < 4; ++j) h[j] = h[j] * rs * gg[j];
            if (i >= 0) {
#pragma unroll
                for (int j = 0; j < 4; ++j) {
                    const f32x4 xx = hp[j] - h[j];
                    const f32x4 a = h[j] + xx * mr[j], b = h[j] + xx * mk[j], c = h[j] + xx * mv[j];
                    const size_t off = (size_t)row * DM + 4 * lane + 256 * j;
                    u32x2 w; w.x = pk2(a.x, a.y); w.y = pk2(a.z, a.w); *(u32x2*)(XSR + off) = w;
                    w.x = pk2(b.x, b.y); w.y = pk2(b.z, b.w); *(u32x2*)(XSK + off) = w;
                    w.x = pk2(c.x, c.y); w.y = pk2(c.z, c.w); *(u32x2*)(XSV + off) = w;
                    w.x = pk2(h[j].x, h[j].y); w.y = pk2(h[j].z, h[j].w); *(u32x2*)(H1 + off) = w;
                }
            }
#pragma unroll
            for (int j = 0; j < 4; ++j) hp[j] = h[j];
        }
    }
}
__device__ __forceinline__ void p10_loramid(const Args& A) {
    const bf16_t* P = WSP(bf16_t, OFF_P); bf16_t* AW = WSP(bf16_t, OFF_AW); bf16_t* AA = WSP(bf16_t, OFF_AA); bf16_t* AG = WSP(bf16_t, OFF_AG);
    const size_t total = (size_t)MTOK * 512;
    for (size_t idx = (size_t)blockIdx.x * NTHR + threadIdx.x; idx < total; idx += (size_t)gridDim.x * NTHR) {
        const int m = (int)(idx >> 9), j = (int)(idx & 511); const bool first = (m & (SEQ - 1)) == 0;
        const bf16_t* p0 = P + (size_t)m * 768; const bf16_t* pm = p0 - 768;
        if (j < 128) {
            float v = 0.f; if (j < 64) { const float x = bf2f(p0[j]) + (first ? 0.f : bf2f(pm[64 + j])); const float e = __expf(-2.f * fabsf(x)); const float th = (1.f - e) / (1.f + e); v = x < 0.f ? -th : th; }
            AW[(size_t)m * 128 + j] = (bf16_t)f2bf(v);
        } else if (j < 256) {
            const int jj = j - 128; float v = 0.f; if (jj < 64) v = bf2f(p0[128 + jj]) + (first ? 0.f : bf2f(pm[192 + jj]));
            AA[(size_t)m * 128 + jj] = (bf16_t)f2bf(v);
        } else {
            const int jj = j - 256; float v = 0.f; if (jj < 160) { const float x = bf2f(p0[256 + jj]) + (first ? 0.f : bf2f(pm[416 + jj])); v = sigmoidf_(x); }
            AG[(size_t)m * 256 + jj] = (bf16_t)f2bf(v);
        }
    }
}
__device__ __forceinline__ void p12_naive(const Args& A, unsigned char* lds) {
    const int tid = opaque_tid(), lane = tid & 63, wave = tid >> 6;
    const int gw = blockIdx.x * NWAVES + wave, NGW = gridDim.x * NWAVES;
    float* sh = (float*)lds + wave * 320;
    const bf16_t* R = WSP(bf16_t, OFF_R); const bf16_t* KR = WSP(bf16_t, OFF_KR); const bf16_t* VV = WSP(bf16_t, OFF_VV); const bf16_t* E = WSP(bf16_t, OFF_E); const bf16_t* AS = WSP(bf16_t, OFF_A);
    bf16_t* Y = WSP(bf16_t, OFF_Y);
    for (int it = gw; it < BATCH * 16; it += NGW) {
        const int b = it >> 4, h = it & 15;
        float S[64];
#pragma unroll
        for (int j = 0; j < 64; ++j) S[j] = 0.f;
        const float kkw = A.in[IN_KK][h * 64 + lane], kaw = A.in[IN_KA][h * 64 + lane];
        const size_t base = (size_t)b * SEQ * DM + h * 64 + lane;
        bf16_t rn = R[base], kn = KR[base], vn = VV[base], en = E[base], an = AS[base];
#pragma unroll 1
        for (int t = 0; t < SEQ; ++t) {
            const float r = bf2f(rn), k = bf2f(kn), v = bf2f(vn), e = bf2f(en), a = bf2f(an);
            if (t + 1 < SEQ) { const size_t ix = base + (size_t)(t + 1) * DM; rn = R[ix]; kn = KR[ix]; vn = VV[ix]; en = E[ix]; an = AS[ix]; }
            float kk = k * kkw; const float ss = wave_sum(kk * kk); kk *= rsqrtf(fmaxf(ss, 1e-24f));
            const float kt = k * (1.f + (a - 1.f) * kaw), bb = kk * a, w = __expf(e);
            sh[lane] = -kk; sh[64 + lane] = w; sh[128 + lane] = bb; sh[192 + lane] = kt; sh[256 + lane] = r;
            LDS_WAIT();
            float sa = 0.f;
#pragma unroll
            for (int j = 0; j < 64; ++j) sa += S[j] * sh[j];
            float y = 0.f;
#pragma unroll
            for (int j = 0; j < 64; ++j) { S[j] = S[j] * sh[64 + j] + sa * sh[128 + j] + v * sh[192 + j]; y += S[j] * sh[256 + j]; }
            Y[base + (size_t)t * DM] = (bf16_t)f2bf(y);
            LDS_WAIT();
        }
    }
}
__device__ __forceinline__ void p12b_stats(const Args& A) {
    const int tid = opaque_tid(), lane = tid & 63, wave = tid >> 6;
    const int gw = blockIdx.x * NWAVES + wave, NGW = gridDim.x * NWAVES;
    const bf16_t* R = WSP(bf16_t, OFF_R); const bf16_t* KR = WSP(bf16_t, OFF_KR); const bf16_t* AS = WSP(bf16_t, OFF_A); const bf16_t* Y = WSP(bf16_t, OFF_Y);
    float* ST = WSP(float, OFF_STATS); float* BO = WSP(float, OFF_BONUS);
    for (int it = gw; it < MTOK * 16; it += NGW) {
        const int h = it & 15; const size_t ix = (size_t)(it >> 4) * DM + h * 64 + lane;
        const float y = bf2f(Y[ix]), r = bf2f(R[ix]), k = bf2f(KR[ix]), a = bf2f(AS[ix]);
        const float kt = k * (1.f + (a - 1.f) * A.in[IN_KA][h * 64 + lane]);
        const float s1 = wave_sum(y), s2 = wave_sum(y * y), bo = wave_sum(r * kt * A.in[IN_RK][h * 64 + lane]);
        if (lane == 0) { *(f32x4*)(ST + (size_t)it * 4) = (f32x4){s1, s2, 0.f, 0.f}; BO[it] = bo; }
    }
}

template <int CTRL> __device__ __forceinline__ float dppf(float v) { return __int_as_float(__builtin_amdgcn_mov_dpp(__float_as_int(v), CTRL, 0xF, 0xF, false)); }
template <int CTRL> __device__ __forceinline__ int dppi(int v) { return __builtin_amdgcn_mov_dpp(v, CTRL, 0xF, 0xF, false); }
__device__ __forceinline__ float row16_allsum(float v) { v += dppf<0xB1>(v); v += dppf<0x4E>(v); v += dppf<0x124>(v); v += dppf<0x128>(v); return v; }
__device__ __forceinline__ float ffma_s(float a, float b, float c) { float r; asm("v_fma_f32 %0, %1, %2, %3" : "=v"(r) : "v"(a), "v"(b), "v"(c)); return r; }
__device__ __forceinline__ float fmul_s(float a, float b) { float r; asm("v_mul_f32_e32 %0, %1, %2" : "=v"(r) : "v"(a), "v"(b)); return r; }
__device__ __forceinline__ float row16_allsum_fused(float v) {
    float a, b, c, d;
    asm("s_nop 1\n\tv_add_f32_dpp %0, %1, %1 quad_perm:[1,0,3,2] row_mask:0xf bank_mask:0xf" : "=v"(a) : "v"(v));
    asm("s_nop 1\n\tv_add_f32_dpp %0, %1, %1 quad_perm:[2,3,0,1] row_mask:0xf bank_mask:0xf" : "=v"(b) : "v"(a));
    asm("s_nop 1\n\tv_add_f32_dpp %0, %1, %1 row_ror:4 row_mask:0xf bank_mask:0xf" : "=v"(c) : "v"(b));
    asm("s_nop 1\n\tv_add_f32_dpp %0, %1, %1 row_ror:8 row_mask:0xf bank_mask:0xf" : "=v"(d) : "v"(c));
    return d;
}
__device__ __forceinline__ int row16_allsum_i(int v) { v += dppi<0xB1>(v); v += dppi<0x4E>(v); v += dppi<0x124>(v); v += dppi<0x128>(v); return v; }
__device__ __forceinline__ int wave_allsum_i(int v) {
    v = row16_allsum_i(v);
    return __builtin_amdgcn_readlane(v, 0) + __builtin_amdgcn_readlane(v, 16) + __builtin_amdgcn_readlane(v, 32) + __builtin_amdgcn_readlane(v, 48);
}

constexpr int P2_LD = 2052;
template <int MODE = 0> __device__ __forceinline__ void p2_fast(const Args& A, unsigned char* lds) {
    const int tid = opaque_tid(), lane = tid & 63, wave = __builtin_amdgcn_readfirstlane(tid >> 6), fr = lane & 15, fq = lane >> 4;
    float* sc = (float*)lds;
    const bf16_t* QI = WSP(bf16_t, OFF_QI); const bf16_t* KI = WSP(bf16_t, OFF_KI); const float* WI = WSP(float, OFF_WI); unsigned* MASK = WSP(unsigned, MODE == 0 ? OFF_MASK : 160 * MiB);
    for (int it = blockIdx.x; it < 1024; it += gridDim.x) {
        const int q = it >> 8, c = it & 255, b = c & 7, s5 = c >> 3;
        const int tt = (q == 0) ? s5 : (q == 1) ? 63 - s5 : (q == 2) ? 64 + s5 : 127 - s5;
        const int t0 = 16 * tt, m0 = b * SEQ + t0;
        if (t0 >= 256 - 15) {
            bf16x8 qf[8][2]; float wv[8];
#pragma unroll
            for (int h = 0; h < 8; ++h) {
#pragma unroll
                for (int ks = 0; ks < 2; ++ks) qf[h][ks] = *(const bf16x8*)(QI + (size_t)(m0 + fr) * 512 + h * 64 + ks * 32 + fq * 8);
                wv[h] = WI[(size_t)(m0 + fr) * 8 + h];
            }
            const bf16_t* kbase = KI + (size_t)(b * SEQ + fr) * 64 + fq * 8;
            bf16x8 ka0 = *(const bf16x8*)(kbase + (size_t)wave * 16 * 64), ka1 = *(const bf16x8*)(kbase + (size_t)wave * 16 * 64 + 32);
#pragma unroll 1
            for (int kt = wave; kt <= tt; kt += NWAVES) {
                const bf16x8 a0 = ka0, a1 = ka1;
                if (kt + NWAVES <= tt) { ka0 = *(const bf16x8*)(kbase + (size_t)(kt + NWAVES) * 16 * 64); ka1 = *(const bf16x8*)(kbase + (size_t)(kt + NWAVES) * 16 * 64 + 32); }
                f32x4 acc = {0.f, 0.f, 0.f, 0.f};
#pragma unroll
                for (int h = 0; h < 8; ++h) {
                    f32x4 d = __builtin_amdgcn_mfma_f32_16x16x32_bf16(a0, qf[h][0], (f32x4){0.f, 0.f, 0.f, 0.f}, 0, 0, 0);
                    d = __builtin_amdgcn_mfma_f32_16x16x32_bf16(a1, qf[h][1], d, 0, 0, 0);
#pragma unroll
                    for (int e = 0; e < 4; ++e) acc[e] += wv[h] * fmaxf(d[e], 0.f);
                }
                *(f32x4*)(sc + fr * P2_LD + kt * 16 + 4 * fq) = acc;
            }
        }
        __syncthreads();
#pragma unroll 1
        for (int rr = 2 * wave; rr < 2 * wave + (MODE == 1 ? 0 : 2); ++rr) {
            const int t = t0 + rr, nk = t + 1;
            unsigned long long* mrow = (unsigned long long*)(MASK + (size_t)(m0 + rr) * 64);
            if (t < 256) {
                if (lane < 32) { const int lo = lane * 64; mrow[lane] = (nk >= lo + 64) ? ~0ull : (nk <= lo ? 0ull : ((1ull << (nk - lo)) - 1ull)); }
                continue;
            }
            const int nj = (nk + 63) >> 6;
            float x[32];
            const float* srow = sc + rr * P2_LD + lane;
#pragma unroll
            for (int j = 0; j < 32; ++j) x[j] = srow[64 * j];
            float mx = -INFINITY, mn = INFINITY;
#pragma unroll
            for (int j = 0; j < 32; ++j) { const bool ok = lane + 64 * j < nk; mn = fminf(mn, ok ? x[j] : INFINITY); x[j] = ok ? x[j] : -INFINITY; mx = fmaxf(mx, x[j]); }
            mx = wave_max(mx); mn = -wave_max(-mn);
            mx = __int_as_float(__builtin_amdgcn_readfirstlane(__float_as_int(mx))); mn = __int_as_float(__builtin_amdgcn_readfirstlane(__float_as_int(mn)));
#define P2_COUNT_GE(thr, out) do { int c_ = 0; const float th_ = (thr);     \
                _Pragma("unroll") for (int g_ = 0; g_ < 4; ++g_) if (nj > 8 * g_) { unsigned long long m_[8]; \
                    asm("v_cmp_ge_f32_e64 %0, %8, %16\n\tv_cmp_ge_f32_e64 %1, %9, %16\n\tv_cmp_ge_f32_e64 %2, %10, %16\n\tv_cmp_ge_f32_e64 %3, %11, %16\n\tv_cmp_ge_f32_e64 %4, %12, %16\n\tv_cmp_ge_f32_e64 %5, %13, %16\n\tv_cmp_ge_f32_e64 %6, %14, %16\n\tv_cmp_ge_f32_e64 %7, %15, %16" \
                        : "=&s"(m_[0]), "=&s"(m_[1]), "=&s"(m_[2]), "=&s"(m_[3]), "=&s"(m_[4]), "=&s"(m_[5]), "=&s"(m_[6]), "=&s"(m_[7]) \
                        : "v"(x[8 * g_]), "v"(x[8 * g_ + 1]), "v"(x[8 * g_ + 2]), "v"(x[8 * g_ + 3]), "v"(x[8 * g_ + 4]), "v"(x[8 * g_ + 5]), "v"(x[8 * g_ + 6]), "v"(x[8 * g_ + 7]), "v"(th_)); \
                    _Pragma("unroll") for (int j_ = 0; j_ < 8; ++j_) c_ += __popcll(m_[j_]); } \
                (out) = c_; } while (0)
            float lo = mn, hi = mx, thr = 0.f; int c_hi; bool exact = false;
            P2_COUNT_GE(mx, c_hi);
            if (c_hi >= 256) { lo = mx; c_hi = 0; }
            else {
#pragma unroll 1
                for (int iter_ = 0;; ++iter_) {
                    if (MODE == 3 && iter_ >= 6) break;
                    const float mid = lo + (hi - lo) * 0.5f;
                    if (!(mid > lo && mid < hi)) break;
                    int cm; P2_COUNT_GE(mid, cm);
                    if (cm == 256) { exact = true; thr = mid; break; }
                    if (cm > 256) lo = mid; else { hi = mid; c_hi = cm; }
                }
            }
            unsigned long long mine = 0ull;
            if (exact) {
#pragma unroll
                for (int j = 0; j < 32; ++j) { const unsigned long long bal = __ballot(x[j] >= thr); if (lane == j) mine = bal; }
            } else {
                int need = 256 - c_hi;
#pragma unroll
                for (int j = 0; j < 32; ++j) {
                    const bool eq = (x[j] == lo); const unsigned long long beq = __ballot(eq);
                    const int pre = __builtin_amdgcn_mbcnt_hi((unsigned)(beq >> 32), __builtin_amdgcn_mbcnt_lo((unsigned)beq, 0));
                    const unsigned long long bal = __ballot((x[j] > lo) || (eq && pre < need));
                    need -= __popcll(beq); need = need < 0 ? 0 : need;
                    if (lane == j) mine = bal;
                }
            }
            if (lane < 32) mrow[lane] = mine;
#undef P2_COUNT_GE
        }
        __syncthreads();
    }
}

constexpr int SC_TC = 32, SC_BUF_F = 5 * SC_TC * 64 + SC_TC * 32;
__device__ __forceinline__ void p12_fast(const Args& A, unsigned char* lds) {
    const int tid = opaque_tid(), lane = tid & 63, wave = __builtin_amdgcn_readfirstlane(tid >> 6);
    const int kq = lane & 15, row = 4 * wave + (lane >> 4), tl = tid >> 4;
    float* fl = (float*)lds; float* ybuf = fl + 2 * SC_BUF_F;
    const bf16_t* R = WSP(bf16_t, OFF_R); const bf16_t* KR = WSP(bf16_t, OFF_KR); const bf16_t* VV = WSP(bf16_t, OFF_VV); const bf16_t* E = WSP(bf16_t, OFF_E); const bf16_t* AS = WSP(bf16_t, OFF_A);
    bf16_t* Y = WSP(bf16_t, OFF_Y); float* ST = WSP(float, OFF_STATS); float* BO = WSP(float, OFF_BONUS);
    for (int it = blockIdx.x; it < BATCH * 16 * 2; it += gridDim.x) {
        const int half = it & 1, h = (it >> 1) & 15, b = it >> 5;
        const f32x4 kkw = *(const f32x4*)(A.in[IN_KK] + h * 64 + 4 * kq), kaw = *(const f32x4*)(A.in[IN_KA] + h * 64 + 4 * kq), rkw = *(const f32x4*)(A.in[IN_RK] + h * 64 + 4 * kq);
        const size_t gbase = ((size_t)b * SEQ + tl) * DM + h * 64 + 4 * kq;
        u32x2 pr, pk, pv, pe, pa;
#define SC_PREFETCH(c) do { const size_t gi_ = gbase + (size_t)(c) * SC_TC * DM; pr = *(const u32x2*)(R + gi_); pk = *(const u32x2*)(KR + gi_); pv = *(const u32x2*)(VV + gi_); pe = *(const u32x2*)(E + gi_); pa = *(const u32x2*)(AS + gi_); } while (0)
#define SC_UNPK(p, o) do { o[0] = __uint_as_float(p.x << 16); o[1] = __uint_as_float(p.x & 0xffff0000u); o[2] = __uint_as_float(p.y << 16); o[3] = __uint_as_float(p.y & 0xffff0000u); } while (0)
#define SC_DERIVE(c) do { float* bf_ = fl + ((c) & 1) * SC_BUF_F; float r_[4], k_[4], v_[4], e_[4], a_[4]; SC_UNPK(pr, r_); SC_UNPK(pk, k_); SC_UNPK(pv, v_); SC_UNPK(pe, e_); SC_UNPK(pa, a_); \
            f32x4 kkv_, w_, n_, b_, kt_, rr_; float ss_ = 0.f, bo_ = 0.f; \
            _Pragma("unroll") for (int i_ = 0; i_ < 4; ++i_) { kkv_[i_] = k_[i_] * kkw[i_]; ss_ += kkv_[i_] * kkv_[i_]; } \
            ss_ = row16_allsum(ss_); const float inv_ = rsqrtf(fmaxf(ss_, 1e-24f)); \
            _Pragma("unroll") for (int i_ = 0; i_ < 4; ++i_) { n_[i_] = -kkv_[i_] * inv_; b_[i_] = -n_[i_] * a_[i_]; kt_[i_] = k_[i_] * (1.f + (a_[i_] - 1.f) * kaw[i_]); w_[i_] = __expf(e_[i_]); rr_[i_] = r_[i_]; bo_ += r_[i_] * kt_[i_] * rkw[i_]; } \
            bo_ = row16_allsum(bo_); \
            if (half == 0 && kq == 0) BO[((size_t)b * SEQ + (c) * SC_TC + tl) * 16 + h] = bo_; \
            float* d_ = bf_ + tl * 64 + 4 * kq; *(f32x4*)(d_) = w_; *(f32x4*)(d_ + 2048) = n_; *(f32x4*)(d_ + 4096) = b_; *(f32x4*)(d_ + 6144) = kt_; *(f32x4*)(d_ + 8192) = rr_; \
            if ((kq >> 3) == half) *(f32x4*)(bf_ + 10240 + tl * 32 + 4 * (kq & 7)) = (f32x4){v_[0], v_[1], v_[2], v_[3]}; } while (0)
        __syncthreads();
        SC_PREFETCH(0); SC_DERIVE(0);
        __syncthreads();
        float S0 = 0.f, S1 = 0.f, S2 = 0.f, S3 = 0.f;
#pragma unroll 1
        for (int c = 0; c < SEQ / SC_TC; ++c) {
            if (c + 1 < SEQ / SC_TC) SC_PREFETCH(c + 1);
            const float* bf = fl + (c & 1) * SC_BUF_F + 4 * kq; const float* vb = fl + (c & 1) * SC_BUF_F + 10240 + row; float* yb = ybuf + (c & 1) * 1024 + row;
#define SC_LOAD(P, tt_) do { P##w = *(const f32x4*)(bf + (tt_) * 64); P##n = *(const f32x4*)(bf + (tt_) * 64 + 2048); P##b = *(const f32x4*)(bf + (tt_) * 64 + 4096); P##k = *(const f32x4*)(bf + (tt_) * 64 + 6144); P##r = *(const f32x4*)(bf + (tt_) * 64 + 8192); P##v = vb[(tt_) * 32]; } while (0)
#define SC_STEP(P, tt_) do { \
                float p_ = fmul_s(S0, P##n.x); p_ = ffma_s(S1, P##n.y, p_); p_ = ffma_s(S2, P##n.z, p_); p_ = ffma_s(S3, P##n.w, p_); \
                float t0_ = fmul_s(S0, P##w.x), t1_ = fmul_s(S1, P##w.y), t2_ = fmul_s(S2, P##w.z), t3_ = fmul_s(S3, P##w.w); \
                t0_ = ffma_s(P##v, P##k.x, t0_); t1_ = ffma_s(P##v, P##k.y, t1_); t2_ = ffma_s(P##v, P##k.z, t2_); t3_ = ffma_s(P##v, P##k.w, t3_); \
                const float sa_ = row16_allsum_fused(p_); \
                S0 = ffma_s(sa_, P##b.x, t0_); S1 = ffma_s(sa_, P##b.y, t1_); S2 = ffma_s(sa_, P##b.z, t2_); S3 = ffma_s(sa_, P##b.w, t3_); \
                float qy_ = fmul_s(S0, P##r.x); qy_ = ffma_s(S1, P##r.y, qy_); qy_ = ffma_s(S2, P##r.z, qy_); qy_ = ffma_s(S3, P##r.w, qy_); \
                const float y_ = row16_allsum_fused(qy_); \
                if (kq == 0) yb[(tt_) * 32] = y_; } while (0)
            f32x4 Aw, An, Ab, Ak, Ar, Bw, Bn, Bb, Bk, Br; float Av, Bv;
            SC_LOAD(A, 0);
#pragma unroll 1
            for (int tt = 0; tt < SC_TC; tt += 2) {
                SC_LOAD(B, tt + 1);
                SC_STEP(A, tt);
                if (tt + 2 < SC_TC) SC_LOAD(A, tt + 2);
                SC_STEP(B, tt + 1);
            }
#undef SC_LOAD
#undef SC_STEP
            if (c + 1 < SEQ / SC_TC) SC_DERIVE(c + 1);
            __syncthreads();
            {
                const int j = tid & 15; const float* ys = ybuf + (c & 1) * 1024 + tl * 32 + 2 * j;
                const float y0 = ys[0], y1 = ys[1];
                const float s1 = row16_allsum(y0 + y1), s2 = row16_allsum(y0 * y0 + y1 * y1);
                const size_t m = (size_t)b * SEQ + c * SC_TC + tl;
                *(unsigned*)(Y + m * DM + h * 64 + 32 * half + 2 * j) = pk2(y0, y1);
                if (j == 0) *(f32x2*)(ST + (m * 16 + h) * 4 + 2 * half) = (f32x2){s1, s2};
            }
        }
#undef SC_PREFETCH
#undef SC_UNPK
#undef SC_DERIVE
    }
}

namespace attn_body {
using bf16=__hip_bfloat16;
using bf16x8=__attribute__((ext_vector_type(8)))short;
using s16x4=__attribute__((ext_vector_type(4)))short;
using f32x16=__attribute__((ext_vector_type(16)))float;
using u32x4=__attribute__((ext_vector_type(4)))unsigned;
constexpr int BATCH=8,NHEAD=16,SEQ=2048,D=64,DM=NHEAD*D,KP=256;
constexpr int NW=8,QBLK=32,QB=QBLK*NW,KVBLK=64,NQB=SEQ/QB;
constexpr int ATTN_PITCH=DM, ATTN_UNIT_ROWS=QB;
__device__ __forceinline__ int crow(int r,int hi){return (r&3)+8*(r>>2)+4*hi;}
#define SBAR() __builtin_amdgcn_sched_barrier(0)
__device__ __forceinline__ void bmask(f32x16&p0,f32x16&p1,unsigned long long mw,int hi){
  const unsigned lo=(unsigned)mw>>(4*hi), hw=(unsigned)(mw>>32)>>(4*hi);
  #pragma unroll
  for(int r=0;r<16;++r){const int c=(r&3)+8*(r>>2); const int m0=__builtin_amdgcn_sbfe((int)lo,c,1), m1=__builtin_amdgcn_sbfe((int)hw,c,1);
    p0[r]=__int_as_float((__float_as_int(p0[r])&m0)|((int)0xff800000&~m0)); p1[r]=__int_as_float((__float_as_int(p1[r])&m1)|((int)0xff800000&~m1));}
}

constexpr int NSLOT=3, SLOTB=8192;
constexpr int LDS_K=0, LDS_V=NSLOT*SLOTB, LDS_WS=2*NSLOT*SLOTB, LDS_OST=LDS_WS+NW*64*4, LDS_MSK=LDS_OST+NW*4096, LDS_BYTES=LDS_MSK+64*256;
constexpr float C2=0.125f*1.4426950408889634f;
__device__ __forceinline__ void glds16(const void*gsrc,unsigned lds_dst){unsigned keep;
  asm volatile("s_mov_b32 %0, m0\n\ts_mov_b32 m0, %2\n\ts_nop 0\n\tglobal_load_lds_dwordx4 %1, off\n\ts_mov_b32 m0, %0":"=&s"(keep):"v"(gsrc),"s"(lds_dst):"memory");}
__device__ __forceinline__ float max3f(float a,float b,float c){float r;asm("v_max3_f32 %0, %1, %2, %3":"=v"(r):"v"(a),"v"(b),"v"(c));return r;}
__device__ __forceinline__ float max2f(float a,float b){float r;asm("v_max_f32_e32 %0, %1, %2":"=v"(r):"v"(a),"v"(b));return r;}
__device__ __forceinline__ float fadd_s(float a,float b){float r;asm("v_add_f32_e32 %0, %1, %2":"=v"(r):"v"(a),"v"(b));return r;}
__device__ __forceinline__ float fsub_s(float a,float b){float r;asm("v_sub_f32_e32 %0, %1, %2":"=v"(r):"v"(a),"v"(b));return r;}
typedef float f32x2_t __attribute__((ext_vector_type(2))); typedef __bf16 bf16x2_t __attribute__((ext_vector_type(2)));
__device__ __forceinline__ unsigned cvtpk_s(float lo,float hi){f32x2_t v={lo,hi};bf16x2_t b=__builtin_convertvector(v,bf16x2_t);return __builtin_bit_cast(unsigned,b);}
#define WAIT_BAR(N) asm volatile("s_waitcnt vmcnt(" #N ") lgkmcnt(0)\n\ts_barrier":::"memory")

__device__ __forceinline__ void qkt(f32x16&p0,f32x16&p1,const char*Kslot,const bf16x8*qr,const f32x16&negm,int r32,int hi){
  const char*kb=Kslot+hi*1024+r32*16;
  #pragma unroll
  for(int d0=0;d0<4;++d0){
    const bf16x8 b0=*reinterpret_cast<const bf16x8*>(kb+d0*2048);
    const bf16x8 b1=*reinterpret_cast<const bf16x8*>(kb+d0*2048+512);
    if(d0==0){p0=__builtin_amdgcn_mfma_f32_32x32x16_bf16(b0,qr[0],negm,0,0,0);p1=__builtin_amdgcn_mfma_f32_32x32x16_bf16(b1,qr[0],negm,0,0,0);}
    else{p0=__builtin_amdgcn_mfma_f32_32x32x16_bf16(b0,qr[d0],p0,0,0,0);p1=__builtin_amdgcn_mfma_f32_32x32x16_bf16(b1,qr[d0],p1,0,0,0);}}
}
typedef __attribute__((address_space(3))) const char* lds_cptr;
typedef short v4i16_t __attribute__((ext_vector_type(4)));
__device__ __forceinline__ void kload8(bf16x8*kf,lds_cptr kp){
  kf[0]=*(const __attribute__((address_space(3))) bf16x8*)(kp);      kf[1]=*(const __attribute__((address_space(3))) bf16x8*)(kp+512);
  kf[2]=*(const __attribute__((address_space(3))) bf16x8*)(kp+2048); kf[3]=*(const __attribute__((address_space(3))) bf16x8*)(kp+2560);
  kf[4]=*(const __attribute__((address_space(3))) bf16x8*)(kp+4096); kf[5]=*(const __attribute__((address_space(3))) bf16x8*)(kp+4608);
  kf[6]=*(const __attribute__((address_space(3))) bf16x8*)(kp+6144); kf[7]=*(const __attribute__((address_space(3))) bf16x8*)(kp+6656);
}
__device__ __forceinline__ void kload2(bf16x8*kf,lds_cptr kp,int j){ kf[2*j]=*(const __attribute__((address_space(3))) bf16x8*)(kp+j*2048); kf[2*j+1]=*(const __attribute__((address_space(3))) bf16x8*)(kp+j*2048+512); }
__device__ __forceinline__ s16x4 vtr(lds_cptr p){ return __builtin_bit_cast(s16x4,__builtin_amdgcn_ds_read_tr16_b64_v4i16((__attribute__((address_space(3))) v4i16_t*)p)); }
__device__ __forceinline__ float rowmax(const f32x16&p0,const f32x16&p1){
  float a=max3f(p0[0],p0[1],p1[0]),b=max3f(p0[2],p0[3],p1[1]);a=max3f(a,p1[2],p1[3]);
  #pragma unroll
  for(int r=4;r<16;r+=4){a=max3f(a,p0[r],p0[r+1]);b=max3f(b,p0[r+2],p0[r+3]);a=max3f(a,p1[r],p1[r+1]);b=max3f(b,p1[r+2],p1[r+3]);}
  const float m=max2f(a,b);
  auto rr=__builtin_amdgcn_permlane32_swap(__float_as_uint(m),__float_as_uint(m),false,false);
  return max2f(__uint_as_float(rr[0]),__uint_as_float(rr[1]));
}
__device__ __forceinline__ void pv(f32x16*o,int vb,bf16x8 pa0,bf16x8 pa1,bf16x8 pa2,bf16x8 pa3){
  #pragma unroll
  for(int d0=0;d0<2;++d0){s16x4 lo[4],hi[4];
    #pragma unroll
    for(int ks=0;ks<4;++ks){
      asm volatile("ds_read_b64_tr_b16 %0,%1 offset:%c2":"=&v"(lo[ks]):"v"(vb),"i"(d0*4096+ks*1024):"memory");
      asm volatile("ds_read_b64_tr_b16 %0,%1 offset:%c2":"=&v"(hi[ks]):"v"(vb),"i"(d0*4096+ks*1024+512):"memory");}
    asm volatile("s_waitcnt lgkmcnt(0)":::"memory");SBAR();
    #define PK(k) (bf16x8){lo[k][0],lo[k][1],lo[k][2],lo[k][3],hi[k][0],hi[k][1],hi[k][2],hi[k][3]}
    o[d0]=__builtin_amdgcn_mfma_f32_32x32x16_bf16(pa0,PK(0),o[d0],0,0,0);
    o[d0]=__builtin_amdgcn_mfma_f32_32x32x16_bf16(pa1,PK(1),o[d0],0,0,0);
    o[d0]=__builtin_amdgcn_mfma_f32_32x32x16_bf16(pa2,PK(2),o[d0],0,0,0);
    o[d0]=__builtin_amdgcn_mfma_f32_32x32x16_bf16(pa3,PK(3),o[d0],0,0,0);
    #undef PK
  }
}

#ifndef ATTN_STORE16
#define ATTN_STORE16(p,v) (*(u32x4*)(p)=(v))
#endif
template<int THRL> __device__ __forceinline__ void attn_unit(int b,int n,int qt,const bf16*Q,const bf16*__restrict__ K,const bf16*__restrict__ V,bf16*O,const unsigned*__restrict__ MASK,char*shm){
  const int tid=opaque_tid(),lane=tid&63,r32=lane&31,hi=lane>>5; const int wid=__builtin_amdgcn_readfirstlane(tid>>6);
  const long rowbase=(long)b*SEQ; const int q0=qt*64;
  const int hq=4*n+(wid>>1), tok0=q0+32*(wid&1);
  const bf16*Qw=Q+(rowbase+tok0)*DM+hq*D;
  const bf16*Kh=K+rowbase*KP+n*D,*Vh=V+rowbase*KP+n*D;
  const unsigned lds0=(unsigned)(uintptr_t)shm;
  float*wsf=(float*)(shm+LDS_WS)+wid*64;
  const bf16*ksrc=Kh+(long)lane*KP+wid*8;
  const bf16*vsrc=Vh+(long)(16*(wid&3)+(lane>>2))*KP+(wid>>2)*32+(lane&3)*8;
  const unsigned kdst=lds0+LDS_K+wid*1024, vdst=lds0+LDS_V+wid*1024;
  #define DMA_K(t,slot) glds16(ksrc+(long)(t)*KVBLK*KP,(unsigned)__builtin_amdgcn_readfirstlane(kdst+(slot)))
  #define DMA_V(t,slot) glds16(vsrc+(long)(t)*KVBLK*KP,(unsigned)__builtin_amdgcn_readfirstlane(vdst+(slot)))
  const int vb0=(int)(lds0+LDS_V)+((lane>>4)&1)*32+(lane&3)*8+(4*hi+((lane&15)>>2))*64;
  const char*Kbase=shm+LDS_K; bf16x8 kf[8];
  const lds_cptr shm3=(lds_cptr)shm; const lds_cptr kp0=shm3+LDS_K+hi*1024+r32*16; const lds_cptr vp0=shm3+LDS_V+((lane>>4)&1)*32+(lane&3)*8+(4*hi+((lane&15)>>2))*64;
  const int nt0=qt+1; const int NT=nt0<4?4:((nt0+1)&~1);
  DMA_K(0,0);DMA_V(0,0);DMA_K(1,SLOTB);
  bf16x8 qr[4];
  #pragma unroll
  for(int d0=0;d0<4;++d0)qr[d0]=*reinterpret_cast<const bf16x8*>(&Qw[(long)r32*DM+d0*16+hi*8]);
  { const int tk=tid>>3,pc=tid&7; const u32x4*ms=(const u32x4*)(MASK+((size_t)(rowbase+q0+tk))*64+pc*8); const u32x4 m0=ms[0],m1=ms[1];
    __attribute__((address_space(3))) u32x4*md=(__attribute__((address_space(3))) u32x4*)((__attribute__((address_space(3))) char*)shm+LDS_MSK+tk*256+pc*32); md[0]=m0; md[1]=m1; }
  const __attribute__((address_space(3))) unsigned long long*mskrow=(const __attribute__((address_space(3))) unsigned long long*)((__attribute__((address_space(3))) char*)shm+LDS_MSK+(32*(wid&1)+r32)*256);
  float mhat=0.f,l_reg=0.f;f32x16 o[2];o[0]=f32x16{};o[1]=f32x16{};f32x16 negm=f32x16{};asm volatile("":"+v"(negm));
  #define CMASK(P0,P1,t) bmask(P0,P1,mw_,hi)
  bool resc=false;
  #define START(P0,P1) do{ const float rm=max2f(rowmax(P0,P1),-1000.f); resc=false; \
    { const float dl=rm; mhat=fadd_s(mhat,dl); \
      _Pragma("unroll") for(int r=0;r<16;++r){P0[r]=fsub_s(P0[r],dl);P1[r]=fsub_s(P1[r],dl);} \
      _Pragma("unroll") for(int r=0;r<16;++r)negm[r]=-mhat; asm volatile("":"+v"(negm)); } \
    _Pragma("unroll") for(int r=0;r<16;++r)P0[r]=__builtin_amdgcn_exp2f(P0[r]); }while(0)
  #define RESC() do{ if(resc){ asm volatile("s_waitcnt lgkmcnt(0)":::"memory"); \
      _Pragma("unroll") for(int d_=0;d_<2;++d_) _Pragma("unroll") for(int r=0;r<16;++r)o[d_][r]*=wsf[crow(r,hi)]; } }while(0)
  f32x16 pA0,pA1,pB0,pB1;
  int sl_prev=0,sl_cur=0,sl_next=SLOTB;
  #define ROT() do{sl_prev=sl_cur;sl_cur=sl_next;sl_next=(sl_next==(NSLOT-1)*SLOTB)?0:sl_next+SLOTB;}while(0)
  DMA_K(2,2*SLOTB);
  WAIT_BAR(3);
  qkt(pA0,pA1,Kbase,qr,negm,r32,hi);asm volatile("s_nop 15\n\ts_nop 7":"+v"(pA0),"+v"(pA1));{const unsigned long long mw_=mskrow[0];CMASK(pA0,pA1,0);}
  START(pA0,pA1);
  _Pragma("unroll") for(int r=0;r<16;++r)pA1[r]=__builtin_amdgcn_exp2f(pA1[r]);
  WAIT_BAR(0);
  DMA_K(3,0);DMA_V(1,SLOTB);
  ROT();
  kload8(kf,kp0+sl_cur);
  WAIT_BAR(2);
  s16x4 vlo[8],vhi[8]; u32x4 pw0,pw1,pw2,pw3;
  #define PKW(P,B) cvtpk_s(P[B],P[B+1])
  #define PAF(k) __builtin_bit_cast(bf16x8,pw##k)
  #define VFR(i) (bf16x8){vlo[i][0],vlo[i][1],vlo[i][2],vlo[i][3],vhi[i][0],vhi[i][1],vhi[i][2],vhi[i][3]}
  #define PIN(x) asm volatile("":"+v"(x))
  #define MX3(a,b,c) __builtin_fmaxf(__builtin_fmaxf((a),(b)),(c))
  #define GAPA(MF,A0,A1,A2,A3,W0,W1,PW) do{ MF; sacc+=A0; sacc+=A1; sacc+=A2; sacc+=A3; PIN(sacc); W0; W1; PIN(PW); SBAR(); }while(0)
  #define EX(v) __builtin_amdgcn_exp2f(v)
  #define GAPB(MF,X,B) do{ MF; X[B]=EX(X[B]); X[B+1]=EX(X[B+1]); X[B+2]=EX(X[B+2]); X[B+3]=EX(X[B+3]); PIN(X); SBAR(); }while(0)
  #define VRD(i) do{ vlo[i]=vtr(vp_+(((i)>>2)*4096+((i)&3)*1024)); vhi[i]=vtr(vp_+(((i)>>2)*4096+((i)&3)*1024+512)); }while(0)
  #define KRD(G,j) do{ if(G){ kload2(kf,kp0+sl_next,j); SBAR(); } }while(0)
  #define STEP(C0,C1,P0,P1,t,GK,GV,GL) do{ SBAR(); \
    const lds_cptr vp_=vp0+sl_prev; const unsigned long long mw_=mskrow[(t)]; \
    VRD(0); SBAR(); float sacc=(P0[0]+P0[1]); \
    GAPA(C0=__builtin_amdgcn_mfma_f32_32x32x16_bf16(kf[0],qr[0],negm,0,0,0), P0[2],P0[3],P0[4],P0[5],     pw0[0]=PKW(P0,0), pw0[1]=PKW(P0,2), pw0); \
    VRD(4); SBAR(); GAPA(C1=__builtin_amdgcn_mfma_f32_32x32x16_bf16(kf[1],qr[0],negm,0,0,0), P0[6],P0[7],P0[8],P0[9],     pw0[2]=PKW(P0,4), pw0[3]=PKW(P0,6), pw0); \
    VRD(1); SBAR(); GAPA(C0=__builtin_amdgcn_mfma_f32_32x32x16_bf16(kf[2],qr[1],C0,0,0,0),   P0[10],P0[11],P0[12],P0[13], pw1[0]=PKW(P0,8), pw1[1]=PKW(P0,10), pw1); \
    VRD(5); SBAR(); GAPA(C1=__builtin_amdgcn_mfma_f32_32x32x16_bf16(kf[3],qr[1],C1,0,0,0),   P0[14],P0[15],P1[0],P1[1],   pw1[2]=PKW(P0,12),pw1[3]=PKW(P0,14), pw1); \
    VRD(2); SBAR(); GAPA(C0=__builtin_amdgcn_mfma_f32_32x32x16_bf16(kf[4],qr[2],C0,0,0,0),   P1[2],P1[3],P1[4],P1[5],     pw2[0]=PKW(P1,0), pw2[1]=PKW(P1,2), pw2); \
    VRD(6); SBAR(); GAPA(C1=__builtin_amdgcn_mfma_f32_32x32x16_bf16(kf[5],qr[2],C1,0,0,0),   P1[6],P1[7],P1[8],P1[9],     pw2[2]=PKW(P1,4), pw2[3]=PKW(P1,6), pw2); \
    VRD(3); SBAR(); GAPA(C0=__builtin_amdgcn_mfma_f32_32x32x16_bf16(kf[6],qr[3],C0,0,0,0),   P1[10],P1[11],P1[12],P1[13], pw3[0]=PKW(P1,8), pw3[1]=PKW(P1,10), pw3); \
    VRD(7); SBAR(); GAPA(C1=__builtin_amdgcn_mfma_f32_32x32x16_bf16(kf[7],qr[3],C1,0,0,0),   P1[14],P1[15],0.f,0.f,       pw3[2]=PKW(P1,12),pw3[3]=PKW(P1,14), pw3); \
    l_reg+=sacc; \
    if(GK){DMA_K((t)+3,sl_cur);} if(GV){DMA_V((t)+1,sl_next);} \
    CMASK(C0,C1,t); \
    { float a=MX3(C0[0],C0[1],C1[0]),b=MX3(C0[2],C0[3],C1[1]); a=MX3(a,C1[2],C1[3]); \
      _Pragma("unroll") for(int r=4;r<16;r+=4){a=MX3(a,C0[r],C0[r+1]);b=MX3(b,C0[r+2],C0[r+3]);a=MX3(a,C1[r],C1[r+1]);b=MX3(b,C1[r+2],C1[r+3]);} \
      float rm=__builtin_fmaxf(a,b); { auto rr=__builtin_amdgcn_permlane32_swap(__float_as_uint(rm),__float_as_uint(rm),false,false); rm=__builtin_fmaxf(__uint_as_float(rr[0]),__uint_as_float(rr[1])); } \
      resc=false; \
      if(__builtin_expect(__any(rm>(float)THRL),0)){ const float dl=__builtin_fmaxf(rm,0.f); mhat+=dl; \
        _Pragma("unroll") for(int r=0;r<16;++r){C0[r]-=dl;C1[r]-=dl;} \
        _Pragma("unroll") for(int r=0;r<16;++r)negm[r]=-mhat; asm volatile("":"+v"(negm)); \
        const float f=__builtin_amdgcn_exp2f(-dl); l_reg*=f; if(hi==0)wsf[r32]=f; resc=true; } } \
    SBAR(); \
    GAPB(o[0]=__builtin_amdgcn_mfma_f32_32x32x16_bf16(PAF(0),VFR(0),o[0],0,0,0), C0,0); \
    GAPB(o[1]=__builtin_amdgcn_mfma_f32_32x32x16_bf16(PAF(0),VFR(4),o[1],0,0,0), C0,4); \
    KRD(GL,0); GAPB(o[0]=__builtin_amdgcn_mfma_f32_32x32x16_bf16(PAF(1),VFR(1),o[0],0,0,0), C0,8); \
    KRD(GL,1); GAPB(o[1]=__builtin_amdgcn_mfma_f32_32x32x16_bf16(PAF(1),VFR(5),o[1],0,0,0), C0,12); \
    KRD(GL,2); GAPB(o[0]=__builtin_amdgcn_mfma_f32_32x32x16_bf16(PAF(2),VFR(2),o[0],0,0,0), C1,0); \
    KRD(GL,3); GAPB(o[1]=__builtin_amdgcn_mfma_f32_32x32x16_bf16(PAF(2),VFR(6),o[1],0,0,0), C1,4); \
    GAPB(o[0]=__builtin_amdgcn_mfma_f32_32x32x16_bf16(PAF(3),VFR(3),o[0],0,0,0), C1,8); \
    GAPB(o[1]=__builtin_amdgcn_mfma_f32_32x32x16_bf16(PAF(3),VFR(7),o[1],0,0,0), C1,12); \
    }while(0)
  int t=1;
  for(;t+5<NT;t+=2){
    STEP(pB0,pB1,pA0,pA1,t,true,true,true);     WAIT_BAR(2); RESC(); ROT();
    STEP(pA0,pA1,pB0,pB1,t+1,true,true,true);   WAIT_BAR(2); RESC(); ROT();
  }
  #define ENDW(tt) do{ if((tt)+3<NT){WAIT_BAR(2);} else if((tt)+2<NT){WAIT_BAR(1);} else {WAIT_BAR(0);} }while(0)
  for(;t+1<NT;t+=2){
    STEP(pB0,pB1,pA0,pA1,t,(t+3<NT),(t+1<NT),(t+1<NT));       ENDW(t);   RESC(); ROT();
    STEP(pA0,pA1,pB0,pB1,t+1,(t+4<NT),(t+2<NT),(t+2<NT));     ENDW(t+1); RESC(); ROT();
  }
  STEP(pB0,pB1,pA0,pA1,NT-1,false,false,false); RESC();
  { float sacc=pB0[0]+pB0[1]; _Pragma("unroll") for(int r=2;r<16;++r)sacc+=pB0[r]; _Pragma("unroll") for(int r=0;r<16;++r)sacc+=pB1[r]; l_reg+=sacc;
    pw0=(u32x4){PKW(pB0,0),PKW(pB0,2),PKW(pB0,4),PKW(pB0,6)};pw1=(u32x4){PKW(pB0,8),PKW(pB0,10),PKW(pB0,12),PKW(pB0,14)};pw2=(u32x4){PKW(pB1,0),PKW(pB1,2),PKW(pB1,4),PKW(pB1,6)};pw3=(u32x4){PKW(pB1,8),PKW(pB1,10),PKW(pB1,12),PKW(pB1,14)};
    SBAR(); pv(o,vb0+sl_cur,PAF(0),PAF(1),PAF(2),PAF(3)); }
  #undef PKW
  #undef PAF
  #undef VFR
  #undef PIN
  #undef MX3
  #undef GAPA
  #undef GAPB
  #undef EX
  #undef VRD
  #undef KRD
  #undef STEP
  #undef ENDW
  {auto rr=__builtin_amdgcn_permlane32_swap(__float_as_uint(l_reg),__float_as_uint(l_reg),false,false);l_reg=__uint_as_float(rr[0])+__uint_as_float(rr[1]);}
  if(hi==0)wsf[32+r32]=l_reg;asm volatile("s_waitcnt lgkmcnt(0)":::"memory");
  float rli[16];
  #pragma unroll
  for(int r=0;r<16;++r)rli[r]=__builtin_amdgcn_rcpf(wsf[32+crow(r,hi)]);
  bf16*Ow=O+(rowbase+tok0)*DM+hq*D;
  { bf16*stg=(bf16*)(shm+LDS_OST)+wid*2048;
    #pragma unroll
    for(int r=0;r<16;++r){const int orow=crow(r,hi);
      #pragma unroll
      for(int d0=0;d0<2;++d0)stg[orow*64+d0*32+r32]=__float2bfloat16(o[d0][r]*rli[r]);}
    asm volatile("s_waitcnt lgkmcnt(0)":::"memory");
    #pragma unroll
    for(int i=0;i<4;++i){const int row=i*8+(lane>>3),ch=lane&7; const u32x4 v=*(const u32x4*)(stg+row*64+ch*8); ATTN_STORE16(Ow+(long)row*DM+ch*8,v);} }
  asm volatile("s_waitcnt lgkmcnt(0)\n\ts_barrier":::"memory");
  #undef DMA_K
  #undef DMA_V
  #undef CMASK
  #undef START
  #undef RESC
  #undef ROT
}
constexpr int ATTN_LDS_BYTES=LDS_BYTES;
struct AttnTensors { const bf16* Q; const bf16* K; const bf16* V; bf16* O; const unsigned* MASK; };
struct AttnUnit { int bn; int qt; };
struct StaticOrder {
  int vcu, G;
  __device__ __forceinline__ explicit StaticOrder(int grid,int block):vcu((grid%8==0)?(block%8)*(grid/8)+block/8:block),G(grid){}
  __device__ __forceinline__ bool next(int i,AttnUnit&u)const{
    if(G==256){ if(i>=4)return false; const int s=vcu&7; u.bn=vcu>>3; u.qt=(i==0)?31-s:(i==1)?16+s:(i==2)?15-s:s; return true; }
    const int id=vcu+i*G; if(id>=1024)return false; u.bn=id>>5; u.qt=31-(id&31); return true; }
};
template<class Sched,int THRL=8> __device__ __forceinline__ void attn_phase(char*lds,const AttnTensors&T,const Sched&S){
  AttnUnit u;
  for(int i=0;S.next(i,u);++i){ attn_unit<THRL>(u.bn>>2,u.bn&3,u.qt,T.Q,T.K,T.V,T.O,T.MASK,lds); }
}
#undef SBAR
#undef WAIT_BAR
}


constexpr int CH = 16, NCHUNK = SEQ / CH;
constexpr size_t OFF_SM = 84 * MiB, OFF_WC = 3 * MiB;
__device__ __forceinline__ unsigned char* arr_base(const Args& A, int arr) { return A.ws + (arr == 0 ? OFF_R : arr == 1 ? OFF_KR : arr == 2 ? OFF_E : OFF_A); }
__device__ __forceinline__ unsigned char* piece_ptr(const Args& A, int blk, int lane, int m0, int h) {
    const int pidx = blk * 64 + lane, p7 = pidx & 127, t = p7 >> 3, seg = p7 & 7;
    return arr_base(A, pidx >> 7) + ((size_t)(m0 + t) * DM + h * 64 + seg * 8) * 2;
}
__device__ __forceinline__ unsigned cvtpk(float lo, float hi) { typedef float f2_ __attribute__((ext_vector_type(2))); typedef __bf16 b2_ __attribute__((ext_vector_type(2))); f2_ v = {lo, hi}; b2_ b = __builtin_convertvector(v, b2_); return __builtin_bit_cast(unsigned, b); }
__device__ __forceinline__ float quad_allsum(float v) { v += dppf<0xB1>(v); v += dppf<0x4E>(v); return v; }
__device__ __forceinline__ bf16x8 mk8(unsigned a, unsigned b, unsigned c, unsigned d) { u32x4 w = {a, b, c, d}; return __builtin_bit_cast(bf16x8, w); }

__device__ __forceinline__ void p12_chunk_prep(const Args& A, unsigned char* lds) {
    const int tid = opaque_tid(), lane = tid & 63, wave = __builtin_amdgcn_readfirstlane(tid >> 6), q = lane >> 4, c = lane & 15;
    unsigned char* wl = lds + wave * 14336;
    bf16_t* arr = (bf16_t*)wl;
    bf16_t* bkb = (bf16_t*)(wl + 8192);
    float* gs = (float*)(wl + 12288);
    float* invs = (float*)(wl + 13312);
    const bf16_t* R = WSP(bf16_t, OFF_R); const bf16_t* KR = WSP(bf16_t, OFF_KR); const bf16_t* E = WSP(bf16_t, OFF_E); const bf16_t* AS = WSP(bf16_t, OFF_A);
    float* BO = WSP(float, OFF_BONUS); float* WC = WSP(float, OFF_WC); unsigned char* SM = A.ws + OFF_SM;
    const int gw = blockIdx.x * NWAVES + wave, NGW = gridDim.x * NWAVES;
    u32x4 nr0, nr1, nk0, nk1, ne0, ne1, na0, na1;
#define P12_LOAD(itm) do { const int bh_ = (itm) >> 7, ch_ = (itm) & 127; const size_t go_ = (size_t)((bh_ >> 4) * SEQ + ch_ * CH + (lane >> 2)) * DM + (bh_ & 15) * 64 + (lane & 3) * 16; \
        nr0 = *(const u32x4*)(R + go_); nr1 = *(const u32x4*)(R + go_ + 8); nk0 = *(const u32x4*)(KR + go_); nk1 = *(const u32x4*)(KR + go_ + 8); \
        ne0 = *(const u32x4*)(E + go_); ne1 = *(const u32x4*)(E + go_ + 8); na0 = *(const u32x4*)(AS + go_); na1 = *(const u32x4*)(AS + go_ + 8); } while (0)
    if (gw < BATCH * 16 * NCHUNK) P12_LOAD(gw);
#pragma unroll 1
    for (int item = gw; item < BATCH * 16 * NCHUNK; item += NGW) {
        const int bh = item >> 7, ch = item & 127, b = bh >> 4, h = bh & 15, m0 = b * SEQ + ch * CH;
        {
            const int t = lane >> 2, sg = lane & 3;
            const u32x4 r0 = nr0, r1 = nr1, k0 = nk0, k1 = nk1, e0 = ne0, e1 = ne1, a0 = na0, a1 = na1;
            if (item + NGW < BATCH * 16 * NCHUNK) P12_LOAD(item + NGW);
            u32x4* d = (u32x4*)(arr + t * 64 + sg * 16);
            d[0] = r0; d[1] = r1; d[128] = k0; d[129] = k1; d[256] = e0; d[257] = e1; d[384] = a0; d[385] = a1;
            float ss = 0.f, bo = 0.f;
#pragma unroll
            for (int w = 0; w < 8; ++w) {
                const unsigned rw = w < 4 ? r0[w & 3] : r1[w & 3], kw = w < 4 ? k0[w & 3] : k1[w & 3], aw = w < 4 ? a0[w & 3] : a1[w & 3];
                const int kk0 = h * 64 + sg * 16 + 2 * w;
#pragma unroll
                for (int p = 0; p < 2; ++p) {
                    const float rv = p ? __uint_as_float(rw & 0xffff0000u) : __uint_as_float(rw << 16), kv = p ? __uint_as_float(kw & 0xffff0000u) : __uint_as_float(kw << 16), av = p ? __uint_as_float(aw & 0xffff0000u) : __uint_as_float(aw << 16);
                    const float kkv = kv * A.in[IN_KK][kk0 + p]; ss += kkv * kkv;
                    bo += rv * (kv * (1.f + (av - 1.f) * A.in[IN_KA][kk0 + p])) * A.in[IN_RK][kk0 + p];
                }
            }
            ss = quad_allsum(ss); bo = quad_allsum(bo);
            if (sg == 0) { invs[t] = rsqrtf(fmaxf(ss, 1e-24f)); BO[(size_t)(m0 + t) * 16 + h] = bo; }
        }
        LDS_WAIT();
        float wc;
        {
            const float kkw = A.in[IN_KK][h * 64 + lane], kaw = A.in[IN_KA][h * 64 + lane];
            float Ecum = 0.f, ep_prev = 1.f; float bt[16], ktl[16];
#pragma unroll
            for (int t = 0; t < 16; ++t) {
                const float r = bf2f(arr[t * 64 + lane]), k = bf2f(arr[1024 + t * 64 + lane]), e = bf2f(arr[2048 + t * 64 + lane]), a = bf2f(arr[3072 + t * 64 + lane]);
                const float n = -(k * kkw) * invs[t], bb = -n * a, kt = k * (1.f + (a - 1.f) * kaw);
                Ecum += e; const float ep = __expf(Ecum), em = __builtin_amdgcn_rcpf(ep);
                bt[t] = bb * em; ktl[t] = kt * em;
                arr[t * 64 + lane] = (bf16_t)f2bf(r * ep); arr[1024 + t * 64 + lane] = (bf16_t)f2bf(n * ep_prev);
                arr[2048 + t * 64 + lane] = (bf16_t)f2bf(bt[t]); arr[3072 + t * 64 + lane] = (bf16_t)f2bf(ktl[t]);
                ep_prev = ep;
            }
            wc = ep_prev;
            u32x4* bd = (u32x4*)(bkb + lane * 16); u32x4* kd = (u32x4*)(bkb + 1024 + lane * 16);
            bd[0] = (u32x4){cvtpk(bt[0] * wc, bt[1] * wc), cvtpk(bt[2] * wc, bt[3] * wc), cvtpk(bt[4] * wc, bt[5] * wc), cvtpk(bt[6] * wc, bt[7] * wc)};
            bd[1] = (u32x4){cvtpk(bt[8] * wc, bt[9] * wc), cvtpk(bt[10] * wc, bt[11] * wc), cvtpk(bt[12] * wc, bt[13] * wc), cvtpk(bt[14] * wc, bt[15] * wc)};
            kd[0] = (u32x4){cvtpk(ktl[0] * wc, ktl[1] * wc), cvtpk(ktl[2] * wc, ktl[3] * wc), cvtpk(ktl[4] * wc, ktl[5] * wc), cvtpk(ktl[6] * wc, ktl[7] * wc)};
            kd[1] = (u32x4){cvtpk(ktl[8] * wc, ktl[9] * wc), cvtpk(ktl[10] * wc, ktl[11] * wc), cvtpk(ktl[12] * wc, ktl[13] * wc), cvtpk(ktl[14] * wc, ktl[15] * wc)};
        }
        LDS_WAIT();
        f32x4 gnb = {0.f, 0.f, 0.f, 0.f}, gnk = gnb, grb = gnb, grk = gnb;
#pragma unroll
        for (int ks = 0; ks < 2; ++ks) {
            const int o = c * 64 + ks * 32 + q * 8;
            const bf16x8 Ab = *(const bf16x8*)(arr + 2048 + o), Ak = *(const bf16x8*)(arr + 3072 + o), Bn = *(const bf16x8*)(arr + 1024 + o), Br = *(const bf16x8*)(arr + o);
            gnb = __builtin_amdgcn_mfma_f32_16x16x32_bf16(Ab, Bn, gnb, 0, 0, 0); gnk = __builtin_amdgcn_mfma_f32_16x16x32_bf16(Ak, Bn, gnk, 0, 0, 0);
            grb = __builtin_amdgcn_mfma_f32_16x16x32_bf16(Ab, Br, grb, 0, 0, 0); grk = __builtin_amdgcn_mfma_f32_16x16x32_bf16(Ak, Br, grk, 0, 0, 0);
        }
#pragma unroll
        for (int rg = 0; rg < 4; ++rg) { const int sI = 4 * q + rg; if (!(sI < c)) { gnb[rg] = 0.f; gnk[rg] = 0.f; } if (!(sI <= c)) { grb[rg] = 0.f; grk[rg] = 0.f; } gs[sI * 16 + c] = gnb[rg]; }
        LDS_WAIT();
        {
            float Tc[16];
#pragma unroll
            for (int sI = 15; sI >= 0; --sI) {
                float acc = (sI == c) ? 1.f : 0.f;
#pragma unroll
                for (int j = sI + 1; j < 16; ++j) acc += gs[sI * 16 + j] * Tc[j];
                Tc[sI] = acc;
            }
            LDS_WAIT();
            if (q == 0) {
#pragma unroll
                for (int j = 0; j < 4; ++j) *(f32x4*)(gs + c * 16 + 4 * j) = (f32x4){Tc[4 * j], Tc[4 * j + 1], Tc[4 * j + 2], Tc[4 * j + 3]};
            }
        }
        LDS_WAIT();
#pragma unroll
        for (int blk = 0; blk < 4; ++blk) {
            const int ks = blk & 1; const bf16_t* src = arr + (blk < 2 ? 1024 : 0) + c * 64 + ks * 32 + 4 * q;
            const u32x2 lo = *(const u32x2*)src, hi = *(const u32x2*)(src + 16);
            *(u32x4*)piece_ptr(A, blk, lane, m0, h) = (u32x4){lo.x, lo.y, hi.x, hi.y};
        }
#pragma unroll
        for (int ct = 0; ct < 4; ++ct) {
            const u32x2 lo = *(const u32x2*)(bkb + (16 * ct + c) * 16 + 4 * q), hi = *(const u32x2*)(bkb + 1024 + (16 * ct + c) * 16 + 4 * q);
            *(u32x4*)piece_ptr(A, 4 + ct, lane, m0, h) = (u32x4){lo.x, lo.y, hi.x, hi.y};
        }
        {
            unsigned char* sm = SM + (size_t)item * 2048;
            *(u32x2*)(sm + lane * 8) = (u32x2){cvtpk(gnk[0], gnk[1]), cvtpk(gnk[2], gnk[3])};
            const f32x4 tv = *(const f32x4*)(gs + c * 16 + 4 * q);
            *(u32x2*)(sm + 512 + lane * 8) = (u32x2){cvtpk(tv[0], tv[1]), cvtpk(tv[2], tv[3])};
            *(u32x4*)(sm + 1024 + lane * 16) = (u32x4){cvtpk(grb[0], grb[1]), cvtpk(grb[2], grb[3]), cvtpk(grk[0], grk[1]), cvtpk(grk[2], grk[3])};
            WC[(size_t)item * 64 + lane] = wc;
        }
        LDS_WAIT();
    }
}

constexpr int CS_SLOT = 12800, CS_PD = 4, CS_YT = 1024 + 3 * CS_SLOT;
#define CS_BAR() asm volatile("s_waitcnt lgkmcnt(0)\n\ts_barrier" ::: "memory")
__device__ __forceinline__ void p13_chunk_scan(const Args& A, unsigned char* lds) {
    const int tid = opaque_tid(), lane = tid & 63, wave = __builtin_amdgcn_readfirstlane(tid >> 6), q = lane >> 4, c = lane & 15;
    float* part = (float*)lds; unsigned char* slots = lds + 1024;
    const bf16_t* VV = WSP(bf16_t, OFF_VV); bf16_t* Y = WSP(bf16_t, OFF_R); float* ST = WSP(float, OFF_STATS); const float* WC = WSP(float, OFF_WC); const unsigned char* SM = A.ws + OFF_SM;
    if (DEFER_W && (int)gridDim.x > BATCH * 16 && (int)blockIdx.x >= BATCH * 16) {
        float* scr = (float*)(lds + wave * 16384);
        const int gwi = ((int)blockIdx.x - BATCH * 16) * NWAVES + wave, ngwi = ((int)gridDim.x - BATCH * 16) * NWAVES;
        p0_weight<9>(A, WSP(bf16_t, OFF_WO1), 1024, 1024, scr, gwi, ngwi, lane);
        p0_weight<10>(A, WSP(bf16_t, OFF_WUP1), 4096, 1024, scr, gwi, ngwi, lane);
        p0_weight<11>(A, WSP(bf16_t, OFF_WDN1), 1024, 4096, scr, gwi, ngwi, lane);
        return;
    }
#pragma unroll 1
    for (int it = blockIdx.x; it < BATCH * 16; it += gridDim.x) {
        const int b = it >> 4, h = it & 15;
        __syncthreads();
        if (wave >= 4) {
            const int lw = wave - 4;
            const unsigned char* src[4]; int dst[4]; size_t step[4]; bool on[4];
#pragma unroll
            for (int i = 0; i < 4; ++i) { src[i] = A.ws; dst[i] = 0; step[i] = 0; on[i] = false; }
            if (lw < 2) {
#pragma unroll
                for (int i = 0; i < 4; ++i) { src[i] = piece_ptr(A, 4 * lw + i, lane, b * SEQ, h); dst[i] = (4 * lw + i) * 1024 + lane * 16; step[i] = (size_t)CH * DM * 2; on[i] = true; }
            } else if (lw == 2) {
                src[0] = SM + (size_t)it * NCHUNK * 2048 + lane * 32; src[1] = src[0] + 16; dst[0] = 8192 + lane * 32; dst[1] = dst[0] + 16; step[0] = step[1] = 2048; on[0] = on[1] = true;
                src[2] = (const unsigned char*)(WC + (size_t)it * NCHUNK * 64) + (lane & 15) * 16; dst[2] = 10240 + (lane & 15) * 16; step[2] = 256; on[2] = lane < 16;
            } else {
                src[0] = (const unsigned char*)(VV + (size_t)(b * SEQ + (lane >> 2)) * DM + h * 64 + (lane & 3) * 16); src[1] = src[0] + 16; dst[0] = 10496 + (lane >> 2) * 128 + (lane & 3) * 32; dst[1] = dst[0] + 16;
                step[0] = step[1] = (size_t)CH * DM * 2; on[0] = on[1] = true;
            }
            u32x4 ld[CS_PD][4];
#define LD_ISSUE(slotreg, chn) do { _Pragma("unroll") for (int i_ = 0; i_ < 4; ++i_) if (on[i_]) ld[slotreg][i_] = *(const u32x4*)(src[i_] + (size_t)(chn) * step[i_]); } while (0)
#define LD_WRITE(slotreg, chn) do { unsigned char* sl_ = slots + ((chn) % 3) * CS_SLOT; _Pragma("unroll") for (int i_ = 0; i_ < 4; ++i_) if (on[i_]) *(u32x4*)(sl_ + dst[i_]) = ld[slotreg][i_]; } while (0)
#define YT_OUT(chn) do { const unsigned char* yt_ = lds + CS_YT + ((chn) & 1) * 2048 + (lane >> 2) * 128 + (lane & 3) * 32; \
                const u32x4 ya_ = *(const u32x4*)yt_, yb_ = *(const u32x4*)(yt_ + 16); float s1_ = 0.f, s2_ = 0.f; \
                _Pragma("unroll") for (int i_ = 0; i_ < 4; ++i_) { const float a0_ = __uint_as_float(ya_[i_] << 16), a1_ = __uint_as_float(ya_[i_] & 0xffff0000u), b0_ = __uint_as_float(yb_[i_] << 16), b1_ = __uint_as_float(yb_[i_] & 0xffff0000u); \
                    s1_ += (a0_ + a1_) + (b0_ + b1_); s2_ += (a0_ * a0_ + a1_ * a1_) + (b0_ * b0_ + b1_ * b1_); } \
                s1_ = quad_allsum(s1_); s2_ = quad_allsum(s2_); \
                const size_t m_ = (size_t)b * SEQ + (chn) * CH + (lane >> 2); \
                u32x4* yg_ = (u32x4*)(Y + m_ * DM + h * 64 + (lane & 3) * 16); yg_[0] = ya_; yg_[1] = yb_; \
                if ((lane & 3) == 0) *(f32x4*)(ST + (m_ * 16 + h) * 4) = (f32x4){s1_, s2_, 0.f, 0.f}; } while (0)
#pragma unroll
            for (int u = 0; u < CS_PD; ++u) LD_ISSUE(u, u);
            LD_WRITE(0, 0); LD_ISSUE(0, CS_PD);
            LD_WRITE(1, 1); LD_ISSUE(1, CS_PD + 1);
            CS_BAR();
#pragma unroll 1
            for (int ch = 0; ch < NCHUNK; ch += CS_PD) {
#pragma unroll
                for (int u = 0; u < CS_PD; ++u) {
                    const int cc = ch + u, wn = cc + 2;
                    if (wn < NCHUNK) { LD_WRITE((u + 2) % CS_PD, wn); if (wn + CS_PD < NCHUNK) LD_ISSUE((u + 2) % CS_PD, wn + CS_PD); }
                    if (lw == 3 && cc >= 1) YT_OUT(cc - 1);
                    CS_BAR();
                }
            }
            if (lw == 3) YT_OUT(NCHUNK - 1);
#undef LD_ISSUE
#undef LD_WRITE
#undef YT_OUT
        } else {
            const int rt = wave;
            f32x4 St[4];
#pragma unroll
            for (int i = 0; i < 4; ++i) St[i] = (f32x4){0.f, 0.f, 0.f, 0.f};
            bf16x8 n0, n1, r0, r1, bk0, bk1, bk2, bk3, gr; u32x2 gnk, tt; unsigned short v0, v1, v2, v3; f32x4 w0, w1, w2, w3;
#define CS_LOAD(chn) do { const unsigned char* sl_ = slots + ((chn) % 3) * CS_SLOT; \
            n0 = *(const bf16x8*)(sl_ + lane * 16); n1 = *(const bf16x8*)(sl_ + 1024 + lane * 16); r0 = *(const bf16x8*)(sl_ + 2048 + lane * 16); r1 = *(const bf16x8*)(sl_ + 3072 + lane * 16); \
            bk0 = *(const bf16x8*)(sl_ + 4096 + lane * 16); bk1 = *(const bf16x8*)(sl_ + 5120 + lane * 16); bk2 = *(const bf16x8*)(sl_ + 6144 + lane * 16); bk3 = *(const bf16x8*)(sl_ + 7168 + lane * 16); \
            gnk = *(const u32x2*)(sl_ + 8192 + lane * 8); tt = *(const u32x2*)(sl_ + 8704 + lane * 8); gr = *(const bf16x8*)(sl_ + 9216 + lane * 16); \
            const float* wp_ = (const float*)(sl_ + 10240) + 4 * q; w0 = *(const f32x4*)(wp_); w1 = *(const f32x4*)(wp_ + 16); w2 = *(const f32x4*)(wp_ + 32); w3 = *(const f32x4*)(wp_ + 48); \
            const bf16_t* vp_ = (const bf16_t*)(sl_ + 10496) + (4 * q) * 64 + 16 * rt + c; v0 = vp_[0]; v1 = vp_[64]; v2 = vp_[128]; v3 = vp_[192]; } while (0)
            CS_BAR();
            CS_LOAD(0);
#pragma unroll 1
            for (int ch = 0; ch < NCHUNK; ++ch) {
                const int m0 = b * SEQ + ch * CH;
                const bf16x8 cn0 = n0, cn1 = n1, cr0 = r0, cr1 = r1, cb0 = bk0, cb1 = bk1, cb2 = bk2, cb3 = bk3, cgr = gr; const u32x2 cgnk = gnk, ctt = tt;
                const unsigned vlo = (unsigned)v0 | ((unsigned)v1 << 16), vhi = (unsigned)v2 | ((unsigned)v3 << 16); const f32x4 cw0 = w0, cw1 = w1, cw2 = w2, cw3 = w3;
                if (ch + 1 < NCHUNK) CS_LOAD(ch + 1);
                const f32x4 z = {0.f, 0.f, 0.f, 0.f};
                const bf16x8 bS0 = mk8(cvtpk(St[0][0], St[0][1]), cvtpk(St[0][2], St[0][3]), cvtpk(St[1][0], St[1][1]), cvtpk(St[1][2], St[1][3]));
                const bf16x8 bS1 = mk8(cvtpk(St[2][0], St[2][1]), cvtpk(St[2][2], St[2][3]), cvtpk(St[3][0], St[3][1]), cvtpk(St[3][2], St[3][3]));
                f32x4 X = __builtin_amdgcn_mfma_f32_16x16x32_bf16(cn0, bS0, z, 0, 0, 0);
                X = __builtin_amdgcn_mfma_f32_16x16x32_bf16(cn1, bS1, X, 0, 0, 0);
                X = __builtin_amdgcn_mfma_f32_16x16x32_bf16(mk8(cgnk.x, cgnk.y, 0u, 0u), mk8(vlo, vhi, 0u, 0u), X, 0, 0, 0);
                const f32x4 U = __builtin_amdgcn_mfma_f32_16x16x32_bf16(mk8(ctt.x, ctt.y, 0u, 0u), mk8(cvtpk(X[0], X[1]), cvtpk(X[2], X[3]), 0u, 0u), z, 0, 0, 0);
                const bf16x8 bUV = mk8(cvtpk(U[0], U[1]), cvtpk(U[2], U[3]), vlo, vhi);
                f32x4 Yt = __builtin_amdgcn_mfma_f32_16x16x32_bf16(cr0, bS0, z, 0, 0, 0);
                Yt = __builtin_amdgcn_mfma_f32_16x16x32_bf16(cr1, bS1, Yt, 0, 0, 0);
                Yt = __builtin_amdgcn_mfma_f32_16x16x32_bf16(cgr, bUV, Yt, 0, 0, 0);
                St[0] = __builtin_amdgcn_mfma_f32_16x16x32_bf16(cb0, bUV, St[0] * cw0, 0, 0, 0);
                St[1] = __builtin_amdgcn_mfma_f32_16x16x32_bf16(cb1, bUV, St[1] * cw1, 0, 0, 0);
                St[2] = __builtin_amdgcn_mfma_f32_16x16x32_bf16(cb2, bUV, St[2] * cw2, 0, 0, 0);
                St[3] = __builtin_amdgcn_mfma_f32_16x16x32_bf16(cb3, bUV, St[3] * cw3, 0, 0, 0);
                {
                    bf16_t* ytp = (bf16_t*)(lds + CS_YT + (ch & 1) * 2048) + (4 * q) * 64 + 16 * rt + c;
                    const unsigned y01 = cvtpk(Yt[0], Yt[1]), y23 = cvtpk(Yt[2], Yt[3]);
                    ytp[0] = (bf16_t)(y01 & 0xffffu); ytp[64] = (bf16_t)(y01 >> 16); ytp[128] = (bf16_t)(y23 & 0xffffu); ytp[192] = (bf16_t)(y23 >> 16);
                }
                CS_BAR();
            }
#undef CS_LOAD
        }
    }
}
#undef CS_BAR

__device__ __forceinline__ void p18_final(const Args& A) {
    const int tid = opaque_tid(), lane = tid & 63, wave = tid >> 6;
    const int gw = blockIdx.x * NWAVES + wave, NGW = gridDim.x * NWAVES;
    const f32x4* gr = (const f32x4*)A.in[IN_FINN] + lane;
    for (int m = gw; m < MTOK; m += NGW) {
        f32x4* xr = (f32x4*)(A.out + (size_t)m * DM) + lane; f32x4 v[4]; float s = 0.f;
#pragma unroll
        for (int j = 0; j < 4; ++j) { v[j] = xr[64 * j]; s += (v[j].x * v[j].x + v[j].y * v[j].y) + (v[j].z * v[j].z + v[j].w * v[j].w); }
        const float rs = rsqrtf(wave_sum(s) * (1.f / DM) + NORM_EPS);
#pragma unroll
        for (int j = 0; j < 4; ++j) xr[64 * j] = v[j] * rs * gr[64 * j];
    }
}

typedef GAS unsigned gu32;
#define RLX_AGENT __ATOMIC_RELAXED, __HIP_MEMORY_SCOPE_AGENT
constexpr int CW_BAR = 4096;
constexpr int RING_BYTES = 131072, LDSCTL_OFF = RING_BYTES, MISC_OFF = LDSCTL_OFF + 320;
#define XB_TMO      128
#define XB_XCNT(j)  (256  + 64 * (j))
#define XB_XSUB(j)  (1280 + 64 * (j))
#define XB_XGEN(j)  (2304 + 64 * (j))
#define XB_TOP      3328
#define XB_TOPGEN   3392
#define XCD_BAR_WORDS 3456
#define XB_SPIN_CAP (1u << 18)

__device__ __forceinline__ unsigned xb_ld(unsigned* p)              { return __hip_atomic_load(p, __ATOMIC_RELAXED, __HIP_MEMORY_SCOPE_AGENT); }
__device__ __forceinline__ unsigned xb_add(unsigned* p, unsigned v) { return __hip_atomic_fetch_add(p, v, __ATOMIC_RELAXED, __HIP_MEMORY_SCOPE_AGENT); }
__device__ __forceinline__ unsigned xb_xcc_id() { return (unsigned)__builtin_amdgcn_s_getreg((3 << 11) | 20) & 0xFu; }
#define XB_SPIN(cond, bar) do { unsigned _sp = 0; while (cond) { __builtin_amdgcn_s_sleep(1); \
    if ((++_sp & 255u) == 0u) { if (xb_ld(&(bar)[XB_TMO])) break; if (_sp > XB_SPIN_CAP) { atomicAdd(&(bar)[XB_TMO], 1u); break; } } } } while (0)

struct XcdBarrier {
    unsigned* bar; unsigned x;
    volatile LAS unsigned* st;
};

__device__ __forceinline__ XcdBarrier xcd_barrier_post(unsigned* bar, volatile LAS unsigned* st) {
    XcdBarrier b; b.bar = bar; b.x = xb_xcc_id(); b.st = st;
    if (threadIdx.x == 0) (void)xb_add(&bar[XB_XCNT(b.x)], 1u);
    return b;
}
__device__ __forceinline__ void xcd_barrier_complete(unsigned* bar, unsigned x, unsigned& nloc, unsigned& nx) {
    const unsigned G = gridDim.x * gridDim.y * gridDim.z;
    unsigned sum, cnt, mine, sp = 0u;
    for (;;) {
        sum = 0u; cnt = 0u; mine = 0u;
#pragma unroll
        for (unsigned j = 0; j < 16; ++j) { const unsigned c = xb_ld(&bar[XB_XCNT(j)]); sum += c; cnt += (c > 0u) ? 1u : 0u; mine = (j == x) ? c : mine; }
        if (sum == G) break;
        __builtin_amdgcn_s_sleep(1);
        if ((++sp & 255u) == 0u) { if (xb_ld(&bar[XB_TMO])) break; if (sp > XB_SPIN_CAP) { atomicAdd(&bar[XB_TMO], 1u); break; } }
    }
    nloc = mine > 0u ? mine : 1u; nx = cnt > 0u ? cnt : 1u;
}

__device__ __forceinline__ void xcd_barrier(const XcdBarrier& b) {
    asm volatile("s_waitcnt vmcnt(0)" ::: "memory");
    __syncthreads();
    if (threadIdx.x == 0) {
        unsigned* bar = b.bar;
        __builtin_amdgcn_s_waitcnt(0);
        unsigned nloc = b.st[0], nx = b.st[1];
        if (nloc == 0u) { xcd_barrier_complete(bar, b.x, nloc, nx); b.st[0] = nloc; b.st[1] = nx; }
        const unsigned old = xb_add(&bar[XB_XSUB(b.x)], 1u);
        const unsigned gen = old / nloc;
        if (old + 1u == (gen + 1u) * nloc) {
            __builtin_amdgcn_fence(__ATOMIC_RELEASE, "agent");
            asm volatile("s_waitcnt vmcnt(0)" ::: "memory");
            const unsigned og = xb_add(&bar[XB_TOP], 1u);
            const unsigned tg = og / nx;
            if (og + 1u == (tg + 1u) * nx) xb_add(&bar[XB_TOPGEN], 1u);
            else XB_SPIN(xb_ld(&bar[XB_TOPGEN]) == tg, bar);
            __builtin_amdgcn_fence(__ATOMIC_ACQUIRE, "agent");
            xb_add(&bar[XB_XGEN(b.x)], 1u);
            asm volatile("s_waitcnt vmcnt(0)" ::: "memory");
        } else {
            XB_SPIN(xb_ld(&bar[XB_XGEN(b.x)]) == gen, bar);
            __builtin_amdgcn_fence(__ATOMIC_ACQUIRE, "agent");
            asm volatile("s_waitcnt vmcnt(0)" ::: "memory");
        }
    }
    __syncthreads();
}

constexpr int N_PHASES = 19;
template <int LO, int HI> __global__ void __launch_bounds__(NTHR, 2) mk_fwd(Args A) {
    extern __shared__ __attribute__((aligned(16))) unsigned char lds[];
#define IN(k) (LO <= (k) && (k) < HI)
    constexpr bool FUSED = (HI - LO) > 1;
    XcdBarrier bar; bar.bar = nullptr; bar.x = 0; bar.st = nullptr;
    if constexpr (FUSED) {
        for (int u = threadIdx.x; u < (LDS_BYTES - LDSCTL_OFF) / 4; u += NTHR) ((LAS unsigned*)((LAS unsigned char*)lds + LDSCTL_OFF))[u] = 0u;
        __syncthreads();
        bar = xcd_barrier_post(WSP(unsigned, OFF_CTL) + CW_BAR, (volatile LAS unsigned*)((LAS unsigned char*)lds + MISC_OFF) + 8);
    }
#define SEAM(k) do { if constexpr (FUSED && IN(k) && IN((k) + 1)) { if ((k) == 0) cg::this_grid().sync(); else xcd_barrier(bar); if (DBG_TS && blockIdx.x == 0 && threadIdx.x == 0) ((unsigned long long*)(A.ws + OFF_CTL + 16384))[(k) + 1] = __builtin_amdgcn_s_memrealtime(); } } while (0)
    if (DBG_TS && FUSED && blockIdx.x == 0 && threadIdx.x == 0) ((unsigned long long*)(A.ws + OFF_CTL + 16384))[0] = __builtin_amdgcn_s_memrealtime();
    if constexpr (IN(0)) p0_prologue(A, lds);
    if constexpr (FUSED && IN(0) && ((REP_MASK >> 0) & 1u)) xcd_barrier(bar);
    if constexpr (FUSED && IN(0) && ((REP_MASK >> 0) & 1u)) p0_prologue(A, lds);
    SEAM(0);
    if constexpr (IN(1)) {
        Gemm g{WSP(bf16_t, OFF_H0), WSP(bf16_t, OFF_H0), 1 << 30, WSP(bf16_t, OFF_WIN), MTOK, 2304, DM};
        EpiInProj E{WSP(bf16_t, OFF_QO), WSP(bf16_t, OFF_K), WSP(bf16_t, OFF_V), WSP(bf16_t, OFF_QI), WSP(bf16_t, OFF_KI), WSP(float, OFF_WI), WSP(float, OFF_ROPE)};
        gemm_phase(lds, g, E);
    }
    SEAM(1);
    if constexpr (IN(2)) { if (FAST_TOPK) p2_fast(A, lds); else p2_naive(A, lds);
#if DBG_TOPK
        __syncthreads(); p2_naive(A, lds, 160 * MiB);
#endif
    }
    if constexpr (FUSED && IN(2) && ((REP_MASK >> 2) & 1u)) xcd_barrier(bar);
    if constexpr (FUSED && IN(2) && ((REP_MASK >> 2) & 1u)) { if (FAST_TOPK) p2_fast(A, lds); else p2_naive(A, lds);
#if DBG_TOPK
        __syncthreads(); p2_naive(A, lds, 160 * MiB);
#endif
    }
    if constexpr (FUSED && IN(2) && PROBE_P2 > 0) { xcd_barrier(bar); p2_fast<PROBE_P2>(A, lds); }
    SEAM(2);
    if constexpr (IN(3)) {
#if DBG_TOPK
        {
            const int lane_ = threadIdx.x & 63, gw_ = blockIdx.x * NWAVES + (threadIdx.x >> 6);
            const unsigned* M1 = WSP(unsigned, OFF_MASK); const unsigned* M2 = WSP(unsigned, 160 * MiB); unsigned rows_ = 0, bits_ = 0, bad1_ = 0, bad2_ = 0;
            for (int m = gw_; m < MTOK; m += gridDim.x * NWAVES) { const unsigned d = M1[(size_t)m * 64 + lane_] ^ M2[(size_t)m * 64 + lane_]; const int nb = wave_allsum_i(__popc(d)); if (nb) { rows_ += 1; bits_ += nb; }
                const int t_ = m & (SEQ - 1), ex_ = t_ + 1 < 256 ? t_ + 1 : 256; if (wave_allsum_i(__popc(M1[(size_t)m * 64 + lane_])) != ex_) bad1_ += 1; if (wave_allsum_i(__popc(M2[(size_t)m * 64 + lane_])) != ex_) bad2_ += 1; }
            if (lane_ == 0) { atomicAdd(WSP(unsigned, OFF_CTL) + 1000, rows_); atomicAdd(WSP(unsigned, OFF_CTL) + 1001, bits_); atomicAdd(WSP(unsigned, OFF_CTL) + 1002, bad1_); atomicAdd(WSP(unsigned, OFF_CTL) + 1003, bad2_); }
        }
#endif
        if (FAST_ATTN) {
            static_assert(attn_body::ATTN_LDS_BYTES <= RING_BYTES, "attention LDS");
            const attn_body::AttnTensors AT{(const attn_body::bf16*)WSP(bf16_t, OFF_QO), (const attn_body::bf16*)WSP(bf16_t, OFF_K), (const attn_body::bf16*)WSP(bf16_t, OFF_V), (attn_body::bf16*)WSP(bf16_t, OFF_QO), WSP(unsigned, OFF_MASK)};
            const attn_body::StaticOrder S((int)gridDim.x, (int)blockIdx.x);
            attn_body::attn_phase<attn_body::StaticOrder>((char*)lds, AT, S);
        } else p3_naive(A, lds);
    }
    if constexpr (FUSED && REP_123 && IN(3)) xcd_barrier(bar);
    if constexpr (FUSED && REP_123 && IN(3)) {
        Gemm g{WSP(bf16_t, OFF_H0), WSP(bf16_t, OFF_H0), 1 << 30, WSP(bf16_t, OFF_WIN), MTOK, 2304, DM};
        EpiInProj E{WSP(bf16_t, OFF_QO), WSP(bf16_t, OFF_K), WSP(bf16_t, OFF_V), WSP(bf16_t, OFF_QI), WSP(bf16_t, OFF_KI), WSP(float, OFF_WI), WSP(float, OFF_ROPE)};
        gemm_phase(lds, g, E);
    }
    if constexpr (FUSED && REP_123 && IN(3)) xcd_barrier(bar);
    if constexpr (FUSED && REP_123 && IN(3)) { if (FAST_TOPK) p2_fast(A, lds); else p2_naive(A, lds);
#if DBG_TOPK
        __syncthreads(); p2_naive(A, lds, 160 * MiB);
#endif
    }
    if constexpr (FUSED && REP_123 && IN(3)) xcd_barrier(bar);
    if constexpr (FUSED && REP_123 && IN(3)) {
#if DBG_TOPK
        {
            const int lane_ = threadIdx.x & 63, gw_ = blockIdx.x * NWAVES + (threadIdx.x >> 6);
            const unsigned* M1 = WSP(unsigned, OFF_MASK); const unsigned* M2 = WSP(unsigned, 160 * MiB); unsigned rows_ = 0, bits_ = 0, bad1_ = 0, bad2_ = 0;
            for (int m = gw_; m < MTOK; m += gridDim.x * NWAVES) { const unsigned d = M1[(size_t)m * 64 + lane_] ^ M2[(size_t)m * 64 + lane_]; const int nb = wave_allsum_i(__popc(d)); if (nb) { rows_ += 1; bits_ += nb; }
                const int t_ = m & (SEQ - 1), ex_ = t_ + 1 < 256 ? t_ + 1 : 256; if (wave_allsum_i(__popc(M1[(size_t)m * 64 + lane_])) != ex_) bad1_ += 1; if (wave_allsum_i(__popc(M2[(size_t)m * 64 + lane_])) != ex_) bad2_ += 1; }
            if (lane_ == 0) { atomicAdd(WSP(unsigned, OFF_CTL) + 1000, rows_); atomicAdd(WSP(unsigned, OFF_CTL) + 1001, bits_); atomicAdd(WSP(unsigned, OFF_CTL) + 1002, bad1_); atomicAdd(WSP(unsigned, OFF_CTL) + 1003, bad2_); }
        }
#endif
        if (FAST_ATTN) {
            static_assert(attn_body::ATTN_LDS_BYTES <= RING_BYTES, "attention LDS");
            const attn_body::AttnTensors AT{(const attn_body::bf16*)WSP(bf16_t, OFF_QO), (const attn_body::bf16*)WSP(bf16_t, OFF_K), (const attn_body::bf16*)WSP(bf16_t, OFF_V), (attn_body::bf16*)WSP(bf16_t, OFF_QO), WSP(unsigned, OFF_MASK)};
            const attn_body::StaticOrder S((int)gridDim.x, (int)blockIdx.x);
            attn_body::attn_phase<attn_body::StaticOrder>((char*)lds, AT, S);
        } else p3_naive(A, lds);
    }
    SEAM(3);
    if constexpr (IN(4)) {
        Gemm g{WSP(bf16_t, OFF_QO), WSP(bf16_t, OFF_QO), 1 << 30, WSP(bf16_t, OFF_WO0), MTOK, DM, DM};
        EpiResid E{A.in[IN_X], A.out, WSP(bf16_t, OFF_XB), WSP(float, OFF_SSQ0)};
        gemm_phase(lds, g, E);
    }
    SEAM(4);
    if constexpr (IN(5)) {
        Gemm g{WSP(bf16_t, OFF_XB), WSP(bf16_t, OFF_XB), 1 << 30, WSP(bf16_t, OFF_WUP0), MTOK, FF, DM};
        EpiUp E{WSP(bf16_t, OFF_U), WSP(float, OFF_SSQ0)};
        gemm_phase(lds, g, E);
    }
    if constexpr (FUSED && IN(5) && ((REP_MASK >> 5) & 1u)) xcd_barrier(bar);
    if constexpr (FUSED && IN(5) && ((REP_MASK >> 5) & 1u)) {
        Gemm g{WSP(bf16_t, OFF_XB), WSP(bf16_t, OFF_XB), 1 << 30, WSP(bf16_t, OFF_WUP0), MTOK, FF, DM};
        EpiUp E{WSP(bf16_t, OFF_U), WSP(float, OFF_SSQ0)};
        gemm_phase(lds, g, E);
    }
    SEAM(5);
    if constexpr (IN(6)) {
        Gemm g{WSP(bf16_t, OFF_U), WSP(bf16_t, OFF_U), 1 << 30, WSP(bf16_t, OFF_WDN0), MTOK, DM, FF};
        EpiResid E{A.out, A.out, nullptr, nullptr};
        gemm_phase(lds, g, E);
    }
    SEAM(6);
    if constexpr (IN(7)) p7_prep(A);
    if constexpr (FUSED && IN(7) && ((REP_MASK >> 7) & 1u)) xcd_barrier(bar);
    if constexpr (FUSED && IN(7) && ((REP_MASK >> 7) & 1u)) p7_prep(A);
    SEAM(7);
    if constexpr (IN(8)) {
        Gemm g{WSP(bf16_t, OFF_XSR), WSP(bf16_t, OFF_XSK), 4, WSP(bf16_t, OFF_WRK), MTOK, 2048, DM};
        EpiStore E{WSP(bf16_t, OFF_R), DM, 4, WSP(bf16_t, OFF_KR), DM};
        gemm_phase(lds, g, E);
    }
    if constexpr (FUSED && IN(8) && ((REP_MASK >> 8) & 1u)) xcd_barrier(bar);
    if constexpr (FUSED && IN(8) && ((REP_MASK >> 8) & 1u)) {
        Gemm g{WSP(bf16_t, OFF_XSR), WSP(bf16_t, OFF_XSK), 4, WSP(bf16_t, OFF_WRK), MTOK, 2048, DM};
        EpiStore E{WSP(bf16_t, OFF_R), DM, 4, WSP(bf16_t, OFF_KR), DM};
        gemm_phase(lds, g, E);
    }
    SEAM(8);
    if constexpr (IN(9)) {
        Gemm g{WSP(bf16_t, OFF_XSV), WSP(bf16_t, OFF_H1), 4, WSP(bf16_t, OFF_WVL), MTOK, 1792, DM};
        EpiStore E{WSP(bf16_t, OFF_VV), DM, 4, WSP(bf16_t, OFF_P), 768};
        gemm_phase(lds, g, E);
    }
    if constexpr (FUSED && IN(9) && ((REP_MASK >> 9) & 1u)) xcd_barrier(bar);
    if constexpr (FUSED && IN(9) && ((REP_MASK >> 9) & 1u)) {
        Gemm g{WSP(bf16_t, OFF_XSV), WSP(bf16_t, OFF_H1), 4, WSP(bf16_t, OFF_WVL), MTOK, 1792, DM};
        EpiStore E{WSP(bf16_t, OFF_VV), DM, 4, WSP(bf16_t, OFF_P), 768};
        gemm_phase(lds, g, E);
    }
    SEAM(9);
    if constexpr (IN(10)) p10_loramid(A);
    if constexpr (FUSED && IN(10) && ((REP_MASK >> 10) & 1u)) xcd_barrier(bar);
    if constexpr (FUSED && IN(10) && ((REP_MASK >> 10) & 1u)) p10_loramid(A);
    SEAM(10);
    if constexpr (IN(11)) {
        Gemm g{WSP(bf16_t, OFF_AW), WSP(bf16_t, OFF_AA), 4, WSP(bf16_t, OFF_W2T), MTOK, 2048, 128};
        EpiLoraUp E{WSP(bf16_t, OFF_E), WSP(bf16_t, OFF_A), A.in[IN_W0], A.in[IN_A0]};
        gemm_phase(lds, g, E);
    }
    if constexpr (FUSED && IN(11) && ((REP_MASK >> 11) & 1u)) xcd_barrier(bar);
    if constexpr (FUSED && IN(11) && ((REP_MASK >> 11) & 1u)) {
        Gemm g{WSP(bf16_t, OFF_AW), WSP(bf16_t, OFF_AA), 4, WSP(bf16_t, OFF_W2T), MTOK, 2048, 128};
        EpiLoraUp E{WSP(bf16_t, OFF_E), WSP(bf16_t, OFF_A), A.in[IN_W0], A.in[IN_A0]};
        gemm_phase(lds, g, E);
    }
    SEAM(11);
    if constexpr (IN(12)) { if (CHUNK_SCAN) p12_chunk_prep(A, lds); else if (FAST_SCAN) p12_fast(A, lds); else p12_naive(A, lds); }
    if constexpr (FUSED && IN(12) && ((REP_MASK >> 12) & 1u)) xcd_barrier(bar);
    if constexpr (FUSED && IN(12) && ((REP_MASK >> 12) & 1u)) { if (FAST_SCAN) p12_fast(A, lds); else p12_naive(A, lds); }
    SEAM(12);
    if constexpr (IN(13)) { if (CHUNK_SCAN) p13_chunk_scan(A, lds); else if (!FAST_SCAN) p12b_stats(A); }
    SEAM(13);
    if constexpr (IN(14)) {
        Gemm g{WSP(bf16_t, OFF_AG), WSP(bf16_t, OFF_AG), 1 << 30, WSP(bf16_t, OFF_G2T), MTOK, DM, 256};
        EpiGatePost E{WSP(bf16_t, OFF_AO), WSP(bf16_t, CHUNK_SCAN ? OFF_R : OFF_Y), WSP(bf16_t, OFF_VV), WSP(float, OFF_STATS), WSP(float, OFF_BONUS), A.in[IN_LNW], A.in[IN_LNB]};
        gemm_phase(lds, g, E);
    }
    if constexpr (FUSED && IN(14) && ((REP_MASK >> 14) & 1u)) xcd_barrier(bar);
    if constexpr (FUSED && IN(14) && ((REP_MASK >> 14) & 1u)) {
        Gemm g{WSP(bf16_t, OFF_AG), WSP(bf16_t, OFF_AG), 1 << 30, WSP(bf16_t, OFF_G2T), MTOK, DM, 256};
        EpiGatePost E{WSP(bf16_t, OFF_AO), WSP(bf16_t, CHUNK_SCAN ? OFF_R : OFF_Y), WSP(bf16_t, OFF_VV), WSP(float, OFF_STATS), WSP(float, OFF_BONUS), A.in[IN_LNW], A.in[IN_LNB]};
        gemm_phase(lds, g, E);
    }
    SEAM(14);
    if constexpr (IN(15)) {
        Gemm g{WSP(bf16_t, OFF_AO), WSP(bf16_t, OFF_AO), 1 << 30, WSP(bf16_t, OFF_WO1), MTOK, DM, DM};
        EpiResid E{A.out, A.out, WSP(bf16_t, OFF_XB), WSP(float, OFF_SSQ1)};
        gemm_phase(lds, g, E);
    }
    SEAM(15);
    if constexpr (IN(16)) {
        Gemm g{WSP(bf16_t, OFF_XB), WSP(bf16_t, OFF_XB), 1 << 30, WSP(bf16_t, OFF_WUP1), MTOK, FF, DM};
        EpiUp E{WSP(bf16_t, OFF_U), WSP(float, OFF_SSQ1)};
        gemm_phase(lds, g, E);
    }
    if constexpr (FUSED && IN(16) && ((REP_MASK >> 16) & 1u)) xcd_barrier(bar);
    if constexpr (FUSED && IN(16) && ((REP_MASK >> 16) & 1u)) {
        Gemm g{WSP(bf16_t, OFF_XB), WSP(bf16_t, OFF_XB), 1 << 30, WSP(bf16_t, OFF_WUP1), MTOK, FF, DM};
        EpiUp E{WSP(bf16_t, OFF_U), WSP(float, OFF_SSQ1)};
        gemm_phase(lds, g, E);
    }
    SEAM(16);
    if constexpr (IN(17)) {
        Gemm g{WSP(bf16_t, OFF_U), WSP(bf16_t, OFF_U), 1 << 30, WSP(bf16_t, OFF_WDN1), MTOK, DM, FF};
        EpiResid E{A.out, A.out, nullptr, nullptr};
        gemm_phase(lds, g, E);
    }
    SEAM(17);
    if constexpr (IN(18)) {
        p18_final(A);
#if DBG_TS
        {   __syncthreads(); const unsigned long long* ts_ = (const unsigned long long*)(A.ws + OFF_CTL + 16384);
            const float usA_ = (float)(ts_[DBG_TS_A + 1] - ts_[DBG_TS_A]) * 0.01f;
            if (blockIdx.x == 1 && threadIdx.x == 0) A.out[12345] = usA_ * 0.2f; }
#endif
#if DBG_TOPK
        {   __syncthreads(); const float sc_ = 1.f + (float)WSP(unsigned, OFF_CTL)[1000 + DBG_WHICH] * DBG_UNIT;
            const int gw_ = blockIdx.x * NWAVES + (threadIdx.x >> 6), lane_ = threadIdx.x & 63;
            for (int m = gw_; m < MTOK; m += gridDim.x * NWAVES) for (int j = 0; j < 16; ++j) A.out[(size_t)m * DM + lane_ + 64 * j] *= sc_; }
#endif
    }
#undef IN
#undef SEAM
}

template <int P> static void launch_all(int grid, hipStream_t stream, const Args& a) {
    if constexpr (P < N_PHASES) {
        static bool attr_done = false;
        if (!attr_done) { (void)hipFuncSetAttribute((const void*)mk_fwd<P, P + 1>, hipFuncAttributeMaxDynamicSharedMemorySize, LDS_BYTES); attr_done = true; }
        hipLaunchKernelGGL((mk_fwd<P, P + 1>), dim3(grid), dim3(NTHR), LDS_BYTES, stream, a);
        launch_all<P + 1>(grid, stream, a);
    }
}
extern "C" void kernel_launch(void* const* d_in, const int* in_sizes, int n_in, void* d_out, int out_size, void* d_ws, size_t ws_size, hipStream_t stream) {
    static int grid = 0;
    if (grid == 0) {
        if (n_in != N_IN || out_size != MTOK * DM || ws_size < WS_END) { fprintf(stderr, "kernel_launch: unexpected shapes (n_in %d out %d ws %zu)\n", n_in, out_size, ws_size); grid = -1; return; }
        int dev = 0, cus = 0;
        (void)hipGetDevice(&dev); (void)hipDeviceGetAttribute(&cus, hipDeviceAttributeMultiprocessorCount, dev);
        grid = cus > 0 ? cus : 256;
    }
    if (grid < 0) return;
    (void)hipMemsetAsync((char*)d_ws + OFF_CTL, 0, CTL_BYTES, stream);
    Args a{};
    for (int i = 0; i < N_IN; ++i) a.in[i] = (const float*)d_in[i];
    a.out = (float*)d_out; a.ws = (unsigned char*)d_ws;
#if ONE_LAUNCH
    static bool attr_done = false;
    if (!attr_done) {
        (void)hipFuncSetAttribute((const void*)mk_fwd<0, N_PHASES>, hipFuncAttributeMaxDynamicSharedMemorySize, LDS_BYTES);
        int per_cu = 0;
        if (hipOccupancyMaxActiveBlocksPerMultiprocessor(&per_cu, (const void*)mk_fwd<0, N_PHASES>, NTHR, LDS_BYTES) != hipSuccess || per_cu < 1)
            fprintf(stderr, "kernel_launch: occupancy query reports %d blocks per CU\n", per_cu);
        (void)hipGetLastError();
        attr_done = true;
    }
    void* kargs[] = {(void*)&a};
    hipError_t e = hipLaunchCooperativeKernel((const void*)mk_fwd<0, N_PHASES>, dim3(grid), dim3(NTHR), kargs, LDS_BYTES, stream);
    if (e != hipSuccess) fprintf(stderr, "kernel_launch: cooperative launch failed: %s (grid %d)\n", hipGetErrorString(e), grid);
#else
    launch_all<0>(grid, stream, a);
#endif
}
```

```cpp
#include <hip/hip_runtime.h>
#include <hip/hip_cooperative_groups.h>
#include <hip/hip_bf16.h>
#include <cmath>
#include <cstdio>
#include <cstdint>
namespace cg = cooperative_groups;

#ifndef ONE_LAUNCH
#define ONE_LAUNCH 1
#endif
#ifndef DBG_TOPK
#define DBG_TOPK 0
#define DBG_WHICH 2
#define DBG_UNIT 0.001f
#endif
#ifndef REP_MASK
#define REP_MASK 0u
#endif
#ifndef REP_123
#define REP_123 0
#endif
#ifndef DBG_TS
#define DBG_TS 0
#define DBG_TS_A 12
#define DBG_TS_B 13
#endif
#ifndef PROBE_P2
#define PROBE_P2 0
#endif
#ifndef DEFER_W
#define DEFER_W 1
#endif
#ifndef CHUNK_SCAN
#define CHUNK_SCAN 1
#endif
#ifndef FAST_ATTN
#define FAST_ATTN 1
#endif
#ifndef FAST_TOPK
#define FAST_TOPK 1
#endif
#ifndef FAST_SCAN
#define FAST_SCAN 1
#endif
#ifndef FAST_GEMM
#define FAST_GEMM 1
#endif

#define LAS __attribute__((address_space(3)))
#define GAS __attribute__((address_space(1)))
typedef unsigned short bf16_t;
typedef short bf16x8 __attribute__((ext_vector_type(8)));
typedef float f32x4 __attribute__((ext_vector_type(4)));
typedef float f32x2 __attribute__((ext_vector_type(2)));
typedef unsigned u32x4 __attribute__((ext_vector_type(4)));
typedef unsigned u32x2 __attribute__((ext_vector_type(2)));

constexpr int BATCH = 8, SEQ = 2048, DM = 1024, MTOK = BATCH * SEQ, FF = 4096;
constexpr int NWAVES = 8, NTHR = 512;
constexpr int LDS_BYTES = 147456;
constexpr float NORM_EPS = 1e-6f, LNX_EPS = 64e-5f;
constexpr float QSCALE = 0.125f * 1.4426950408889634f;
constexpr float WI_SCALE = 0.044194173824159216f;

enum { IN_X = 0, IN_MIXN, IN_MLPN, IN_WUP, IN_WDN, IN_FINN, IN_WIN, IN_WO, IN_MU, IN_WRKV, IN_W0, IN_W1, IN_W2, IN_A0, IN_A1, IN_A2,
       IN_G1, IN_G2, IN_KK, IN_KA, IN_RK, IN_LNW, IN_LNB, IN_WO1, N_IN };

constexpr size_t MiB = 1u << 20;
constexpr size_t OFF_CTL = 0, CTL_BYTES = 1 * MiB;
constexpr size_t OFF_SSQ0 = 256 * 1024, OFF_SSQ1 = 320 * 1024;
constexpr size_t OFF_ROPE = 1 * MiB;
constexpr size_t OFF_WIN = 2 * MiB, OFF_WO0 = 7 * MiB, OFF_WUP0 = 9 * MiB, OFF_WDN0 = 17 * MiB, OFF_WRK = 25 * MiB  , OFF_WVL = 31 * MiB  ;
constexpr size_t OFF_W2T = 33 * MiB, OFF_A2T = 33 * MiB + 256 * 1024, OFF_G2T = 33 * MiB + 512 * 1024, OFF_WO1 = 34 * MiB, OFF_WUP1 = 36 * MiB, OFF_WDN1 = 44 * MiB;
constexpr size_t OFF_BONUS = 2 * MiB;
constexpr size_t OFF_H0 = 52 * MiB, OFF_QO = 84 * MiB, OFF_K = 116 * MiB, OFF_V = 124 * MiB, OFF_QI = 132 * MiB, OFF_KI = 148 * MiB, OFF_WI = 150 * MiB, OFF_MASK = 152 * MiB;
constexpr size_t OFF_XB = 52 * MiB, OFF_U = 84 * MiB;
constexpr size_t OFF_XSR = 52 * MiB, OFF_XSK = 84 * MiB, OFF_XSV = 116 * MiB, OFF_H1 = 148 * MiB, OFF_R = 180 * MiB, OFF_KR = 212 * MiB;
constexpr int P_LD = 640;
constexpr size_t OFF_VV = 52 * MiB, OFF_P = 2 * MiB  , OFF_AW = 108 * MiB, OFF_AA = 112 * MiB, OFF_AG = 244 * MiB;
constexpr size_t OFF_E = 116 * MiB, OFF_A = 148 * MiB, OFF_Y = 84 * MiB, OFF_STATS = 252 * MiB, OFF_AO = 116 * MiB;
constexpr size_t WS_END = 256 * MiB;

struct Args { const float* in[N_IN]; float* out; unsigned char* ws; int ph_lo, ph_hi; };
#define WSP(T, off) ((T*)(A.ws + (off)))

__device__ __forceinline__ float bf2f(bf16_t u) { return __uint_as_float((unsigned)u << 16); }
__device__ __forceinline__ unsigned f2bf(float f) { unsigned u = __float_as_uint(f); return (u + 0x7fffu + ((u >> 16) & 1u)) >> 16; }
__device__ __forceinline__ unsigned pk2(float lo, float hi) { return f2bf(lo) | (f2bf(hi) << 16); }
__device__ __forceinline__ float wave_sum(float v) {
#pragma unroll
    for (int o = 1; o < 64; o <<= 1) v += __shfl_xor(v, o);
    return v;
}
__device__ __forceinline__ float wave_max(float v) {
#pragma unroll
    for (int o = 1; o < 64; o <<= 1) v = fmaxf(v, __shfl_xor(v, o));
    return v;
}
#define LDS_WAIT() asm volatile("s_waitcnt lgkmcnt(0)" ::: "memory")
__device__ __forceinline__ int opaque_tid() { int t = threadIdx.x; asm volatile("" : "+v"(t)); return t; }
__device__ __forceinline__ float sigmoidf_(float z) { return __builtin_amdgcn_rcpf(1.f + __expf(-z)); }

__device__ __forceinline__ float block_sum(float v, float* red, int wave, int lane) {
    v = wave_sum(v); __syncthreads(); if (lane == 0) red[wave] = v; __syncthreads();
    float s = 0.f;
#pragma unroll
    for (int i = 0; i < NWAVES; ++i) s += red[i];
    return s;
}
__device__ __forceinline__ float block_max(float v, float* red, int wave, int lane) {
    v = wave_max(v); __syncthreads(); if (lane == 0) red[wave] = v; __syncthreads();
    float s = red[0];
#pragma unroll
    for (int i = 1; i < NWAVES; ++i) s = fmaxf(s, red[i]);
    return s;
}

template <int ID> __device__ __forceinline__ float wval(const Args& A, int n, int k) {
    if constexpr (ID == 0) {
        int col;
        if (n < 1280 || (n >= 1536 && n < 2112)) { const int hd = n >> 6, j = n & 63; col = (hd << 6) + (j >> 1) + ((j & 1) << 5); }
        else if (n < 2120) col = n; else return 0.f;
        return A.in[IN_WIN][(size_t)k * 2120 + col];
    } else if constexpr (ID == 1) { return A.in[IN_WO][(size_t)k * 1024 + n];
    } else if constexpr (ID == 2) { return A.in[IN_WUP][(size_t)k * 4096 + n] * A.in[IN_MLPN][k];
    } else if constexpr (ID == 3) { return A.in[IN_WDN][(size_t)k * 1024 + n];
    } else if constexpr (ID == 4) {
        if (n < 2048) return A.in[IN_WRKV][(size_t)(n >> 10) * 1048576 + (size_t)k * 1024 + (n & 1023)];
        const int j = n - 2048; const float* mu = A.in[IN_MU];
        if (j < 128) { const float m = mu[3 * 1024 + k], w = A.in[IN_W1][k * 64 + (j & 63)]; return (j < 64 ? 1.f - m : m) * w; }
        if (j < 256) { const float m = mu[4 * 1024 + k], w = A.in[IN_A1][k * 64 + (j & 63)]; return (j < 192 ? 1.f - m : m) * w; }
        if (j < 576) { const float m = mu[5 * 1024 + k]; const int jj = j - 256, c = jj < 160 ? jj : jj - 160; const float w = A.in[IN_G1][k * 160 + c]; return (jj < 160 ? 1.f - m : m) * w; }
        return 0.f;
    } else if constexpr (ID == 5) { return A.in[IN_WRKV][(size_t)2 * 1048576 + (size_t)k * 1024 + n];
    } else if constexpr (ID == 6) { return k < 64 ? A.in[IN_W2][(size_t)k * 1024 + n] : 0.f;
    } else if constexpr (ID == 7) { return k < 64 ? A.in[IN_A2][(size_t)k * 1024 + n] : 0.f;
    } else if constexpr (ID == 8) { return k < 160 ? A.in[IN_G2][(size_t)k * 1024 + n] : 0.f;
    } else if constexpr (ID == 9) { return A.in[IN_WO1][(size_t)k * 1024 + n];
    } else if constexpr (ID == 10) { return A.in[IN_WUP][(size_t)4194304 + (size_t)k * 4096 + n] * A.in[IN_MLPN][1024 + k];
    } else { return A.in[IN_WDN][(size_t)4194304 + (size_t)k * 1024 + n]; }
}
template <int ID> __device__ __forceinline__ void p0_weight(const Args& A, bf16_t* dst, int N, int K, float* scr, int gw, int NGW, int lane) {
    const int nblk = N / 32, nitems = (K / 64) * nblk;
    for (int it = gw; it < nitems; it += NGW) {
        const int kb = it / nblk, nb = it % nblk, k0 = 64 * kb, n0 = 32 * nb;
#pragma unroll 8
        for (int i = 0; i < 32; ++i) { const int kk = 2 * i + (lane >> 5); scr[kk * 33 + (lane & 31)] = wval<ID>(A, n0 + (lane & 31), k0 + kk); }
        LDS_WAIT();
        const int c = lane & 7;
#pragma unroll
        for (int j = 0; j < 4; ++j) { const int n = (lane >> 3) + 8 * j; const float* s = scr + (8 * c) * 33 + n;
            u32x4 o; o.x = pk2(s[0 * 33], s[1 * 33]); o.y = pk2(s[2 * 33], s[3 * 33]); o.z = pk2(s[4 * 33], s[5 * 33]); o.w = pk2(s[6 * 33], s[7 * 33]);
            *(u32x4*)(dst + (size_t)(n0 + n) * K + k0 + 8 * c) = o; }
        LDS_WAIT();
    }
}
__device__ __forceinline__ void rms_row_to_bf16(const float* xrow, const float* g, bf16_t* orow, int lane) {
    const f32x4* xr = (const f32x4*)xrow + lane; const f32x4* gr = (const f32x4*)g + lane;
    f32x4 v[4]; float s = 0.f;
#pragma unroll
    for (int j = 0; j < 4; ++j) { v[j] = xr[64 * j]; s += (v[j].x * v[j].x + v[j].y * v[j].y) + (v[j].z * v[j].z + v[j].w * v[j].w); }
    const float rs = rsqrtf(wave_sum(s) * (1.f / DM) + NORM_EPS);
    u32x2* o8 = (u32x2*)orow + lane;
#pragma unroll
    for (int j = 0; j < 4; ++j) { const f32x4 gg = gr[64 * j]; u32x2 w; w.x = pk2(v[j].x * rs * gg.x, v[j].y * rs * gg.y); w.y = pk2(v[j].z * rs * gg.z, v[j].w * rs * gg.w); o8[64 * j] = w; }
}
__device__ __forceinline__ void p0_prologue(const Args& A, unsigned char* lds) {
    const int tid = opaque_tid(), lane = tid & 63, wave = tid >> 6;
    float* scr = (float*)(lds + wave * 16384);
    const int gw = blockIdx.x * NWAVES + wave, NGW = gridDim.x * NWAVES;
    p0_weight<0>(A, WSP(bf16_t, OFF_WIN), 2304, 1024, scr, gw, NGW, lane);
    p0_weight<1>(A, WSP(bf16_t, OFF_WO0), 1024, 1024, scr, gw, NGW, lane);
    p0_weight<2>(A, WSP(bf16_t, OFF_WUP0), 4096, 1024, scr, gw, NGW, lane);
    p0_weight<3>(A, WSP(bf16_t, OFF_WDN0), 1024, 4096, scr, gw, NGW, lane);
    p0_weight<4>(A, WSP(bf16_t, OFF_WRK), 2816, 1024, scr, gw, NGW, lane);
    p0_weight<5>(A, WSP(bf16_t, OFF_WVL), 1024, 1024, scr, gw, NGW, lane);
    p0_weight<6>(A, WSP(bf16_t, OFF_W2T), 1024, 128, scr, gw, NGW, lane);
    p0_weight<7>(A, WSP(bf16_t, OFF_A2T), 1024, 128, scr, gw, NGW, lane);
    p0_weight<8>(A, WSP(bf16_t, OFF_G2T), 1024, 256, scr, gw, NGW, lane);
    if (!(DEFER_W && gridDim.x > BATCH * 16)) {
        p0_weight<9>(A, WSP(bf16_t, OFF_WO1), 1024, 1024, scr, gw, NGW, lane);
        p0_weight<10>(A, WSP(bf16_t, OFF_WUP1), 4096, 1024, scr, gw, NGW, lane);
        p0_weight<11>(A, WSP(bf16_t, OFF_WDN1), 1024, 4096, scr, gw, NGW, lane);
    }
    float* rc = WSP(float, OFF_ROPE); float* rsn = rc + 2048 * 32;
    for (int idx = blockIdx.x * NTHR + tid; idx < 2048 * 32; idx += gridDim.x * NTHR) {
        const int t = idx >> 5, d = idx & 31;
        double inv = 1.0; for (int i = 0; i < d; ++i) inv *= 0.74989420933245582730;
        const double ang = (double)t * inv;
        const double q = rint(ang * 0.63661977236758134308); const double r = (ang - q * 1.5707963267948966192) - q * 6.123233995736766036e-17;
        const double r2 = r * r;
        double sn = 1.0, cs = 1.0, ts = 1.0, tc = 1.0;
#pragma unroll
        for (int i = 1; i <= 9; ++i) { tc *= -r2 / (double)((2 * i - 1) * (2 * i)); ts *= -r2 / (double)((2 * i) * (2 * i + 1)); cs += tc; sn += ts; }
        sn *= r;
        const int qi = ((int)q) & 3;
        const double c = (qi == 0) ? cs : (qi == 1) ? -sn : (qi == 2) ? -cs : sn;
        const double s = (qi == 0) ? sn : (qi == 1) ? cs : (qi == 2) ? -sn : -cs;
        rc[idx] = (float)c; rsn[idx] = (float)s;
    }
    bf16_t* H0 = WSP(bf16_t, OFF_H0);
    for (int m = gw; m < MTOK; m += NGW) rms_row_to_bf16(A.in[IN_X] + (size_t)m * DM, A.in[IN_MIXN], H0 + (size_t)m * DM, lane);
}

struct Unit { int pm, pn; };
struct Gemm { const bf16_t* A; const bf16_t* A2; int pn2; const bf16_t* Bt; int M, N, K; const bf16_t* A3 = nullptr; int pn3 = 1 << 30; };
constexpr int NXCD = 8, WGM = 8;
struct StaticOrder {
    int nM, nN, nwg, G, c;
    __device__ void init(int M, int N, int G_, int c_) { nM = M / 256; nN = N / 256; nwg = nM * nN; G = G_; c = c_; }
    __device__ bool next(int i, Unit& u) const {
        const long L = (long)i * G + c; if (L >= nwg) return false;
        int wgid = (int)L; { const int q = nwg / NXCD, r = nwg % NXCD, xcd = wgid % NXCD, off = wgid / NXCD; wgid = (xcd < r ? xcd * (q + 1) : r * (q + 1) + (xcd - r) * q) + off; }
        const int nig = WGM * nN, gid = wgid / nig, fm = gid * WGM, gsz = (nM - fm) < WGM ? (nM - fm) : WGM;
        u.pm = fm + ((wgid % nig) % gsz); u.pn = (wgid % nig) / gsz; return true;
    }
};
typedef f32x4 AccT[2][2][4][2];

template <class Epi> __device__ __forceinline__ void gemm_naive(const Gemm g, const Epi& E) {
    const int tid = opaque_tid(), wave = tid >> 6, lane = tid & 63, wr = wave >> 2, wc = wave & 3, fr = lane & 15, fq = lane >> 4;
    StaticOrder S; S.init(g.M, g.N, gridDim.x, blockIdx.x);
    Unit u;
    for (int i = 0; S.next(i, u); ++i) {
        AccT acc;
#pragma unroll
        for (int a = 0; a < 2; ++a)
#pragma unroll
            for (int b = 0; b < 2; ++b)
#pragma unroll
                for (int m = 0; m < 4; ++m)
#pragma unroll
                    for (int n = 0; n < 2; ++n) acc[a][b][m][n] = (f32x4){0.f, 0.f, 0.f, 0.f};
        const bf16_t* Ab = (u.pn >= g.pn3 ? g.A3 : u.pn >= g.pn2 ? g.A2 : g.A) + (size_t)(u.pm * 256 + wr * 64 + fr) * g.K;
        const bf16_t* Bb = g.Bt + (size_t)(u.pn * 256 + wc * 32) * g.K;
        for (int k0 = 0; k0 < g.K; k0 += 8) {
            bf16x8 af[2][4];
#pragma unroll
            for (int ai = 0; ai < 2; ++ai)
#pragma unroll
                for (int m = 0; m < 4; ++m) af[ai][m] = *(const bf16x8*)(Ab + (size_t)(ai * 128 + m * 16) * g.K + k0);
#pragma unroll
            for (int bj = 0; bj < 2; ++bj)
#pragma unroll
                for (int n = 0; n < 2; ++n)
#pragma unroll
                    for (int c = 0; c < 4; ++c) {
                        const int col = bj * 128 + (Epi::PERM ? 8 * fq + 4 * n + c : 16 * n + 4 * fq + c);
                        const bf16x8 b = *(const bf16x8*)(Bb + (size_t)col * g.K + k0);
                        float bf[8];
#pragma unroll
                        for (int e = 0; e < 8; ++e) bf[e] = bf2f((bf16_t)b[e]);
#pragma unroll
                        for (int ai = 0; ai < 2; ++ai)
#pragma unroll
                            for (int m = 0; m < 4; ++m) { float s = acc[ai][bj][m][n][c];
#pragma unroll
                                for (int e = 0; e < 8; ++e) s += bf2f((bf16_t)af[ai][m][e]) * bf[e];
                                acc[ai][bj][m][n][c] = s; }
                        asm volatile("" ::: "memory");
                    }
        }
        E(acc, u, wr, wc, fr, fq);
    }
}

struct EpiInProj {
    static constexpr bool PERM = true;
    bf16_t *Q, *K, *V, *QI, *KI; float* WI; const float* rope;
    __device__ __forceinline__ void operator()(const AccT& acc, const Unit& u, int wr, int wc, int fr, int fq) const {
        const int pn = u.pn;
#pragma unroll
        for (int ai = 0; ai < 2; ++ai)
#pragma unroll
            for (int m = 0; m < 4; ++m) {
                const int row = u.pm * 256 + ai * 128 + wr * 64 + m * 16 + fr, t = row & (SEQ - 1);
#pragma unroll
                for (int bj = 0; bj < 2; ++bj) {
                    const int cl = bj * 128 + wc * 32 + fq * 8;
                    f32x4 v0 = acc[ai][bj][m][0], v1 = acc[ai][bj][m][1];
                    const bool rot = (pn <= 4) || pn == 6 || pn == 7 || (pn == 8 && cl < 64);
                    if (rot) {
                        const int d0 = (cl & 63) >> 1;
                        const f32x4 c = *(const f32x4*)(rope + t * 32 + d0), s = *(const f32x4*)(rope + 2048 * 32 + t * 32 + d0);
                        f32x4 a0, a1;
                        a0.x = v0.x * c.x - v0.y * s.x; a0.y = v0.y * c.x + v0.x * s.x;
                        a0.z = v0.z * c.y - v0.w * s.y; a0.w = v0.w * c.y + v0.z * s.y;
                        a1.x = v1.x * c.z - v1.y * s.z; a1.y = v1.y * c.z + v1.x * s.z;
                        a1.z = v1.z * c.w - v1.w * s.w; a1.w = v1.w * c.w + v1.z * s.w;
                        v0 = a0; v1 = a1;
                    }
                    if (pn < 4) { v0 = v0 * QSCALE; v1 = v1 * QSCALE; }
                    u32x4 w; w.x = pk2(v0.x, v0.y); w.y = pk2(v0.z, v0.w); w.z = pk2(v1.x, v1.y); w.w = pk2(v1.z, v1.w);
                    if (pn < 4) *(u32x4*)(Q + (size_t)row * 1024 + pn * 256 + cl) = w;
                    else if (pn == 4) *(u32x4*)(K + (size_t)row * 256 + cl) = w;
                    else if (pn == 5) *(u32x4*)(V + (size_t)row * 256 + cl) = w;
                    else if (pn < 8) *(u32x4*)(QI + (size_t)row * 512 + (pn - 6) * 256 + cl) = w;
                    else { if (cl < 64) *(u32x4*)(KI + (size_t)row * 64 + cl) = w;
                           else if (cl == 64) { *(f32x4*)(WI + (size_t)row * 8) = v0 * WI_SCALE; *(f32x4*)(WI + (size_t)row * 8 + 4) = v1 * WI_SCALE; } }
                }
            }
    }
};
struct EpiResid {
    static constexpr bool PERM = false;
    const float* xin; float* xout; bf16_t* xb; float* ssq;
    __device__ __forceinline__ void operator()(const AccT& acc, const Unit& u, int wr, int wc, int fr, int fq) const {
#pragma unroll
        for (int ai = 0; ai < 2; ++ai)
#pragma unroll
            for (int m = 0; m < 4; ++m) {
                const int row = u.pm * 256 + ai * 128 + wr * 64 + m * 16 + fr; float s = 0.f;
#pragma unroll
                for (int bj = 0; bj < 2; ++bj)
#pragma unroll
                    for (int n = 0; n < 2; ++n) {
                        const size_t off = (size_t)row * DM + u.pn * 256 + bj * 128 + wc * 32 + n * 16 + fq * 4;
                        const f32x4 x = *(const f32x4*)(xin + off) + acc[ai][bj][m][n];
                        *(f32x4*)(xout + off) = x;
                        if (xb) { u32x2 w; w.x = pk2(x.x, x.y); w.y = pk2(x.z, x.w); *(u32x2*)(xb + off) = w; }
                        s += (x.x * x.x + x.y * x.y) + (x.z * x.z + x.w * x.w);
                    }
                if (ssq) { s += __shfl_xor(s, 16); s += __shfl_xor(s, 32); if (fq == 0) atomicAdd(ssq + row, s); }
            }
    }
};
struct EpiUp {
    static constexpr bool PERM = true;
    bf16_t* U; const float* ssq;
    __device__ __forceinline__ void operator()(const AccT& acc, const Unit& u, int wr, int wc, int fr, int fq) const {
#pragma unroll
        for (int ai = 0; ai < 2; ++ai)
#pragma unroll
            for (int m = 0; m < 4; ++m) {
                const int row = u.pm * 256 + ai * 128 + wr * 64 + m * 16 + fr;
                const float rs = rsqrtf(ssq[row] * (1.f / DM) + NORM_EPS);
#pragma unroll
                for (int bj = 0; bj < 2; ++bj) {
                    f32x4 v0 = acc[ai][bj][m][0] * rs, v1 = acc[ai][bj][m][1] * rs;
#pragma unroll
                    for (int c = 0; c < 4; ++c) { const float a = fmaxf(v0[c], 0.f), b = fmaxf(v1[c], 0.f); v0[c] = a * a; v1[c] = b * b; }
                    u32x4 w; w.x = pk2(v0.x, v0.y); w.y = pk2(v0.z, v0.w); w.z = pk2(v1.x, v1.y); w.w = pk2(v1.z, v1.w);
                    *(u32x4*)(U + (size_t)row * FF + u.pn * 256 + bj * 128 + wc * 32 + fq * 8) = w;
                }
            }
    }
};
struct EpiStore {
    static constexpr bool PERM = true;
    bf16_t* b0; int ld0; int split; bf16_t* b1; int ld1;
    __device__ __forceinline__ void operator()(const AccT& acc, const Unit& u, int wr, int wc, int fr, int fq) const {
        bf16_t* base = u.pn < split ? b0 + u.pn * 256 : b1 + (u.pn - split) * 256; const int ld = u.pn < split ? ld0 : ld1; const int climit = u.pn < split ? (1 << 30) : ld1 - (u.pn - split) * 256;
#pragma unroll
        for (int ai = 0; ai < 2; ++ai)
#pragma unroll
            for (int m = 0; m < 4; ++m) {
                const int row = u.pm * 256 + ai * 128 + wr * 64 + m * 16 + fr;
#pragma unroll
                for (int bj = 0; bj < 2; ++bj) {
                    const f32x4 v0 = acc[ai][bj][m][0], v1 = acc[ai][bj][m][1];
                    u32x4 w; w.x = pk2(v0.x, v0.y); w.y = pk2(v0.z, v0.w); w.z = pk2(v1.x, v1.y); w.w = pk2(v1.z, v1.w);
                    if (bj * 128 + wc * 32 + fq * 8 < climit) *(u32x4*)(base + (size_t)row * ld + bj * 128 + wc * 32 + fq * 8) = w;
                }
            }
    }
};
struct EpiRKP { static constexpr bool PERM = true; EpiStore rk, p;
    __device__ __forceinline__ void operator()(const AccT& acc, const Unit& u, int wr, int wc, int fr, int fq) const { if (u.pn < 8) rk(acc, u, wr, wc, fr, fq); else { Unit v = u; v.pn -= 8; p(acc, v, wr, wc, fr, fq); } } };
struct EpiLoraUp {
    static constexpr bool PERM = true;
    bf16_t* E; bf16_t* AS; const float* w0; const float* a0;
    __device__ __forceinline__ void operator()(const AccT& acc, const Unit& u, int wr, int wc, int fr, int fq) const {
        const bool dec = u.pn < 4; bf16_t* O = dec ? E : AS; const float* bias = dec ? w0 : a0; const float sc = dec ? -0.6065306597126334f : 1.f;
#pragma unroll
        for (int bj = 0; bj < 2; ++bj) {
            const int col = (u.pn & 3) * 256 + bj * 128 + wc * 32 + fq * 8;
            const f32x4 b0 = *(const f32x4*)(bias + col), b1 = *(const f32x4*)(bias + col + 4);
#pragma unroll
            for (int ai = 0; ai < 2; ++ai)
#pragma unroll
                for (int m = 0; m < 4; ++m) {
                    const int row = u.pm * 256 + ai * 128 + wr * 64 + m * 16 + fr;
                    f32x4 v0 = acc[ai][bj][m][0] + b0, v1 = acc[ai][bj][m][1] + b1;
#pragma unroll
                    for (int c = 0; c < 4; ++c) { v0[c] = sc * sigmoidf_(v0[c]); v1[c] = sc * sigmoidf_(v1[c]); }
                    u32x4 w; w.x = pk2(v0.x, v0.y); w.y = pk2(v0.z, v0.w); w.z = pk2(v1.x, v1.y); w.w = pk2(v1.z, v1.w);
                    *(u32x4*)(O + (size_t)row * DM + col) = w;
                    asm volatile("" ::: "memory");
                }
        }
    }
};
struct EpiGatePost {
    static constexpr bool PERM = true;
    bf16_t* AO; const bf16_t* Y; const bf16_t* V; const float* stats; const float* bonus; const float* lnw; const float* lnb;
    __device__ __forceinline__ void operator()(const AccT& acc, const Unit& u, int wr, int wc, int fr, int fq) const {
#pragma unroll
        for (int bj = 0; bj < 2; ++bj) {
            const int col = u.pn * 256 + bj * 128 + wc * 32 + fq * 8, hd = col >> 6;
            const f32x4 w0 = *(const f32x4*)(lnw + col), w1 = *(const f32x4*)(lnw + col + 4), c0 = *(const f32x4*)(lnb + col), c1 = *(const f32x4*)(lnb + col + 4);
#pragma unroll
            for (int ai = 0; ai < 2; ++ai)
#pragma unroll
                for (int m = 0; m < 4; ++m) {
                    const int row = u.pm * 256 + ai * 128 + wr * 64 + m * 16 + fr;
                    const f32x4 st = *(const f32x4*)(stats + ((size_t)row * 16 + hd) * 4);
                    const float mean = (st.x + st.z) * (1.f / 64.f), var = fmaxf((st.y + st.w) * (1.f / 64.f) - mean * mean, 0.f), rstd = rsqrtf(var + LNX_EPS);
                    const float bo = bonus[(size_t)row * 16 + hd];
                    const bf16x8 yv = *(const bf16x8*)(Y + (size_t)row * DM + col), vv = *(const bf16x8*)(V + (size_t)row * DM + col);
                    const f32x4 g0 = acc[ai][bj][m][0], g1 = acc[ai][bj][m][1];
                    float o[8];
#pragma unroll
                    for (int c = 0; c < 4; ++c) {
                        o[c] = ((bf2f((bf16_t)yv[c]) - mean) * rstd * w0[c] + c0[c] + bo * bf2f((bf16_t)vv[c])) * g0[c];
                        o[4 + c] = ((bf2f((bf16_t)yv[4 + c]) - mean) * rstd * w1[c] + c1[c] + bo * bf2f((bf16_t)vv[4 + c])) * g1[c];
                    }
                    u32x4 w; w.x = pk2(o[0], o[1]); w.y = pk2(o[2], o[3]); w.z = pk2(o[4], o[5]); w.w = pk2(o[6], o[7]);
                    *(u32x4*)(AO + (size_t)row * DM + col) = w;
                }
        }
    }
};

#define PG8_LAS __attribute__((address_space(3)))
constexpr int BM = 256, BK = 64, HALF = 128, HTB = HALF * BK * 2  , STAGE_BYTES = 8 * HTB;
__host__ __device__ __forceinline__ int lds_byte(int r, int c) { const int st = (r >> 4) * 2 + (c >> 5), rr = r & 15, cc = c & 31, ob = rr * 64 + cc * 2; return st * 1024 + (ob ^ (((ob >> 9) & 1) << 5)); }
__host__ __device__ __forceinline__ void stage_rc(int b, int& R, int& C) { const int st = b / 1024, sb = b % 1024, swz = sb ^ (((sb >> 9) & 1) << 5); R = (st >> 1) * 16 + swz / 64; C = (st & 1) * 32 + (swz % 64) / 2; }
__host__ __device__ __forceinline__ int perm32(int rho) { const int n = rho >> 4, i = rho & 15; return 8 * (i >> 2) + 4 * n + (i & 3); }
template <class Epi, bool ALIGN_EPI = true, bool SP2 = true>
__device__ __forceinline__ void gemm_fast(PG8_LAS unsigned char* lds, const Gemm g, const Epi& E) {
    StaticOrder S; S.init(g.M, g.N, gridDim.x, blockIdx.x);
    const int tid = opaque_tid(), wid = __builtin_amdgcn_readfirstlane(tid >> 6), lane = tid & 63, wr = wid >> 2, wc = wid & 3, fr = lane & 15, fq = lane >> 4;
    int K_ = g.K; asm volatile("" : "+s"(K_));
    const int K = K_, nt = K / BK;
    unsigned voffA[2], voffB[2];
#pragma unroll
    for (int i = 0; i < 2; ++i) { int R, C; stage_rc(tid * 16 + i * 8192, R, C); const int Rb = Epi::PERM ? ((R & ~31) + perm32(R & 31)) : R;
        voffA[i] = (unsigned)(R * K + C) * 2u; voffB[i] = (unsigned)(Rb * K + C) * 2u; }
    const size_t kstep = (size_t)(BK * 2);
    const size_t hstep = (size_t)HALF * K * 2;
    const size_t tstep = 2 * hstep;
    const unsigned ldsw = (unsigned)wid * 1024u;
    const int aoff = lds_byte(wr * 64 + fr, fq * 8), boff = lds_byte(wc * 32 + fr, fq * 8);
#define PG8_SA(b, h) (((b) * 2 + (h)) * HTB)
#define PG8_SB(b, h) ((4 + (b) * 2 + (h)) * HTB)
#define PG8_STAGE(bufoff, gbase, voff) do { _Pragma("unroll") for (int _i = 0; _i < 2; ++_i) \
        __builtin_amdgcn_global_load_lds((const unsigned*)((const char*)(gbase) + (voff)[_i]), (PG8_LAS unsigned*)(lds + (bufoff) + ldsw + _i * 8192), 16, 0, 0); } while (0)
#define PG8_LDA(dst, b, h) do { _Pragma("unroll") for (int m = 0; m < 4; ++m) _Pragma("unroll") for (int k = 0; k < 2; ++k) dst[m][k] = *(const PG8_LAS bf16x8*)(lds + PG8_SA(b, h) + aoff + m * 2048 + k * 1024); } while (0)
#define PG8_LDB(dst, b, h) do { _Pragma("unroll") for (int n = 0; n < 2; ++n) _Pragma("unroll") for (int k = 0; k < 2; ++k) dst[n][k] = *(const PG8_LAS bf16x8*)(lds + PG8_SB(b, h) + boff + n * 2048 + k * 1024); } while (0)
#define PG8_MMA(ai, bj, At, Bt) do { __builtin_amdgcn_s_setprio(1); _Pragma("unroll") for (int m = 0; m < 4; ++m) _Pragma("unroll") for (int n = 0; n < 2; ++n) _Pragma("unroll") for (int k = 0; k < 2; ++k) \
        acc[ai][bj][m][n] = __builtin_amdgcn_mfma_f32_16x16x32_bf16(Bt[n][k], At[m][k], acc[ai][bj][m][n], 0, 0, 0); __builtin_amdgcn_s_setprio(0); } while (0)
#define PG8_WAIT_V(n) asm volatile("s_waitcnt vmcnt(" #n ")" ::: "memory")
#define PG8_WAIT_L(n) asm volatile("s_waitcnt lgkmcnt(" #n ")" ::: "memory")
#define PG8_BAR __builtin_amdgcn_s_barrier()
#define PG8_SCHED __builtin_amdgcn_sched_barrier(0)
    Unit cur, nxt; int ui = 0;
    if (!S.next(0, cur)) return;
    AccT acc;
#pragma unroll
    for (int a = 0; a < 2; ++a)
#pragma unroll
        for (int b = 0; b < 2; ++b)
#pragma unroll
            for (int m = 0; m < 4; ++m)
#pragma unroll
                for (int n = 0; n < 2; ++n) acc[a][b][m][n] = (f32x4){0.f, 0.f, 0.f, 0.f};
    bf16x8 At[4][2], B0[2][2], B1[2][2];
    const char* cA = (const char*)(cur.pn >= g.pn3 ? g.A3 : cur.pn >= g.pn2 ? g.A2 : g.A) + (size_t)cur.pm * tstep; const char* cB = (const char*)g.Bt + (size_t)cur.pn * tstep;
    if constexpr (SP2) {
        PG8_STAGE(PG8_SB(0, 0), cB, voffB); PG8_STAGE(PG8_SB(0, 1), cB + hstep, voffB); PG8_STAGE(PG8_SA(0, 0), cA, voffA); PG8_STAGE(PG8_SA(0, 1), cA + hstep, voffA);
        if (wr == 1) PG8_BAR;
        PG8_WAIT_V(2); PG8_BAR;
        PG8_STAGE(PG8_SB(1, 0), cB + kstep, voffB); PG8_STAGE(PG8_SA(1, 0), cA + kstep, voffA); PG8_STAGE(PG8_SB(1, 1), cB + hstep + kstep, voffB);
        PG8_WAIT_V(6); PG8_BAR;
    } else {
        PG8_STAGE(PG8_SB(0, 0), cB, voffB); PG8_STAGE(PG8_SA(0, 0), cA, voffA); PG8_STAGE(PG8_SB(0, 1), cB + hstep, voffB); PG8_STAGE(PG8_SA(0, 1), cA + hstep, voffA);
        if (wr == 1) PG8_BAR;
        PG8_WAIT_V(4); PG8_BAR;
        PG8_STAGE(PG8_SB(1, 0), cB + kstep, voffB); PG8_STAGE(PG8_SA(1, 0), cA + kstep, voffA); PG8_STAGE(PG8_SB(1, 1), cB + hstep + kstep, voffB);
        PG8_WAIT_V(6); PG8_BAR;
    }
    for (;;) {
        const bool has_next = S.next(ui + 1, nxt);
        const char* nA = has_next ? (const char*)(nxt.pn >= g.pn3 ? g.A3 : nxt.pn >= g.pn2 ? g.A2 : g.A) + (size_t)nxt.pm * tstep : cA; const char* nB = has_next ? (const char*)g.Bt + (size_t)nxt.pn * tstep : cB;
        for (int t = 0; t < nt; t += 2) {
            const bool last = (t == nt - 2);
            const char* a1 = cA + (size_t)(t + 1) * kstep;
            const char* a2 = last ? nA : cA + (size_t)(t + 2) * kstep; const char* b2 = last ? nB : cB + (size_t)(t + 2) * kstep;
            const char* a3 = a2 + kstep; const char* b3 = b2 + kstep;
            if constexpr (SP2) {
            PG8_LDB(B0, 0, 0); PG8_LDB(B1, 0, 1); PG8_SCHED; PG8_LDA(At, 0, 0); PG8_STAGE(PG8_SA(1, 1), a1 + hstep, voffA);
            PG8_WAIT_V(8); PG8_WAIT_L(0); PG8_BAR; PG8_MMA(0, 0, At, B0); PG8_MMA(0, 1, At, B1); PG8_BAR; PG8_SCHED;
            PG8_LDA(At, 0, 1); PG8_STAGE(PG8_SB(0, 0), b2, voffB); PG8_STAGE(PG8_SB(0, 1), b2 + hstep, voffB); PG8_STAGE(PG8_SA(0, 0), a2, voffA);
            PG8_WAIT_V(8); PG8_WAIT_L(0); PG8_BAR; PG8_MMA(1, 0, At, B0); PG8_MMA(1, 1, At, B1); PG8_BAR; PG8_SCHED;
            PG8_LDB(B0, 1, 0); PG8_LDB(B1, 1, 1); PG8_SCHED; PG8_LDA(At, 1, 0); PG8_STAGE(PG8_SA(0, 1), a2 + hstep, voffA);
            PG8_WAIT_V(8); PG8_WAIT_L(0); PG8_BAR; PG8_MMA(0, 0, At, B0); PG8_MMA(0, 1, At, B1); PG8_BAR; PG8_SCHED;
            PG8_LDA(At, 1, 1); PG8_STAGE(PG8_SB(1, 0), b3, voffB); PG8_STAGE(PG8_SB(1, 1), b3 + hstep, voffB); PG8_STAGE(PG8_SA(1, 0), a3, voffA);
            PG8_WAIT_V(8); PG8_WAIT_L(0); PG8_BAR; PG8_MMA(1, 0, At, B0); PG8_MMA(1, 1, At, B1); PG8_BAR; PG8_SCHED;
            } else {
            PG8_LDB(B0, 0, 0); PG8_SCHED; PG8_LDA(At, 0, 0); PG8_STAGE(PG8_SA(1, 1), a1 + hstep, voffA);
            PG8_WAIT_L(8); PG8_BAR; PG8_WAIT_L(0); PG8_MMA(0, 0, At, B0); PG8_BAR; PG8_SCHED;
            PG8_LDB(B1, 0, 1); PG8_STAGE(PG8_SB(0, 0), b2, voffB);
            PG8_BAR; PG8_WAIT_L(0); PG8_MMA(0, 1, At, B1); PG8_BAR;
            PG8_LDA(At, 0, 1); PG8_STAGE(PG8_SA(0, 0), a2, voffA);
            PG8_BAR; PG8_WAIT_L(0); PG8_MMA(1, 0, At, B0); PG8_BAR; PG8_SCHED;
            PG8_STAGE(PG8_SB(0, 1), b2 + hstep, voffB);
            PG8_WAIT_V(6); PG8_BAR; PG8_MMA(1, 1, At, B1); PG8_BAR;
            PG8_LDB(B0, 1, 0); PG8_SCHED; PG8_LDA(At, 1, 0); PG8_STAGE(PG8_SA(0, 1), a2 + hstep, voffA);
            PG8_WAIT_L(8); PG8_BAR; PG8_WAIT_L(0); PG8_MMA(0, 0, At, B0); PG8_BAR; PG8_SCHED;
            PG8_LDB(B1, 1, 1); PG8_STAGE(PG8_SB(1, 0), b3, voffB);
            PG8_BAR; PG8_WAIT_L(0); PG8_MMA(0, 1, At, B1); PG8_BAR;
            PG8_LDA(At, 1, 1); PG8_STAGE(PG8_SA(1, 0), a3, voffA);
            PG8_BAR; PG8_WAIT_L(0); PG8_MMA(1, 0, At, B0); PG8_BAR; PG8_SCHED;
            PG8_STAGE(PG8_SB(1, 1), b3 + hstep, voffB);
            PG8_WAIT_V(6); PG8_BAR; PG8_MMA(1, 1, At, B1); PG8_BAR;
            }
        }
        if constexpr (ALIGN_EPI) { if (wr == 0) PG8_BAR; }
        E(acc, cur, wr, wc, fr, fq);
        if (!has_next) break;
#pragma unroll
        for (int a = 0; a < 2; ++a)
#pragma unroll
            for (int b = 0; b < 2; ++b)
#pragma unroll
                for (int m = 0; m < 4; ++m)
#pragma unroll
                    for (int n = 0; n < 2; ++n) acc[a][b][m][n] = (f32x4){0.f, 0.f, 0.f, 0.f};
        cur = nxt; cA = nA; cB = nB; ++ui;
        if constexpr (ALIGN_EPI) { if (wr == 1) PG8_BAR; }
    }
    PG8_WAIT_V(0);
    if constexpr (!ALIGN_EPI) { if (wr == 0) PG8_BAR; }
    PG8_BAR;
#undef PG8_SA
#undef PG8_SB
#undef PG8_STAGE
#undef PG8_LDA
#undef PG8_LDB
#undef PG8_MMA
#undef PG8_WAIT_V
#undef PG8_WAIT_L
#undef PG8_BAR
#undef PG8_SCHED
}

template <class Epi> __device__ __forceinline__ void gemm_phase(unsigned char* lds, const Gemm g, const Epi& E) {
#if FAST_GEMM
    gemm_fast<Epi>((PG8_LAS unsigned char*)lds, g, E);
#else
    gemm_naive<Epi>(g, E);
#endif
}

__device__ __forceinline__ void p2_naive(const Args& A, unsigned char* lds, size_t mask_off = OFF_MASK) {
    const int tid = opaque_tid(), lane = tid & 63, wave = tid >> 6;
    float* sc = (float*)lds; float* qf = sc + 2048; float* wf = qf + 512;
    const bf16_t* QI = WSP(bf16_t, OFF_QI); const bf16_t* KI = WSP(bf16_t, OFF_KI); const float* WI = WSP(float, OFF_WI); unsigned* MASK = WSP(unsigned, mask_off);
    for (int m = blockIdx.x; m < MTOK; m += gridDim.x) {
        const int t = m & (SEQ - 1), b0 = m - t, nk = t + 1;
        unsigned* mrow = MASK + (size_t)m * 64;
        if (t < 256) { if (tid < 64) { const int lo = tid * 32; mrow[tid] = (nk >= lo + 32) ? 0xffffffffu : (nk <= lo ? 0u : ((1u << (nk - lo)) - 1u)); } continue; }
        __syncthreads();
        qf[tid] = bf2f(QI[(size_t)m * 512 + tid]);
        if (tid < 8) wf[tid] = WI[(size_t)m * 8 + tid];
        __syncthreads();
        for (int s = tid; s < nk; s += NTHR) {
            const bf16_t* kr = KI + (size_t)(b0 + s) * 64; float kf[64];
#pragma unroll
            for (int c = 0; c < 8; ++c) { const bf16x8 kv = *(const bf16x8*)(kr + 8 * c);
#pragma unroll
                for (int e = 0; e < 8; ++e) kf[8 * c + e] = bf2f((bf16_t)kv[e]); }
            float score = 0.f;
#pragma unroll
            for (int h = 0; h < 8; ++h) { float d = 0.f;
#pragma unroll
                for (int e = 0; e < 64; ++e) d += qf[h * 64 + e] * kf[e];
                score += wf[h] * fmaxf(d, 0.f); }
            sc[s] = score;
        }
        __syncthreads();
#pragma unroll 1
        for (int j = 0; j < 4; ++j) {
            const int base = 512 * j + 64 * wave;
            if (base >= nk) { if (lane < 2) mrow[(base >> 5) + lane] = 0u; continue; }
            const int s = base + lane; const bool valid = s < nk; const float my = valid ? sc[s] : 0.f; int cnt = 0;
            for (int s2 = 0; s2 < nk; ++s2) { const float o = sc[s2]; cnt += ((o > my) || (o == my && s2 < s)) ? 1 : 0; }
            const unsigned long long bal = __ballot(valid && cnt < 256);
            if (lane == 0) { mrow[base >> 5] = (unsigned)bal; mrow[(base >> 5) + 1] = (unsigned)(bal >> 32); }
        }
    }
}

__device__ __forceinline__ void p3_naive(const Args& A, unsigned char* lds) {
    const int tid = opaque_tid(), lane = tid & 63, wave = tid >> 6;
    float* lg = (float*)lds; float* qf = lg + 2048; float* red = qf + 1024; unsigned* mw = (unsigned*)(red + 1024);
    bf16_t* QO = WSP(bf16_t, OFF_QO); const bf16_t* K = WSP(bf16_t, OFF_K); const bf16_t* V = WSP(bf16_t, OFF_V); const unsigned* MASK = WSP(unsigned, OFF_MASK);
    for (int m = blockIdx.x; m < MTOK; m += gridDim.x) {
        const int t = m & (SEQ - 1), b0 = m - t, nk = t + 1;
        __syncthreads();
        qf[tid] = bf2f(QO[(size_t)m * 1024 + tid]); qf[tid + 512] = bf2f(QO[(size_t)m * 1024 + 512 + tid]);
        if (tid < 64) mw[tid] = MASK[(size_t)m * 64 + tid];
        __syncthreads();
#pragma unroll 1
        for (int hd = 0; hd < 16; ++hd) {
            const int n = hd >> 2; float mx = -INFINITY;
            for (int s = tid; s < nk; s += NTHR) {
                float v = -INFINITY;
                if ((mw[s >> 5] >> (s & 31)) & 1u) {
                    const bf16_t* kr = K + (size_t)(b0 + s) * 256 + n * 64; float d = 0.f;
#pragma unroll
                    for (int c = 0; c < 8; ++c) { const bf16x8 kv = *(const bf16x8*)(kr + 8 * c);
#pragma unroll
                        for (int e = 0; e < 8; ++e) d += qf[hd * 64 + 8 * c + e] * bf2f((bf16_t)kv[e]); }
                    v = d;
                }
                lg[s] = v; mx = fmaxf(mx, v);
            }
            mx = block_max(mx, red, wave, lane);
            float sm = 0.f;
            for (int s = tid; s < nk; s += NTHR) { const float p = exp2f(lg[s] - mx); lg[s] = p; sm += p; }
            sm = block_sum(sm, red, wave, lane);
            float acc = 0.f;
            for (int s = wave; s < nk; s += NWAVES) { const float p = lg[s]; if (p != 0.f) acc += p * bf2f(V[(size_t)(b0 + s) * 256 + n * 64 + lane]); }
            __syncthreads();
            red[16 + wave * 64 + lane] = acc;
            __syncthreads();
            if (tid < 64) { float o = 0.f;
#pragma unroll
                for (int p = 0; p < NWAVES; ++p) o += red[16 + p * 64 + tid];
                QO[(size_t)m * 1024 + hd * 64 + tid] = (bf16_t)f2bf(o / sm); }
            __syncthreads();
        }
    }
}

__device__ __forceinline__ void p7_prep(const Args& A) {
    const int tid = opaque_tid(), lane = tid & 63, wave = tid >> 6;
    const int gw = blockIdx.x * NWAVES + wave, NGW = gridDim.x * NWAVES;
    const float* X = A.out; const float* g = A.in[IN_MIXN] + DM; const float* mu = A.in[IN_MU];
    bf16_t* XSR = WSP(bf16_t, OFF_XSR); bf16_t* XSK = WSP(bf16_t, OFF_XSK); bf16_t* XSV = WSP(bf16_t, OFF_XSV); bf16_t* H1 = WSP(bf16_t, OFF_H1);
    f32x4 gg[4], mr[4], mk[4], mv[4];
#pragma unroll
    for (int j = 0; j < 4; ++j) { gg[j] = ((const f32x4*)g)[lane + 64 * j]; mr[j] = ((const f32x4*)mu)[lane + 64 * j]; mk[j] = ((const f32x4*)(mu + DM))[lane + 64 * j]; mv[j] = ((const f32x4*)(mu + 2 * DM))[lane + 64 * j]; }
    for (int run = gw; run < MTOK / 16; run += NGW) {
        const int r0 = run * 16; f32x4 hp[4];
#pragma unroll 1
        for (int i = -1; i < 16; ++i) {
            const int row = r0 + i; f32x4 h[4];
            if (i < 0 && (r0 & (SEQ - 1)) == 0) {
#pragma unroll
                for (int j = 0; j < 4; ++j) hp[j] = (f32x4){0.f, 0.f, 0.f, 0.f};
                continue;
            }
            const f32x4* xr = (const f32x4*)(X + (size_t)row * DM) + lane; float s = 0.f;
#pragma unroll
            for (int j = 0; j < 4; ++j) { h[j] = xr[64 * j]; s += (h[j].x * h[j].x + h[j].y * h[j].y) + (h[j].z * h[j].z + h[j].w * h[j].w); }
            const float rs = rsqrtf(wave_sum(s) * (1.f / DM) + NORM_EPS);
#pragma unroll
            for (int j = 0; j < 4; ++j) h[j] = h[j] * rs * gg[j];
            if (i >= 0) {
#pragma unroll
                for (int j = 0; j < 4; ++j) {
                    const f32x4 xx = hp[j] - h[j];
                    const f32x4 a = h[j] + xx * mr[j], b = h[j] + xx * mk[j], c = h[j] + xx * mv[j];
                    const size_t off = (size_t)row * DM + 4 * lane + 256 * j;
                    u32x2 w; w.x = pk2(a.x, a.y); w.y = pk2(a.z, a.w); *(u32x2*)(XSR + off) = w;
                    w.x = pk2(b.x, b.y); w.y = pk2(b.z, b.w); *(u32x2*)(XSK + off) = w;
                    w.x = pk2(c.x, c.y); w.y = pk2(c.z, c.w); *(u32x2*)(XSV + off) = w;
                    w.x = pk2(h[j].x, h[j].y); w.y = pk2(h[j].z, h[j].w); *(u32x2*)(H1 + off) = w;
                }
            }
#pragma unroll
            for (int j = 0; j < 4; ++j) hp[j] = h[j];
        }
    }
}
__device__ __forceinline__ void p10_loramid(const Args& A) {
    const bf16_t* P = WSP(bf16_t, OFF_P); bf16_t* AW = WSP(bf16_t, OFF_AW); bf16_t* AA = WSP(bf16_t, OFF_AA); bf16_t* AG = WSP(bf16_t, OFF_AG);
    const size_t total = (size_t)MTOK * 512;
    for (size_t idx = (size_t)blockIdx.x * NTHR + threadIdx.x; idx < total; idx += (size_t)gridDim.x * NTHR) {
        const int m = (int)(idx >> 9), j = (int)(idx & 511); const bool first = (m & (SEQ - 1)) == 0;
        const bf16_t* p0 = P + (size_t)m * P_LD; const bf16_t* pm = p0 - P_LD;
        if (j < 128) {
            float v = 0.f; if (j < 64) { const float x = bf2f(p0[j]) + (first ? 0.f : bf2f(pm[64 + j])); const float e = __expf(-2.f * fabsf(x)); const float th = (1.f - e) / (1.f + e); v = x < 0.f ? -th : th; }
            AW[(size_t)m * 128 + j] = (bf16_t)f2bf(v);
        } else if (j < 256) {
            const int jj = j - 128; float v = 0.f; if (jj < 64) v = bf2f(p0[128 + jj]) + (first ? 0.f : bf2f(pm[192 + jj]));
            AA[(size_t)m * 128 + jj] = (bf16_t)f2bf(v);
        } else {
            const int jj = j - 256; float v = 0.f; if (jj < 160) { const float x = bf2f(p0[256 + jj]) + (first ? 0.f : bf2f(pm[416 + jj])); v = sigmoidf_(x); }
            AG[(size_t)m * 256 + jj] = (bf16_t)f2bf(v);
        }
    }
}
__device__ __forceinline__ void p12_naive(const Args& A, unsigned char* lds) {
    const int tid = opaque_tid(), lane = tid & 63, wave = tid >> 6;
    const int gw = blockIdx.x * NWAVES + wave, NGW = gridDim.x * NWAVES;
    float* sh = (float*)lds + wave * 320;
    const bf16_t* R = WSP(bf16_t, OFF_R); const bf16_t* KR = WSP(bf16_t, OFF_KR); const bf16_t* VV = WSP(bf16_t, OFF_VV); const bf16_t* E = WSP(bf16_t, OFF_E); const bf16_t* AS = WSP(bf16_t, OFF_A);
    bf16_t* Y = WSP(bf16_t, OFF_Y);
    for (int it = gw; it < BATCH * 16; it += NGW) {
        const int b = it >> 4, h = it & 15;
        float S[64];
#pragma unroll
        for (int j = 0; j < 64; ++j) S[j] = 0.f;
        const float kkw = A.in[IN_KK][h * 64 + lane], kaw = A.in[IN_KA][h * 64 + lane];
        const size_t base = (size_t)b * SEQ * DM + h * 64 + lane;
        bf16_t rn = R[base], kn = KR[base], vn = VV[base], en = E[base], an = AS[base];
#pragma unroll 1
        for (int t = 0; t < SEQ; ++t) {
            const float r = bf2f(rn), k = bf2f(kn), v = bf2f(vn), e = bf2f(en), a = bf2f(an);
            if (t + 1 < SEQ) { const size_t ix = base + (size_t)(t + 1) * DM; rn = R[ix]; kn = KR[ix]; vn = VV[ix]; en = E[ix]; an = AS[ix]; }
            float kk = k * kkw; const float ss = wave_sum(kk * kk); kk *= rsqrtf(fmaxf(ss, 1e-24f));
            const float kt = k * (1.f + (a - 1.f) * kaw), bb = kk * a, w = __expf(e);
            sh[lane] = -kk; sh[64 + lane] = w; sh[128 + lane] = bb; sh[192 + lane] = kt; sh[256 + lane] = r;
            LDS_WAIT();
            float sa = 0.f;
#pragma unroll
            for (int j = 0; j < 64; ++j) sa += S[j] * sh[j];
            float y = 0.f;
#pragma unroll
            for (int j = 0; j < 64; ++j) { S[j] = S[j] * sh[64 + j] + sa * sh[128 + j] + v * sh[192 + j]; y += S[j] * sh[256 + j]; }
            Y[base + (size_t)t * DM] = (bf16_t)f2bf(y);
            LDS_WAIT();
        }
    }
}
__device__ __forceinline__ void p12b_stats(const Args& A) {
    const int tid = opaque_tid(), lane = tid & 63, wave = tid >> 6;
    const int gw = blockIdx.x * NWAVES + wave, NGW = gridDim.x * NWAVES;
    const bf16_t* R = WSP(bf16_t, OFF_R); const bf16_t* KR = WSP(bf16_t, OFF_KR); const bf16_t* AS = WSP(bf16_t, OFF_A); const bf16_t* Y = WSP(bf16_t, OFF_Y);
    float* ST = WSP(float, OFF_STATS); float* BO = WSP(float, OFF_BONUS);
    for (int it = gw; it < MTOK * 16; it += NGW) {
        const int h = it & 15; const size_t ix = (size_t)(it >> 4) * DM + h * 64 + lane;
        const float y = bf2f(Y[ix]), r = bf2f(R[ix]), k = bf2f(KR[ix]), a = bf2f(AS[ix]);
        const float kt = k * (1.f + (a - 1.f) * A.in[IN_KA][h * 64 + lane]);
        const float s1 = wave_sum(y), s2 = wave_sum(y * y), bo = wave_sum(r * kt * A.in[IN_RK][h * 64 + lane]);
        if (lane == 0) { *(f32x4*)(ST + (size_t)it * 4) = (f32x4){s1, s2, 0.f, 0.f}; BO[it] = bo; }
    }
}

template <int CTRL> __device__ __forceinline__ float dppf(float v) { return __int_as_float(__builtin_amdgcn_mov_dpp(__float_as_int(v), CTRL, 0xF, 0xF, false)); }
template <int CTRL> __device__ __forceinline__ int dppi(int v) { return __builtin_amdgcn_mov_dpp(v, CTRL, 0xF, 0xF, false); }
__device__ __forceinline__ float row16_allsum(float v) { v += dppf<0xB1>(v); v += dppf<0x4E>(v); v += dppf<0x124>(v); v += dppf<0x128>(v); return v; }
__device__ __forceinline__ float ffma_s(float a, float b, float c) { float r; asm("v_fma_f32 %0, %1, %2, %3" : "=v"(r) : "v"(a), "v"(b), "v"(c)); return r; }
__device__ __forceinline__ float fmul_s(float a, float b) { float r; asm("v_mul_f32_e32 %0, %1, %2" : "=v"(r) : "v"(a), "v"(b)); return r; }
__device__ __forceinline__ float row16_allsum_fused(float v) {
    float a, b, c, d;
    asm("s_nop 1\n\tv_add_f32_dpp %0, %1, %1 quad_perm:[1,0,3,2] row_mask:0xf bank_mask:0xf" : "=v"(a) : "v"(v));
    asm("s_nop 1\n\tv_add_f32_dpp %0, %1, %1 quad_perm:[2,3,0,1] row_mask:0xf bank_mask:0xf" : "=v"(b) : "v"(a));
    asm("s_nop 1\n\tv_add_f32_dpp %0, %1, %1 row_ror:4 row_mask:0xf bank_mask:0xf" : "=v"(c) : "v"(b));
    asm("s_nop 1\n\tv_add_f32_dpp %0, %1, %1 row_ror:8 row_mask:0xf bank_mask:0xf" : "=v"(d) : "v"(c));
    return d;
}
__device__ __forceinline__ int row16_allsum_i(int v) { v += dppi<0xB1>(v); v += dppi<0x4E>(v); v += dppi<0x124>(v); v += dppi<0x128>(v); return v; }
__device__ __forceinline__ int wave_allsum_i(int v) {
    v = row16_allsum_i(v);
    return __builtin_amdgcn_readlane(v, 0) + __builtin_amdgcn_readlane(v, 16) + __builtin_amdgcn_readlane(v, 32) + __builtin_amdgcn_readlane(v, 48);
}

constexpr int P2_LD = 2052;
template <int MODE = 0> __device__ __forceinline__ void p2_fast(const Args& A, unsigned char* lds) {
    const int tid = opaque_tid(), lane = tid & 63, wave = __builtin_amdgcn_readfirstlane(tid >> 6), fr = lane & 15, fq = lane >> 4;
    float* sc = (float*)lds;
    const bf16_t* QI = WSP(bf16_t, OFF_QI); const bf16_t* KI = WSP(bf16_t, OFF_KI); const float* WI = WSP(float, OFF_WI); unsigned* MASK = WSP(unsigned, MODE == 0 ? OFF_MASK : 160 * MiB);
    for (int it = blockIdx.x; it < 1024; it += gridDim.x) {
        const int q = it >> 8, c = it & 255, b = c & 7, s5 = c >> 3;
        const int tt = (q == 0) ? s5 : (q == 1) ? 63 - s5 : (q == 2) ? 64 + s5 : 127 - s5;
        const int t0 = 16 * tt, m0 = b * SEQ + t0;
        if (t0 >= 256 - 15) {
            bf16x8 qf[8][2]; float wv[8];
#pragma unroll
            for (int h = 0; h < 8; ++h) {
#pragma unroll
                for (int ks = 0; ks < 2; ++ks) qf[h][ks] = *(const bf16x8*)(QI + (size_t)(m0 + fr) * 512 + h * 64 + ks * 32 + fq * 8);
                wv[h] = WI[(size_t)(m0 + fr) * 8 + h];
            }
            const bf16_t* kbase = KI + (size_t)(b * SEQ + fr) * 64 + fq * 8;
            bf16x8 ka0 = *(const bf16x8*)(kbase + (size_t)wave * 16 * 64), ka1 = *(const bf16x8*)(kbase + (size_t)wave * 16 * 64 + 32);
#pragma unroll 1
            for (int kt = wave; kt <= tt; kt += NWAVES) {
                const bf16x8 a0 = ka0, a1 = ka1;
                if (kt + NWAVES <= tt) { ka0 = *(const bf16x8*)(kbase + (size_t)(kt + NWAVES) * 16 * 64); ka1 = *(const bf16x8*)(kbase + (size_t)(kt + NWAVES) * 16 * 64 + 32); }
                f32x4 acc = {0.f, 0.f, 0.f, 0.f};
#pragma unroll
                for (int h = 0; h < 8; ++h) {
                    f32x4 d = __builtin_amdgcn_mfma_f32_16x16x32_bf16(a0, qf[h][0], (f32x4){0.f, 0.f, 0.f, 0.f}, 0, 0, 0);
                    d = __builtin_amdgcn_mfma_f32_16x16x32_bf16(a1, qf[h][1], d, 0, 0, 0);
#pragma unroll
                    for (int e = 0; e < 4; ++e) acc[e] += wv[h] * fmaxf(d[e], 0.f);
                }
                *(f32x4*)(sc + fr * P2_LD + kt * 16 + 4 * fq) = acc;
            }
        }
        __syncthreads();
#pragma unroll 1
        for (int rr = 2 * wave; rr < 2 * wave + (MODE == 1 ? 0 : 2); ++rr) {
            const int t = t0 + rr, nk = t + 1;
            unsigned long long* mrow = (unsigned long long*)(MASK + (size_t)(m0 + rr) * 64);
            if (t < 256) {
                if (lane < 32) { const int lo = lane * 64; mrow[lane] = (nk >= lo + 64) ? ~0ull : (nk <= lo ? 0ull : ((1ull << (nk - lo)) - 1ull)); }
                continue;
            }
            const int nj = (nk + 63) >> 6;
            float x[32];
            const float* srow = sc + rr * P2_LD + lane;
#pragma unroll
            for (int j = 0; j < 32; ++j) x[j] = srow[64 * j];
            float mx = -INFINITY, mn = INFINITY;
#pragma unroll
            for (int j = 0; j < 32; ++j) { const bool ok = lane + 64 * j < nk; mn = fminf(mn, ok ? x[j] : INFINITY); x[j] = ok ? x[j] : -INFINITY; mx = fmaxf(mx, x[j]); }
            mx = wave_max(mx); mn = -wave_max(-mn);
            mx = __int_as_float(__builtin_amdgcn_readfirstlane(__float_as_int(mx))); mn = __int_as_float(__builtin_amdgcn_readfirstlane(__float_as_int(mn)));
#define P2_COUNT_GE(thr, out) do { int c_ = 0; const float th_ = (thr);     \
                _Pragma("unroll") for (int g_ = 0; g_ < 4; ++g_) if (nj > 8 * g_) { unsigned long long m_[8]; \
                    asm("v_cmp_ge_f32_e64 %0, %8, %16\n\tv_cmp_ge_f32_e64 %1, %9, %16\n\tv_cmp_ge_f32_e64 %2, %10, %16\n\tv_cmp_ge_f32_e64 %3, %11, %16\n\tv_cmp_ge_f32_e64 %4, %12, %16\n\tv_cmp_ge_f32_e64 %5, %13, %16\n\tv_cmp_ge_f32_e64 %6, %14, %16\n\tv_cmp_ge_f32_e64 %7, %15, %16" \
                        : "=&s"(m_[0]), "=&s"(m_[1]), "=&s"(m_[2]), "=&s"(m_[3]), "=&s"(m_[4]), "=&s"(m_[5]), "=&s"(m_[6]), "=&s"(m_[7]) \
                        : "v"(x[8 * g_]), "v"(x[8 * g_ + 1]), "v"(x[8 * g_ + 2]), "v"(x[8 * g_ + 3]), "v"(x[8 * g_ + 4]), "v"(x[8 * g_ + 5]), "v"(x[8 * g_ + 6]), "v"(x[8 * g_ + 7]), "v"(th_)); \
                    _Pragma("unroll") for (int j_ = 0; j_ < 8; ++j_) c_ += __popcll(m_[j_]); } \
                (out) = c_; } while (0)
            float lo = mn, hi = mx, thr = 0.f; int c_hi; bool exact = false;
            P2_COUNT_GE(mx, c_hi);
            if (c_hi >= 256) { lo = mx; c_hi = 0; }
            else {
#pragma unroll 1
                for (int iter_ = 0;; ++iter_) {
                    if (MODE == 3 && iter_ >= 6) break;
                    const float mid = lo + (hi - lo) * 0.5f;
                    if (!(mid > lo && mid < hi)) break;
                    int cm; P2_COUNT_GE(mid, cm);
                    if (cm == 256) { exact = true; thr = mid; break; }
                    if (cm > 256) lo = mid; else { hi = mid; c_hi = cm; }
                }
            }
            unsigned long long mine = 0ull;
            if (exact) {
#pragma unroll
                for (int j = 0; j < 32; ++j) { const unsigned long long bal = __ballot(x[j] >= thr); if (lane == j) mine = bal; }
            } else {
                int need = 256 - c_hi;
#pragma unroll
                for (int j = 0; j < 32; ++j) {
                    const bool eq = (x[j] == lo); const unsigned long long beq = __ballot(eq);
                    const int pre = __builtin_amdgcn_mbcnt_hi((unsigned)(beq >> 32), __builtin_amdgcn_mbcnt_lo((unsigned)beq, 0));
                    const unsigned long long bal = __ballot((x[j] > lo) || (eq && pre < need));
                    need -= __popcll(beq); need = need < 0 ? 0 : need;
                    if (lane == j) mine = bal;
                }
            }
            if (lane < 32) mrow[lane] = mine;
#undef P2_COUNT_GE
        }
        __syncthreads();
    }
}

constexpr int SC_TC = 32, SC_BUF_F = 5 * SC_TC * 64 + SC_TC * 32;
__device__ __forceinline__ void p12_fast(const Args& A, unsigned char* lds) {
    const int tid = opaque_tid(), lane = tid & 63, wave = __builtin_amdgcn_readfirstlane(tid >> 6);
    const int kq = lane & 15, row = 4 * wave + (lane >> 4), tl = tid >> 4;
    float* fl = (float*)lds; float* ybuf = fl + 2 * SC_BUF_F;
    const bf16_t* R = WSP(bf16_t, OFF_R); const bf16_t* KR = WSP(bf16_t, OFF_KR); const bf16_t* VV = WSP(bf16_t, OFF_VV); const bf16_t* E = WSP(bf16_t, OFF_E); const bf16_t* AS = WSP(bf16_t, OFF_A);
    bf16_t* Y = WSP(bf16_t, OFF_Y); float* ST = WSP(float, OFF_STATS); float* BO = WSP(float, OFF_BONUS);
    for (int it = blockIdx.x; it < BATCH * 16 * 2; it += gridDim.x) {
        const int half = it & 1, h = (it >> 1) & 15, b = it >> 5;
        const f32x4 kkw = *(const f32x4*)(A.in[IN_KK] + h * 64 + 4 * kq), kaw = *(const f32x4*)(A.in[IN_KA] + h * 64 + 4 * kq), rkw = *(const f32x4*)(A.in[IN_RK] + h * 64 + 4 * kq);
        const size_t gbase = ((size_t)b * SEQ + tl) * DM + h * 64 + 4 * kq;
        u32x2 pr, pk, pv, pe, pa;
#define SC_PREFETCH(c) do { const size_t gi_ = gbase + (size_t)(c) * SC_TC * DM; pr = *(const u32x2*)(R + gi_); pk = *(const u32x2*)(KR + gi_); pv = *(const u32x2*)(VV + gi_); pe = *(const u32x2*)(E + gi_); pa = *(const u32x2*)(AS + gi_); } while (0)
#define SC_UNPK(p, o) do { o[0] = __uint_as_float(p.x << 16); o[1] = __uint_as_float(p.x & 0xffff0000u); o[2] = __uint_as_float(p.y << 16); o[3] = __uint_as_float(p.y & 0xffff0000u); } while (0)
#define SC_DERIVE(c) do { float* bf_ = fl + ((c) & 1) * SC_BUF_F; float r_[4], k_[4], v_[4], e_[4], a_[4]; SC_UNPK(pr, r_); SC_UNPK(pk, k_); SC_UNPK(pv, v_); SC_UNPK(pe, e_); SC_UNPK(pa, a_); \
            f32x4 kkv_, w_, n_, b_, kt_, rr_; float ss_ = 0.f, bo_ = 0.f; \
            _Pragma("unroll") for (int i_ = 0; i_ < 4; ++i_) { kkv_[i_] = k_[i_] * kkw[i_]; ss_ += kkv_[i_] * kkv_[i_]; } \
            ss_ = row16_allsum(ss_); const float inv_ = rsqrtf(fmaxf(ss_, 1e-24f)); \
            _Pragma("unroll") for (int i_ = 0; i_ < 4; ++i_) { n_[i_] = -kkv_[i_] * inv_; b_[i_] = -n_[i_] * a_[i_]; kt_[i_] = k_[i_] * (1.f + (a_[i_] - 1.f) * kaw[i_]); w_[i_] = __expf(e_[i_]); rr_[i_] = r_[i_]; bo_ += r_[i_] * kt_[i_] * rkw[i_]; } \
            bo_ = row16_allsum(bo_); \
            if (half == 0 && kq == 0) BO[((size_t)b * SEQ + (c) * SC_TC + tl) * 16 + h] = bo_; \
            float* d_ = bf_ + tl * 64 + 4 * kq; *(f32x4*)(d_) = w_; *(f32x4*)(d_ + 2048) = n_; *(f32x4*)(d_ + 4096) = b_; *(f32x4*)(d_ + 6144) = kt_; *(f32x4*)(d_ + 8192) = rr_; \
            if ((kq >> 3) == half) *(f32x4*)(bf_ + 10240 + tl * 32 + 4 * (kq & 7)) = (f32x4){v_[0], v_[1], v_[2], v_[3]}; } while (0)
        __syncthreads();
        SC_PREFETCH(0); SC_DERIVE(0);
        __syncthreads();
        float S0 = 0.f, S1 = 0.f, S2 = 0.f, S3 = 0.f;
#pragma unroll 1
        for (int c = 0; c < SEQ / SC_TC; ++c) {
            if (c + 1 < SEQ / SC_TC) SC_PREFETCH(c + 1);
            const float* bf = fl + (c & 1) * SC_BUF_F + 4 * kq; const float* vb = fl + (c & 1) * SC_BUF_F + 10240 + row; float* yb = ybuf + (c & 1) * 1024 + row;
#define SC_LOAD(P, tt_) do { P##w = *(const f32x4*)(bf + (tt_) * 64); P##n = *(const f32x4*)(bf + (tt_) * 64 + 2048); P##b = *(const f32x4*)(bf + (tt_) * 64 + 4096); P##k = *(const f32x4*)(bf + (tt_) * 64 + 6144); P##r = *(const f32x4*)(bf + (tt_) * 64 + 8192); P##v = vb[(tt_) * 32]; } while (0)
#define SC_STEP(P, tt_) do { \
                float p_ = fmul_s(S0, P##n.x); p_ = ffma_s(S1, P##n.y, p_); p_ = ffma_s(S2, P##n.z, p_); p_ = ffma_s(S3, P##n.w, p_); \
                float t0_ = fmul_s(S0, P##w.x), t1_ = fmul_s(S1, P##w.y), t2_ = fmul_s(S2, P##w.z), t3_ = fmul_s(S3, P##w.w); \
                t0_ = ffma_s(P##v, P##k.x, t0_); t1_ = ffma_s(P##v, P##k.y, t1_); t2_ = ffma_s(P##v, P##k.z, t2_); t3_ = ffma_s(P##v, P##k.w, t3_); \
                const float sa_ = row16_allsum_fused(p_); \
                S0 = ffma_s(sa_, P##b.x, t0_); S1 = ffma_s(sa_, P##b.y, t1_); S2 = ffma_s(sa_, P##b.z, t2_); S3 = ffma_s(sa_, P##b.w, t3_); \
                float qy_ = fmul_s(S0, P##r.x); qy_ = ffma_s(S1, P##r.y, qy_); qy_ = ffma_s(S2, P##r.z, qy_); qy_ = ffma_s(S3, P##r.w, qy_); \
                const float y_ = row16_allsum_fused(qy_); \
                if (kq == 0) yb[(tt_) * 32] = y_; } while (0)
            f32x4 Aw, An, Ab, Ak, Ar, Bw, Bn, Bb, Bk, Br; float Av, Bv;
            SC_LOAD(A, 0);
#pragma unroll 1
            for (int tt = 0; tt < SC_TC; tt += 2) {
                SC_LOAD(B, tt + 1);
                SC_STEP(A, tt);
                if (tt + 2 < SC_TC) SC_LOAD(A, tt + 2);
                SC_STEP(B, tt + 1);
            }
#undef SC_LOAD
#undef SC_STEP
            if (c + 1 < SEQ / SC_TC) SC_DERIVE(c + 1);
            __syncthreads();
            {
                const int j = tid & 15; const float* ys = ybuf + (c & 1) * 1024 + tl * 32 + 2 * j;
                const float y0 = ys[0], y1 = ys[1];
                const float s1 = row16_allsum(y0 + y1), s2 = row16_allsum(y0 * y0 + y1 * y1);
                const size_t m = (size_t)b * SEQ + c * SC_TC + tl;
                *(unsigned*)(Y + m * DM + h * 64 + 32 * half + 2 * j) = pk2(y0, y1);
                if (j == 0) *(f32x2*)(ST + (m * 16 + h) * 4 + 2 * half) = (f32x2){s1, s2};
            }
        }
#undef SC_PREFETCH
#undef SC_UNPK
#undef SC_DERIVE
    }
}

namespace attn_body {
using bf16=__hip_bfloat16;
using bf16x8=__attribute__((ext_vector_type(8)))short;
using s16x4=__attribute__((ext_vector_type(4)))short;
using f32x16=__attribute__((ext_vector_type(16)))float;
using u32x4=__attribute__((ext_vector_type(4)))unsigned;
constexpr int BATCH=8,NHEAD=16,SEQ=2048,D=64,DM=NHEAD*D,KP=256;
constexpr int NW=8,QBLK=32,QB=QBLK*NW,KVBLK=64,NQB=SEQ/QB;
constexpr int ATTN_PITCH=DM, ATTN_UNIT_ROWS=QB;
__device__ __forceinline__ int crow(int r,int hi){return (r&3)+8*(r>>2)+4*hi;}
#define SBAR() __builtin_amdgcn_sched_barrier(0)
__device__ __forceinline__ void bmask(f32x16&p0,f32x16&p1,unsigned long long mw,int hi){
  const unsigned lo=(unsigned)mw>>(4*hi), hw=(unsigned)(mw>>32)>>(4*hi);
  #pragma unroll
  for(int r=0;r<16;++r){const int c=(r&3)+8*(r>>2); const int m0=__builtin_amdgcn_sbfe((int)lo,c,1), m1=__builtin_amdgcn_sbfe((int)hw,c,1);
    p0[r]=__int_as_float((__float_as_int(p0[r])&m0)|((int)0xff800000&~m0)); p1[r]=__int_as_float((__float_as_int(p1[r])&m1)|((int)0xff800000&~m1));}
}

constexpr int NSLOT=3, SLOTB=8192;
constexpr int LDS_K=0, LDS_V=NSLOT*SLOTB, LDS_WS=2*NSLOT*SLOTB, LDS_OST=LDS_WS+NW*64*4, LDS_MSK=LDS_OST+NW*4096, LDS_BYTES=LDS_MSK+64*256;
constexpr float C2=0.125f*1.4426950408889634f;
__device__ __forceinline__ void glds16(const void*gsrc,unsigned lds_dst){unsigned keep;
  asm volatile("s_mov_b32 %0, m0\n\ts_mov_b32 m0, %2\n\ts_nop 0\n\tglobal_load_lds_dwordx4 %1, off\n\ts_mov_b32 m0, %0":"=&s"(keep):"v"(gsrc),"s"(lds_dst):"memory");}
__device__ __forceinline__ float max3f(float a,float b,float c){float r;asm("v_max3_f32 %0, %1, %2, %3":"=v"(r):"v"(a),"v"(b),"v"(c));return r;}
__device__ __forceinline__ float max2f(float a,float b){float r;asm("v_max_f32_e32 %0, %1, %2":"=v"(r):"v"(a),"v"(b));return r;}
__device__ __forceinline__ float fadd_s(float a,float b){float r;asm("v_add_f32_e32 %0, %1, %2":"=v"(r):"v"(a),"v"(b));return r;}
__device__ __forceinline__ float fsub_s(float a,float b){float r;asm("v_sub_f32_e32 %0, %1, %2":"=v"(r):"v"(a),"v"(b));return r;}
typedef float f32x2_t __attribute__((ext_vector_type(2))); typedef __bf16 bf16x2_t __attribute__((ext_vector_type(2)));
__device__ __forceinline__ unsigned cvtpk_s(float lo,float hi){f32x2_t v={lo,hi};bf16x2_t b=__builtin_convertvector(v,bf16x2_t);return __builtin_bit_cast(unsigned,b);}
#define WAIT_BAR(N) asm volatile("s_waitcnt vmcnt(" #N ") lgkmcnt(0)\n\ts_barrier":::"memory")

__device__ __forceinline__ void qkt(f32x16&p0,f32x16&p1,const char*Kslot,const bf16x8*qr,const f32x16&negm,int r32,int hi){
  const char*kb=Kslot+hi*1024+r32*16;
  #pragma unroll
  for(int d0=0;d0<4;++d0){
    const bf16x8 b0=*reinterpret_cast<const bf16x8*>(kb+d0*2048);
    const bf16x8 b1=*reinterpret_cast<const bf16x8*>(kb+d0*2048+512);
    if(d0==0){p0=__builtin_amdgcn_mfma_f32_32x32x16_bf16(b0,qr[0],negm,0,0,0);p1=__builtin_amdgcn_mfma_f32_32x32x16_bf16(b1,qr[0],negm,0,0,0);}
    else{p0=__builtin_amdgcn_mfma_f32_32x32x16_bf16(b0,qr[d0],p0,0,0,0);p1=__builtin_amdgcn_mfma_f32_32x32x16_bf16(b1,qr[d0],p1,0,0,0);}}
}
typedef __attribute__((address_space(3))) const char* lds_cptr;
typedef short v4i16_t __attribute__((ext_vector_type(4)));
__device__ __forceinline__ void kload8(bf16x8*kf,lds_cptr kp){
  kf[0]=*(const __attribute__((address_space(3))) bf16x8*)(kp);      kf[1]=*(const __attribute__((address_space(3))) bf16x8*)(kp+512);
  kf[2]=*(const __attribute__((address_space(3))) bf16x8*)(kp+2048); kf[3]=*(const __attribute__((address_space(3))) bf16x8*)(kp+2560);
  kf[4]=*(const __attribute__((address_space(3))) bf16x8*)(kp+4096); kf[5]=*(const __attribute__((address_space(3))) bf16x8*)(kp+4608);
  kf[6]=*(const __attribute__((address_space(3))) bf16x8*)(kp+6144); kf[7]=*(const __attribute__((address_space(3))) bf16x8*)(kp+6656);
}
__device__ __forceinline__ void kload2(bf16x8*kf,lds_cptr kp,int j){ kf[2*j]=*(const __attribute__((address_space(3))) bf16x8*)(kp+j*2048); kf[2*j+1]=*(const __attribute__((address_space(3))) bf16x8*)(kp+j*2048+512); }
__device__ __forceinline__ s16x4 vtr(lds_cptr p){ return __builtin_bit_cast(s16x4,__builtin_amdgcn_ds_read_tr16_b64_v4i16((__attribute__((address_space(3))) v4i16_t*)p)); }
__device__ __forceinline__ float rowmax(const f32x16&p0,const f32x16&p1){
  float a=max3f(p0[0],p0[1],p1[0]),b=max3f(p0[2],p0[3],p1[1]);a=max3f(a,p1[2],p1[3]);
  #pragma unroll
  for(int r=4;r<16;r+=4){a=max3f(a,p0[r],p0[r+1]);b=max3f(b,p0[r+2],p0[r+3]);a=max3f(a,p1[r],p1[r+1]);b=max3f(b,p1[r+2],p1[r+3]);}
  const float m=max2f(a,b);
  auto rr=__builtin_amdgcn_permlane32_swap(__float_as_uint(m),__float_as_uint(m),false,false);
  return max2f(__uint_as_float(rr[0]),__uint_as_float(rr[1]));
}
__device__ __forceinline__ void pv(f32x16*o,int vb,bf16x8 pa0,bf16x8 pa1,bf16x8 pa2,bf16x8 pa3){
  #pragma unroll
  for(int d0=0;d0<2;++d0){s16x4 lo[4],hi[4];
    #pragma unroll
    for(int ks=0;ks<4;++ks){
      asm volatile("ds_read_b64_tr_b16 %0,%1 offset:%c2":"=&v"(lo[ks]):"v"(vb),"i"(d0*4096+ks*1024):"memory");
      asm volatile("ds_read_b64_tr_b16 %0,%1 offset:%c2":"=&v"(hi[ks]):"v"(vb),"i"(d0*4096+ks*1024+512):"memory");}
    asm volatile("s_waitcnt lgkmcnt(0)":::"memory");SBAR();
    #define PK(k) (bf16x8){lo[k][0],lo[k][1],lo[k][2],lo[k][3],hi[k][0],hi[k][1],hi[k][2],hi[k][3]}
    o[d0]=__builtin_amdgcn_mfma_f32_32x32x16_bf16(pa0,PK(0),o[d0],0,0,0);
    o[d0]=__builtin_amdgcn_mfma_f32_32x32x16_bf16(pa1,PK(1),o[d0],0,0,0);
    o[d0]=__builtin_amdgcn_mfma_f32_32x32x16_bf16(pa2,PK(2),o[d0],0,0,0);
    o[d0]=__builtin_amdgcn_mfma_f32_32x32x16_bf16(pa3,PK(3),o[d0],0,0,0);
    #undef PK
  }
}

#ifndef ATTN_STORE16
#define ATTN_STORE16(p,v) (*(u32x4*)(p)=(v))
#endif
template<int THRL> __device__ __forceinline__ void attn_unit(int b,int n,int qt,const bf16*Q,const bf16*__restrict__ K,const bf16*__restrict__ V,bf16*O,const unsigned*__restrict__ MASK,char*shm){
  const int tid=opaque_tid(),lane=tid&63,r32=lane&31,hi=lane>>5; const int wid=__builtin_amdgcn_readfirstlane(tid>>6);
  const long rowbase=(long)b*SEQ; const int q0=qt*64;
  const int hq=4*n+(wid>>1), tok0=q0+32*(wid&1);
  const bf16*Qw=Q+(rowbase+tok0)*DM+hq*D;
  const bf16*Kh=K+rowbase*KP+n*D,*Vh=V+rowbase*KP+n*D;
  const unsigned lds0=(unsigned)(uintptr_t)shm;
  float*wsf=(float*)(shm+LDS_WS)+wid*64;
  const bf16*ksrc=Kh+(long)lane*KP+wid*8;
  const bf16*vsrc=Vh+(long)(16*(wid&3)+(lane>>2))*KP+(wid>>2)*32+(lane&3)*8;
  const unsigned kdst=lds0+LDS_K+wid*1024, vdst=lds0+LDS_V+wid*1024;
  #define DMA_K(t,slot) glds16(ksrc+(long)(t)*KVBLK*KP,(unsigned)__builtin_amdgcn_readfirstlane(kdst+(slot)))
  #define DMA_V(t,slot) glds16(vsrc+(long)(t)*KVBLK*KP,(unsigned)__builtin_amdgcn_readfirstlane(vdst+(slot)))
  const int vb0=(int)(lds0+LDS_V)+((lane>>4)&1)*32+(lane&3)*8+(4*hi+((lane&15)>>2))*64;
  const char*Kbase=shm+LDS_K; bf16x8 kf[8];
  const lds_cptr shm3=(lds_cptr)shm; const lds_cptr kp0=shm3+LDS_K+hi*1024+r32*16; const lds_cptr vp0=shm3+LDS_V+((lane>>4)&1)*32+(lane&3)*8+(4*hi+((lane&15)>>2))*64;
  const int nt0=qt+1; const int NT=nt0<4?4:((nt0+1)&~1);
  DMA_K(0,0);DMA_V(0,0);DMA_K(1,SLOTB);
  bf16x8 qr[4];
  #pragma unroll
  for(int d0=0;d0<4;++d0)qr[d0]=*reinterpret_cast<const bf16x8*>(&Qw[(long)r32*DM+d0*16+hi*8]);
  { const int tk=tid>>3,pc=tid&7; const u32x4*ms=(const u32x4*)(MASK+((size_t)(rowbase+q0+tk))*64+pc*8); const u32x4 m0=ms[0],m1=ms[1];
    __attribute__((address_space(3))) u32x4*md=(__attribute__((address_space(3))) u32x4*)((__attribute__((address_space(3))) char*)shm+LDS_MSK+tk*256+pc*32); md[0]=m0; md[1]=m1; }
  const __attribute__((address_space(3))) unsigned long long*mskrow=(const __attribute__((address_space(3))) unsigned long long*)((__attribute__((address_space(3))) char*)shm+LDS_MSK+(32*(wid&1)+r32)*256);
  float mhat=0.f,l_reg=0.f;f32x16 o[2];o[0]=f32x16{};o[1]=f32x16{};f32x16 negm=f32x16{};asm volatile("":"+v"(negm));
  #define CMASK(P0,P1,t) bmask(P0,P1,mw_,hi)
  bool resc=false;
  #define START(P0,P1) do{ const float rm=max2f(rowmax(P0,P1),-1000.f); resc=false; \
    { const float dl=rm; mhat=fadd_s(mhat,dl); \
      _Pragma("unroll") for(int r=0;r<16;++r){P0[r]=fsub_s(P0[r],dl);P1[r]=fsub_s(P1[r],dl);} \
      _Pragma("unroll") for(int r=0;r<16;++r)negm[r]=-mhat; asm volatile("":"+v"(negm)); } \
    _Pragma("unroll") for(int r=0;r<16;++r)P0[r]=__builtin_amdgcn_exp2f(P0[r]); }while(0)
  #define RESC() do{ if(resc){ asm volatile("s_waitcnt lgkmcnt(0)":::"memory"); \
      _Pragma("unroll") for(int d_=0;d_<2;++d_) _Pragma("unroll") for(int r=0;r<16;++r)o[d_][r]*=wsf[crow(r,hi)]; } }while(0)
  f32x16 pA0,pA1,pB0,pB1;
  int sl_prev=0,sl_cur=0,sl_next=SLOTB;
  #define ROT() do{sl_prev=sl_cur;sl_cur=sl_next;sl_next=(sl_next==(NSLOT-1)*SLOTB)?0:sl_next+SLOTB;}while(0)
  DMA_K(2,2*SLOTB);
  WAIT_BAR(3);
  qkt(pA0,pA1,Kbase,qr,negm,r32,hi);asm volatile("s_nop 15\n\ts_nop 7":"+v"(pA0),"+v"(pA1));{const unsigned long long mw_=mskrow[0];CMASK(pA0,pA1,0);}
  START(pA0,pA1);
  _Pragma("unroll") for(int r=0;r<16;++r)pA1[r]=__builtin_amdgcn_exp2f(pA1[r]);
  WAIT_BAR(0);
  DMA_K(3,0);DMA_V(1,SLOTB);
  ROT();
  kload8(kf,kp0+sl_cur);
  WAIT_BAR(2);
  s16x4 vlo[8],vhi[8]; u32x4 pw0,pw1,pw2,pw3;
  #define PKW(P,B) cvtpk_s(P[B],P[B+1])
  #define PAF(k) __builtin_bit_cast(bf16x8,pw##k)
  #define VFR(i) (bf16x8){vlo[i][0],vlo[i][1],vlo[i][2],vlo[i][3],vhi[i][0],vhi[i][1],vhi[i][2],vhi[i][3]}
  #define PIN(x) asm volatile("":"+v"(x))
  #define MX3(a,b,c) __builtin_fmaxf(__builtin_fmaxf((a),(b)),(c))
  #define GAPA(MF,A0,A1,A2,A3,W0,W1,PW) do{ MF; sacc+=A0; sacc+=A1; sacc+=A2; sacc+=A3; PIN(sacc); W0; W1; PIN(PW); SBAR(); }while(0)
  #define EX(v) __builtin_amdgcn_exp2f(v)
  #define GAPB(MF,X,B) do{ MF; X[B]=EX(X[B]); X[B+1]=EX(X[B+1]); X[B+2]=EX(X[B+2]); X[B+3]=EX(X[B+3]); PIN(X); SBAR(); }while(0)
  #define VRD(i) do{ vlo[i]=vtr(vp_+(((i)>>2)*4096+((i)&3)*1024)); vhi[i]=vtr(vp_+(((i)>>2)*4096+((i)&3)*1024+512)); }while(0)
  #define KRD(G,j) do{ if(G){ kload2(kf,kp0+sl_next,j); SBAR(); } }while(0)
  #define STEP(C0,C1,P0,P1,t,GK,GV,GL) do{ SBAR(); \
    const lds_cptr vp_=vp0+sl_prev; const unsigned long long mw_=mskrow[(t)]; \
    VRD(0); SBAR(); float sacc=(P0[0]+P0[1]); \
    GAPA(C0=__builtin_amdgcn_mfma_f32_32x32x16_bf16(kf[0],qr[0],negm,0,0,0), P0[2],P0[3],P0[4],P0[5],     pw0[0]=PKW(P0,0), pw0[1]=PKW(P0,2), pw0); \
    VRD(4); SBAR(); GAPA(C1=__builtin_amdgcn_mfma_f32_32x32x16_bf16(kf[1],qr[0],negm,0,0,0), P0[6],P0[7],P0[8],P0[9],     pw0[2]=PKW(P0,4), pw0[3]=PKW(P0,6), pw0); \
    VRD(1); SBAR(); GAPA(C0=__builtin_amdgcn_mfma_f32_32x32x16_bf16(kf[2],qr[1],C0,0,0,0),   P0[10],P0[11],P0[12],P0[13], pw1[0]=PKW(P0,8), pw1[1]=PKW(P0,10), pw1); \
    VRD(5); SBAR(); GAPA(C1=__builtin_amdgcn_mfma_f32_32x32x16_bf16(kf[3],qr[1],C1,0,0,0),   P0[14],P0[15],P1[0],P1[1],   pw1[2]=PKW(P0,12),pw1[3]=PKW(P0,14), pw1); \
    VRD(2); SBAR(); GAPA(C0=__builtin_amdgcn_mfma_f32_32x32x16_bf16(kf[4],qr[2],C0,0,0,0),   P1[2],P1[3],P1[4],P1[5],     pw2[0]=PKW(P1,0), pw2[1]=PKW(P1,2), pw2); \
    VRD(6); SBAR(); GAPA(C1=__builtin_amdgcn_mfma_f32_32x32x16_bf16(kf[5],qr[2],C1,0,0,0),   P1[6],P1[7],P1[8],P1[9],     pw2[2]=PKW(P1,4), pw2[3]=PKW(P1,6), pw2); \
    VRD(3); SBAR(); GAPA(C0=__builtin_amdgcn_mfma_f32_32x32x16_bf16(kf[6],qr[3],C0,0,0,0),   P1[10],P1[11],P1[12],P1[13], pw3[0]=PKW(P1,8), pw3[1]=PKW(P1,10), pw3); \
    VRD(7); SBAR(); GAPA(C1=__builtin_amdgcn_mfma_f32_32x32x16_bf16(kf[7],qr[3],C1,0,0,0),   P1[14],P1[15],0.f,0.f,       pw3[2]=PKW(P1,12),pw3[3]=PKW(P1,14), pw3); \
    l_reg+=sacc; \
    if(GK){DMA_K((t)+3,sl_cur);} if(GV){DMA_V((t)+1,sl_next);} \
    CMASK(C0,C1,t); \
    { float a=MX3(C0[0],C0[1],C1[0]),b=MX3(C0[2],C0[3],C1[1]); a=MX3(a,C1[2],C1[3]); \
      _Pragma("unroll") for(int r=4;r<16;r+=4){a=MX3(a,C0[r],C0[r+1]);b=MX3(b,C0[r+2],C0[r+3]);a=MX3(a,C1[r],C1[r+1]);b=MX3(b,C1[r+2],C1[r+3]);} \
      float rm=__builtin_fmaxf(a,b); { auto rr=__builtin_amdgcn_permlane32_swap(__float_as_uint(rm),__float_as_uint(rm),false,false); rm=__builtin_fmaxf(__uint_as_float(rr[0]),__uint_as_float(rr[1])); } \
      resc=false; \
      if(__builtin_expect(__any(rm>(float)THRL),0)){ const float dl=__builtin_fmaxf(rm,0.f); mhat+=dl; \
        _Pragma("unroll") for(int r=0;r<16;++r){C0[r]-=dl;C1[r]-=dl;} \
        _Pragma("unroll") for(int r=0;r<16;++r)negm[r]=-mhat; asm volatile("":"+v"(negm)); \
        const float f=__builtin_amdgcn_exp2f(-dl); l_reg*=f; if(hi==0)wsf[r32]=f; resc=true; } } \
    SBAR(); \
    GAPB(o[0]=__builtin_amdgcn_mfma_f32_32x32x16_bf16(PAF(0),VFR(0),o[0],0,0,0), C0,0); \
    GAPB(o[1]=__builtin_amdgcn_mfma_f32_32x32x16_bf16(PAF(0),VFR(4),o[1],0,0,0), C0,4); \
    KRD(GL,0); GAPB(o[0]=__builtin_amdgcn_mfma_f32_32x32x16_bf16(PAF(1),VFR(1),o[0],0,0,0), C0,8); \
    KRD(GL,1); GAPB(o[1]=__builtin_amdgcn_mfma_f32_32x32x16_bf16(PAF(1),VFR(5),o[1],0,0,0), C0,12); \
    KRD(GL,2); GAPB(o[0]=__builtin_amdgcn_mfma_f32_32x32x16_bf16(PAF(2),VFR(2),o[0],0,0,0), C1,0); \
    KRD(GL,3); GAPB(o[1]=__builtin_amdgcn_mfma_f32_32x32x16_bf16(PAF(2),VFR(6),o[1],0,0,0), C1,4); \
    GAPB(o[0]=__builtin_amdgcn_mfma_f32_32x32x16_bf16(PAF(3),VFR(3),o[0],0,0,0), C1,8); \
    GAPB(o[1]=__builtin_amdgcn_mfma_f32_32x32x16_bf16(PAF(3),VFR(7),o[1],0,0,0), C1,12); \
    }while(0)
  int t=1;
  for(;t+5<NT;t+=2){
    STEP(pB0,pB1,pA0,pA1,t,true,true,true);     WAIT_BAR(2); RESC(); ROT();
    STEP(pA0,pA1,pB0,pB1,t+1,true,true,true);   WAIT_BAR(2); RESC(); ROT();
  }
  #define ENDW(tt) do{ if((tt)+3<NT){WAIT_BAR(2);} else if((tt)+2<NT){WAIT_BAR(1);} else {WAIT_BAR(0);} }while(0)
  for(;t+1<NT;t+=2){
    STEP(pB0,pB1,pA0,pA1,t,(t+3<NT),(t+1<NT),(t+1<NT));       ENDW(t);   RESC(); ROT();
    STEP(pA0,pA1,pB0,pB1,t+1,(t+4<NT),(t+2<NT),(t+2<NT));     ENDW(t+1); RESC(); ROT();
  }
  STEP(pB0,pB1,pA0,pA1,NT-1,false,false,false); RESC();
  { float sacc=pB0[0]+pB0[1]; _Pragma("unroll") for(int r=2;r<16;++r)sacc+=pB0[r]; _Pragma("unroll") for(int r=0;r<16;++r)sacc+=pB1[r]; l_reg+=sacc;
    pw0=(u32x4){PKW(pB0,0),PKW(pB0,2),PKW(pB0,4),PKW(pB0,6)};pw1=(u32x4){PKW(pB0,8),PKW(pB0,10),PKW(pB0,12),PKW(pB0,14)};pw2=(u32x4){PKW(pB1,0),PKW(pB1,2),PKW(pB1,4),PKW(pB1,6)};pw3=(u32x4){PKW(pB1,8),PKW(pB1,10),PKW(pB1,12),PKW(pB1,14)};
    SBAR(); pv(o,vb0+sl_cur,PAF(0),PAF(1),PAF(2),PAF(3)); }
  #undef PKW
  #undef PAF
  #undef VFR
  #undef PIN
  #undef MX3
  #undef GAPA
  #undef GAPB
  #undef EX
  #undef VRD
  #undef KRD
  #undef STEP
  #undef ENDW
  {auto rr=__builtin_amdgcn_permlane32_swap(__float_as_uint(l_reg),__float_as_uint(l_reg),false,false);l_reg=__uint_as_float(rr[0])+__uint_as_float(rr[1]);}
  if(hi==0)wsf[32+r32]=l_reg;asm volatile("s_waitcnt lgkmcnt(0)":::"memory");
  float rli[16];
  #pragma unroll
  for(int r=0;r<16;++r)rli[r]=__builtin_amdgcn_rcpf(wsf[32+crow(r,hi)]);
  bf16*Ow=O+(rowbase+tok0)*DM+hq*D;
  { bf16*stg=(bf16*)(shm+LDS_OST)+wid*2048;
    #pragma unroll
    for(int r=0;r<16;++r){const int orow=crow(r,hi);
      #pragma unroll
      for(int d0=0;d0<2;++d0)stg[orow*64+d0*32+r32]=__float2bfloat16(o[d0][r]*rli[r]);}
    asm volatile("s_waitcnt lgkmcnt(0)":::"memory");
    #pragma unroll
    for(int i=0;i<4;++i){const int row=i*8+(lane>>3),ch=lane&7; const u32x4 v=*(const u32x4*)(stg+row*64+ch*8); ATTN_STORE16(Ow+(long)row*DM+ch*8,v);} }
  asm volatile("s_waitcnt lgkmcnt(0)\n\ts_barrier":::"memory");
  #undef DMA_K
  #undef DMA_V
  #undef CMASK
  #undef START
  #undef RESC
  #undef ROT
}
constexpr int ATTN_LDS_BYTES=LDS_BYTES;
struct AttnTensors { const bf16* Q; const bf16* K; const bf16* V; bf16* O; const unsigned* MASK; };
struct AttnUnit { int bn; int qt; };
struct StaticOrder {
  int vcu, G;
  __device__ __forceinline__ explicit StaticOrder(int grid,int block):vcu((grid%8==0)?(block%8)*(grid/8)+block/8:block),G(grid){}
  __device__ __forceinline__ bool next(int i,AttnUnit&u)const{
    if(G==256){ if(i>=4)return false; const int s=vcu&7; u.bn=vcu>>3; u.qt=(i==0)?31-s:(i==1)?16+s:(i==2)?15-s:s; return true; }
    const int id=vcu+i*G; if(id>=1024)return false; u.bn=id>>5; u.qt=31-(id&31); return true; }
};
template<class Sched,int THRL=8> __device__ __forceinline__ void attn_phase(char*lds,const AttnTensors&T,const Sched&S){
  AttnUnit u;
  for(int i=0;S.next(i,u);++i){ attn_unit<THRL>(u.bn>>2,u.bn&3,u.qt,T.Q,T.K,T.V,T.O,T.MASK,lds); }
}
#undef SBAR
#undef WAIT_BAR
}


constexpr int CH = 16, NCHUNK = SEQ / CH;
constexpr size_t OFF_SM = 84 * MiB, OFF_WC = 3 * MiB;
__device__ __forceinline__ unsigned char* arr_base(const Args& A, int arr) { return A.ws + (arr == 0 ? OFF_R : arr == 1 ? OFF_KR : arr == 2 ? OFF_E : OFF_A); }
__device__ __forceinline__ unsigned char* piece_ptr(const Args& A, int blk, int lane, int m0, int h) {
    const int pidx = blk * 64 + lane, p7 = pidx & 127, t = p7 >> 3, seg = p7 & 7;
    return arr_base(A, pidx >> 7) + ((size_t)(m0 + t) * DM + h * 64 + seg * 8) * 2;
}
__device__ __forceinline__ unsigned cvtpk(float lo, float hi) { typedef float f2_ __attribute__((ext_vector_type(2))); typedef __bf16 b2_ __attribute__((ext_vector_type(2))); f2_ v = {lo, hi}; b2_ b = __builtin_convertvector(v, b2_); return __builtin_bit_cast(unsigned, b); }
__device__ __forceinline__ float quad_allsum(float v) { v += dppf<0xB1>(v); v += dppf<0x4E>(v); return v; }
__device__ __forceinline__ bf16x8 mk8(unsigned a, unsigned b, unsigned c, unsigned d) { u32x4 w = {a, b, c, d}; return __builtin_bit_cast(bf16x8, w); }

__device__ __forceinline__ void p12_chunk_prep(const Args& A, unsigned char* lds) {
    const int tid = opaque_tid(), lane = tid & 63, wave = __builtin_amdgcn_readfirstlane(tid >> 6), q = lane >> 4, c = lane & 15;
    unsigned char* wl = lds + wave * 14336;
    bf16_t* arr = (bf16_t*)wl;
    bf16_t* bkb = (bf16_t*)(wl + 8192);
    float* gs = (float*)(wl + 12288);
    float* invs = (float*)(wl + 13312);
    const bf16_t* R = WSP(bf16_t, OFF_R); const bf16_t* KR = WSP(bf16_t, OFF_KR); const bf16_t* E = WSP(bf16_t, OFF_E); const bf16_t* AS = WSP(bf16_t, OFF_A);
    float* BO = WSP(float, OFF_BONUS); float* WC = WSP(float, OFF_WC); unsigned char* SM = A.ws + OFF_SM;
    const int gw = blockIdx.x * NWAVES + wave, NGW = gridDim.x * NWAVES;
    u32x4 nr0, nr1, nk0, nk1, ne0, ne1, na0, na1;
#define P12_LOAD(itm) do { const int bh_ = (itm) >> 7, ch_ = (itm) & 127; const size_t go_ = (size_t)((bh_ >> 4) * SEQ + ch_ * CH + (lane >> 2)) * DM + (bh_ & 15) * 64 + (lane & 3) * 16; \
        nr0 = *(const u32x4*)(R + go_); nr1 = *(const u32x4*)(R + go_ + 8); nk0 = *(const u32x4*)(KR + go_); nk1 = *(const u32x4*)(KR + go_ + 8); \
        ne0 = *(const u32x4*)(E + go_); ne1 = *(const u32x4*)(E + go_ + 8); na0 = *(const u32x4*)(AS + go_); na1 = *(const u32x4*)(AS + go_ + 8); } while (0)
    if (gw < BATCH * 16 * NCHUNK) P12_LOAD(gw);
#pragma unroll 1
    for (int item = gw; item < BATCH * 16 * NCHUNK; item += NGW) {
        const int bh = item >> 7, ch = item & 127, b = bh >> 4, h = bh & 15, m0 = b * SEQ + ch * CH;
        {
            const int t = lane >> 2, sg = lane & 3;
            const u32x4 r0 = nr0, r1 = nr1, k0 = nk0, k1 = nk1, e0 = ne0, e1 = ne1, a0 = na0, a1 = na1;
            if (item + NGW < BATCH * 16 * NCHUNK) P12_LOAD(item + NGW);
            u32x4* d = (u32x4*)(arr + t * 64 + sg * 16);
            d[0] = r0; d[1] = r1; d[128] = k0; d[129] = k1; d[256] = e0; d[257] = e1; d[384] = a0; d[385] = a1;
            float ss = 0.f, bo = 0.f;
#pragma unroll
            for (int w = 0; w < 8; ++w) {
                const unsigned rw = w < 4 ? r0[w & 3] : r1[w & 3], kw = w < 4 ? k0[w & 3] : k1[w & 3], aw = w < 4 ? a0[w & 3] : a1[w & 3];
                const int kk0 = h * 64 + sg * 16 + 2 * w;
#pragma unroll
                for (int p = 0; p < 2; ++p) {
                    const float rv = p ? __uint_as_float(rw & 0xffff0000u) : __uint_as_float(rw << 16), kv = p ? __uint_as_float(kw & 0xffff0000u) : __uint_as_float(kw << 16), av = p ? __uint_as_float(aw & 0xffff0000u) : __uint_as_float(aw << 16);
                    const float kkv = kv * A.in[IN_KK][kk0 + p]; ss += kkv * kkv;
                    bo += rv * (kv * (1.f + (av - 1.f) * A.in[IN_KA][kk0 + p])) * A.in[IN_RK][kk0 + p];
                }
            }
            ss = quad_allsum(ss); bo = quad_allsum(bo);
            if (sg == 0) { invs[t] = rsqrtf(fmaxf(ss, 1e-24f)); BO[(size_t)(m0 + t) * 16 + h] = bo; }
        }
        LDS_WAIT();
        float wc;
        {
            const float kkw = A.in[IN_KK][h * 64 + lane], kaw = A.in[IN_KA][h * 64 + lane];
            float Ecum = 0.f, ep_prev = 1.f; float bt[16], ktl[16];
#pragma unroll
            for (int t = 0; t < 16; ++t) {
                const float r = bf2f(arr[t * 64 + lane]), k = bf2f(arr[1024 + t * 64 + lane]), e = bf2f(arr[2048 + t * 64 + lane]), a = bf2f(arr[3072 + t * 64 + lane]);
                const float n = -(k * kkw) * invs[t], bb = -n * a, kt = k * (1.f + (a - 1.f) * kaw);
                Ecum += e; const float ep = __expf(Ecum), em = __builtin_amdgcn_rcpf(ep);
                bt[t] = bb * em; ktl[t] = kt * em;
                arr[t * 64 + lane] = (bf16_t)f2bf(r * ep); arr[1024 + t * 64 + lane] = (bf16_t)f2bf(n * ep_prev);
                arr[2048 + t * 64 + lane] = (bf16_t)f2bf(bt[t]); arr[3072 + t * 64 + lane] = (bf16_t)f2bf(ktl[t]);
                ep_prev = ep;
            }
            wc = ep_prev;
            u32x4* bd = (u32x4*)(bkb + lane * 16); u32x4* kd = (u32x4*)(bkb + 1024 + lane * 16);
            bd[0] = (u32x4){cvtpk(bt[0] * wc, bt[1] * wc), cvtpk(bt[2] * wc, bt[3] * wc), cvtpk(bt[4] * wc, bt[5] * wc), cvtpk(bt[6] * wc, bt[7] * wc)};
            bd[1] = (u32x4){cvtpk(bt[8] * wc, bt[9] * wc), cvtpk(bt[10] * wc, bt[11] * wc), cvtpk(bt[12] * wc, bt[13] * wc), cvtpk(bt[14] * wc, bt[15] * wc)};
            kd[0] = (u32x4){cvtpk(ktl[0] * wc, ktl[1] * wc), cvtpk(ktl[2] * wc, ktl[3] * wc), cvtpk(ktl[4] * wc, ktl[5] * wc), cvtpk(ktl[6] * wc, ktl[7] * wc)};
            kd[1] = (u32x4){cvtpk(ktl[8] * wc, ktl[9] * wc), cvtpk(ktl[10] * wc, ktl[11] * wc), cvtpk(ktl[12] * wc, ktl[13] * wc), cvtpk(ktl[14] * wc, ktl[15] * wc)};
        }
        LDS_WAIT();
        f32x4 gnb = {0.f, 0.f, 0.f, 0.f}, gnk = gnb, grb = gnb, grk = gnb;
#pragma unroll
        for (int ks = 0; ks < 2; ++ks) {
            const int o = c * 64 + ks * 32 + q * 8;
            const bf16x8 Ab = *(const bf16x8*)(arr + 2048 + o), Ak = *(const bf16x8*)(arr + 3072 + o), Bn = *(const bf16x8*)(arr + 1024 + o), Br = *(const bf16x8*)(arr + o);
            gnb = __builtin_amdgcn_mfma_f32_16x16x32_bf16(Ab, Bn, gnb, 0, 0, 0); gnk = __builtin_amdgcn_mfma_f32_16x16x32_bf16(Ak, Bn, gnk, 0, 0, 0);
            grb = __builtin_amdgcn_mfma_f32_16x16x32_bf16(Ab, Br, grb, 0, 0, 0); grk = __builtin_amdgcn_mfma_f32_16x16x32_bf16(Ak, Br, grk, 0, 0, 0);
        }
#pragma unroll
        for (int rg = 0; rg < 4; ++rg) { const int sI = 4 * q + rg; if (!(sI < c)) { gnb[rg] = 0.f; gnk[rg] = 0.f; } if (!(sI <= c)) { grb[rg] = 0.f; grk[rg] = 0.f; } gs[sI * 16 + c] = gnb[rg]; }
        LDS_WAIT();
        {
            float Tc[16];
#pragma unroll
            for (int sI = 15; sI >= 0; --sI) {
                float acc = (sI == c) ? 1.f : 0.f;
#pragma unroll
                for (int j = sI + 1; j < 16; ++j) acc += gs[sI * 16 + j] * Tc[j];
                Tc[sI] = acc;
            }
            LDS_WAIT();
            if (q == 0) {
#pragma unroll
                for (int j = 0; j < 4; ++j) *(f32x4*)(gs + c * 16 + 4 * j) = (f32x4){Tc[4 * j], Tc[4 * j + 1], Tc[4 * j + 2], Tc[4 * j + 3]};
            }
        }
        LDS_WAIT();
#pragma unroll
        for (int blk = 0; blk < 4; ++blk) {
            const int ks = blk & 1; const bf16_t* src = arr + (blk < 2 ? 1024 : 0) + c * 64 + ks * 32 + 4 * q;
            const u32x2 lo = *(const u32x2*)src, hi = *(const u32x2*)(src + 16);
            *(u32x4*)piece_ptr(A, blk, lane, m0, h) = (u32x4){lo.x, lo.y, hi.x, hi.y};
        }
#pragma unroll
        for (int ct = 0; ct < 4; ++ct) {
            const u32x2 lo = *(const u32x2*)(bkb + (16 * ct + c) * 16 + 4 * q), hi = *(const u32x2*)(bkb + 1024 + (16 * ct + c) * 16 + 4 * q);
            *(u32x4*)piece_ptr(A, 4 + ct, lane, m0, h) = (u32x4){lo.x, lo.y, hi.x, hi.y};
        }
        {
            unsigned char* sm = SM + (size_t)item * 2048;
            *(u32x2*)(sm + lane * 8) = (u32x2){cvtpk(gnk[0], gnk[1]), cvtpk(gnk[2], gnk[3])};
            const f32x4 tv = *(const f32x4*)(gs + c * 16 + 4 * q);
            *(u32x2*)(sm + 512 + lane * 8) = (u32x2){cvtpk(tv[0], tv[1]), cvtpk(tv[2], tv[3])};
            *(u32x4*)(sm + 1024 + lane * 16) = (u32x4){cvtpk(grb[0], grb[1]), cvtpk(grb[2], grb[3]), cvtpk(grk[0], grk[1]), cvtpk(grk[2], grk[3])};
            WC[(size_t)item * 64 + lane] = wc;
        }
        LDS_WAIT();
    }
}

constexpr int CS_SLOT = 12800, CS_PD = 4, CS_YT = 1024 + 3 * CS_SLOT;
#define CS_BAR() asm volatile("s_waitcnt lgkmcnt(0)\n\ts_barrier" ::: "memory")
__device__ __forceinline__ void p13_chunk_scan(const Args& A, unsigned char* lds) {
    const int tid = opaque_tid(), lane = tid & 63, wave = __builtin_amdgcn_readfirstlane(tid >> 6), q = lane >> 4, c = lane & 15;
    float* part = (float*)lds; unsigned char* slots = lds + 1024;
    const bf16_t* VV = WSP(bf16_t, OFF_VV); bf16_t* Y = WSP(bf16_t, OFF_R); float* ST = WSP(float, OFF_STATS); const float* WC = WSP(float, OFF_WC); const unsigned char* SM = A.ws + OFF_SM;
    if (DEFER_W && (int)gridDim.x > BATCH * 16 && (int)blockIdx.x >= BATCH * 16) {
        float* scr = (float*)(lds + wave * 16384);
        const int gwi = ((int)blockIdx.x - BATCH * 16) * NWAVES + wave, ngwi = ((int)gridDim.x - BATCH * 16) * NWAVES;
        p0_weight<9>(A, WSP(bf16_t, OFF_WO1), 1024, 1024, scr, gwi, ngwi, lane);
        p0_weight<10>(A, WSP(bf16_t, OFF_WUP1), 4096, 1024, scr, gwi, ngwi, lane);
        p0_weight<11>(A, WSP(bf16_t, OFF_WDN1), 1024, 4096, scr, gwi, ngwi, lane);
        return;
    }
#pragma unroll 1
    for (int it = blockIdx.x; it < BATCH * 16; it += gridDim.x) {
        const int b = it >> 4, h = it & 15;
        __syncthreads();
        if (wave >= 4) {
            const int lw = wave - 4;
            const unsigned char* src[4]; int dst[4]; size_t step[4]; bool on[4];
#pragma unroll
            for (int i = 0; i < 4; ++i) { src[i] = A.ws; dst[i] = 0; step[i] = 0; on[i] = false; }
            if (lw < 2) {
#pragma unroll
                for (int i = 0; i < 4; ++i) { src[i] = piece_ptr(A, 4 * lw + i, lane, b * SEQ, h); dst[i] = (4 * lw + i) * 1024 + lane * 16; step[i] = (size_t)CH * DM * 2; on[i] = true; }
            } else if (lw == 2) {
                src[0] = SM + (size_t)it * NCHUNK * 2048 + lane * 32; src[1] = src[0] + 16; dst[0] = 8192 + lane * 32; dst[1] = dst[0] + 16; step[0] = step[1] = 2048; on[0] = on[1] = true;
                src[2] = (const unsigned char*)(WC + (size_t)it * NCHUNK * 64) + (lane & 15) * 16; dst[2] = 10240 + (lane & 15) * 16; step[2] = 256; on[2] = lane < 16;
            } else {
                src[0] = (const unsigned char*)(VV + (size_t)(b * SEQ + (lane >> 2)) * DM + h * 64 + (lane & 3) * 16); src[1] = src[0] + 16; dst[0] = 10496 + (lane >> 2) * 128 + (lane & 3) * 32; dst[1] = dst[0] + 16;
                step[0] = step[1] = (size_t)CH * DM * 2; on[0] = on[1] = true;
            }
            u32x4 ld[CS_PD][4];
#define LD_ISSUE(slotreg, chn) do { _Pragma("unroll") for (int i_ = 0; i_ < 4; ++i_) if (on[i_]) ld[slotreg][i_] = *(const u32x4*)(src[i_] + (size_t)(chn) * step[i_]); } while (0)
#define LD_WRITE(slotreg, chn) do { unsigned char* sl_ = slots + ((chn) % 3) * CS_SLOT; _Pragma("unroll") for (int i_ = 0; i_ < 4; ++i_) if (on[i_]) *(u32x4*)(sl_ + dst[i_]) = ld[slotreg][i_]; } while (0)
#define YT_OUT(chn) do { const unsigned char* yt_ = lds + CS_YT + ((chn) & 1) * 2048 + (lane >> 2) * 128 + (lane & 3) * 32; \
                const u32x4 ya_ = *(const u32x4*)yt_, yb_ = *(const u32x4*)(yt_ + 16); float s1_ = 0.f, s2_ = 0.f; \
                _Pragma("unroll") for (int i_ = 0; i_ < 4; ++i_) { const float a0_ = __uint_as_float(ya_[i_] << 16), a1_ = __uint_as_float(ya_[i_] & 0xffff0000u), b0_ = __uint_as_float(yb_[i_] << 16), b1_ = __uint_as_float(yb_[i_] & 0xffff0000u); \
                    s1_ += (a0_ + a1_) + (b0_ + b1_); s2_ += (a0_ * a0_ + a1_ * a1_) + (b0_ * b0_ + b1_ * b1_); } \
                s1_ = quad_allsum(s1_); s2_ = quad_allsum(s2_); \
                const size_t m_ = (size_t)b * SEQ + (chn) * CH + (lane >> 2); \
                u32x4* yg_ = (u32x4*)(Y + m_ * DM + h * 64 + (lane & 3) * 16); yg_[0] = ya_; yg_[1] = yb_; \
                if ((lane & 3) == 0) *(f32x4*)(ST + (m_ * 16 + h) * 4) = (f32x4){s1_, s2_, 0.f, 0.f}; } while (0)
#pragma unroll
            for (int u = 0; u < CS_PD; ++u) LD_ISSUE(u, u);
            LD_WRITE(0, 0); LD_ISSUE(0, CS_PD);
            LD_WRITE(1, 1); LD_ISSUE(1, CS_PD + 1);
            CS_BAR();
#pragma unroll 1
            for (int ch = 0; ch < NCHUNK; ch += CS_PD) {
#pragma unroll
                for (int u = 0; u < CS_PD; ++u) {
                    const int cc = ch + u, wn = cc + 2;
                    if (wn < NCHUNK) { LD_WRITE((u + 2) % CS_PD, wn); if (wn + CS_PD < NCHUNK) LD_ISSUE((u + 2) % CS_PD, wn + CS_PD); }
                    if (lw == 3 && cc >= 1) YT_OUT(cc - 1);
                    CS_BAR();
                }
            }
            if (lw == 3) YT_OUT(NCHUNK - 1);
#undef LD_ISSUE
#undef LD_WRITE
#undef YT_OUT
        } else {
            const int rt = wave;
            f32x4 St[4];
#pragma unroll
            for (int i = 0; i < 4; ++i) St[i] = (f32x4){0.f, 0.f, 0.f, 0.f};
            bf16x8 n0, n1, r0, r1, bk0, bk1, bk2, bk3, gr; u32x2 gnk, tt; unsigned short v0, v1, v2, v3; f32x4 w0, w1, w2, w3;
#define CS_LOAD(chn) do { const unsigned char* sl_ = slots + ((chn) % 3) * CS_SLOT; \
            n0 = *(const bf16x8*)(sl_ + lane * 16); n1 = *(const bf16x8*)(sl_ + 1024 + lane * 16); r0 = *(const bf16x8*)(sl_ + 2048 + lane * 16); r1 = *(const bf16x8*)(sl_ + 3072 + lane * 16); \
            bk0 = *(const bf16x8*)(sl_ + 4096 + lane * 16); bk1 = *(const bf16x8*)(sl_ + 5120 + lane * 16); bk2 = *(const bf16x8*)(sl_ + 6144 + lane * 16); bk3 = *(const bf16x8*)(sl_ + 7168 + lane * 16); \
            gnk = *(const u32x2*)(sl_ + 8192 + lane * 8); tt = *(const u32x2*)(sl_ + 8704 + lane * 8); gr = *(const bf16x8*)(sl_ + 9216 + lane * 16); \
            const float* wp_ = (const float*)(sl_ + 10240) + 4 * q; w0 = *(const f32x4*)(wp_); w1 = *(const f32x4*)(wp_ + 16); w2 = *(const f32x4*)(wp_ + 32); w3 = *(const f32x4*)(wp_ + 48); \
            const bf16_t* vp_ = (const bf16_t*)(sl_ + 10496) + (4 * q) * 64 + 16 * rt + c; v0 = vp_[0]; v1 = vp_[64]; v2 = vp_[128]; v3 = vp_[192]; } while (0)
            CS_BAR();
            CS_LOAD(0);
#pragma unroll 1
            for (int ch = 0; ch < NCHUNK; ++ch) {
                const int m0 = b * SEQ + ch * CH;
                const bf16x8 cn0 = n0, cn1 = n1, cr0 = r0, cr1 = r1, cb0 = bk0, cb1 = bk1, cb2 = bk2, cb3 = bk3, cgr = gr; const u32x2 cgnk = gnk, ctt = tt;
                const unsigned vlo = (unsigned)v0 | ((unsigned)v1 << 16), vhi = (unsigned)v2 | ((unsigned)v3 << 16); const f32x4 cw0 = w0, cw1 = w1, cw2 = w2, cw3 = w3;
                if (ch + 1 < NCHUNK) CS_LOAD(ch + 1);
                const f32x4 z = {0.f, 0.f, 0.f, 0.f};
                const bf16x8 bS0 = mk8(cvtpk(St[0][0], St[0][1]), cvtpk(St[0][2], St[0][3]), cvtpk(St[1][0], St[1][1]), cvtpk(St[1][2], St[1][3]));
                const bf16x8 bS1 = mk8(cvtpk(St[2][0], St[2][1]), cvtpk(St[2][2], St[2][3]), cvtpk(St[3][0], St[3][1]), cvtpk(St[3][2], St[3][3]));
                f32x4 X = __builtin_amdgcn_mfma_f32_16x16x32_bf16(cn0, bS0, z, 0, 0, 0);
                X = __builtin_amdgcn_mfma_f32_16x16x32_bf16(cn1, bS1, X, 0, 0, 0);
                X = __builtin_amdgcn_mfma_f32_16x16x32_bf16(mk8(cgnk.x, cgnk.y, 0u, 0u), mk8(vlo, vhi, 0u, 0u), X, 0, 0, 0);
                const f32x4 U = __builtin_amdgcn_mfma_f32_16x16x32_bf16(mk8(ctt.x, ctt.y, 0u, 0u), mk8(cvtpk(X[0], X[1]), cvtpk(X[2], X[3]), 0u, 0u), z, 0, 0, 0);
                const bf16x8 bUV = mk8(cvtpk(U[0], U[1]), cvtpk(U[2], U[3]), vlo, vhi);
                f32x4 Yt = __builtin_amdgcn_mfma_f32_16x16x32_bf16(cr0, bS0, z, 0, 0, 0);
                Yt = __builtin_amdgcn_mfma_f32_16x16x32_bf16(cr1, bS1, Yt, 0, 0, 0);
                Yt = __builtin_amdgcn_mfma_f32_16x16x32_bf16(cgr, bUV, Yt, 0, 0, 0);
                St[0] = __builtin_amdgcn_mfma_f32_16x16x32_bf16(cb0, bUV, St[0] * cw0, 0, 0, 0);
                St[1] = __builtin_amdgcn_mfma_f32_16x16x32_bf16(cb1, bUV, St[1] * cw1, 0, 0, 0);
                St[2] = __builtin_amdgcn_mfma_f32_16x16x32_bf16(cb2, bUV, St[2] * cw2, 0, 0, 0);
                St[3] = __builtin_amdgcn_mfma_f32_16x16x32_bf16(cb3, bUV, St[3] * cw3, 0, 0, 0);
                {
                    bf16_t* ytp = (bf16_t*)(lds + CS_YT + (ch & 1) * 2048) + (4 * q) * 64 + 16 * rt + c;
                    const unsigned y01 = cvtpk(Yt[0], Yt[1]), y23 = cvtpk(Yt[2], Yt[3]);
                    ytp[0] = (bf16_t)(y01 & 0xffffu); ytp[64] = (bf16_t)(y01 >> 16); ytp[128] = (bf16_t)(y23 & 0xffffu); ytp[192] = (bf16_t)(y23 >> 16);
                }
                CS_BAR();
            }
#undef CS_LOAD
        }
    }
}
#undef CS_BAR

__device__ __forceinline__ void p18_final(const Args& A) {
    const int tid = opaque_tid(), lane = tid & 63, wave = tid >> 6;
    const int gw = blockIdx.x * NWAVES + wave, NGW = gridDim.x * NWAVES;
    const f32x4* gr = (const f32x4*)A.in[IN_FINN] + lane;
    for (int m = gw; m < MTOK; m += NGW) {
        f32x4* xr = (f32x4*)(A.out + (size_t)m * DM) + lane; f32x4 v[4]; float s = 0.f;
#pragma unroll
        for (int j = 0; j < 4; ++j) { v[j] = xr[64 * j]; s += (v[j].x * v[j].x + v[j].y * v[j].y) + (v[j].z * v[j].z + v[j].w * v[j].w); }
        const float rs = rsqrtf(wave_sum(s) * (1.f / DM) + NORM_EPS);
#pragma unroll
        for (int j = 0; j < 4; ++j) xr[64 * j] = v[j] * rs * gr[64 * j];
    }
}

typedef GAS unsigned gu32;
#define RLX_AGENT __ATOMIC_RELAXED, __HIP_MEMORY_SCOPE_AGENT
constexpr int CW_BAR = 4096;
constexpr int RING_BYTES = 131072, LDSCTL_OFF = RING_BYTES, MISC_OFF = LDSCTL_OFF + 320;
#define XB_TMO      128
#define XB_XCNT(j)  (256  + 64 * (j))
#define XB_XSUB(j)  (1280 + 64 * (j))
#define XB_XGEN(j)  (2304 + 64 * (j))
#define XB_TOP      3328
#define XB_TOPGEN   3392
#define XCD_BAR_WORDS 3456
#define XB_SPIN_CAP (1u << 18)

__device__ __forceinline__ unsigned xb_ld(unsigned* p)              { return __hip_atomic_load(p, __ATOMIC_RELAXED, __HIP_MEMORY_SCOPE_AGENT); }
__device__ __forceinline__ unsigned xb_add(unsigned* p, unsigned v) { return __hip_atomic_fetch_add(p, v, __ATOMIC_RELAXED, __HIP_MEMORY_SCOPE_AGENT); }
__device__ __forceinline__ unsigned xb_xcc_id() { return (unsigned)__builtin_amdgcn_s_getreg((3 << 11) | 20) & 0xFu; }
#define XB_SPIN(cond, bar) do { unsigned _sp = 0; while (cond) { __builtin_amdgcn_s_sleep(1); \
    if ((++_sp & 255u) == 0u) { if (xb_ld(&(bar)[XB_TMO])) break; if (_sp > XB_SPIN_CAP) { atomicAdd(&(bar)[XB_TMO], 1u); break; } } } } while (0)

struct XcdBarrier {
    unsigned* bar; unsigned x;
    volatile LAS unsigned* st;
};

__device__ __forceinline__ XcdBarrier xcd_barrier_post(unsigned* bar, volatile LAS unsigned* st) {
    XcdBarrier b; b.bar = bar; b.x = xb_xcc_id(); b.st = st;
    if (threadIdx.x == 0) (void)xb_add(&bar[XB_XCNT(b.x)], 1u);
    return b;
}
__device__ __forceinline__ void xcd_barrier_complete(unsigned* bar, unsigned x, unsigned& nloc, unsigned& nx) {
    const unsigned G = gridDim.x * gridDim.y * gridDim.z;
    unsigned sum, cnt, mine, sp = 0u;
    for (;;) {
        sum = 0u; cnt = 0u; mine = 0u;
#pragma unroll
        for (unsigned j = 0; j < 16; ++j) { const unsigned c = xb_ld(&bar[XB_XCNT(j)]); sum += c; cnt += (c > 0u) ? 1u : 0u; mine = (j == x) ? c : mine; }
        if (sum == G) break;
        __builtin_amdgcn_s_sleep(1);
        if ((++sp & 255u) == 0u) { if (xb_ld(&bar[XB_TMO])) break; if (sp > XB_SPIN_CAP) { atomicAdd(&bar[XB_TMO], 1u); break; } }
    }
    nloc = mine > 0u ? mine : 1u; nx = cnt > 0u ? cnt : 1u;
}

__device__ __forceinline__ void xcd_barrier(const XcdBarrier& b) {
    asm volatile("s_waitcnt vmcnt(0)" ::: "memory");
    __syncthreads();
    if (threadIdx.x == 0) {
        unsigned* bar = b.bar;
        __builtin_amdgcn_s_waitcnt(0);
        unsigned nloc = b.st[0], nx = b.st[1];
        if (nloc == 0u) { xcd_barrier_complete(bar, b.x, nloc, nx); b.st[0] = nloc; b.st[1] = nx; }
        const unsigned old = xb_add(&bar[XB_XSUB(b.x)], 1u);
        const unsigned gen = old / nloc;
        if (old + 1u == (gen + 1u) * nloc) {
            __builtin_amdgcn_fence(__ATOMIC_RELEASE, "agent");
            asm volatile("s_waitcnt vmcnt(0)" ::: "memory");
            const unsigned og = xb_add(&bar[XB_TOP], 1u);
            const unsigned tg = og / nx;
            if (og + 1u == (tg + 1u) * nx) xb_add(&bar[XB_TOPGEN], 1u);
            else XB_SPIN(xb_ld(&bar[XB_TOPGEN]) == tg, bar);
            __builtin_amdgcn_fence(__ATOMIC_ACQUIRE, "agent");
            xb_add(&bar[XB_XGEN(b.x)], 1u);
            asm volatile("s_waitcnt vmcnt(0)" ::: "memory");
        } else {
            XB_SPIN(xb_ld(&bar[XB_XGEN(b.x)]) == gen, bar);
            __builtin_amdgcn_fence(__ATOMIC_ACQUIRE, "agent");
            asm volatile("s_waitcnt vmcnt(0)" ::: "memory");
        }
    }
    __syncthreads();
}

constexpr int N_PHASES = 19;
template <int LO, int HI> __global__ void __launch_bounds__(NTHR, 2) mk_fwd(Args A) {
    extern __shared__ __attribute__((aligned(16))) unsigned char lds[];
#define IN(k) (LO <= (k) && (k) < HI)
    constexpr bool FUSED = (HI - LO) > 1;
    XcdBarrier bar; bar.bar = nullptr; bar.x = 0; bar.st = nullptr;
    if constexpr (FUSED) {
        if (A.ph_lo == 0x7fffffff) cg::this_grid().sync();

        for (int u = threadIdx.x; u < (LDS_BYTES - LDSCTL_OFF) / 4; u += NTHR) ((LAS unsigned*)((LAS unsigned char*)lds + LDSCTL_OFF))[u] = 0u;
        __syncthreads();
        bar = xcd_barrier_post(WSP(unsigned, OFF_CTL) + CW_BAR, (volatile LAS unsigned*)((LAS unsigned char*)lds + MISC_OFF) + 8);
    }
#define SEAM(k) do { if constexpr (FUSED && IN(k) && IN((k) + 1)) { xcd_barrier(bar); if (DBG_TS && blockIdx.x == 0 && threadIdx.x == 0) ((unsigned long long*)(A.ws + OFF_CTL + 16384))[(k) + 1] = __builtin_amdgcn_s_memrealtime(); } } while (0)
    if (DBG_TS && FUSED && blockIdx.x == 0 && threadIdx.x == 0) ((unsigned long long*)(A.ws + OFF_CTL + 16384))[0] = __builtin_amdgcn_s_memrealtime();
    if constexpr (IN(0)) p0_prologue(A, lds);
    if constexpr (FUSED && IN(0) && ((REP_MASK >> 0) & 1u)) xcd_barrier(bar);
    if constexpr (FUSED && IN(0) && ((REP_MASK >> 0) & 1u)) p0_prologue(A, lds);
    SEAM(0);
    if constexpr (IN(1)) {
        Gemm g{WSP(bf16_t, OFF_H0), WSP(bf16_t, OFF_H0), 1 << 30, WSP(bf16_t, OFF_WIN), MTOK, 2304, DM};
        EpiInProj E{WSP(bf16_t, OFF_QO), WSP(bf16_t, OFF_K), WSP(bf16_t, OFF_V), WSP(bf16_t, OFF_QI), WSP(bf16_t, OFF_KI), WSP(float, OFF_WI), WSP(float, OFF_ROPE)};
        gemm_phase(lds, g, E);
    }
    SEAM(1);
    if constexpr (IN(2)) { if (FAST_TOPK) p2_fast(A, lds); else p2_naive(A, lds);
#if DBG_TOPK
        __syncthreads(); p2_naive(A, lds, 160 * MiB);
#endif
    }
    if constexpr (FUSED && IN(2) && ((REP_MASK >> 2) & 1u)) xcd_barrier(bar);
    if constexpr (FUSED && IN(2) && ((REP_MASK >> 2) & 1u)) { if (FAST_TOPK) p2_fast(A, lds); else p2_naive(A, lds);
#if DBG_TOPK
        __syncthreads(); p2_naive(A, lds, 160 * MiB);
#endif
    }
    if constexpr (FUSED && IN(2) && PROBE_P2 > 0) { xcd_barrier(bar); p2_fast<PROBE_P2>(A, lds); }
    SEAM(2);
    if constexpr (IN(3)) {
#if DBG_TOPK
        {
            const int lane_ = threadIdx.x & 63, gw_ = blockIdx.x * NWAVES + (threadIdx.x >> 6);
            const unsigned* M1 = WSP(unsigned, OFF_MASK); const unsigned* M2 = WSP(unsigned, 160 * MiB); unsigned rows_ = 0, bits_ = 0, bad1_ = 0, bad2_ = 0;
            for (int m = gw_; m < MTOK; m += gridDim.x * NWAVES) { const unsigned d = M1[(size_t)m * 64 + lane_] ^ M2[(size_t)m * 64 + lane_]; const int nb = wave_allsum_i(__popc(d)); if (nb) { rows_ += 1; bits_ += nb; }
                const int t_ = m & (SEQ - 1), ex_ = t_ + 1 < 256 ? t_ + 1 : 256; if (wave_allsum_i(__popc(M1[(size_t)m * 64 + lane_])) != ex_) bad1_ += 1; if (wave_allsum_i(__popc(M2[(size_t)m * 64 + lane_])) != ex_) bad2_ += 1; }
            if (lane_ == 0) { atomicAdd(WSP(unsigned, OFF_CTL) + 1000, rows_); atomicAdd(WSP(unsigned, OFF_CTL) + 1001, bits_); atomicAdd(WSP(unsigned, OFF_CTL) + 1002, bad1_); atomicAdd(WSP(unsigned, OFF_CTL) + 1003, bad2_); }
        }
#endif
        if (FAST_ATTN) {
            static_assert(attn_body::ATTN_LDS_BYTES <= RING_BYTES, "attention LDS");
            const attn_body::AttnTensors AT{(const attn_body::bf16*)WSP(bf16_t, OFF_QO), (const attn_body::bf16*)WSP(bf16_t, OFF_K), (const attn_body::bf16*)WSP(bf16_t, OFF_V), (attn_body::bf16*)WSP(bf16_t, OFF_QO), WSP(unsigned, OFF_MASK)};
            const attn_body::StaticOrder S((int)gridDim.x, (int)blockIdx.x);
            attn_body::attn_phase<attn_body::StaticOrder>((char*)lds, AT, S);
        } else p3_naive(A, lds);
    }
    if constexpr (FUSED && REP_123 && IN(3)) xcd_barrier(bar);
    if constexpr (FUSED && REP_123 && IN(3)) {
        Gemm g{WSP(bf16_t, OFF_H0), WSP(bf16_t, OFF_H0), 1 << 30, WSP(bf16_t, OFF_WIN), MTOK, 2304, DM};
        EpiInProj E{WSP(bf16_t, OFF_QO), WSP(bf16_t, OFF_K), WSP(bf16_t, OFF_V), WSP(bf16_t, OFF_QI), WSP(bf16_t, OFF_KI), WSP(float, OFF_WI), WSP(float, OFF_ROPE)};
        gemm_phase(lds, g, E);
    }
    if constexpr (FUSED && REP_123 && IN(3)) xcd_barrier(bar);
    if constexpr (FUSED && REP_123 && IN(3)) { if (FAST_TOPK) p2_fast(A, lds); else p2_naive(A, lds);
#if DBG_TOPK
        __syncthreads(); p2_naive(A, lds, 160 * MiB);
#endif
    }
    if constexpr (FUSED && REP_123 && IN(3)) xcd_barrier(bar);
    if constexpr (FUSED && REP_123 && IN(3)) {
#if DBG_TOPK
        {
            const int lane_ = threadIdx.x & 63, gw_ = blockIdx.x * NWAVES + (threadIdx.x >> 6);
            const unsigned* M1 = WSP(unsigned, OFF_MASK); const unsigned* M2 = WSP(unsigned, 160 * MiB); unsigned rows_ = 0, bits_ = 0, bad1_ = 0, bad2_ = 0;
            for (int m = gw_; m < MTOK; m += gridDim.x * NWAVES) { const unsigned d = M1[(size_t)m * 64 + lane_] ^ M2[(size_t)m * 64 + lane_]; const int nb = wave_allsum_i(__popc(d)); if (nb) { rows_ += 1; bits_ += nb; }
                const int t_ = m & (SEQ - 1), ex_ = t_ + 1 < 256 ? t_ + 1 : 256; if (wave_allsum_i(__popc(M1[(size_t)m * 64 + lane_])) != ex_) bad1_ += 1; if (wave_allsum_i(__popc(M2[(size_t)m * 64 + lane_])) != ex_) bad2_ += 1; }
            if (lane_ == 0) { atomicAdd(WSP(unsigned, OFF_CTL) + 1000, rows_); atomicAdd(WSP(unsigned, OFF_CTL) + 1001, bits_); atomicAdd(WSP(unsigned, OFF_CTL) + 1002, bad1_); atomicAdd(WSP(unsigned, OFF_CTL) + 1003, bad2_); }
        }
#endif
        if (FAST_ATTN) {
            static_assert(attn_body::ATTN_LDS_BYTES <= RING_BYTES, "attention LDS");
            const attn_body::AttnTensors AT{(const attn_body::bf16*)WSP(bf16_t, OFF_QO), (const attn_body::bf16*)WSP(bf16_t, OFF_K), (const attn_body::bf16*)WSP(bf16_t, OFF_V), (attn_body::bf16*)WSP(bf16_t, OFF_QO), WSP(unsigned, OFF_MASK)};
            const attn_body::StaticOrder S((int)gridDim.x, (int)blockIdx.x);
            attn_body::attn_phase<attn_body::StaticOrder>((char*)lds, AT, S);
        } else p3_naive(A, lds);
    }
    SEAM(3);
    if constexpr (IN(4)) {
        Gemm g{WSP(bf16_t, OFF_QO), WSP(bf16_t, OFF_QO), 1 << 30, WSP(bf16_t, OFF_WO0), MTOK, DM, DM};
        EpiResid E{A.in[IN_X], A.out, WSP(bf16_t, OFF_XB), WSP(float, OFF_SSQ0)};
        gemm_phase(lds, g, E);
    }
    SEAM(4);
    if constexpr (IN(5)) {
        Gemm g{WSP(bf16_t, OFF_XB), WSP(bf16_t, OFF_XB), 1 << 30, WSP(bf16_t, OFF_WUP0), MTOK, FF, DM};
        EpiUp E{WSP(bf16_t, OFF_U), WSP(float, OFF_SSQ0)};
        gemm_phase(lds, g, E);
    }
    if constexpr (FUSED && IN(5) && ((REP_MASK >> 5) & 1u)) xcd_barrier(bar);
    if constexpr (FUSED && IN(5) && ((REP_MASK >> 5) & 1u)) {
        Gemm g{WSP(bf16_t, OFF_XB), WSP(bf16_t, OFF_XB), 1 << 30, WSP(bf16_t, OFF_WUP0), MTOK, FF, DM};
        EpiUp E{WSP(bf16_t, OFF_U), WSP(float, OFF_SSQ0)};
        gemm_phase(lds, g, E);
    }
    SEAM(5);
    if constexpr (IN(6)) {
        Gemm g{WSP(bf16_t, OFF_U), WSP(bf16_t, OFF_U), 1 << 30, WSP(bf16_t, OFF_WDN0), MTOK, DM, FF};
        EpiResid E{A.out, A.out, nullptr, nullptr};
        gemm_phase(lds, g, E);
    }
    SEAM(6);
    if constexpr (IN(7)) p7_prep(A);
    if constexpr (FUSED && IN(7) && ((REP_MASK >> 7) & 1u)) xcd_barrier(bar);
    if constexpr (FUSED && IN(7) && ((REP_MASK >> 7) & 1u)) p7_prep(A);
    SEAM(7);
    if constexpr (IN(8)) {
        Gemm g{WSP(bf16_t, OFF_XSR), WSP(bf16_t, OFF_XSK), 4, WSP(bf16_t, OFF_WRK), MTOK, 2816, DM, WSP(bf16_t, OFF_H1), 8};
        EpiRKP E{EpiStore{WSP(bf16_t, OFF_R), DM, 4, WSP(bf16_t, OFF_KR), DM}, EpiStore{nullptr, 0, 0, WSP(bf16_t, OFF_P), P_LD}};
        gemm_phase(lds, g, E);
    }
    SEAM(8);
    if constexpr (IN(9)) {
        Gemm g{WSP(bf16_t, OFF_XSV), WSP(bf16_t, OFF_XSV), 1 << 30, WSP(bf16_t, OFF_WVL), MTOK, DM, DM};
        EpiStore E{WSP(bf16_t, OFF_VV), DM, 1 << 30, nullptr, 0};
        gemm_phase(lds, g, E);
        p10_loramid(A);
    }
    SEAM(10);
    if constexpr (IN(11)) {
        Gemm g{WSP(bf16_t, OFF_AW), WSP(bf16_t, OFF_AA), 4, WSP(bf16_t, OFF_W2T), MTOK, 2048, 128};
        EpiLoraUp E{WSP(bf16_t, OFF_E), WSP(bf16_t, OFF_A), A.in[IN_W0], A.in[IN_A0]};
        gemm_phase(lds, g, E);
    }
    if constexpr (FUSED && IN(11) && ((REP_MASK >> 11) & 1u)) xcd_barrier(bar);
    if constexpr (FUSED && IN(11) && ((REP_MASK >> 11) & 1u)) {
        Gemm g{WSP(bf16_t, OFF_AW), WSP(bf16_t, OFF_AA), 4, WSP(bf16_t, OFF_W2T), MTOK, 2048, 128};
        EpiLoraUp E{WSP(bf16_t, OFF_E), WSP(bf16_t, OFF_A), A.in[IN_W0], A.in[IN_A0]};
        gemm_phase(lds, g, E);
    }
    SEAM(11);
    if constexpr (IN(12)) { if (CHUNK_SCAN) p12_chunk_prep(A, lds); else if (FAST_SCAN) p12_fast(A, lds); else p12_naive(A, lds); }
    if constexpr (FUSED && IN(12) && ((REP_MASK >> 12) & 1u)) xcd_barrier(bar);
    if constexpr (FUSED && IN(12) && ((REP_MASK >> 12) & 1u)) { if (FAST_SCAN) p12_fast(A, lds); else p12_naive(A, lds); }
    SEAM(12);
    if constexpr (IN(13)) { if (CHUNK_SCAN) p13_chunk_scan(A, lds); else if (!FAST_SCAN) p12b_stats(A); }
    SEAM(13);
    if constexpr (IN(14)) {
        Gemm g{WSP(bf16_t, OFF_AG), WSP(bf16_t, OFF_AG), 1 << 30, WSP(bf16_t, OFF_G2T), MTOK, DM, 256};
        EpiGatePost E{WSP(bf16_t, OFF_AO), WSP(bf16_t, CHUNK_SCAN ? OFF_R : OFF_Y), WSP(bf16_t, OFF_VV), WSP(float, OFF_STATS), WSP(float, OFF_BONUS), A.in[IN_LNW], A.in[IN_LNB]};
        gemm_phase(lds, g, E);
    }
    if constexpr (FUSED && IN(14) && ((REP_MASK >> 14) & 1u)) xcd_barrier(bar);
    if constexpr (FUSED && IN(14) && ((REP_MASK >> 14) & 1u)) {
        Gemm g{WSP(bf16_t, OFF_AG), WSP(bf16_t, OFF_AG), 1 << 30, WSP(bf16_t, OFF_G2T), MTOK, DM, 256};
        EpiGatePost E{WSP(bf16_t, OFF_AO), WSP(bf16_t, CHUNK_SCAN ? OFF_R : OFF_Y), WSP(bf16_t, OFF_VV), WSP(float, OFF_STATS), WSP(float, OFF_BONUS), A.in[IN_LNW], A.in[IN_LNB]};
        gemm_phase(lds, g, E);
    }
    SEAM(14);
    if constexpr (IN(15)) {
        Gemm g{WSP(bf16_t, OFF_AO), WSP(bf16_t, OFF_AO), 1 << 30, WSP(bf16_t, OFF_WO1), MTOK, DM, DM};
        EpiResid E{A.out, A.out, WSP(bf16_t, OFF_XB), WSP(float, OFF_SSQ1)};
        gemm_phase(lds, g, E);
    }
    SEAM(15);
    if constexpr (IN(16)) {
        Gemm g{WSP(bf16_t, OFF_XB), WSP(bf16_t, OFF_XB), 1 << 30, WSP(bf16_t, OFF_WUP1), MTOK, FF, DM};
        EpiUp E{WSP(bf16_t, OFF_U), WSP(float, OFF_SSQ1)};
        gemm_phase(lds, g, E);
    }
    if constexpr (FUSED && IN(16) && ((REP_MASK >> 16) & 1u)) xcd_barrier(bar);
    if constexpr (FUSED && IN(16) && ((REP_MASK >> 16) & 1u)) {
        Gemm g{WSP(bf16_t, OFF_XB), WSP(bf16_t, OFF_XB), 1 << 30, WSP(bf16_t, OFF_WUP1), MTOK, FF, DM};
        EpiUp E{WSP(bf16_t, OFF_U), WSP(float, OFF_SSQ1)};
        gemm_phase(lds, g, E);
    }
    SEAM(16);
    if constexpr (IN(17)) {
        Gemm g{WSP(bf16_t, OFF_U), WSP(bf16_t, OFF_U), 1 << 30, WSP(bf16_t, OFF_WDN1), MTOK, DM, FF};
        EpiResid E{A.out, A.out, nullptr, nullptr};
        gemm_phase(lds, g, E);
    }
    SEAM(17);
    if constexpr (IN(18)) {
        p18_final(A);
#if DBG_TS
        {   __syncthreads(); const unsigned long long* ts_ = (const unsigned long long*)(A.ws + OFF_CTL + 16384);
            const float usA_ = (float)(ts_[DBG_TS_A + 1] - ts_[DBG_TS_A]) * 0.01f;
            if (blockIdx.x == 1 && threadIdx.x == 0) A.out[12345] = usA_ * 0.2f; }
#endif
#if DBG_TOPK
        {   __syncthreads(); const float sc_ = 1.f + (float)WSP(unsigned, OFF_CTL)[1000 + DBG_WHICH] * DBG_UNIT;
            const int gw_ = blockIdx.x * NWAVES + (threadIdx.x >> 6), lane_ = threadIdx.x & 63;
            for (int m = gw_; m < MTOK; m += gridDim.x * NWAVES) for (int j = 0; j < 16; ++j) A.out[(size_t)m * DM + lane_ + 64 * j] *= sc_; }
#endif
    }
#undef IN
#undef SEAM
}

template <int P> static void launch_all(int grid, hipStream_t stream, const Args& a) {
    if constexpr (P < N_PHASES) {
        static bool attr_done = false;
        if (!attr_done) { (void)hipFuncSetAttribute((const void*)mk_fwd<P, P + 1>, hipFuncAttributeMaxDynamicSharedMemorySize, LDS_BYTES); attr_done = true; }
        hipLaunchKernelGGL((mk_fwd<P, P + 1>), dim3(grid), dim3(NTHR), LDS_BYTES, stream, a);
        launch_all<P + 1>(grid, stream, a);
    }
}
extern "C" void kernel_launch(void* const* d_in, const int* in_sizes, int n_in, void* d_out, int out_size, void* d_ws, size_t ws_size, hipStream_t stream) {
    static int grid = 0;
    if (grid == 0) {
        if (n_in != N_IN || out_size != MTOK * DM || ws_size < WS_END) { fprintf(stderr, "kernel_launch: unexpected shapes (n_in %d out %d ws %zu)\n", n_in, out_size, ws_size); grid = -1; return; }
        int dev = 0, cus = 0;
        (void)hipGetDevice(&dev); (void)hipDeviceGetAttribute(&cus, hipDeviceAttributeMultiprocessorCount, dev);
        grid = cus > 0 ? cus : 256;
    }
    if (grid < 0) return;
    (void)hipMemsetAsync((char*)d_ws + OFF_CTL, 0, CTL_BYTES, stream);
    Args a{};
    for (int i = 0; i < N_IN; ++i) a.in[i] = (const float*)d_in[i];
    a.out = (float*)d_out; a.ws = (unsigned char*)d_ws;
#if ONE_LAUNCH
    static bool attr_done = false;
    if (!attr_done) {
        (void)hipFuncSetAttribute((const void*)mk_fwd<0, N_PHASES>, hipFuncAttributeMaxDynamicSharedMemorySize, LDS_BYTES);
        int per_cu = 0;
        if (hipOccupancyMaxActiveBlocksPerMultiprocessor(&per_cu, (const void*)mk_fwd<0, N_PHASES>, NTHR, LDS_BYTES) != hipSuccess || per_cu < 1)
            fprintf(stderr, "kernel_launch: occupancy query reports %d blocks per CU\n", per_cu);
        (void)hipGetLastError();
        attr_done = true;
    }
    void* kargs[] = {(void*)&a};
    hipError_t e = hipLaunchCooperativeKernel((const void*)mk_fwd<0, N_PHASES>, dim3(grid), dim3(NTHR), kargs, LDS_BYTES, stream);
    if (e != hipSuccess) fprintf(stderr, "kernel_launch: cooperative launch failed: %s (grid %d)\n", hipGetErrorString(e), grid);
#else
    launch_all<0>(grid, stream, a);
#endif
}
```
